# Optimizing an MI355X kernel written in HIP

```python
import jax, jax.numpy as jnp
from jax import lax
import numpy as np

D_MODEL = 1024
BATCH = 4
SEQ = 8192
DEPTH = 1

PLE_DIM = 256
ATT_GROUPS = ((128, 1), (512, 4), (2048, 16))
N_ATT_GROUPS = 3
ATT_SLOTS = 4
ATT_HEADS = N_ATT_GROUPS * ATT_SLOTS
ATT_HEAD_DIM = 128
ATT_WIDTH = ATT_HEADS * ATT_HEAD_DIM
ATT_OUT_WIDTH = ATT_SLOTS * ATT_HEAD_DIM
ROPE_THETA = 500000.0
ROPE_DIM = ATT_HEAD_DIM // 4
MLSTM_HEADS = 4
MLSTM_HEAD_DIM = 128
MLSTM_WIDTH = MLSTM_HEADS * MLSTM_HEAD_DIM
MLSTM_CHUNK = 128
CONV_WIDTH = 4
D_FF = 2816
NORM_EPS = 1e-6
IN_WIDTHS = (ATT_WIDTH, ATT_WIDTH, ATT_WIDTH,
             MLSTM_WIDTH, MLSTM_WIDTH, MLSTM_WIDTH, MLSTM_WIDTH,
             MLSTM_HEADS, MLSTM_HEADS,
             D_MODEL, D_MODEL)
D_IN = sum(IN_WIDTHS)

kernel_name = 'hybrid_dilated_attn_mlstm_macaron_block'


def rms_norm(x, g):
    xf = x.astype(jnp.float32)
    y = xf * lax.rsqrt(jnp.mean(xf * xf, axis=-1, keepdims=True) + NORM_EPS)
    return (y * g.astype(jnp.float32)).astype(x.dtype)


def swiglu(x, w_in, w_out):
    a, b = jnp.split(x @ w_in, 2, axis=-1)
    return (jax.nn.silu(a) * b) @ w_out


def split_columns(z):
    offs, acc = [], 0
    for w in IN_WIDTHS[:-1]:
        acc += w
        offs.append(acc)
    return jnp.split(z, offs, axis=-1)


def rope_partial(x, pos):
    half = ROPE_DIM // 2
    inv_freq = 1.0 / (ROPE_THETA ** (jnp.arange(half, dtype=jnp.float32) / half))
    ang = pos[:, None] * inv_freq[None, :]
    cos = jnp.cos(ang)[:, None, None, :]
    sin = jnp.sin(ang)[:, None, None, :]
    x1, x2, rest = x[..., :half], x[..., half:ROPE_DIM], x[..., ROPE_DIM:]
    return jnp.concatenate([x1 * cos - x2 * sin, x2 * cos + x1 * sin, rest], axis=-1)


def dilated_window_attention(q, k, v, window, dilation):
    B, S, H, E = q.shape
    wd = window // dilation
    n = S // dilation
    nb = -(-n // wd)
    npad = nb * wd

    def to_sub(t):
        t = t.reshape(B, n, dilation, H, E).transpose(0, 2, 3, 1, 4)
        return jnp.pad(t, ((0, 0), (0, 0), (0, 0), (0, npad - n), (0, 0)))

    def kv_blocks(t):
        t = jnp.pad(to_sub(t), ((0, 0), (0, 0), (0, 0), (wd, 0), (0, 0)))
        t = t.reshape(B, dilation, H, nb + 1, wd, E)
        return jnp.concatenate([t[:, :, :, :-1], t[:, :, :, 1:]], axis=4)

    qb = to_sub(q).reshape(B, dilation, H, nb, wd, E)
    kb, vb = kv_blocks(k), kv_blocks(v)
    s = jnp.einsum('brhnqe,brhnke->brhnqk', qb, kb) * (E ** -0.5)
    qi = jnp.arange(wd)[:, None]
    kj = jnp.arange(2 * wd)[None, :]
    blk = jnp.arange(nb)[:, None, None]
    mask = (kj >= qi) & (kj <= qi + wd) & ((blk > 0) | (kj >= wd))
    s = jnp.where(mask, s, -jnp.inf)
    m = jnp.max(s, axis=-1, keepdims=True)
    e = jnp.exp(s - m)
    den = jnp.sum(e, axis=-1)
    o = jnp.einsum('brhnqk,brhnke->brhnqe', e, vb) / den[..., None]
    lse = m[..., 0] + jnp.log(den)

    def from_sub(t):
        t = t.reshape(B, dilation, H, npad, *t.shape[5:])[:, :, :, :n]
        t = jnp.moveaxis(t, 3, 1)
        return t.reshape(B, S, H, *t.shape[4:])

    return from_sub(o), from_sub(lse)


def dilated_attention_mixer(q, k, v, q_gain, k_gain):
    B, S, _ = q.shape
    shape = (B, S, N_ATT_GROUPS, ATT_SLOTS, ATT_HEAD_DIM)
    pos = jnp.arange(S, dtype=jnp.float32)
    q = rope_partial(rms_norm(q.reshape(shape).astype(jnp.float32), q_gain), pos)
    k = rope_partial(rms_norm(k.reshape(shape).astype(jnp.float32), k_gain), pos)
    v = v.reshape(shape).astype(jnp.float32)
    outs, lses = [], []
    for g, (window, dilation) in enumerate(ATT_GROUPS):
        o, l = dilated_window_attention(q[:, :, g], k[:, :, g], v[:, :, g], window, dilation)
        outs.append(o)
        lses.append(l)
    alpha = jax.nn.softmax(jnp.stack(lses, axis=0), axis=0)
    out = jnp.einsum('gbsh,gbshe->bshe', alpha, jnp.stack(outs, axis=0))
    return out.reshape(B, S, ATT_OUT_WIDTH)


def causal_dwconv(x, w, b):
    K = w.shape[0]
    S = x.shape[1]
    xp = jnp.pad(x, ((0, 0), (K - 1, 0), (0, 0)))
    out = b
    for j in range(K):
        out = out + xp[:, j:j + S] * w[j]
    return out


def mlstm_chunkwise(q, k, v, logi, logf):
    B, S, H, E = q.shape
    L = MLSTM_CHUNK
    nc = S // L

    def chunks(t):
        return t.reshape(B, nc, L, H, E).transpose(1, 0, 3, 2, 4)

    def gchunks(t):
        return t.reshape(B, nc, L, H).transpose(1, 0, 3, 2)

    causal = jnp.tril(jnp.ones((L, L), dtype=bool))

    def step(carry, inp):
        C, n, m = carry
        qc, kc, vc, li, lf = inp
        b = jnp.cumsum(lf, axis=-1)
        Dm = b[..., :, None] - b[..., None, :] + li[..., None, :]
        Dm = jnp.where(causal, Dm, -jnp.inf)
        inter = b + m[..., None]
        m_t = jnp.maximum(inter, jnp.max(Dm, axis=-1))
        W = jnp.exp(Dm - m_t[..., None])
        a = jnp.exp(inter - m_t)
        qk = jnp.einsum('bhte,bhse->bhts', qc, kc) * W
        num = a[..., None] * jnp.einsum('bhte,bhef->bhtf', qc, C) + jnp.einsum('bhts,bhsf->bhtf', qk, vc)
        den = a * jnp.einsum('bhte,bhe->bht', qc, n) + jnp.sum(qk, axis=-1)
        h = num / jnp.maximum(jnp.abs(den), jnp.exp(-m_t))[..., None]
        bL = b[..., -1]
        g = bL[..., None] - b + li
        m_new = jnp.maximum(bL + m, jnp.max(g, axis=-1))
        wk = jnp.exp(g - m_new[..., None])
        decay = jnp.exp(bL + m - m_new)
        C_new = decay[..., None, None] * C + jnp.einsum('bhs,bhse,bhsf->bhef', wk, kc, vc)
        n_new = decay[..., None] * n + jnp.einsum('bhs,bhse->bhe', wk, kc)
        return (C_new, n_new, m_new), h

    init = (jnp.zeros((B, H, E, E), jnp.float32),
            jnp.zeros((B, H, E), jnp.float32),
            jnp.zeros((B, H), jnp.float32))
    _, hs = lax.scan(step, init, (chunks(q), chunks(k), chunks(v), gchunks(logi), gchunks(logf)))
    return hs.transpose(1, 0, 3, 2, 4).reshape(B, S, H, E)


def mlstm_mixer(q, k, v, o_pre, i_pre, f_pre, conv_w, conv_b, i_bias, f_bias):
    B, S, _ = q.shape
    qk = jax.nn.silu(causal_dwconv(jnp.concatenate([q, k], axis=-1), conv_w, conv_b))
    q, k = jnp.split(qk, 2, axis=-1)
    shape = (B, S, MLSTM_HEADS, MLSTM_HEAD_DIM)
    qh = q.reshape(shape).astype(jnp.float32)
    kh = k.reshape(shape).astype(jnp.float32) * (MLSTM_HEAD_DIM ** -0.5)
    vh = v.reshape(shape).astype(jnp.float32)
    logi = (i_pre + i_bias).astype(jnp.float32)
    logf = jax.nn.log_sigmoid((f_pre + f_bias).astype(jnp.float32))
    h = mlstm_chunkwise(qh, kh, vh, logi, logf).reshape(B, S, MLSTM_WIDTH)
    return (jax.nn.sigmoid(o_pre.astype(jnp.float32)) * h).astype(q.dtype)


def hybrid_layer(x, p_i, ffn1_norm, ffn1_w_in, ffn1_w_out, mix_norm, w_in, q_gain, k_gain,
                 conv_w, conv_b, i_bias, f_bias, w_up_att, w_up_mlstm, w_out,
                 ffn2_norm, ffn2_w_in, ffn2_w_out, ple_norm, w_ple_gate, w_ple_proj):
    h = x + 0.5 * swiglu(rms_norm(x, ffn1_norm), ffn1_w_in, ffn1_w_out)
    z = rms_norm(h, mix_norm) @ w_in
    aq, ak, av, mq, mk, mv, mo, mi, mf, ga, gb = split_columns(z)
    y_att = dilated_attention_mixer(aq, ak, av, q_gain, k_gain).astype(x.dtype) @ w_up_att
    y_ml = mlstm_mixer(mq, mk, mv, mo, mi, mf, conv_w, conv_b, i_bias, f_bias) @ w_up_mlstm
    merged = jax.nn.sigmoid(ga) * y_att + jax.nn.sigmoid(gb) * y_ml
    h = h + merged @ w_out
    h = h + 0.5 * swiglu(rms_norm(h, ffn2_norm), ffn2_w_in, ffn2_w_out)
    h = h + (p_i @ w_ple_proj) * jax.nn.sigmoid(rms_norm(h, ple_norm) @ w_ple_gate)
    return h


def setup_inputs(seed: int = 0) -> dict:
    key = jax.random.key(seed)
    ks = jax.random.split(key, 24)
    f32 = jnp.float32

    def nrm(k, shape, scale):
        return jax.random.normal(k, shape, f32) * scale

    def gain(k, shape):
        return 1.0 + 0.02 * jax.random.normal(k, shape, f32)

    return {
        'x': nrm(ks[0], (BATCH, SEQ, D_MODEL), 1.0),
        'p': nrm(ks[1], (DEPTH, BATCH, SEQ, PLE_DIM), 1.0),
        'ffn1_norm': gain(ks[2], (DEPTH, D_MODEL)),
        'ffn1_w_in': nrm(ks[3], (DEPTH, D_MODEL, 2 * D_FF), D_MODEL ** -0.5),
        'ffn1_w_out': nrm(ks[4], (DEPTH, D_FF, D_MODEL), D_FF ** -0.5),
        'mix_norm': gain(ks[5], (DEPTH, D_MODEL)),
        'w_in': nrm(ks[6], (DEPTH, D_MODEL, D_IN), D_MODEL ** -0.5),
        'q_gain': gain(ks[7], (DEPTH, ATT_HEAD_DIM)),
        'k_gain': gain(ks[8], (DEPTH, ATT_HEAD_DIM)),
        'conv_w': nrm(ks[9], (DEPTH, CONV_WIDTH, 2 * MLSTM_WIDTH), CONV_WIDTH ** -0.5),
        'conv_b': nrm(ks[10], (DEPTH, 2 * MLSTM_WIDTH), 0.02),
        'i_bias': nrm(ks[11], (DEPTH, MLSTM_HEADS), 0.1),
        'f_bias': jnp.linspace(3.0, 6.0, MLSTM_HEADS, dtype=f32)[None, :] + nrm(ks[12], (DEPTH, MLSTM_HEADS), 0.1),
        'w_up_att': nrm(ks[13], (DEPTH, ATT_OUT_WIDTH, D_MODEL), ATT_OUT_WIDTH ** -0.5),
        'w_up_mlstm': nrm(ks[14], (DEPTH, MLSTM_WIDTH, D_MODEL), MLSTM_WIDTH ** -0.5),
        'w_out': nrm(ks[15], (DEPTH, D_MODEL, D_MODEL), D_MODEL ** -0.5),
        'ffn2_norm': gain(ks[16], (DEPTH, D_MODEL)),
        'ffn2_w_in': nrm(ks[17], (DEPTH, D_MODEL, 2 * D_FF), D_MODEL ** -0.5),
        'ffn2_w_out': nrm(ks[18], (DEPTH, D_FF, D_MODEL), D_FF ** -0.5),
        'ple_norm': gain(ks[19], (DEPTH, D_MODEL)),
        'w_ple_gate': nrm(ks[20], (DEPTH, D_MODEL, D_MODEL), D_MODEL ** -0.5),
        'w_ple_proj': nrm(ks[21], (DEPTH, PLE_DIM, D_MODEL), PLE_DIM ** -0.5),
    }


def reference(x, p, ffn1_norm, ffn1_w_in, ffn1_w_out, mix_norm, w_in, q_gain, k_gain,
              conv_w, conv_b, i_bias, f_bias, w_up_att, w_up_mlstm, w_out,
              ffn2_norm, ffn2_w_in, ffn2_w_out, ple_norm, w_ple_gate, w_ple_proj):
    h = x
    for i in range(DEPTH):
        h = hybrid_layer(h, p[i], ffn1_norm[i], ffn1_w_in[i], ffn1_w_out[i], mix_norm[i], w_in[i],
                         q_gain[i], k_gain[i], conv_w[i], conv_b[i], i_bias[i], f_bias[i],
                         w_up_att[i], w_up_mlstm[i], w_out[i], ffn2_norm[i], ffn2_w_in[i],
                         ffn2_w_out[i], ple_norm[i], w_ple_gate[i], w_ple_proj[i])
    return h
```

```cpp
#include <hip/hip_runtime.h>
#include <cstdio>
#include <cstdint>

#ifndef PROBE_MASK
#define PROBE_MASK 0u
#endif
#define REP(k) for (int rep_ = 0; rep_ < 1 + (int)((PROBE_MASK >> (k)) & 1u); ++rep_)
#ifndef MK_PER_PHASE
#define MK_PER_PHASE 0
#endif

namespace pg8 {
#define PG8_LAS __attribute__((address_space(3)))
typedef unsigned short bf16_t;
typedef short bf16x8 __attribute__((ext_vector_type(8)));
typedef float f32x4 __attribute__((ext_vector_type(4)));
typedef unsigned u32x4 __attribute__((ext_vector_type(4)));
constexpr int BM = 256, BK = 64, HALF = 128, HTB = HALF * BK * 2, STAGE_BYTES = 8 * HTB, NXCD = 8, WGM = 8;

__host__ __device__ __forceinline__ int lds_byte(int r, int c) { const int st = (r >> 4) * 2 + (c >> 5), rr = r & 15, cc = c & 31, ob = rr * 64 + cc * 2; return st * 1024 + (ob ^ (((ob >> 9) & 1) << 5)); }
__host__ __device__ __forceinline__ void stage_rc(int b, int& R, int& C) { const int st = b / 1024, sb = b % 1024, swz = sb ^ (((sb >> 9) & 1) << 5); R = (st >> 1) * 16 + swz / 64; C = (st & 1) * 32 + (swz % 64) / 2; }
__host__ __device__ __forceinline__ int perm32(int rho) { const int n = rho >> 4, i = rho & 15; return 8 * (i >> 2) + 4 * n + (i & 3); }

struct Unit { int pm, pn, w; };
struct Gemm { const bf16_t* A; const bf16_t* Bt; int M, N, K; const float* scw; const float* sch; const bf16_t* A2; const bf16_t* Bt2; int K2; };
typedef int i32x4 __attribute__((ext_vector_type(4)));

struct StaticOrder {
    static constexpr bool PAIR = false;
    int nM, nN, nwg, G, c;
    __host__ __device__ void init(int M, int N, int G_, int c_) { nM = M / BM; nN = N / BM; nwg = nM * nN; G = G_; c = c_; }
    __host__ __device__ bool next(int i, Unit& u) const {
        const long L = (long)i * G + c; if (L >= nwg) return false;
        int wgid = (int)L; { const int q = nwg / NXCD, r = nwg % NXCD, xcd = wgid % NXCD, off = wgid / NXCD; wgid = (xcd < r ? xcd * (q + 1) : r * (q + 1) + (xcd - r) * q) + off; }
        const int nig = WGM * nN, gid = wgid / nig, fm = gid * WGM, gsz = (nM - fm) < WGM ? (nM - fm) : WGM;
        u.pm = fm + ((wgid % nig) % gsz); u.pn = (wgid % nig) / gsz; u.w = 0; return true;
    }
};
struct PairOrder {
    static constexpr bool PAIR = true;
    StaticOrder base;
    __host__ __device__ void init(int M, int N, int G_, int c_) { base.init(M, N, G_, c_); }
    __host__ __device__ bool next(int i, Unit& u) const { const bool ok = base.next(i >> 1, u); u.w = i & 1; return ok; }
};

__device__ __forceinline__ unsigned cvt_pk_bf16(float lo, float hi) { unsigned r; asm volatile("v_cvt_pk_bf16_f32 %0, %1, %2" : "=v"(r) : "v"(lo), "v"(hi)); return r; }
__device__ __forceinline__ float bf_lo(unsigned u) { return __uint_as_float(u << 16); }
__device__ __forceinline__ float bf_hi(unsigned u) { return __uint_as_float(u & 0xffff0000u); }

constexpr float RMS_EPS = 1e-6f;
constexpr int RTAB_OFF = 152576;
__device__ __forceinline__ float sigmoidf_(float v) { return __builtin_amdgcn_rcpf(1.0f + __builtin_amdgcn_exp2f(-1.4426950408889634f * v)); }
__device__ __forceinline__ void swap16_(float& a, float& b) { asm volatile("s_nop 1\n\tv_permlane16_swap_b32 %0, %1" : "+v"(a), "+v"(b)); }
__device__ __forceinline__ void swap32_(float& a, float& b) { asm volatile("s_nop 1\n\tv_permlane32_swap_b32 %0, %1" : "+v"(a), "+v"(b)); }
__device__ __forceinline__ float xsum_16_32(float x) { float a = x, b = x; swap16_(a, b); x = a + b; a = x; b = x; swap32_(a, b); return a + b; }
__device__ __forceinline__ float xmax_16_32(float x) { float a = x, b = x; swap16_(a, b); x = fmaxf(a, b); a = x; b = x; swap32_(a, b); return fmaxf(a, b); }
__device__ __forceinline__ float xor32_(float x, bool hi) { float a = x, b = x; swap32_(a, b); return hi ? a : b; }
struct EpiSwiglu {
    static constexpr bool PERM = true, AFTER_DRAIN = false, NEED_R = true;
    bf16_t* O; int ldc; const float* RS;
    __device__ __forceinline__ void operator()(f32x4 (&acc)[2][2][4][2], const Unit& u, int wr, int wc, int fr, int fq, const PG8_LAS float* rtab) const {
        const int row0 = u.pm * BM + wr * 64 + fr, col0 = u.pn * HALF + wc * 32 + 8 * fq;
#pragma unroll
        for (int ai = 0; ai < 2; ++ai)
#pragma unroll
            for (int m = 0; m < 4; ++m) { const int row = row0 + ai * HALF + m * 16; const float r = rtab[ai * HALF + wr * 64 + m * 16 + fr];
                const float rl = r * -1.4426950408889634f, r2 = r * r; f32x4 hv[2];
#pragma unroll
                for (int n = 0; n < 2; ++n) { const f32x4 a = acc[ai][0][m][n], b = acc[ai][1][m][n]; const f32x4 t = a * rl; f32x4 e;
                    e[0] = __builtin_amdgcn_exp2f(t[0]); e[1] = __builtin_amdgcn_exp2f(t[1]); e[2] = __builtin_amdgcn_exp2f(t[2]); e[3] = __builtin_amdgcn_exp2f(t[3]);
                    const f32x4 d = e + 1.0f; f32x4 q;
                    q[0] = __builtin_amdgcn_rcpf(d[0]); q[1] = __builtin_amdgcn_rcpf(d[1]); q[2] = __builtin_amdgcn_rcpf(d[2]); q[3] = __builtin_amdgcn_rcpf(d[3]);
                    hv[n] = (a * b) * (q * r2); }
                u32x4 w; w.x = cvt_pk_bf16(hv[0][0], hv[0][1]); w.y = cvt_pk_bf16(hv[0][2], hv[0][3]); w.z = cvt_pk_bf16(hv[1][0], hv[1][1]); w.w = cvt_pk_bf16(hv[1][2], hv[1][3]);
                *(u32x4*)(O + (size_t)row * ldc + col0) = w; }
    }
};
template <bool BASE_F32> struct EpiResid {
    static constexpr bool PERM = true, AFTER_DRAIN = false, NEED_R = false;
    const float* basef; const bf16_t* baseh; bf16_t* HBo; float* RSo; float alpha;
    __device__ __forceinline__ void operator()(f32x4 (&acc)[2][2][4][2], const Unit& u, int wr, int wc, int fr, int fq, const PG8_LAS float*) const {
        const int row0 = u.pm * BM + wr * 64 + fr, col0 = u.pn * BM + wc * 32 + 8 * fq;
#pragma unroll
        for (int ai = 0; ai < 2; ++ai) {
            f32x4 bv[4][2][2];
#pragma unroll
            for (int m = 0; m < 4; ++m)
#pragma unroll
                for (int bj = 0; bj < 2; ++bj) { const size_t off = (size_t)(row0 + ai * HALF + m * 16) * 1024 + col0 + bj * HALF;
                    if constexpr (BASE_F32) { bv[m][bj][0] = *(const f32x4*)(basef + off); bv[m][bj][1] = *(const f32x4*)(basef + off + 4); }
                    else { const u32x4 p = *(const u32x4*)(baseh + off); bv[m][bj][0] = (f32x4){bf_lo(p.x), bf_hi(p.x), bf_lo(p.y), bf_hi(p.y)}; bv[m][bj][1] = (f32x4){bf_lo(p.z), bf_hi(p.z), bf_lo(p.w), bf_hi(p.w)}; } }
            asm volatile("" ::: "memory");
#pragma unroll
            for (int m = 0; m < 4; ++m) { const int row = row0 + ai * HALF + m * 16; float ssq = 0.f;
#pragma unroll
                for (int bj = 0; bj < 2; ++bj) { const size_t off = (size_t)row * 1024 + col0 + bj * HALF;
                    const f32x4 v0 = bv[m][bj][0] + acc[ai][bj][m][0] * alpha, v1 = bv[m][bj][1] + acc[ai][bj][m][1] * alpha;
                    u32x4 w; w.x = cvt_pk_bf16(v0[0], v0[1]); w.y = cvt_pk_bf16(v0[2], v0[3]); w.z = cvt_pk_bf16(v1[0], v1[1]); w.w = cvt_pk_bf16(v1[2], v1[3]);
                    *(u32x4*)(HBo + off) = w;
                    ssq += (v0[0] * v0[0] + v0[1] * v0[1]) + (v0[2] * v0[2] + v0[3] * v0[3]) + (v1[0] * v1[0] + v1[1] * v1[1]) + (v1[2] * v1[2] + v1[3] * v1[3]); }
                ssq = xsum_16_32(ssq);
                if (fq == 0) RSo[(size_t)row * 16 + u.pn * 4 + wc] = ssq; }
            asm volatile("" ::: "memory"); }
    }
};
struct EpiZ {
    static constexpr bool PERM = true, AFTER_DRAIN = false, NEED_R = true;
    bf16_t* O; int ldc; const float* RS; int gate_pn; float* GATES;
    __device__ __forceinline__ void operator()(f32x4 (&acc)[2][2][4][2], const Unit& u, int wr, int wc, int fr, int fq, const PG8_LAS float* rtab) const {
        const int row0 = u.pm * BM + wr * 64 + fr, col0 = u.pn * BM + wc * 32 + 8 * fq;
        const bool gate = (u.pn == gate_pn);
#pragma unroll
        for (int ai = 0; ai < 2; ++ai)
#pragma unroll
            for (int m = 0; m < 4; ++m) { const int row = row0 + ai * HALF + m * 16; const float r = rtab[ai * HALF + wr * 64 + m * 16 + fr];
                if (gate) { if (wc == 0 && fq == 0) { *(f32x4*)(GATES + (size_t)row * 8) = acc[ai][0][m][0] * r; *(f32x4*)(GATES + (size_t)row * 8 + 4) = acc[ai][0][m][1] * r; } }
                else {
#pragma unroll
                    for (int bj = 0; bj < 2; ++bj) { const f32x4 v0 = acc[ai][bj][m][0] * r, v1 = acc[ai][bj][m][1] * r;
                        u32x4 w; w.x = cvt_pk_bf16(v0[0], v0[1]); w.y = cvt_pk_bf16(v0[2], v0[3]); w.z = cvt_pk_bf16(v1[0], v1[1]); w.w = cvt_pk_bf16(v1[2], v1[3]);
                        *(u32x4*)(O + (size_t)row * ldc + col0 + bj * HALF) = w; } } }
    }
};
constexpr int QKP_OFF = 131072;
struct EpiQKV {
    static constexpr bool PERM = true, AFTER_DRAIN = false, NEED_R = true;
    bf16_t* O; const float* RS; const float* par_qg; const float* par_kg; const float* rope; PG8_LAS float* part;
    __device__ __forceinline__ void operator()(f32x4 (&acc)[2][2][4][2], const Unit& u, int wr, int wc, int fr_, int fq_, const PG8_LAS float* rtab) const {
        int lane_; asm volatile("v_mbcnt_lo_u32_b32 %0, -1, 0\n\tv_mbcnt_hi_u32_b32 %0, -1, %0" : "=v"(lane_));
        const int fr = lane_ & 15, fq = lane_ >> 4; (void)fr_; (void)fq_;
        const int row0 = u.pm * BM + wr * 64 + fr, col0 = u.pn * BM + wc * 32 + 8 * fq;
        const bool isq = u.pn < 2, isqk = u.pn < 4;
#pragma unroll
        for (int ai = 0; ai < 2; ++ai)
#pragma unroll
            for (int m = 0; m < 4; ++m) { const int rl = ai * HALF + wr * 64 + m * 16 + fr; const float r = rtab[rl];
#pragma unroll
                for (int bj = 0; bj < 2; ++bj) { acc[ai][bj][m][0] *= r; acc[ai][bj][m][1] *= r;
                    if (isqk) { const f32x4 a = acc[ai][bj][m][0], b = acc[ai][bj][m][1];
                        float ssq = (a[0] * a[0] + a[1] * a[1]) + (a[2] * a[2] + a[3] * a[3]) + (b[0] * b[0] + b[1] * b[1]) + (b[2] * b[2] + b[3] * b[3]);
                        ssq = xsum_16_32(ssq);
                        if (fq == 0) part[(rl * 2 + bj) * 4 + wc] = ssq; } } }
        if (isqk) {
            asm volatile("s_waitcnt lgkmcnt(0)" ::: "memory"); __builtin_amdgcn_s_barrier(); asm volatile("" ::: "memory");
            const float* gp = (isq ? par_qg : par_kg) + wc * 32 + 8 * fq; const f32x4 g0 = *(const f32x4*)gp, g1 = *(const f32x4*)(gp + 4);
            const float qs = isq ? (0.08838834764831845f * 1.4426950408889634f) : 1.0f;
#pragma unroll
            for (int am = 0; am < 4; ++am) {
                f32x4 tb[2][4];
                if (wc == 0) {
#pragma unroll
                    for (int mm = 0; mm < 2; ++mm) { const int ai = am >> 1, m = (am & 1) * 2 + mm; const int pos = (row0 + ai * HALF + m * 16) & (8192 - 1); const f32x4* rp = (const f32x4*)(rope + (size_t)pos * 32 + (fq & 1) * 16);
#pragma unroll
                        for (int q4 = 0; q4 < 4; ++q4) tb[mm][q4] = rp[q4]; }
                }
                asm volatile("" ::: "memory");
#pragma unroll
                for (int mm = 0; mm < 2; ++mm) { const int ai = am >> 1, m = (am & 1) * 2 + mm; const int rl = ai * HALF + wr * 64 + m * 16 + fr;
#pragma unroll
                    for (int bj = 0; bj < 2; ++bj) { const f32x4 p4 = *(const PG8_LAS f32x4*)(part + (rl * 2 + bj) * 4);
                        const float rn = __builtin_amdgcn_rsqf(((p4[0] + p4[1]) + (p4[2] + p4[3])) * (1.0f / 128.0f) + RMS_EPS) * qs;
                        f32x4 a = acc[ai][bj][m][0] * g0 * rn, b = acc[ai][bj][m][1] * g1 * rn;
                        if (wc == 0) {
                            f32x4 oa, ob;
#pragma unroll
                            for (int j = 0; j < 4; ++j) { oa[j] = xor32_(a[j], fq >= 2); ob[j] = xor32_(b[j], fq >= 2); }
                            const f32x4 t0 = tb[mm][0], t1 = tb[mm][1], t2 = tb[mm][2], t3 = tb[mm][3];
                            const float sg = (fq < 2) ? -1.0f : 1.0f;
                            a[0] = a[0] * t0[0] + sg * oa[0] * t0[1]; a[1] = a[1] * t0[2] + sg * oa[1] * t0[3]; a[2] = a[2] * t1[0] + sg * oa[2] * t1[1]; a[3] = a[3] * t1[2] + sg * oa[3] * t1[3];
                            b[0] = b[0] * t2[0] + sg * ob[0] * t2[1]; b[1] = b[1] * t2[2] + sg * ob[1] * t2[3]; b[2] = b[2] * t3[0] + sg * ob[2] * t3[1]; b[3] = b[3] * t3[2] + sg * ob[3] * t3[3]; }
                        unsigned char* op_ = (unsigned char*)O + (size_t)(row0 + ai * HALF + m * 16) * 1536;
                        { typedef unsigned u32x2 __attribute__((ext_vector_type(2))); int w0 = 0, w1 = 0;
                            w0 = __builtin_amdgcn_cvt_pk_fp8_f32(a[0], a[1], w0, false); w0 = __builtin_amdgcn_cvt_pk_fp8_f32(a[2], a[3], w0, true);
                            w1 = __builtin_amdgcn_cvt_pk_fp8_f32(b[0], b[1], w1, false); w1 = __builtin_amdgcn_cvt_pk_fp8_f32(b[2], b[3], w1, true);
                            *(u32x2*)(op_ + col0 + bj * HALF) = (u32x2){(unsigned)w0, (unsigned)w1}; } } }
                asm volatile("" ::: "memory"); }
            return;
        }
#pragma unroll
        for (int ai = 0; ai < 2; ++ai)
#pragma unroll
            for (int m = 0; m < 4; ++m) { const int row = row0 + ai * HALF + m * 16;
#pragma unroll
                for (int bj = 0; bj < 2; ++bj) { const f32x4 v0 = acc[ai][bj][m][0], v1 = acc[ai][bj][m][1];
                    typedef unsigned u32x2 __attribute__((ext_vector_type(2))); int w0 = 0, w1 = 0;
                    w0 = __builtin_amdgcn_cvt_pk_fp8_f32(v0[0], v0[1], w0, false); w0 = __builtin_amdgcn_cvt_pk_fp8_f32(v0[2], v0[3], w0, true);
                    w1 = __builtin_amdgcn_cvt_pk_fp8_f32(v1[0], v1[1], w1, false); w1 = __builtin_amdgcn_cvt_pk_fp8_f32(v1[2], v1[3], w1, true);
                    *(u32x2*)((unsigned char*)O + (size_t)row * 1536 + col0 + bj * HALF) = (u32x2){(unsigned)w0, (unsigned)w1}; } }
    }
};
struct EpiGate {
    static constexpr bool PERM = true, AFTER_DRAIN = false, NEED_R = false;
    const bf16_t* G; int ldg; const bf16_t* prev; bf16_t* O;
    __device__ __forceinline__ void operator()(f32x4 (&acc)[2][2][4][2], const Unit& u, int wr, int wc, int fr, int fq, const PG8_LAS float*) const {
        const int row0 = u.pm * BM + wr * 64 + fr, col0 = u.pn * BM + wc * 32 + 8 * fq;
#pragma unroll
        for (int ai = 0; ai < 2; ++ai) {
            u32x4 gv[4][2], pv[4][2];
#pragma unroll
            for (int m = 0; m < 4; ++m)
#pragma unroll
                for (int bj = 0; bj < 2; ++bj) { const int row = row0 + ai * HALF + m * 16, col = col0 + bj * HALF;
                    gv[m][bj] = *(const u32x4*)(G + (size_t)row * ldg + col); pv[m][bj] = prev ? *(const u32x4*)(prev + (size_t)row * 1024 + col) : (u32x4){0u, 0u, 0u, 0u}; }
            asm volatile("" ::: "memory");
#pragma unroll
            for (int m = 0; m < 4; ++m)
#pragma unroll
                for (int bj = 0; bj < 2; ++bj) { const int row = row0 + ai * HALF + m * 16, col = col0 + bj * HALF; const u32x4 g = gv[m][bj], p = pv[m][bj];
                    float v[8];
                    v[0] = bf_lo(p.x) + sigmoidf_(bf_lo(g.x)) * acc[ai][bj][m][0][0]; v[1] = bf_hi(p.x) + sigmoidf_(bf_hi(g.x)) * acc[ai][bj][m][0][1];
                    v[2] = bf_lo(p.y) + sigmoidf_(bf_lo(g.y)) * acc[ai][bj][m][0][2]; v[3] = bf_hi(p.y) + sigmoidf_(bf_hi(g.y)) * acc[ai][bj][m][0][3];
                    v[4] = bf_lo(p.z) + sigmoidf_(bf_lo(g.z)) * acc[ai][bj][m][1][0]; v[5] = bf_hi(p.z) + sigmoidf_(bf_hi(g.z)) * acc[ai][bj][m][1][1];
                    v[6] = bf_lo(p.w) + sigmoidf_(bf_lo(g.w)) * acc[ai][bj][m][1][2]; v[7] = bf_hi(p.w) + sigmoidf_(bf_hi(g.w)) * acc[ai][bj][m][1][3];
                    u32x4 w; w.x = cvt_pk_bf16(v[0], v[1]); w.y = cvt_pk_bf16(v[2], v[3]); w.z = cvt_pk_bf16(v[4], v[5]); w.w = cvt_pk_bf16(v[6], v[7]);
                    *(u32x4*)(O + (size_t)row * 1024 + col) = w; }
            asm volatile("" ::: "memory"); }
    }
};
struct EpiGF {
    static constexpr bool PERM = true, AFTER_DRAIN = false, NEED_R = true;
    unsigned char* QA; unsigned char* QB; const float* RS;
    __device__ __forceinline__ void operator()(f32x4 (&acc)[2][2][4][2], const Unit& u, int wr, int wc, int fr, int fq, const PG8_LAS float* rtab) const {
        const int row0 = u.pm * BM + wr * 64 + fr, col0 = u.pn * HALF + wc * 32 + 8 * fq;
#pragma unroll
        for (int ai = 0; ai < 2; ++ai)
#pragma unroll
            for (int m = 0; m < 4; ++m) { const int row = row0 + ai * HALF + m * 16; const float rl = rtab[ai * HALF + wr * 64 + m * 16 + fr] * -1.4426950408889634f;
                unsigned qa[2] = {0u, 0u}, qb[2] = {0u, 0u};
#pragma unroll
                for (int n = 0; n < 2; ++n)
#pragma unroll
                    for (int j = 0; j < 4; ++j) { const float sa = __builtin_amdgcn_rcpf(1.0f + __builtin_amdgcn_exp2f(acc[ai][0][m][n][j] * rl)), sb = __builtin_amdgcn_rcpf(1.0f + __builtin_amdgcn_exp2f(acc[ai][1][m][n][j] * rl));
                        qa[n] |= (unsigned)__builtin_rintf(sa * 255.0f) << (8 * j); qb[n] |= (unsigned)fmaxf(__builtin_rintf(sb * 255.0f), 1.0f) << (8 * j); }
                typedef unsigned u32x2 __attribute__((ext_vector_type(2)));
                *(u32x2*)(QA + (size_t)row * 1024 + col0) = (u32x2){qa[0], qa[1]}; *(u32x2*)(QB + (size_t)row * 1024 + col0) = (u32x2){qb[0], qb[1]}; }
    }
};
struct EpiGate2 {
    static constexpr bool PERM = true, AFTER_DRAIN = false, NEED_R = false;
    const unsigned char* QA; const unsigned char* QB; bf16_t* O;
    __device__ __forceinline__ void operator()(f32x4 (&acc)[2][2][4][2], const Unit& u, int wr, int wc, int fr, int fq, const PG8_LAS float*) const {
        typedef unsigned u32x2 __attribute__((ext_vector_type(2)));
        const int row0 = u.pm * BM + wr * 64 + fr, col0 = u.pn * BM + wc * 32 + 8 * fq;
#pragma unroll
        for (int ai = 0; ai < 2; ++ai) {
            u32x2 av[4][2], bv[4][2];
#pragma unroll
            for (int m = 0; m < 4; ++m)
#pragma unroll
                for (int bj = 0; bj < 2; ++bj) { const size_t off = (size_t)(row0 + ai * HALF + m * 16) * 1024 + col0 + bj * HALF; bv[m][bj] = *(const u32x2*)(QB + off); av[m][bj] = u.w ? (u32x2){0u, 0u} : *(const u32x2*)(QA + off); }
            asm volatile("" ::: "memory");
#pragma unroll
            for (int m = 0; m < 4; ++m)
#pragma unroll
                for (int bj = 0; bj < 2; ++bj) {
#pragma unroll
                    for (int n = 0; n < 2; ++n)
#pragma unroll
                        for (int j = 0; j < 4; ++j) { const float b = (float)((bv[m][bj][n] >> (8 * j)) & 255u);
                            if (u.w) acc[ai][bj][m][n][j] *= b * (1.0f / 255.0f);
                            else acc[ai][bj][m][n][j] *= (float)((av[m][bj][n] >> (8 * j)) & 255u) * __builtin_amdgcn_rcpf(b); }
                    if (u.w) { const f32x4 v0 = acc[ai][bj][m][0], v1 = acc[ai][bj][m][1];
                        u32x4 w; w.x = cvt_pk_bf16(v0[0], v0[1]); w.y = cvt_pk_bf16(v0[2], v0[3]); w.z = cvt_pk_bf16(v1[0], v1[1]); w.w = cvt_pk_bf16(v1[2], v1[3]);
                        *(u32x4*)(O + (size_t)(row0 + ai * HALF + m * 16) * 1024 + col0 + bj * HALF) = w; } }
            asm volatile("" ::: "memory"); }
    }
};
struct EpiResidQ {
    static constexpr bool PERM = true, AFTER_DRAIN = false, NEED_R = false;
    bf16_t* HBio; float* RSo; float alpha; unsigned* ROWMAX; unsigned* CNT; unsigned char* Q8; float* SCq;
    __device__ __forceinline__ void operator()(f32x4 (&acc)[2][2][4][2], const Unit& u, int wr, int wc, int fr, int fq, const PG8_LAS float*) const {
        const int row0 = u.pm * BM + wr * 64 + fr, col0 = u.pn * BM + wc * 32 + 8 * fq;
#pragma unroll
        for (int ai = 0; ai < 2; ++ai) {
            u32x4 bv[4][2];
#pragma unroll
            for (int m = 0; m < 4; ++m)
#pragma unroll
                for (int bj = 0; bj < 2; ++bj) bv[m][bj] = *(const u32x4*)(HBio + (size_t)(row0 + ai * HALF + m * 16) * 1024 + col0 + bj * HALF);
            asm volatile("" ::: "memory");
#pragma unroll
            for (int m = 0; m < 4; ++m) { const int row = row0 + ai * HALF + m * 16; float ssq = 0.f, am = 0.f;
#pragma unroll
                for (int bj = 0; bj < 2; ++bj) { const size_t off = (size_t)row * 1024 + col0 + bj * HALF; const u32x4 p = bv[m][bj];
                    const f32x4 v0 = (f32x4){bf_lo(p.x), bf_hi(p.x), bf_lo(p.y), bf_hi(p.y)} + acc[ai][bj][m][0] * alpha, v1 = (f32x4){bf_lo(p.z), bf_hi(p.z), bf_lo(p.w), bf_hi(p.w)} + acc[ai][bj][m][1] * alpha;
                    acc[ai][bj][m][0] = v0; acc[ai][bj][m][1] = v1;
                    u32x4 w; w.x = cvt_pk_bf16(v0[0], v0[1]); w.y = cvt_pk_bf16(v0[2], v0[3]); w.z = cvt_pk_bf16(v1[0], v1[1]); w.w = cvt_pk_bf16(v1[2], v1[3]);
                    *(u32x4*)(HBio + off) = w;
                    ssq += (v0[0] * v0[0] + v0[1] * v0[1]) + (v0[2] * v0[2] + v0[3] * v0[3]) + (v1[0] * v1[0] + v1[1] * v1[1]) + (v1[2] * v1[2] + v1[3] * v1[3]);
                    am = fmaxf(am, fmaxf(fmaxf(fmaxf(fabsf(v0[0]), fabsf(v0[1])), fmaxf(fabsf(v0[2]), fabsf(v0[3]))), fmaxf(fmaxf(fabsf(v1[0]), fabsf(v1[1])), fmaxf(fabsf(v1[2]), fabsf(v1[3]))))); }
                ssq = xsum_16_32(ssq);
                am = xmax_16_32(am);
                if (fq == 0) { RSo[(size_t)row * 16 + u.pn * 4 + wc] = ssq; (void)__hip_atomic_fetch_max(ROWMAX + row, __builtin_bit_cast(unsigned, am), __ATOMIC_RELAXED, __HIP_MEMORY_SCOPE_AGENT); } }
            asm volatile("" ::: "memory"); }
        asm volatile("s_waitcnt vmcnt(0)" ::: "memory"); __builtin_amdgcn_s_barrier();
        if (wr == 0 && wc == 0 && fr == 0 && fq == 0) {
            (void)__hip_atomic_fetch_add(CNT + u.pm, 1u, __ATOMIC_RELAXED, __HIP_MEMORY_SCOPE_AGENT);
            unsigned sp = 0u; while (__hip_atomic_load(CNT + u.pm, __ATOMIC_RELAXED, __HIP_MEMORY_SCOPE_AGENT) < 4u) { __builtin_amdgcn_s_sleep(1); if (++sp > (1u << 22)) break; } }
        asm volatile("s_waitcnt vmcnt(0)" ::: "memory"); __builtin_amdgcn_s_barrier(); asm volatile("" ::: "memory");
        typedef unsigned u32x2 __attribute__((ext_vector_type(2)));
#pragma unroll
        for (int ai = 0; ai < 2; ++ai)
#pragma unroll
            for (int m = 0; m < 4; ++m) { const int row = row0 + ai * HALF + m * 16;
                const float amx = __builtin_bit_cast(float, __hip_atomic_load(ROWMAX + row, __ATOMIC_RELAXED, __HIP_MEMORY_SCOPE_AGENT)); const float inv = (amx > 0.f) ? 127.0f / amx : 0.f;
#pragma unroll
                for (int bj = 0; bj < 2; ++bj) { unsigned q[2];
#pragma unroll
                    for (int n = 0; n < 2; ++n) { unsigned pq = 0u;
#pragma unroll
                        for (int j = 0; j < 4; ++j) pq |= ((unsigned)(int)__builtin_rintf(acc[ai][bj][m][n][j] * inv) & 255u) << (8 * j);
                        q[n] = pq; }
                    *(u32x2*)(Q8 + (size_t)row * 1024 + col0 + bj * HALF) = (u32x2){q[0], q[1]}; }
                if (u.pn == 0 && wc == 0 && fq == 0) SCq[row] = (amx > 0.f) ? amx * (1.0f / 127.0f) : 1.0f; }
    }
};
struct EpiSig8 {
    static constexpr bool PERM = true, AFTER_DRAIN = false, NEED_R = true;
    unsigned char* O8; const float* RS;
    __device__ __forceinline__ void operator()(f32x4 (&acc)[2][2][4][2], const Unit& u, int wr, int wc, int fr, int fq, const PG8_LAS float* rtab) const {
        typedef unsigned u32x2 __attribute__((ext_vector_type(2)));
        const int row0 = u.pm * BM + wr * 64 + fr, col0 = u.pn * BM + wc * 32 + 8 * fq;
#pragma unroll
        for (int ai = 0; ai < 2; ++ai)
#pragma unroll
            for (int m = 0; m < 4; ++m) { const int row = row0 + ai * HALF + m * 16; const float rl = rtab[ai * HALF + wr * 64 + m * 16 + fr] * -1.4426950408889634f;
#pragma unroll
                for (int bj = 0; bj < 2; ++bj) { unsigned q[2];
#pragma unroll
                    for (int n = 0; n < 2; ++n) { unsigned pq = 0u;
#pragma unroll
                        for (int j = 0; j < 4; ++j) pq |= (unsigned)__builtin_rintf(255.0f * __builtin_amdgcn_rcpf(1.0f + __builtin_amdgcn_exp2f(acc[ai][bj][m][n][j] * rl))) << (8 * j);
                        q[n] = pq; }
                    *(u32x2*)(O8 + (size_t)row * 512 + col0 + bj * HALF) = (u32x2){q[0], q[1]}; } }
    }
};
struct EpiResidX {
    static constexpr bool PERM = true, AFTER_DRAIN = false, NEED_R = false;
    const unsigned char* Q8; const unsigned char* E8; const float* SC; bf16_t* HBo; float* RSo; float alpha;
    __device__ __forceinline__ void operator()(f32x4 (&acc)[2][2][4][2], const Unit& u, int wr, int wc, int fr, int fq, const PG8_LAS float*) const {
        typedef unsigned u32x2 __attribute__((ext_vector_type(2)));
        const int row0 = u.pm * BM + wr * 64 + fr, col0 = u.pn * BM + wc * 32 + 8 * fq;
#pragma unroll
        for (int ai = 0; ai < 2; ++ai) {
            u32x2 qv[4][2], ev[4][2]; float sv[4];
#pragma unroll
            for (int m = 0; m < 4; ++m) { const int row = row0 + ai * HALF + m * 16; sv[m] = SC[row];
#pragma unroll
                for (int bj = 0; bj < 2; ++bj) { const size_t off = (size_t)row * 1024 + col0 + bj * HALF; qv[m][bj] = *(const u32x2*)(Q8 + off); ev[m][bj] = *(const u32x2*)(E8 + off); } }
            asm volatile("" ::: "memory");
#pragma unroll
            for (int m = 0; m < 4; ++m) { const int row = row0 + ai * HALF + m * 16; float ssq = 0.f; const float s1 = sv[m], s2 = sv[m] * (1.0f / 254.0f);
#pragma unroll
                for (int bj = 0; bj < 2; ++bj) { const size_t off = (size_t)row * 1024 + col0 + bj * HALF; f32x4 v[2];
#pragma unroll
                    for (int n = 0; n < 2; ++n)
#pragma unroll
                        for (int j = 0; j < 4; ++j) { const float qf_ = (float)(int)(signed char)((qv[m][bj][n] >> (8 * j)) & 255u), ef_ = (float)(int)(signed char)((ev[m][bj][n] >> (8 * j)) & 255u);
                            v[n][j] = (qf_ * s1 + ef_ * s2) + acc[ai][bj][m][n][j] * alpha; }
                    u32x4 w; w.x = cvt_pk_bf16(v[0][0], v[0][1]); w.y = cvt_pk_bf16(v[0][2], v[0][3]); w.z = cvt_pk_bf16(v[1][0], v[1][1]); w.w = cvt_pk_bf16(v[1][2], v[1][3]);
                    *(u32x4*)(HBo + off) = w;
                    ssq += (v[0][0] * v[0][0] + v[0][1] * v[0][1]) + (v[0][2] * v[0][2] + v[0][3] * v[0][3]) + (v[1][0] * v[1][0] + v[1][1] * v[1][1]) + (v[1][2] * v[1][2] + v[1][3] * v[1][3]); }
                ssq = xsum_16_32(ssq);
                if (fq == 0) RSo[(size_t)row * 16 + u.pn * 4 + wc] = ssq; }
            asm volatile("" ::: "memory"); }
    }
};
struct EpiNull {
    static constexpr bool PERM = true, AFTER_DRAIN = false, NEED_R = false;
    float* O;
    __device__ __forceinline__ void operator()(f32x4 (&acc)[2][2][4][2], const Unit& u, int wr, int wc, int fr, int fq, const PG8_LAS float*) const {
        float s_ = 0.f;
#pragma unroll
        for (int ai = 0; ai < 2; ++ai)
#pragma unroll
            for (int bj = 0; bj < 2; ++bj)
#pragma unroll
                for (int m = 0; m < 4; ++m)
#pragma unroll
                    for (int n = 0; n < 2; ++n) s_ += (acc[ai][bj][m][n][0] + acc[ai][bj][m][n][1]) + (acc[ai][bj][m][n][2] + acc[ai][bj][m][n][3]);
        if (s_ == 12345.678f) O[u.pm * 7 + u.pn + wr + wc + fr + fq] = s_;
    }
};
struct EpiPlain {
    static constexpr bool PERM = true, AFTER_DRAIN = false, NEED_R = false;
    bf16_t* O;
    __device__ __forceinline__ void operator()(f32x4 (&acc)[2][2][4][2], const Unit& u, int wr, int wc, int fr, int fq, const PG8_LAS float*) const {
        const int row0 = u.pm * BM + wr * 64 + fr, col0 = u.pn * BM + wc * 32 + 8 * fq;
#pragma unroll
        for (int ai = 0; ai < 2; ++ai)
#pragma unroll
            for (int m = 0; m < 4; ++m) { const int row = row0 + ai * HALF + m * 16;
#pragma unroll
                for (int bj = 0; bj < 2; ++bj) { const f32x4 v0 = acc[ai][bj][m][0], v1 = acc[ai][bj][m][1];
                    u32x4 w; w.x = cvt_pk_bf16(v0[0], v0[1]); w.y = cvt_pk_bf16(v0[2], v0[3]); w.z = cvt_pk_bf16(v1[0], v1[1]); w.w = cvt_pk_bf16(v1[2], v1[3]);
                    *(u32x4*)(O + (size_t)row * 1024 + col0 + bj * HALF) = w; } }
    }
};
struct EpiFinal {
    static constexpr bool PERM = true, AFTER_DRAIN = false, NEED_R = true;
    float* out; const bf16_t* HBr; const bf16_t* PE; const float* RS;
    __device__ __forceinline__ void operator()(f32x4 (&acc)[2][2][4][2], const Unit& u, int wr, int wc, int fr, int fq, const PG8_LAS float* rtab) const {
        const int row0 = u.pm * BM + wr * 64 + fr, col0 = u.pn * BM + wc * 32 + 8 * fq;
#pragma unroll
        for (int ai = 0; ai < 2; ++ai) {
            u32x4 hv[4][2], pv[4][2];
#pragma unroll
            for (int m = 0; m < 4; ++m)
#pragma unroll
                for (int bj = 0; bj < 2; ++bj) { const size_t off = (size_t)(row0 + ai * HALF + m * 16) * 1024 + col0 + bj * HALF; hv[m][bj] = *(const u32x4*)(HBr + off); pv[m][bj] = *(const u32x4*)(PE + off); }
            asm volatile("" ::: "memory");
#pragma unroll
            for (int m = 0; m < 4; ++m) { const float r = rtab[ai * HALF + wr * 64 + m * 16 + fr];
#pragma unroll
                for (int bj = 0; bj < 2; ++bj) { const size_t off = (size_t)(row0 + ai * HALF + m * 16) * 1024 + col0 + bj * HALF; const u32x4 b = hv[m][bj], p = pv[m][bj];
                    f32x4 v0, v1;
                    v0[0] = bf_lo(b.x) + bf_lo(p.x) * sigmoidf_(acc[ai][bj][m][0][0] * r); v0[1] = bf_hi(b.x) + bf_hi(p.x) * sigmoidf_(acc[ai][bj][m][0][1] * r);
                    v0[2] = bf_lo(b.y) + bf_lo(p.y) * sigmoidf_(acc[ai][bj][m][0][2] * r); v0[3] = bf_hi(b.y) + bf_hi(p.y) * sigmoidf_(acc[ai][bj][m][0][3] * r);
                    v1[0] = bf_lo(b.z) + bf_lo(p.z) * sigmoidf_(acc[ai][bj][m][1][0] * r); v1[1] = bf_hi(b.z) + bf_hi(p.z) * sigmoidf_(acc[ai][bj][m][1][1] * r);
                    v1[2] = bf_lo(b.w) + bf_lo(p.w) * sigmoidf_(acc[ai][bj][m][1][2] * r); v1[3] = bf_hi(b.w) + bf_hi(p.w) * sigmoidf_(acc[ai][bj][m][1][3] * r);
                    *(f32x4*)(out + off) = v0; *(f32x4*)(out + off + 4) = v1; } }
            asm volatile("" ::: "memory"); }
    }
};

template <class Epi, class Sched, bool ALIGN_EPI = false, bool SP2 = false, bool BAL = false, bool I8 = false>
__device__ __forceinline__ void gemm_phase(PG8_LAS unsigned char* lds, const Gemm g, const Sched& S, const Epi& E, const int wid) {
    int lane; asm volatile("v_mbcnt_lo_u32_b32 %0, -1, 0\n\tv_mbcnt_hi_u32_b32 %0, -1, %0" : "=v"(lane));
    const int tid = wid * 64 + lane, wr = wid >> 2, wc = wid & 3, fr = lane & 15, fq = lane >> 4;
    const int K = g.K, nt = K / BK;
    unsigned voffA[2], voffB[2];
#pragma unroll
    for (int i = 0; i < 2; ++i) { int R, C; stage_rc(tid * 16 + i * 8192, R, C); const int Rb = Epi::PERM ? ((R & ~31) + perm32(R & 31)) : R;
        voffA[i] = (unsigned)(R * K + C) * 2u; voffB[i] = (unsigned)(Rb * K + C) * 2u; }
    const size_t kstep = (size_t)(BK * 2);
    const size_t hstep = (size_t)HALF * K * 2;
    const size_t tstep = 2 * hstep;
    const unsigned ldsw = (unsigned)wid * 1024u;
    const int aoff = lds_byte(wr * 64 + fr, fq * 8), boff = lds_byte(wc * 32 + fr, fq * 8);
#define PG8_SA(b, h) (((b) * 2 + (h)) * HTB)
#define PG8_SB(b, h) ((4 + (b) * 2 + (h)) * HTB)
#define PG8_STAGE(bufoff, gbase, voff) do { _Pragma("unroll") for (int _i = 0; _i < 2; ++_i) \
        __builtin_amdgcn_global_load_lds((const unsigned*)((const char*)(gbase) + (voff)[_i]), (PG8_LAS unsigned*)(lds + (bufoff) + ldsw + _i * 8192), 16, 0, 0); } while (0)
#define PG8_LDA(dst, b, h) do { _Pragma("unroll") for (int m = 0; m < 4; ++m) _Pragma("unroll") for (int k = 0; k < 2; ++k) dst[m][k] = *(const PG8_LAS bf16x8*)(lds + PG8_SA(b, h) + aoff + m * 2048 + k * 1024); } while (0)
#define PG8_LDB(dst, b, h) do { _Pragma("unroll") for (int n = 0; n < 2; ++n) _Pragma("unroll") for (int k = 0; k < 2; ++k) dst[n][k] = *(const PG8_LAS bf16x8*)(lds + PG8_SB(b, h) + boff + n * 2048 + k * 1024); } while (0)
#define PG8_MMA(ai, bj, At, Bt) do { __builtin_amdgcn_s_setprio(3); _Pragma("unroll") for (int m = 0; m < 4; ++m) _Pragma("unroll") for (int n = 0; n < 2; ++n) _Pragma("unroll") for (int k = 0; k < 2; ++k) \
        { if constexpr (I8) acc[ai][bj][m][n] = __builtin_bit_cast(f32x4, __builtin_amdgcn_mfma_i32_16x16x64_i8(__builtin_bit_cast(i32x4, Bt[n][k]), __builtin_bit_cast(i32x4, At[m][k]), __builtin_bit_cast(i32x4, acc[ai][bj][m][n]), 0, 0, 0)); \
          else acc[ai][bj][m][n] = __builtin_amdgcn_mfma_f32_16x16x32_bf16(Bt[n][k], At[m][k], acc[ai][bj][m][n], 0, 0, 0); } __builtin_amdgcn_s_setprio(0); } while (0)
#define PG8_WAIT_V(n) asm volatile("s_waitcnt vmcnt(" #n ")" ::: "memory")
#define PG8_WAIT_L(n) asm volatile("s_waitcnt lgkmcnt(" #n ")" ::: "memory")
#define PG8_BAR __builtin_amdgcn_s_barrier()
#define PG8_SCHED __builtin_amdgcn_sched_barrier(0)
    Unit cur, nxt; int ui = 0; int rt_pm = -1; PG8_LAS float* rtab = (PG8_LAS float*)(lds + RTAB_OFF);
    if (!S.next(0, cur)) return;
    f32x4 acc[2][2][4][2];
#pragma unroll
    for (int a = 0; a < 2; ++a)
#pragma unroll
        for (int b = 0; b < 2; ++b)
#pragma unroll
            for (int m = 0; m < 4; ++m)
#pragma unroll
                for (int n = 0; n < 2; ++n) acc[a][b][m][n] = (f32x4){0.f, 0.f, 0.f, 0.f};
    bf16x8 At[4][2], B0[2][2], B1[2][2];
    const char* cA = (const char*)g.A + (size_t)cur.pm * tstep; const char* cB = (const char*)g.Bt + (size_t)cur.pn * tstep;
    if constexpr (SP2 && BAL) {
        PG8_STAGE(PG8_SB(0, 0), cB, voffB); PG8_STAGE(PG8_SB(0, 1), cB + hstep, voffB); PG8_STAGE(PG8_SA(0, 0), cA, voffA); PG8_STAGE(PG8_SA(0, 1), cA + hstep, voffA);
        if (wr == 1) PG8_BAR;
        PG8_WAIT_V(2); PG8_BAR;
        PG8_STAGE(PG8_SB(1, 0), cB + kstep, voffB); PG8_STAGE(PG8_SB(1, 1), cB + hstep + kstep, voffB);
        PG8_WAIT_V(4); PG8_BAR;
    } else if constexpr (SP2) {
        PG8_STAGE(PG8_SB(0, 0), cB, voffB); PG8_STAGE(PG8_SB(0, 1), cB + hstep, voffB); PG8_STAGE(PG8_SA(0, 0), cA, voffA); PG8_STAGE(PG8_SA(0, 1), cA + hstep, voffA);
        if (wr == 1) PG8_BAR;
        PG8_WAIT_V(2); PG8_BAR;
        PG8_STAGE(PG8_SB(1, 0), cB + kstep, voffB); PG8_STAGE(PG8_SA(1, 0), cA + kstep, voffA); PG8_STAGE(PG8_SB(1, 1), cB + hstep + kstep, voffB);
        PG8_WAIT_V(6); PG8_BAR;
    } else {
        PG8_STAGE(PG8_SB(0, 0), cB, voffB); PG8_STAGE(PG8_SA(0, 0), cA, voffA); PG8_STAGE(PG8_SB(0, 1), cB + hstep, voffB); PG8_STAGE(PG8_SA(0, 1), cA + hstep, voffA);
        if (wr == 1) PG8_BAR;
        PG8_WAIT_V(4); PG8_BAR;
        PG8_STAGE(PG8_SB(1, 0), cB + kstep, voffB); PG8_STAGE(PG8_SA(1, 0), cA + kstep, voffA); PG8_STAGE(PG8_SB(1, 1), cB + hstep + kstep, voffB);
        PG8_WAIT_V(6); PG8_BAR;
    }
    for (;;) {
        const bool has_next = S.next(ui + 1, nxt);
        const char* nA = has_next ? (const char*)((Sched::PAIR && nxt.w) ? g.A2 : g.A) + (size_t)nxt.pm * tstep : cA; const char* nB = has_next ? (const char*)((Sched::PAIR && nxt.w) ? g.Bt2 : g.Bt) + (size_t)nxt.pn * tstep : cB;
#pragma unroll 1
        for (int t = 0; t < nt; t += 2) {
            const bool last = (t == nt - 2);
            const char* a1 = cA + (size_t)(t + 1) * kstep;
            const char* a2 = last ? nA : cA + (size_t)(t + 2) * kstep; const char* b2 = last ? nB : cB + (size_t)(t + 2) * kstep;
            const char* a3 = a2 + kstep; const char* b3 = b2 + kstep;
            if constexpr (SP2 && BAL) {
            PG8_LDB(B0, 0, 0); PG8_LDB(B1, 0, 1); PG8_SCHED; PG8_LDA(At, 0, 0); PG8_STAGE(PG8_SA(1, 1), a1 + hstep, voffA); PG8_STAGE(PG8_SA(1, 0), a1, voffA);
            PG8_WAIT_V(8); PG8_WAIT_L(0); PG8_BAR; PG8_MMA(0, 0, At, B0); PG8_MMA(0, 1, At, B1); PG8_BAR; PG8_SCHED;
            PG8_LDA(At, 0, 1); PG8_STAGE(PG8_SB(0, 0), b2, voffB); PG8_STAGE(PG8_SB(0, 1), b2 + hstep, voffB);
            PG8_WAIT_V(4); PG8_WAIT_L(0); PG8_BAR; PG8_MMA(1, 0, At, B0); PG8_MMA(1, 1, At, B1); PG8_BAR; PG8_SCHED;
            PG8_LDB(B0, 1, 0); PG8_LDB(B1, 1, 1); PG8_SCHED; PG8_LDA(At, 1, 0); PG8_STAGE(PG8_SA(0, 1), a2 + hstep, voffA); PG8_STAGE(PG8_SA(0, 0), a2, voffA);
            PG8_WAIT_V(8); PG8_WAIT_L(0); PG8_BAR; PG8_MMA(0, 0, At, B0); PG8_MMA(0, 1, At, B1); PG8_BAR; PG8_SCHED;
            PG8_LDA(At, 1, 1); PG8_STAGE(PG8_SB(1, 0), b3, voffB); PG8_STAGE(PG8_SB(1, 1), b3 + hstep, voffB);
            PG8_WAIT_V(4); PG8_WAIT_L(0); PG8_BAR; PG8_MMA(1, 0, At, B0); PG8_MMA(1, 1, At, B1); PG8_BAR; PG8_SCHED;
            } else if constexpr (SP2) {
            PG8_LDB(B0, 0, 0); PG8_LDB(B1, 0, 1); PG8_SCHED; PG8_LDA(At, 0, 0); PG8_STAGE(PG8_SA(1, 1), a1 + hstep, voffA);
            PG8_WAIT_V(8); PG8_WAIT_L(0); PG8_BAR; PG8_MMA(0, 0, At, B0); PG8_MMA(0, 1, At, B1); PG8_BAR; PG8_SCHED;
            PG8_LDA(At, 0, 1); PG8_STAGE(PG8_SB(0, 0), b2, voffB); PG8_STAGE(PG8_SB(0, 1), b2 + hstep, voffB); PG8_STAGE(PG8_SA(0, 0), a2, voffA);
            PG8_WAIT_V(8); PG8_WAIT_L(0); PG8_BAR; PG8_MMA(1, 0, At, B0); PG8_MMA(1, 1, At, B1); PG8_BAR; PG8_SCHED;
            PG8_LDB(B0, 1, 0); PG8_LDB(B1, 1, 1); PG8_SCHED; PG8_LDA(At, 1, 0); PG8_STAGE(PG8_SA(0, 1), a2 + hstep, voffA);
            PG8_WAIT_V(8); PG8_WAIT_L(0); PG8_BAR; PG8_MMA(0, 0, At, B0); PG8_MMA(0, 1, At, B1); PG8_BAR; PG8_SCHED;
            PG8_LDA(At, 1, 1); PG8_STAGE(PG8_SB(1, 0), b3, voffB); PG8_STAGE(PG8_SB(1, 1), b3 + hstep, voffB); PG8_STAGE(PG8_SA(1, 0), a3, voffA);
            PG8_WAIT_V(8); PG8_WAIT_L(0); PG8_BAR; PG8_MMA(1, 0, At, B0); PG8_MMA(1, 1, At, B1); PG8_BAR; PG8_SCHED;
            } else {
            PG8_LDB(B0, 0, 0); PG8_SCHED; PG8_LDA(At, 0, 0); PG8_STAGE(PG8_SA(1, 1), a1 + hstep, voffA);
            PG8_WAIT_L(8); PG8_BAR; PG8_WAIT_L(0); PG8_MMA(0, 0, At, B0); PG8_BAR; PG8_SCHED;
            PG8_LDB(B1, 0, 1); PG8_STAGE(PG8_SB(0, 0), b2, voffB);
            PG8_BAR; PG8_WAIT_L(0); PG8_MMA(0, 1, At, B1); PG8_BAR;
            PG8_LDA(At, 0, 1); PG8_STAGE(PG8_SA(0, 0), a2, voffA);
            PG8_BAR; PG8_WAIT_L(0); PG8_MMA(1, 0, At, B0); PG8_BAR; PG8_SCHED;
            PG8_STAGE(PG8_SB(0, 1), b2 + hstep, voffB);
            PG8_WAIT_V(6); PG8_BAR; PG8_MMA(1, 1, At, B1); PG8_BAR;
            PG8_LDB(B0, 1, 0); PG8_SCHED; PG8_LDA(At, 1, 0); PG8_STAGE(PG8_SA(0, 1), a2 + hstep, voffA);
            PG8_WAIT_L(8); PG8_BAR; PG8_WAIT_L(0); PG8_MMA(0, 0, At, B0); PG8_BAR; PG8_SCHED;
            PG8_LDB(B1, 1, 1); PG8_STAGE(PG8_SB(1, 0), b3, voffB);
            PG8_BAR; PG8_WAIT_L(0); PG8_MMA(0, 1, At, B1); PG8_BAR;
            PG8_LDA(At, 1, 1); PG8_STAGE(PG8_SA(1, 0), a3, voffA);
            PG8_BAR; PG8_WAIT_L(0); PG8_MMA(1, 0, At, B0); PG8_BAR; PG8_SCHED;
            PG8_STAGE(PG8_SB(1, 1), b3 + hstep, voffB);
            PG8_WAIT_V(6); PG8_BAR; PG8_MMA(1, 1, At, B1); PG8_BAR;
            }
        }
        if constexpr (ALIGN_EPI) { if (wr == 0) PG8_BAR; }
        if constexpr (Epi::NEED_R) {
            static_assert(ALIGN_EPI, "row-scale table needs both halves in the epilogue together");
            if (cur.pm != rt_pm) {
                if (tid < 256) { const f32x4* rp = (const f32x4*)(E.RS + (size_t)(cur.pm * BM + tid) * 16); const f32x4 p0 = rp[0], p1 = rp[1], p2 = rp[2], p3 = rp[3];
                    const float ss = ((p0[0] + p0[1]) + (p0[2] + p0[3])) + ((p1[0] + p1[1]) + (p1[2] + p1[3])) + ((p2[0] + p2[1]) + (p2[2] + p2[3])) + ((p3[0] + p3[1]) + (p3[2] + p3[3]));
                    float rv_ = __builtin_amdgcn_rsqf(ss * (1.0f / 1024.0f) + RMS_EPS); if constexpr (I8) rv_ *= g.sch[cur.pm * BM + tid]; rtab[tid] = rv_; }
                PG8_WAIT_L(0); PG8_BAR; rt_pm = cur.pm; }
        }
        if constexpr (I8) {
#pragma unroll
            for (int bj = 0; bj < 2; ++bj) { const float* sp_ = g.scw + cur.pn * BM + bj * HALF + wc * 32 + 8 * fq; const f32x4 s0 = *(const f32x4*)sp_, s1 = *(const f32x4*)(sp_ + 4);
#pragma unroll
                for (int ai = 0; ai < 2; ++ai)
#pragma unroll
                    for (int m = 0; m < 4; ++m) { acc[ai][bj][m][0] = __builtin_convertvector(__builtin_bit_cast(i32x4, acc[ai][bj][m][0]), f32x4) * s0; acc[ai][bj][m][1] = __builtin_convertvector(__builtin_bit_cast(i32x4, acc[ai][bj][m][1]), f32x4) * s1; } } }
        E(acc, cur, wr, wc, fr, fq, (const PG8_LAS float*)rtab);
        if (!has_next) break;
        if (!Sched::PAIR || cur.w) {
#pragma unroll
        for (int a = 0; a < 2; ++a)
#pragma unroll
            for (int b = 0; b < 2; ++b)
#pragma unroll
                for (int m = 0; m < 4; ++m)
#pragma unroll
                    for (int n = 0; n < 2; ++n) acc[a][b][m][n] = (f32x4){0.f, 0.f, 0.f, 0.f}; }
        cur = nxt; cA = nA; cB = nB; ++ui;
        if constexpr (ALIGN_EPI) { if (wr == 1) PG8_BAR; }
    }
    PG8_WAIT_V(0);
    if constexpr (!ALIGN_EPI) { if (wr == 0) PG8_BAR; }
    PG8_BAR;
#undef PG8_SA
#undef PG8_SB
#undef PG8_STAGE
#undef PG8_LDA
#undef PG8_LDB
#undef PG8_MMA
#undef PG8_WAIT_V
#undef PG8_WAIT_L
#undef PG8_BAR
#undef PG8_SCHED
}

struct EpiFinal2 {
    static constexpr bool PERM = true, AFTER_DRAIN = false, NEED_R = true;
    float* out; const bf16_t* HBr; const float* RS;
    static constexpr int NREG = 26;
    struct State { unsigned s8[NREG]; };
    __device__ __forceinline__ void operator()(f32x4 (&acc)[2][2][4][2], State& st, const Unit& u, int wr, int wc, int fr, int fq, const PG8_LAS float* rtab, PG8_LAS unsigned* xl) const {
        if (u.w == 0) {
#pragma unroll
            for (int ai = 0; ai < 2; ++ai)
#pragma unroll
                for (int m = 0; m < 4; ++m) { const float rl = rtab[ai * HALF + wr * 64 + m * 16 + fr] * -1.4426950408889634f;
#pragma unroll
                    for (int bj = 0; bj < 2; ++bj)
#pragma unroll
                        for (int n = 0; n < 2; ++n) { unsigned p = 0u;
#pragma unroll
                            for (int j = 0; j < 4; ++j) { const float sg = __builtin_amdgcn_rcpf(1.0f + __builtin_amdgcn_exp2f(acc[ai][bj][m][n][j] * rl)); p |= (unsigned)__builtin_rintf(sg * 255.0f) << (8 * j); }
                            asm volatile("" : "+v"(p));
                            { constexpr int dummy_ = 0; (void)dummy_; const int ix = ((ai * 2 + bj) * 4 + m) * 2 + n; if (ix < NREG) st.s8[ix < NREG ? ix : 0] = p; else xl[(ix - NREG) * 512] = p; }
                            acc[ai][bj][m][n] = (f32x4){0.f, 0.f, 0.f, 0.f}; } }
        } else {
            const int row0 = u.pm * BM + wr * 64 + fr, col0 = u.pn * BM + wc * 32 + 8 * fq;
#pragma unroll
            for (int ai = 0; ai < 2; ++ai) {
                u32x4 hv[4][2];
#pragma unroll
                for (int m = 0; m < 4; ++m)
#pragma unroll
                    for (int bj = 0; bj < 2; ++bj) hv[m][bj] = *(const u32x4*)(HBr + (size_t)(row0 + ai * HALF + m * 16) * 1024 + col0 + bj * HALF);
                asm volatile("" ::: "memory");
#pragma unroll
                for (int m = 0; m < 4; ++m)
#pragma unroll
                    for (int bj = 0; bj < 2; ++bj) { const size_t off = (size_t)(row0 + ai * HALF + m * 16) * 1024 + col0 + bj * HALF; const u32x4 b = hv[m][bj];
                        const int ix0 = ((ai * 2 + bj) * 4 + m) * 2, ix1 = ix0 + 1; constexpr float I255 = 1.0f / 255.0f;
                        const unsigned q0 = (ix0 < NREG) ? st.s8[ix0 < NREG ? ix0 : 0] : xl[(ix0 - NREG) * 512], q1 = (ix1 < NREG) ? st.s8[ix1 < NREG ? ix1 : 0] : xl[(ix1 - NREG) * 512];
                        f32x4 v0, v1;
                        v0[0] = bf_lo(b.x) + acc[ai][bj][m][0][0] * ((float)(q0 & 255u) * I255); v0[1] = bf_hi(b.x) + acc[ai][bj][m][0][1] * ((float)((q0 >> 8) & 255u) * I255);
                        v0[2] = bf_lo(b.y) + acc[ai][bj][m][0][2] * ((float)((q0 >> 16) & 255u) * I255); v0[3] = bf_hi(b.y) + acc[ai][bj][m][0][3] * ((float)(q0 >> 24) * I255);
                        v1[0] = bf_lo(b.z) + acc[ai][bj][m][1][0] * ((float)(q1 & 255u) * I255); v1[1] = bf_hi(b.z) + acc[ai][bj][m][1][1] * ((float)((q1 >> 8) & 255u) * I255);
                        v1[2] = bf_lo(b.w) + acc[ai][bj][m][1][2] * ((float)((q1 >> 16) & 255u) * I255); v1[3] = bf_hi(b.w) + acc[ai][bj][m][1][3] * ((float)(q1 >> 24) * I255);
                        *(f32x4*)(out + off) = v0; *(f32x4*)(out + off + 4) = v1; }
                asm volatile("" ::: "memory"); }
        }
    }
};
template <class Epi>
__device__ __forceinline__ void gemm_phase_dk(PG8_LAS unsigned char* lds, const Gemm g, const PairOrder& S, const Epi& E, const int wid) {
    int lane; asm volatile("v_mbcnt_lo_u32_b32 %0, -1, 0\n\tv_mbcnt_hi_u32_b32 %0, -1, %0" : "=v"(lane));
    const int tid = wid * 64 + lane, wr = wid >> 2, wc = wid & 3, fr = lane & 15, fq = lane >> 4;
    const int K0 = g.K, K1 = g.K2, nt0 = K0 / BK, nt1 = K1 / BK;
    unsigned vA0[2], vB0[2];
#pragma unroll
    for (int i = 0; i < 2; ++i) { int R, C; stage_rc(tid * 16 + i * 8192, R, C); const int Rb = (R & ~31) + perm32(R & 31);
        vA0[i] = (unsigned)(R * K0 + C) * 2u; vB0[i] = (unsigned)(Rb * K0 + C) * 2u; }
    const size_t kstep = (size_t)(BK * 2);
    const size_t hs0 = (size_t)HALF * K0 * 2, hs1 = (size_t)HALF * K1 * 2;
    const unsigned ldsw = (unsigned)wid * 1024u;
    const int aoff = lds_byte(wr * 64 + fr, fq * 8), boff = lds_byte(wc * 32 + fr, fq * 8);
#define PG8_SA(b, h) (((b) * 2 + (h)) * HTB)
#define PG8_SB(b, h) ((4 + (b) * 2 + (h)) * HTB)
#define PG8_STAGE(bufoff, gbase, voff) do { _Pragma("unroll") for (int _i = 0; _i < 2; ++_i) \
        __builtin_amdgcn_global_load_lds((const unsigned*)((const char*)(gbase) + (voff)[_i]), (PG8_LAS unsigned*)(lds + (bufoff) + ldsw + _i * 8192), 16, 0, 0); } while (0)
#define DK_V1(v) ((((v) >> 11) * (unsigned)K1 + (((v) >> 1) & 1023u)) * 2u)
#define DK_STA(bufoff, gbase, sel) do { if (sel) { unsigned t_[2] = {vA0[0], vA0[1]}; asm volatile("" : "+v"(t_[0]), "+v"(t_[1])); t_[0] = DK_V1(t_[0]); t_[1] = DK_V1(t_[1]); PG8_STAGE(bufoff, gbase, t_); } else PG8_STAGE(bufoff, gbase, vA0); } while (0)
#define DK_STB(bufoff, gbase, sel) do { if (sel) { unsigned t_[2] = {vB0[0], vB0[1]}; asm volatile("" : "+v"(t_[0]), "+v"(t_[1])); t_[0] = DK_V1(t_[0]); t_[1] = DK_V1(t_[1]); PG8_STAGE(bufoff, gbase, t_); } else PG8_STAGE(bufoff, gbase, vB0); } while (0)
#define PG8_LDA(dst, b, h) do { _Pragma("unroll") for (int m = 0; m < 4; ++m) _Pragma("unroll") for (int k = 0; k < 2; ++k) dst[m][k] = *(const PG8_LAS bf16x8*)(lds + PG8_SA(b, h) + aoff + m * 2048 + k * 1024); } while (0)
#define PG8_LDB(dst, b, h) do { _Pragma("unroll") for (int n = 0; n < 2; ++n) _Pragma("unroll") for (int k = 0; k < 2; ++k) dst[n][k] = *(const PG8_LAS bf16x8*)(lds + PG8_SB(b, h) + boff + n * 2048 + k * 1024); } while (0)
#define PG8_MMA(ai, bj, At, Bt) do { __builtin_amdgcn_s_setprio(3); _Pragma("unroll") for (int m = 0; m < 4; ++m) _Pragma("unroll") for (int n = 0; n < 2; ++n) _Pragma("unroll") for (int k = 0; k < 2; ++k) \
        acc[ai][bj][m][n] = __builtin_amdgcn_mfma_f32_16x16x32_bf16(Bt[n][k], At[m][k], acc[ai][bj][m][n], 0, 0, 0); __builtin_amdgcn_s_setprio(0); } while (0)
#define PG8_WAIT_V(n) asm volatile("s_waitcnt vmcnt(" #n ")" ::: "memory")
#define PG8_WAIT_L(n) asm volatile("s_waitcnt lgkmcnt(" #n ")" ::: "memory")
#define PG8_BAR __builtin_amdgcn_s_barrier()
#define PG8_SCHED __builtin_amdgcn_sched_barrier(0)
    Unit cur, nxt; int ui = 0; int rt_pm = -1; PG8_LAS float* rtab = (PG8_LAS float*)(lds + RTAB_OFF);
    if (!S.next(0, cur)) return;
    f32x4 acc[2][2][4][2];
#pragma unroll
    for (int a = 0; a < 2; ++a)
#pragma unroll
        for (int b = 0; b < 2; ++b)
#pragma unroll
            for (int m = 0; m < 4; ++m)
#pragma unroll
                for (int n = 0; n < 2; ++n) acc[a][b][m][n] = (f32x4){0.f, 0.f, 0.f, 0.f};
    typename Epi::State st;
    bf16x8 At[4][2], B0[2][2], B1[2][2];
    const char* cA = (const char*)g.A + (size_t)cur.pm * (2 * hs0); const char* cB = (const char*)g.Bt + (size_t)cur.pn * (2 * hs0);
    PG8_STAGE(PG8_SB(0, 0), cB, vB0); PG8_STAGE(PG8_SB(0, 1), cB + hs0, vB0); PG8_STAGE(PG8_SA(0, 0), cA, vA0); PG8_STAGE(PG8_SA(0, 1), cA + hs0, vA0);
    if (wr == 1) PG8_BAR;
    PG8_WAIT_V(2); PG8_BAR;
    PG8_STAGE(PG8_SB(1, 0), cB + kstep, vB0); PG8_STAGE(PG8_SA(1, 0), cA + kstep, vA0); PG8_STAGE(PG8_SB(1, 1), cB + hs0 + kstep, vB0);
    PG8_WAIT_V(6); PG8_BAR;
    for (;;) {
        const bool has_next = S.next(ui + 1, nxt);
        const bool cw = cur.w != 0, nw = has_next ? (nxt.w != 0) : cw;
        const size_t hsc = cw ? hs1 : hs0; const int ntc = cw ? nt1 : nt0;
        const char* nA = has_next ? (const char*)(nw ? g.A2 : g.A) + (size_t)nxt.pm * (2 * (nw ? hs1 : hs0)) : cA; const char* nB = has_next ? (const char*)(nw ? g.Bt2 : g.Bt) + (size_t)nxt.pn * (2 * (nw ? hs1 : hs0)) : cB;
#pragma unroll 1
        for (int t = 0; t < ntc; t += 2) {
            const bool last = (t == ntc - 2);
            const char* a1 = cA + (size_t)(t + 1) * kstep;
            const char* a2 = last ? nA : cA + (size_t)(t + 2) * kstep; const char* b2 = last ? nB : cB + (size_t)(t + 2) * kstep;
            const char* a3 = a2 + kstep; const char* b3 = b2 + kstep;
            const bool xs = last ? nw : cw; const size_t hx = xs ? hs1 : hs0;
            PG8_LDB(B0, 0, 0); PG8_LDB(B1, 0, 1); PG8_SCHED; PG8_LDA(At, 0, 0); DK_STA(PG8_SA(1, 1), a1 + hsc, cw);
            PG8_WAIT_V(8); PG8_WAIT_L(0); PG8_BAR; PG8_MMA(0, 0, At, B0); PG8_MMA(0, 1, At, B1); PG8_BAR; PG8_SCHED;
            PG8_LDA(At, 0, 1); DK_STB(PG8_SB(0, 0), b2, xs); DK_STB(PG8_SB(0, 1), b2 + hx, xs); DK_STA(PG8_SA(0, 0), a2, xs);
            PG8_WAIT_V(8); PG8_WAIT_L(0); PG8_BAR; PG8_MMA(1, 0, At, B0); PG8_MMA(1, 1, At, B1); PG8_BAR; PG8_SCHED;
            PG8_LDB(B0, 1, 0); PG8_LDB(B1, 1, 1); PG8_SCHED; PG8_LDA(At, 1, 0); DK_STA(PG8_SA(0, 1), a2 + hx, xs);
            PG8_WAIT_V(8); PG8_WAIT_L(0); PG8_BAR; PG8_MMA(0, 0, At, B0); PG8_MMA(0, 1, At, B1); PG8_BAR; PG8_SCHED;
            PG8_LDA(At, 1, 1); DK_STB(PG8_SB(1, 0), b3, xs); DK_STB(PG8_SB(1, 1), b3 + hx, xs); DK_STA(PG8_SA(1, 0), a3, xs);
            PG8_WAIT_V(8); PG8_WAIT_L(0); PG8_BAR; PG8_MMA(1, 0, At, B0); PG8_MMA(1, 1, At, B1); PG8_BAR; PG8_SCHED;
        }
        if (wr == 0) PG8_BAR;
        int l2_; asm volatile("v_mbcnt_lo_u32_b32 %0, -1, 0\n\tv_mbcnt_hi_u32_b32 %0, -1, %0" : "=v"(l2_));
        if (cur.pm != rt_pm) { const int tid2 = wid * 64 + l2_;
            if (tid2 < 256) { const f32x4* rp = (const f32x4*)(E.RS + (size_t)(cur.pm * BM + tid2) * 16); const f32x4 p0 = rp[0], p1 = rp[1], p2 = rp[2], p3 = rp[3];
                const float ss = ((p0[0] + p0[1]) + (p0[2] + p0[3])) + ((p1[0] + p1[1]) + (p1[2] + p1[3])) + ((p2[0] + p2[1]) + (p2[2] + p2[3])) + ((p3[0] + p3[1]) + (p3[2] + p3[3]));
                rtab[tid2] = __builtin_amdgcn_rsqf(ss * (1.0f / 1024.0f) + RMS_EPS); }
            PG8_WAIT_L(0); PG8_BAR; rt_pm = cur.pm; }
        E(acc, st, cur, wr, wc, l2_ & 15, l2_ >> 4, (const PG8_LAS float*)rtab, (PG8_LAS unsigned*)(lds + 139264) + (wid * 64 + l2_));
        if (!has_next) break;
        if (cur.w) {
#pragma unroll
        for (int a = 0; a < 2; ++a)
#pragma unroll
            for (int b = 0; b < 2; ++b)
#pragma unroll
                for (int m = 0; m < 4; ++m)
#pragma unroll
                    for (int n = 0; n < 2; ++n) acc[a][b][m][n] = (f32x4){0.f, 0.f, 0.f, 0.f}; }
        cur = nxt; cA = nA; cB = nB; ++ui;
        if (wr == 1) PG8_BAR;
    }
    PG8_WAIT_V(0);
    PG8_BAR;
#undef PG8_SA
#undef PG8_SB
#undef PG8_STAGE
#undef DK_STA
#undef DK_V1
#undef DK_STB
#undef PG8_LDA
#undef PG8_LDB
#undef PG8_MMA
#undef PG8_WAIT_V
#undef PG8_WAIT_L
#undef PG8_BAR
#undef PG8_SCHED
}
}

using pg8::sigmoidf_;
constexpr int NWAVES = 8, NTHREADS = NWAVES * 64;
constexpr int BATCH = 4, SEQ = 8192, D = 1024, M = BATCH * SEQ, FF = 2816, PLE = 256, D_IN = 8712;
constexpr int NHD = 128;
constexpr int WIN_ROWS = 8960;
constexpr int WIN_ML = 4608, WIN_GT = 6656, WIN_G = 6912;
constexpr int NPHASE = 13;

constexpr size_t MiB = 1u << 20;
constexpr size_t WS_CTL = 0, CTL_ZERO_BYTES = 1 * MiB;
constexpr size_t WS_ROPE = 1 * MiB;
constexpr size_t WS_GATES = 2 * MiB;
constexpr size_t WS_LSE = 3 * MiB;
constexpr size_t WS_RS = 4 * MiB;
constexpr size_t WS_W1IN = 6 * MiB;
constexpr size_t WS_W1OUT = 17 * MiB;
constexpr size_t WS_WIN = 22 * MiB + 512 * 1024;
constexpr size_t WS_WUPA = 40 * MiB, WS_WUPB = 41 * MiB, WS_WO = 42 * MiB;
constexpr size_t WS_W2IN = 44 * MiB, WS_W2OUT = 55 * MiB, WS_WPG = 60 * MiB + 512 * 1024, WS_WPE = 62 * MiB + 512 * 1024;
constexpr size_t WS_HB = 64 * MiB;
constexpr size_t WS_HID = 128 * MiB;
constexpr size_t WS_ML = 128 * MiB;
constexpr size_t WS_MST = 256 * MiB;
constexpr size_t WS_QKV1 = 128 * MiB;
constexpr size_t WS_QKV = 320 * MiB;
constexpr size_t WS_A = 416 * MiB, WS_BM = 448 * MiB;
constexpr size_t WS_PB = 480 * MiB;
constexpr size_t WS_G = 128 * MiB;
constexpr size_t WS_TMP = 256 * MiB, WS_MERGED = 320 * MiB;
constexpr size_t WS_PE = 320 * MiB;
constexpr size_t WS_W8 = 497 * MiB;
constexpr size_t WS_SCW = 504 * MiB;
constexpr size_t WS_SC1 = 504 * MiB + 256 * 1024;
constexpr size_t WS_SCX = 3 * MiB + 512 * 1024;
constexpr size_t WS_W1IN8 = 320 * MiB;
constexpr size_t WS_W2IN8 = 505 * MiB;
constexpr size_t WS_SC2 = 504 * MiB + 512 * 1024;
constexpr size_t WS_END = 511 * MiB;
constexpr int CW_BAR = 4096;
constexpr size_t WS_PCNT = 64 * 1024, WS_ROWMAX = 128 * 1024;
constexpr size_t WS_PAR = 512 * 1024;
constexpr int PAR_QG = 0, PAR_KG = 128, PAR_CW = 256, PAR_CB = 256 + 4096, PAR_IB = PAR_CB + 1024, PAR_FB = PAR_IB + 4, PAR_N = PAR_FB + 4;

constexpr int RING_BYTES = 131072, SCR_BYTES = 4 * 36864 + 8192, LDSCTL_OFF = SCR_BYTES, MISC_OFF = LDSCTL_OFF + 320, LDS_BYTES = 163840;

#define GAS __attribute__((address_space(1)))
#define LAS __attribute__((address_space(3)))
typedef unsigned short bf16;
typedef unsigned v4u __attribute__((ext_vector_type(4)));
typedef unsigned v2u __attribute__((ext_vector_type(2)));
typedef float f32x4 __attribute__((ext_vector_type(4)));
typedef GAS unsigned gu32;
#define RLX_AGENT __ATOMIC_RELAXED, __HIP_MEMORY_SCOPE_AGENT
#define LDS_WAIT() asm volatile("s_waitcnt lgkmcnt(0)" ::: "memory")
#define VM_WAIT() asm volatile("s_waitcnt vmcnt(0)" ::: "memory")
__device__ __forceinline__ unsigned f2bf(float f) { unsigned u = __builtin_bit_cast(unsigned, f); return (u + 0x7fffu + ((u >> 16) & 1u)) >> 16; }
__device__ __forceinline__ unsigned pk2(float lo, float hi) { return f2bf(lo) | (f2bf(hi) << 16); }
__device__ __forceinline__ float bfl(unsigned u) { return __uint_as_float(u << 16); }
__device__ __forceinline__ float bfh(unsigned u) { return __uint_as_float(u & 0xffff0000u); }
__device__ __forceinline__ float bf1(bf16 u) { return __uint_as_float((unsigned)u << 16); }

#define XB_TMO      128
#define XB_XCNT(j)  (256  + 64 * (j))
#define XB_XSUB(j)  (1280 + 64 * (j))
#define XB_XGEN(j)  (2304 + 64 * (j))
#define XB_TOP      3328
#define XB_TOPGEN   3392
#define XCD_BAR_WORDS 3456
#define XB_SPIN_CAP (1u << 20)
__device__ __forceinline__ unsigned xb_ld(unsigned* p)              { return __hip_atomic_load(p, __ATOMIC_RELAXED, __HIP_MEMORY_SCOPE_AGENT); }
__device__ __forceinline__ unsigned xb_add(unsigned* p, unsigned v) { return __hip_atomic_fetch_add(p, v, __ATOMIC_RELAXED, __HIP_MEMORY_SCOPE_AGENT); }
__device__ __forceinline__ unsigned xb_xcc_id() { return (unsigned)__builtin_amdgcn_s_getreg((3 << 11) | 20) & 0xFu; }
#define XB_SPIN(cond, bar) do { unsigned _sp = 0; while (cond) { __builtin_amdgcn_s_sleep(1); \
    if ((++_sp & 255u) == 0u) { if (xb_ld(&(bar)[XB_TMO])) break; if (_sp > XB_SPIN_CAP) { atomicAdd(&(bar)[XB_TMO], 1u); break; } } } } while (0)
struct XcdBarrier { unsigned* bar; unsigned x; volatile LAS unsigned* st; };
__device__ __forceinline__ XcdBarrier xcd_barrier_post(unsigned* bar, volatile LAS unsigned* st, bool leader) {
    XcdBarrier b; b.bar = bar; b.x = xb_xcc_id(); b.st = st;
    if (leader) (void)xb_add(&bar[XB_XCNT(b.x)], 1u);
    return b;
}
__device__ __forceinline__ void xcd_barrier_complete(unsigned* bar, unsigned x, unsigned& nloc, unsigned& nx) {
    const unsigned G = gridDim.x * gridDim.y * gridDim.z;
    unsigned sum, cnt, mine, sp = 0u;
    for (;;) {
        sum = 0u; cnt = 0u; mine = 0u;
#pragma unroll
        for (unsigned j = 0; j < 16; ++j) { const unsigned c = xb_ld(&bar[XB_XCNT(j)]); sum += c; cnt += (c > 0u) ? 1u : 0u; mine = (j == x) ? c : mine; }
        if (sum == G) break;
        __builtin_amdgcn_s_sleep(1);
        if ((++sp & 255u) == 0u) { if (xb_ld(&bar[XB_TMO])) break; if (sp > XB_SPIN_CAP) { atomicAdd(&bar[XB_TMO], 1u); break; } }
    }
    nloc = mine > 0u ? mine : 1u; nx = cnt > 0u ? cnt : 1u;
}
__device__ __forceinline__ void xcd_barrier(const XcdBarrier& b, bool leader) {
    asm volatile("s_waitcnt vmcnt(0)" ::: "memory");
    __syncthreads();
    if (leader) {
        unsigned* bar = b.bar;
        __builtin_amdgcn_s_waitcnt(0);
        unsigned nloc = b.st[0], nx = b.st[1];
        if (nloc == 0u) { xcd_barrier_complete(bar, b.x, nloc, nx); b.st[0] = nloc; b.st[1] = nx; }
        const unsigned old = xb_add(&bar[XB_XSUB(b.x)], 1u);
        const unsigned gen = old / nloc;
        if (old + 1u == (gen + 1u) * nloc) {
            __builtin_amdgcn_fence(__ATOMIC_RELEASE, "agent");
            asm volatile("s_waitcnt vmcnt(0)" ::: "memory");
            const unsigned og = xb_add(&bar[XB_TOP], 1u);
            const unsigned tg = og / nx;
            if (og + 1u == (tg + 1u) * nx) xb_add(&bar[XB_TOPGEN], 1u);
            else XB_SPIN(xb_ld(&bar[XB_TOPGEN]) == tg, bar);
            __builtin_amdgcn_fence(__ATOMIC_ACQUIRE, "agent");
            xb_add(&bar[XB_XGEN(b.x)], 1u);
            asm volatile("s_waitcnt vmcnt(0)" ::: "memory");
        } else {
            XB_SPIN(xb_ld(&bar[XB_XGEN(b.x)]) == gen, bar);
            __builtin_amdgcn_fence(__ATOMIC_ACQUIRE, "agent");
            asm volatile("s_waitcnt vmcnt(0)" ::: "memory");
        }
    }
    __syncthreads();
}

struct WD { int src; int gain; unsigned dst; int K, Nsrc, Ndst, kind; };
__constant__ float c_invfreq[16] = {1.000000000e+00f, 4.403666258e-01f, 1.939227581e-01f, 8.539710194e-02f, 3.760603070e-02f, 1.656044088e-02f, 7.292665076e-03f, 3.211446106e-03f,
    1.414213446e-03f, 6.227724371e-04f, 2.742481884e-04f, 1.207697424e-04f, 5.318296462e-05f, 2.341999789e-05f, 1.031338525e-05f, 4.541670478e-06f};
struct Args { const float* in[22]; float* out; unsigned char* ws; int ph_lo, ph_hi; };
enum { I_X = 0, I_P, I_F1N, I_F1WI, I_F1WO, I_MIXN, I_WIN, I_QG, I_KG, I_CW, I_CB, I_IB, I_FB, I_WUA, I_WUM, I_WOUT, I_F2N, I_F2WI, I_F2WO, I_PLN, I_WPG, I_WPE };

__constant__ WD c_wd[10] = {
    {I_F1WI, I_F1N, (unsigned)WS_W1IN, D, 2 * FF, 2 * FF, 1}, {I_F1WO, -1, (unsigned)WS_W1OUT, FF, D, D, 0}, {I_WIN, I_MIXN, (unsigned)WS_WIN, D, D_IN, WIN_ROWS, 2},
    {I_WUA, -1, (unsigned)WS_WUPA, 512, D, D, 0}, {I_WUM, -1, (unsigned)WS_WUPB, 512, D, D, 0}, {I_WOUT, -1, (unsigned)WS_WO, D, D, D, 0},
    {I_F2WI, I_F2N, (unsigned)WS_W2IN, D, 2 * FF, 2 * FF, 1}, {I_F2WO, -1, (unsigned)WS_W2OUT, FF, D, D, 0}, {I_WPG, I_PLN, (unsigned)WS_WPG, D, D, D, 0}, {I_WPE, -1, (unsigned)WS_WPE, PLE, D, D, 0}};
template <int CTRL> __device__ __forceinline__ float dpp_(float x) { return __builtin_bit_cast(float, __builtin_amdgcn_mov_dpp(__builtin_bit_cast(int, x), CTRL, 0xf, 0xf, true)); }
__device__ __forceinline__ float wave_sum(float v) { v += dpp_<0xB1>(v); v += dpp_<0x4E>(v); v += dpp_<0x141>(v); v += dpp_<0x128>(v); return pg8::xsum_16_32(v); }
__device__ __forceinline__ float wave_max(float v) { v = fmaxf(v, dpp_<0xB1>(v)); v = fmaxf(v, dpp_<0x4E>(v)); v = fmaxf(v, dpp_<0x141>(v)); v = fmaxf(v, dpp_<0x128>(v)); return pg8::xmax_16_32(v); }

__device__ __forceinline__ int wsrc_col(int kind, int n) {
    if (kind == 0) return n;
    if (kind == 1) { const int t = n >> 8, w = n & 255; return (w < 128) ? (128 * t + w) : (FF + 128 * t + (w - 128)); }
    if (n < WIN_ML) { const int g = n / 1536, w = n % 1536, part = w >> 9, c = w & 511; return part * 1536 + g * 512 + c; }
    if (n < WIN_GT + 8) return n;
    if (n < WIN_G) return -1;
    { const int e = n - WIN_G, t = e >> 8, w = e & 255; return (w < 128) ? (WIN_GT + 8) + 128 * t + w : (WIN_GT + 8) + 1024 + 128 * t + (w - 128); }
}
__device__ __forceinline__ void p0_transpose_item(const float* W, const float* gain, int K, int Nsrc, int Ndst, bf16* WT, int kind, LAS float* scr, int item, int lane) {
    const int nblk = Ndst / 64, kb = item / nblk, nb = item % nblk, k0 = 64 * kb, n0 = 64 * nb;
    const int n4 = lane & 15, kr = lane >> 4;
    const int sc = wsrc_col(kind, n0 + 4 * n4);
    f32x4 v[16];
#pragma unroll
    for (int i = 0; i < 16; ++i) { const int k = k0 + 4 * i + kr; v[i] = (sc >= 0) ? *(const f32x4*)(W + (size_t)k * Nsrc + sc) : (f32x4){0.f, 0.f, 0.f, 0.f}; }
#pragma unroll
    for (int i = 0; i < 16; ++i) { const int kk = 4 * i + kr; const float gsc = gain ? gain[k0 + kk] : 1.0f; LAS float* d_ = scr + kk * 65 + 4 * n4;
        d_[0] = v[i][0] * gsc; d_[1] = v[i][1] * gsc; d_[2] = v[i][2] * gsc; d_[3] = v[i][3] * gsc; }
    LDS_WAIT(); asm volatile("" ::: "memory");
#pragma unroll
    for (int j = 0; j < 8; ++j) { const int id = lane + 64 * j, n = id >> 3, c = id & 7; const LAS float* s_ = scr + (8 * c) * 65 + n;
        v4u o; o.x = pk2(s_[0 * 65], s_[1 * 65]); o.y = pk2(s_[2 * 65], s_[3 * 65]); o.z = pk2(s_[4 * 65], s_[5 * 65]); o.w = pk2(s_[6 * 65], s_[7 * 65]);
        *(GAS v4u*)(WT + (size_t)(n0 + n) * K + k0 + 8 * c) = o; }
    LDS_WAIT(); asm volatile("" ::: "memory");
}

__device__ __forceinline__ void mlstm_seq_v0(const Args& a, LAS unsigned char* lds, int bh, int tid) {
    const int f = tid & 127, eg = tid >> 7;
    const int b = bh >> 2, h = bh & 3;
    const bf16* ML = (const bf16*)(a.ws + WS_ML); const float* GT = (const float*)(a.ws + WS_GATES); bf16* BMo = (bf16*)(a.ws + WS_BM);
    LAS float* qs = (LAS float*)lds;
    LAS float* ks = qs + 256;
    LAS float* hp = ks + 256;
    LAS float* dp = hp + 1024;
    const float* par = (const float*)(a.ws + WS_PAR); const float* cw = par + PAR_CW; const float* cb = par + PAR_CB;
    const float ib = par[PAR_IB + h], fb = par[PAR_FB + h];
    const int cch = (tid < 128) ? (h * 128 + tid) : (512 + h * 128 + (tid - 128));
    float w0 = 0.f, w1 = 0.f, w2 = 0.f, w3 = 0.f, wb = 0.f;
    if (tid < 256) { w0 = cw[0 * 1024 + cch]; w1 = cw[1 * 1024 + cch]; w2 = cw[2 * 1024 + cch]; w3 = cw[3 * 1024 + cch]; wb = cb[cch]; }
    float x0 = 0.f, x1 = 0.f, x2 = 0.f;
    float C[32], n[32];
#pragma unroll
    for (int i = 0; i < 32; ++i) { C[i] = 0.f; n[i] = 0.f; }
    float mst = 0.f;
    const size_t row0 = (size_t)b * SEQ;
    float xn = 0.f, vn = 0.f, on = 0.f, lin = 0.f, lfn = 0.f;
    if (tid < 256) xn = bf1(ML[row0 * 2048 + cch]);
    vn = bf1(ML[row0 * 2048 + 1024 + h * 128 + f]); on = bf1(ML[row0 * 2048 + 1536 + h * 128 + f]); lin = GT[row0 * 8 + h]; lfn = GT[row0 * 8 + 4 + h];
    for (int t = 0; t < SEQ; ++t) {
        const int par = t & 1;
        const float x3 = xn, v = vn, og = on, lipre = lin, lfpre = lfn;
        if (t + 1 < SEQ) { const size_t r = row0 + t + 1;
            if (tid < 256) xn = bf1(ML[r * 2048 + cch]);
            vn = bf1(ML[r * 2048 + 1024 + h * 128 + f]); on = bf1(ML[r * 2048 + 1536 + h * 128 + f]); lin = GT[r * 8 + h]; lfn = GT[r * 8 + 4 + h]; }
        if (tid < 256) { float c = wb + w0 * x0 + w1 * x1 + w2 * x2 + w3 * x3; c = c * sigmoidf_(c); if (tid >= 128) c *= 0.08838834764831845f;
            if (tid < 128) qs[par * 128 + tid] = c; else ks[par * 128 + tid - 128] = c; x0 = x1; x1 = x2; x2 = x3; }
        __syncthreads();
        const float li = lipre + ib; const float fx = lfpre + fb;
        const float lf = fminf(fx, 0.f) - log1pf(expf(-fabsf(fx)));
        const float mnew = fmaxf(lf + mst, li);
        const float fp = expf(lf + mst - mnew), ip = expf(li - mnew);
        mst = mnew;
        float hacc = 0.f, dacc = 0.f;
#pragma unroll
        for (int i = 0; i < 32; ++i) { const float kk = ks[par * 128 + eg * 32 + i], qq = qs[par * 128 + eg * 32 + i];
            C[i] = fp * C[i] + ip * kk * v; n[i] = fp * n[i] + ip * kk; hacc += qq * C[i]; dacc += qq * n[i]; }
        hp[par * 512 + eg * 128 + f] = hacc; if (f == 0) dp[par * 4 + eg] = dacc;
        __syncthreads();
        if (tid < 128) { const float num = (hp[par * 512 + f] + hp[par * 512 + 128 + f]) + (hp[par * 512 + 256 + f] + hp[par * 512 + 384 + f]);
            const float den = (dp[par * 4] + dp[par * 4 + 1]) + (dp[par * 4 + 2] + dp[par * 4 + 3]);
            const float hv = num / fmaxf(fabsf(den), expf(-mnew));
            BMo[(row0 + t) * 512 + h * 128 + f] = (bf16)f2bf(sigmoidf_(og) * hv); }
    }
    __syncthreads();
}

__device__ __forceinline__ void attn_v0(const Args& a, LAS unsigned char* lds, int g, int gwave, int ngwave, int wave, int lane, int tid) {
    const int d = (g == 0) ? 1 : (g == 1 ? 4 : 16);
    const bf16* QKV = (const bf16*)(a.ws + WS_QKV); bf16* Ao = (bf16*)(a.ws + WS_A); float* LSE = (float*)(a.ws + WS_LSE);
    const float* rope = (const float*)(a.ws + WS_ROPE);
    const float* qg = (const float*)(a.ws + WS_PAR) + PAR_QG; const float* kg = (const float*)(a.ws + WS_PAR) + PAR_KG;
    LAS float* qsh = (LAS float*)lds + wave * 128;
    LAS float* kgs = (LAS float*)lds + 8 * 128;
    if (tid < 128) kgs[tid] = kg[tid];
    __syncthreads();
    for (int it = gwave; it < M * 4; it += ngwave) {
        const int row = it >> 2, j = it & 3, t = row & (SEQ - 1);
        { const unsigned qq = *(const unsigned*)(QKV + (size_t)row * 1536 + j * 128 + 2 * lane);
          float q0 = bfl(qq), q1 = bfh(qq);
          const float ss = wave_sum(q0 * q0 + q1 * q1); const float rn = __builtin_amdgcn_rsqf(ss * (1.f / 128.f) + 1e-6f);
          q0 *= rn * qg[2 * lane]; q1 *= rn * qg[2 * lane + 1];
          const float p0 = __shfl_xor(q0, 8), p1 = __shfl_xor(q1, 8);
          if (lane < 16) { const int i0 = (2 * lane) & 15; const float c0 = rope[(t * 16 + i0) * 2], s0 = rope[(t * 16 + i0) * 2 + 1], c1 = rope[(t * 16 + i0 + 1) * 2], s1 = rope[(t * 16 + i0 + 1) * 2 + 1];
              if (lane < 8) { q0 = q0 * c0 - p0 * s0; q1 = q1 * c1 - p1 * s1; } else { q0 = q0 * c0 + p0 * s0; q1 = q1 * c1 + p1 * s1; } }
          qsh[2 * lane] = q0; qsh[2 * lane + 1] = q1; }
        LDS_WAIT(); asm volatile("" ::: "memory");
        float sc[3];
#pragma unroll
        for (int c = 0; c < 3; ++c) { const int i = lane + 64 * c; const int s = t - i * d; sc[c] = -INFINITY;
            if (i <= 128 && s >= 0) { const bf16* kr = QKV + (size_t)(row - i * d) * 1536 + 512 + j * 128;
                float ss = 0.f, dot = 0.f; float kx[32];
#pragma unroll
                for (int e8 = 0; e8 < 16; ++e8) { const v4u kv = *(const v4u*)(kr + e8 * 8);
                    float kf[8] = {bfl(kv.x), bfh(kv.x), bfl(kv.y), bfh(kv.y), bfl(kv.z), bfh(kv.z), bfl(kv.w), bfh(kv.w)};
#pragma unroll
                    for (int u = 0; u < 8; ++u) { ss += kf[u] * kf[u]; const int e = e8 * 8 + u; if (e < 32) kx[e] = kf[u] * kgs[e]; else dot += qsh[e] * kf[u] * kgs[e]; } }
#pragma unroll
                for (int i2 = 0; i2 < 16; ++i2) { const float cs = rope[(s * 16 + i2) * 2], sn = rope[(s * 16 + i2) * 2 + 1];
                    dot += qsh[i2] * (kx[i2] * cs - kx[i2 + 16] * sn) + qsh[i2 + 16] * (kx[i2 + 16] * cs + kx[i2] * sn); }
                sc[c] = dot * __builtin_amdgcn_rsqf(ss * (1.f / 128.f) + 1e-6f) * 0.08838834764831845f; } }
        const float mx = wave_max(fmaxf(fmaxf(sc[0], sc[1]), sc[2]));
        float p[3]; float ls = 0.f;
#pragma unroll
        for (int c = 0; c < 3; ++c) { p[c] = expf(sc[c] - mx); ls += p[c]; }
        ls = wave_sum(ls);
        float lse = mx + logf(ls);
        float o0 = 0.f, o1 = 0.f;
        const int imax = (t / d < 128) ? (t / d) : 128;
        for (int i = 0; i <= imax; ++i) { const float psel = (i < 64) ? p[0] : ((i < 128) ? p[1] : p[2]); const float pi = __shfl(psel, i & 63);
            const unsigned vv = *(const unsigned*)(QKV + (size_t)(row - i * d) * 1536 + 1024 + j * 128 + 2 * lane);
            o0 += pi * bfl(vv); o1 += pi * bfh(vv); }
        const float il = 1.f / ls; o0 *= il; o1 *= il;
        if (g > 0) { const float lo = LSE[(size_t)row * 4 + j]; const unsigned ov = *(const unsigned*)(Ao + (size_t)row * 512 + j * 128 + 2 * lane);
            const float mm = fmaxf(lo, lse); const float wo = expf(lo - mm), wn = expf(lse - mm); const float inv = 1.f / (wo + wn);
            o0 = (wo * bfl(ov) + wn * o0) * inv; o1 = (wo * bfh(ov) + wn * o1) * inv; lse = mm + logf(wo + wn); }
        *(unsigned*)(Ao + (size_t)row * 512 + j * 128 + 2 * lane) = pk2(o0, o1);
        if (lane == 0) LSE[(size_t)row * 4 + j] = lse;
    }
    __syncthreads();
}


typedef short bf16x8_t __attribute__((ext_vector_type(8)));
typedef short v4i16_t __attribute__((ext_vector_type(4)));
constexpr int TP = 288, TILE_B = 128 * TP;
#define LANE_ID_F() ({ int _l; asm volatile("v_mbcnt_lo_u32_b32 %0, -1, 0\n\tv_mbcnt_hi_u32_b32 %0, -1, %0" : "=v"(_l)); _l; })
__device__ __forceinline__ bf16x8_t trpair(const LAS unsigned char* pa, const LAS unsigned char* pb) {
    const v4i16_t lo = __builtin_amdgcn_ds_read_tr16_b64_v4i16((LAS v4i16_t*)pa), hi = __builtin_amdgcn_ds_read_tr16_b64_v4i16((LAS v4i16_t*)pb);
    return (bf16x8_t){lo[0], lo[1], lo[2], lo[3], hi[0], hi[1], hi[2], hi[3]};
}
__device__ __forceinline__ void unpack8(const v4u v, float (&f)[8]) { f[0] = bfl(v.x); f[1] = bfh(v.x); f[2] = bfl(v.y); f[3] = bfh(v.y); f[4] = bfl(v.z); f[5] = bfh(v.z); f[6] = bfl(v.w); f[7] = bfh(v.w); }
__device__ __forceinline__ v4u pack8(const float (&f)[8]) { v4u w; w.x = pg8::cvt_pk_bf16(f[0], f[1]); w.y = pg8::cvt_pk_bf16(f[2], f[3]); w.z = pg8::cvt_pk_bf16(f[4], f[5]); w.w = pg8::cvt_pk_bf16(f[6], f[7]); return w; }

typedef float f2_t __attribute__((ext_vector_type(2)));
__device__ __forceinline__ v4u f8to16(const v2u q) {
    const f2_t a_ = __builtin_amdgcn_cvt_pk_f32_fp8((int)q.x, false), b_ = __builtin_amdgcn_cvt_pk_f32_fp8((int)q.x, true), c_ = __builtin_amdgcn_cvt_pk_f32_fp8((int)q.y, false), d_ = __builtin_amdgcn_cvt_pk_f32_fp8((int)q.y, true);
    v4u o_; o_.x = pg8::cvt_pk_bf16(a_[0], a_[1]); o_.y = pg8::cvt_pk_bf16(b_[0], b_[1]); o_.z = pg8::cvt_pk_bf16(c_[0], c_[1]); o_.w = pg8::cvt_pk_bf16(d_[0], d_[1]); return o_; }
__device__ __forceinline__ void attn_fast(unsigned char* ws, const unsigned short* QKV, LAS unsigned char* lds, const int g, const int wave, const int vcu, const int G) {
    const int lane = LANE_ID_F(), tid = wave * 64 + lane, fr = lane & 15, fq = lane >> 4;
    const int lgd = 2 * g, d = 1 << lgd, lgseg = 4 - lgd;
    bf16* Ao = (bf16*)(ws + WS_A); float* LSE = (float*)(ws + WS_LSE);
    const int srow = tid >> 4, c = tid & 15;
    for (int seg = vcu; seg < 256; seg += G) {
        const int stream = seg >> lgseg, n0 = (seg & ((1 << lgseg) - 1)) * 4;
        const int r = stream & (d - 1), j = (stream >> lgd) & 3, b = stream >> (lgd + 2);
        const size_t rowbase = (size_t)b * SEQ + r;
        v2u kreg[4], vreg[4], qraw[4]; bf16x8_t qf[4];
        v2u aold[8]; float lold = 0.f;
#define AT_LOADKV(n) do { _Pragma("unroll") for (int i = 0; i < 4; ++i) { const unsigned char* p_ = (const unsigned char*)QKV + (rowbase + (size_t)((n) * 128 + srow + 32 * i) * d) * 1536 + j * 128 + c * 8; \
            kreg[i] = *(const v2u*)(p_ + 512); vreg[i] = *(const v2u*)(p_ + 1024); } } while (0)
#define AT_LOADQ(n) do { const unsigned char* p_ = (const unsigned char*)QKV + (rowbase + (size_t)((n) * 128 + wave * 16 + fr) * d) * 1536 + j * 128 + fq * 8; \
            _Pragma("unroll") for (int ds = 0; ds < 4; ++ds) qraw[ds] = *(const v2u*)(p_ + ds * 32); } while (0)
        if (n0 > 0) AT_LOADKV(n0 - 1);
#pragma unroll 1
        for (int it = -1; it < 4; ++it) {
            const int n = n0 + it;
            __syncthreads();
            if (it >= 0) {
#pragma unroll
                for (int ds = 0; ds < 4; ++ds) qf[ds] = __builtin_bit_cast(bf16x8_t, f8to16(qraw[ds]));
            }
            { LAS unsigned char* kt = lds + (n & 1) * TILE_B; LAS unsigned char* vt = lds + (2 + (n & 1)) * TILE_B;
              if (n >= 0) {
#pragma unroll
                for (int i = 0; i < 4; ++i) { *(LAS v4u*)(kt + (srow + 32 * i) * TP + c * 16) = f8to16(kreg[i]); *(LAS v4u*)(vt + (srow + 32 * i) * TP + c * 16) = f8to16(vreg[i]); }
              } else {
#pragma unroll
                for (int i = 0; i < 4; ++i) { *(LAS v4u*)(kt + (srow + 32 * i) * TP + c * 16) = (v4u){0u, 0u, 0u, 0u}; *(LAS v4u*)(vt + (srow + 32 * i) * TP + c * 16) = (v4u){0u, 0u, 0u, 0u}; }
              } }
            const size_t qrow = rowbase + (size_t)(n * 128 + wave * 16 + fr) * d;
            bf16* ap = Ao + qrow * 512 + j * 128 + 4 * fq;
            if (it >= 0 && g > 0) {
#pragma unroll
                for (int db = 0; db < 8; ++db) aold[db] = *(const v2u*)(ap + db * 16);
                lold = LSE[qrow * 4 + j]; }
            if (it < 3) { AT_LOADKV(n + 1); AT_LOADQ(n + 1); }
            __syncthreads();
            if (it >= 0) {
                const int kb0 = (wave < 6) ? wave : 6;
                const int slot_prev = (n + 1) & 1, slot_cur = n & 1;
                f32x4 sacc[10];
#pragma unroll
                for (int bp = 0; bp < 5; ++bp) {
                    bf16x8_t kfr[2][4];
#pragma unroll
                    for (int h2 = 0; h2 < 2; ++h2) { const int kb = kb0 + 2 * bp + h2; const int slot = (kb < 8) ? slot_prev : slot_cur;
                        const LAS unsigned char* kp = lds + slot * TILE_B + ((kb & 7) * 16 + fr) * TP + fq * 16;
#pragma unroll
                        for (int ds = 0; ds < 4; ++ds) kfr[h2][ds] = *(const LAS bf16x8_t*)(kp + ds * 64); }
#pragma unroll
                    for (int h2 = 0; h2 < 2; ++h2) { f32x4 a_ = (f32x4){0.f, 0.f, 0.f, 0.f};
#pragma unroll
                        for (int ds = 0; ds < 4; ++ds) a_ = __builtin_amdgcn_mfma_f32_16x16x32_bf16(kfr[h2][ds], qf[ds], a_, 0, 0, 0);
                        sacc[2 * bp + h2] = a_; } }
                const int qi = wave * 16 + fr; float mx = -1e30f;
#pragma unroll
                for (int bb = 0; bb < 10; ++bb) {
                    if (bb < 2 || bb > 7) {
#pragma unroll
                        for (int rg = 0; rg < 4; ++rg) { const int kj = (kb0 + bb) * 16 + 4 * fq + rg; const bool ok = (kj >= qi) && (kj <= qi + 128); sacc[bb][rg] = ok ? sacc[bb][rg] : -1e30f; } }
                    if (n == 0) {
#pragma unroll
                        for (int rg = 0; rg < 4; ++rg) { const int kj = (kb0 + bb) * 16 + 4 * fq + rg; sacc[bb][rg] = (kj >= 128) ? sacc[bb][rg] : -1e30f; } }
#pragma unroll
                    for (int rg = 0; rg < 4; ++rg) mx = fmaxf(mx, sacc[bb][rg]); }
                mx = pg8::xmax_16_32(mx);
                float l = 0.f;
#pragma unroll
                for (int bb = 0; bb < 10; ++bb)
#pragma unroll
                    for (int rg = 0; rg < 4; ++rg) { const float p_ = __builtin_amdgcn_exp2f(sacc[bb][rg] - mx); sacc[bb][rg] = p_; l += p_; }
                l = pg8::xsum_16_32(l);
                f32x4 oacc[8];
#pragma unroll
                for (int db = 0; db < 8; ++db) oacc[db] = (f32x4){0.f, 0.f, 0.f, 0.f};
                const int trq = (lane & 15) >> 2, trp = lane & 3;
#pragma unroll
                for (int sg = 0; sg < 5; ++sg) { const int kbA = kb0 + 2 * sg, kbB = kbA + 1;
                    v4u pw; pw.x = pg8::cvt_pk_bf16(sacc[2 * sg][0], sacc[2 * sg][1]); pw.y = pg8::cvt_pk_bf16(sacc[2 * sg][2], sacc[2 * sg][3]);
                    pw.z = pg8::cvt_pk_bf16(sacc[2 * sg + 1][0], sacc[2 * sg + 1][1]); pw.w = pg8::cvt_pk_bf16(sacc[2 * sg + 1][2], sacc[2 * sg + 1][3]);
                    const bf16x8_t pf = __builtin_bit_cast(bf16x8_t, pw);
                    const LAS unsigned char* va = lds + (2 + ((kbA < 8) ? slot_prev : slot_cur)) * TILE_B + ((kbA & 7) * 16 + 4 * fq + trq) * TP + trp * 8;
                    const LAS unsigned char* vb = lds + (2 + ((kbB < 8) ? slot_prev : slot_cur)) * TILE_B + ((kbB & 7) * 16 + 4 * fq + trq) * TP + trp * 8;
                    bf16x8_t vfr[8];
#pragma unroll
                    for (int db = 0; db < 8; ++db) vfr[db] = trpair(va + db * 32, vb + db * 32);
#pragma unroll
                    for (int db = 0; db < 8; ++db) oacc[db] = __builtin_amdgcn_mfma_f32_16x16x32_bf16(vfr[db], pf, oacc[db], 0, 0, 0); }
                const float il = __builtin_amdgcn_rcpf(l); float lse = mx * 0.6931471805599453f + __logf(l);
                float wo = 0.f, wn = il;
                if (g > 0) { const float mm = fmaxf(lold, lse); const float eo = __expf(lold - mm), en = __expf(lse - mm); const float inv = __builtin_amdgcn_rcpf(eo + en);
                    wo = eo * inv; wn = en * inv * il; lse = mm + __logf(eo + en); }
#pragma unroll
                for (int db = 0; db < 8; ++db) { float o0 = oacc[db][0] * wn, o1 = oacc[db][1] * wn, o2 = oacc[db][2] * wn, o3 = oacc[db][3] * wn;
                    if (g > 0) { const v2u old = aold[db]; o0 += wo * bfl(old.x); o1 += wo * bfh(old.x); o2 += wo * bfl(old.y); o3 += wo * bfh(old.y); }
                    v2u w_; w_.x = pg8::cvt_pk_bf16(o0, o1); w_.y = pg8::cvt_pk_bf16(o2, o3); *(v2u*)(ap + db * 16) = w_; }
                if (fq == 0) LSE[qrow * 4 + j] = lse;
            }
        }
#undef AT_LOADKV
#undef AT_LOADQ
    }
    __syncthreads();
}

constexpr size_t WS_MSC = 496 * MiB;
constexpr size_t WS_CPB = WS_A;
constexpr int GSM_OFF = 4 * TILE_B;
__device__ __forceinline__ float log_sigmoid_(float x) { return fminf(x, 0.f) - log1pf(__expf(-fabsf(x))); }
__device__ __forceinline__ void conv_load(v4u (&raw)[4], const bf16* ML, size_t grow, int tpos, int col) {
#pragma unroll
    for (int jt = 0; jt < 4; ++jt) { const bool ok = (tpos - 3 + jt >= 0); raw[jt] = *(const v4u*)(ML + (ok ? (grow - 3 + jt) : grow) * 2048 + col); }
}
__device__ __forceinline__ void conv_apply(const v4u (&raw)[4], int tpos, const float (&w)[4][8], const float (&bs)[8], float (&o)[8]) {
#pragma unroll
    for (int u = 0; u < 8; ++u) o[u] = bs[u];
#pragma unroll
    for (int jt = 0; jt < 4; ++jt) { const float msk = (tpos - 3 + jt >= 0) ? 1.f : 0.f; float x[8]; unpack8(raw[jt], x);
#pragma unroll
        for (int u = 0; u < 8; ++u) o[u] += (w[jt][u] * msk) * x[u]; }
#pragma unroll
    for (int u = 0; u < 8; ++u) o[u] = o[u] * sigmoidf_(o[u]);
}
__device__ __forceinline__ void conv_piece(const bf16* ML, size_t grow, int tpos, int col, const float (&w)[4][8], const float (&bs)[8], float (&o)[8]) {
    v4u raw[4];
#pragma unroll
    for (int jt = 0; jt < 4; ++jt) { const bool ok = (tpos - 3 + jt >= 0); raw[jt] = *(const v4u*)(ML + (ok ? (grow - 3 + jt) : grow) * 2048 + col); }
#pragma unroll
    for (int u = 0; u < 8; ++u) o[u] = bs[u];
#pragma unroll
    for (int jt = 0; jt < 4; ++jt) { const float msk = (tpos - 3 + jt >= 0) ? 1.f : 0.f; float x[8]; unpack8(raw[jt], x);
#pragma unroll
        for (int u = 0; u < 8; ++u) o[u] += (w[jt][u] * msk) * x[u]; }
#pragma unroll
    for (int u = 0; u < 8; ++u) o[u] = o[u] * sigmoidf_(o[u]);
}
__device__ __forceinline__ float wave_scan_add(float v, int lane) {
#pragma unroll
    for (int o = 1; o < 64; o <<= 1) { const float t = __shfl_up(v, o); if (lane >= o) v += t; }
    return v;
}
__device__ __forceinline__ float wave_scan_max(float v, int lane) {
#pragma unroll
    for (int o = 1; o < 64; o <<= 1) { const float t = __shfl_up(v, o); if (lane >= o) v = fmaxf(v, t); }
    return v;
}
__device__ __forceinline__ void mlstm_b1(unsigned char* ws, LAS unsigned char* lds, const int wave, const int vcu, const int G) {
    const int lane = LANE_ID_F(), tid = wave * 64 + lane, fq = lane >> 4;
    const bf16* ML = (const bf16*)(ws + WS_ML); const float* GT = (const float*)(ws + WS_GATES); const float* par = (const float*)(ws + WS_PAR);
    float* MST = (float*)(ws + WS_MST); float* MSC = (float*)(ws + WS_MSC);
    LAS float* gsm = (LAS float*)(lds + GSM_OFF);
    LAS unsigned char* kt = lds; LAS unsigned char* vt = lds + TILE_B; LAS float* dnp = (LAS float*)(lds + 2 * TILE_B);
    const int srow = tid >> 4, c = tid & 15;
    struct B1Pre { v4u vr[4]; v4u raw[4][4]; };
#define B1_LOAD(P, item_) do { const int bh_ = (item_) >> 6, ch_ = (item_) & 63, h_ = bh_ & 3; const size_t r0_ = (size_t)(bh_ >> 2) * SEQ + ch_ * 128; \
        _Pragma("unroll") for (int i = 0; i < 4; ++i) { const int sr_ = srow + 32 * i; (P).vr[i] = *(const v4u*)(ML + (r0_ + sr_) * 2048 + 1024 + h_ * 128 + c * 8); conv_load((P).raw[i], ML, r0_ + sr_, ch_ * 128 + sr_, 512 + h_ * 128 + c * 8); } } while (0)
    for (int base = 0; base < 1024; base += 4 * G) {
        B1Pre cur_;
        if (base + vcu < 1024) B1_LOAD(cur_, base + vcu);
        __syncthreads();
        { const int k = tid >> 7, s_ = tid & 127, it_ = base + vcu + G * k; const bool ok = it_ < 1024; const int itc = ok ? it_ : 0;
          const int bh = itc >> 6, ch = itc & 63, h = bh & 3; const size_t r = (size_t)(bh >> 2) * SEQ + ch * 128 + s_;
          const float lf = log_sigmoid_(GT[r * 8 + 4 + h] + par[PAR_FB + h]), li = GT[r * 8 + h] + par[PAR_IB + h];
          float b_ = wave_scan_add(lf, lane);
          if (lane == 63) gsm[1664 + wave] = b_;
          __syncthreads();
          if (wave & 1) b_ += gsm[1664 + wave - 1];
          const float bL = gsm[1664 + 2 * k] + gsm[1664 + 2 * k + 1];
          const float g_ = bL - b_ + li;
          const float mw = wave_max(g_);
          if (lane == 0) gsm[1680 + wave] = mw;
          __syncthreads();
          const float mloc = fmaxf(gsm[1680 + 2 * k], gsm[1680 + 2 * k + 1]);
          gsm[k * 128 + s_] = __expf(g_ - mloc);
          if (s_ == 0) { gsm[1696 + k] = mloc; gsm[1700 + k] = bL; }
        }
        __syncthreads();
#pragma unroll 1
        for (int k = 0; k < 4; ++k) { const int item = base + vcu + G * k; if (item >= 1024) break;
            const int bh = item >> 6, ch = item & 63, h = bh & 3; const size_t row0 = (size_t)(bh >> 2) * SEQ + ch * 128;
            if (k > 0) __syncthreads();
            { float w[4][8], bs[8]; const int col = 512 + h * 128 + c * 8;
#pragma unroll
              for (int jt = 0; jt < 4; ++jt)
#pragma unroll
                  for (int u = 0; u < 8; ++u) w[jt][u] = par[PAR_CW + jt * 1024 + col + u];
#pragma unroll
              for (int u = 0; u < 8; ++u) bs[u] = par[PAR_CB + col + u];
              float dn[8];
#pragma unroll
              for (int u = 0; u < 8; ++u) dn[u] = 0.f;
#pragma unroll
              for (int i = 0; i < 4; ++i) { const int sr = srow + 32 * i; float o[8]; conv_apply(cur_.raw[i], ch * 128 + sr, w, bs, o);
                  const float sc = 0.08838834764831845f * gsm[k * 128 + sr];
#pragma unroll
                  for (int u = 0; u < 8; ++u) { o[u] *= sc; dn[u] += o[u]; }
                  *(LAS v4u*)(kt + sr * TP + c * 16) = pack8(o);
                  *(LAS v4u*)(vt + sr * TP + c * 16) = cur_.vr[i]; }
#pragma unroll
              for (int u = 0; u < 8; ++u) dnp[srow * 128 + c * 8 + u] = dn[u]; }
            __syncthreads();
            if (tid < 128) { float a_ = 0.f;
#pragma unroll 8
                for (int r = 0; r < 32; ++r) a_ += dnp[r * 128 + tid];
                MSC[(size_t)item * 256 + tid] = a_; }
            if (tid == 0) { MSC[(size_t)item * 256 + 128] = gsm[1696 + k]; MSC[(size_t)item * 256 + 129] = gsm[1700 + k]; }
            { const int nitem = item + G; if (k < 3 && nitem < 1024) B1_LOAD(cur_, nitem); }
            { const int trq = (lane & 15) >> 2, trp = lane & 3; f32x4 acc[8];
#pragma unroll
              for (int fb = 0; fb < 8; ++fb) acc[fb] = (f32x4){0.f, 0.f, 0.f, 0.f};
#pragma unroll
              for (int ks = 0; ks < 4; ++ks) { const int ra = ks * 32 + 4 * fq + trq;
                  const bf16x8_t kf = trpair(kt + ra * TP + (wave * 16 + 4 * trp) * 2, kt + (ra + 16) * TP + (wave * 16 + 4 * trp) * 2);
                  bf16x8_t vfr[8];
#pragma unroll
                  for (int fb = 0; fb < 8; ++fb) vfr[fb] = trpair(vt + ra * TP + (fb * 16 + 4 * trp) * 2, vt + (ra + 16) * TP + (fb * 16 + 4 * trp) * 2);
#pragma unroll
                  for (int fb = 0; fb < 8; ++fb) acc[fb] = __builtin_amdgcn_mfma_f32_16x16x32_bf16(vfr[fb], kf, acc[fb], 0, 0, 0); }
              float* dst = MST + (size_t)item * 16384 + (size_t)(wave * 16 + (lane & 15)) * 128 + 4 * fq;
#pragma unroll
              for (int fb = 0; fb < 8; ++fb) *(f32x4*)(dst + fb * 16) = acc[fb]; }
        }
    }
    __syncthreads();
}
__device__ __forceinline__ void mlstm_b2(unsigned char* ws, const int wave, const int vcu, const int G) {
    const int lane = LANE_ID_F(), tid = wave * 64 + lane;
    const float* MST = (const float*)(ws + WS_MST); float* MSC = (float*)(ws + WS_MSC); unsigned* CPB = (unsigned*)(ws + WS_CPB);
    typedef float f32x2 __attribute__((ext_vector_type(2)));
    for (int gid = vcu * NTHREADS + tid; gid < 16 * 8192; gid += G * NTHREADS) {
        const int bh = gid >> 13, rem = gid & 8191;
        float m = 0.f; f32x2 C = {0.f, 0.f}, nn = {0.f, 0.f};
        const f32x2* p = (const f32x2*)(MST + (size_t)bh * 64 * 16384) + rem; unsigned* cp = CPB + (size_t)bh * 64 * 8192 + rem; float* sc = MSC + (size_t)bh * 64 * 256;
#pragma unroll 1
        for (int c0 = 0; c0 < 64; c0 += 16) {
            f32x2 dv[16], dn[16]; float ml[16], bl[16];
#pragma unroll
            for (int k = 0; k < 16; ++k) { dv[k] = p[(size_t)(c0 + k) * 8192]; ml[k] = sc[(c0 + k) * 256 + 128]; bl[k] = sc[(c0 + k) * 256 + 129]; if (rem < 64) dn[k] = *(const f32x2*)(sc + (c0 + k) * 256 + 2 * rem); }
#pragma unroll
            for (int k = 0; k < 16; ++k) { const float mn = fmaxf(bl[k] + m, ml[k]); const float sp = __expf(bl[k] + m - mn), sn = __expf(ml[k] - mn);
                cp[(size_t)(c0 + k) * 8192] = pg8::cvt_pk_bf16(C[0], C[1]); C = C * sp + dv[k] * sn;
                if (rem < 64) { *(f32x2*)(sc + (c0 + k) * 256 + 2 * rem) = nn; nn = nn * sp + dn[k] * sn; }
                if (rem == 0) sc[(c0 + k) * 256 + 130] = m;
                m = mn; }
        }
    }
}
__device__ __forceinline__ void mlstm_b3(unsigned char* ws, const unsigned char* MO8, LAS unsigned char* lds, const int wave, const int vcu, const int G) {
    const int lane = LANE_ID_F(), tid = wave * 64 + lane, fr = lane & 15, fq = lane >> 4;
    const bf16* ML = (const bf16*)(ws + WS_ML); const float* GT = (const float*)(ws + WS_GATES); const float* par = (const float*)(ws + WS_PAR);
    const bf16* CPBr = (const bf16*)(ws + WS_CPB); const float* MSC = (const float*)(ws + WS_MSC); bf16* BMo = (bf16*)(ws + WS_BM);
    LAS float* gsm = (LAS float*)(lds + GSM_OFF);
    LAS unsigned char* qt = lds; LAS unsigned char* kt = lds + TILE_B; LAS unsigned char* vt = lds + 2 * TILE_B; LAS unsigned char* ct = lds + 3 * TILE_B;
    const int srow = tid >> 4, c = tid & 15;
    struct B3Pre { v4u vr[4], cr[4]; };
#define B3_LOAD(P, item_) do { const int bh_ = (item_) >> 6, ch_ = (item_) & 63, h_ = bh_ & 3; const size_t r0_ = (size_t)(bh_ >> 2) * SEQ + ch_ * 128; \
        _Pragma("unroll") for (int i = 0; i < 4; ++i) { const int sr_ = srow + 32 * i; (P).vr[i] = *(const v4u*)(ML + (r0_ + sr_) * 2048 + 1024 + h_ * 128 + c * 8); (P).cr[i] = *(const v4u*)(CPBr + (size_t)(item_) * 16384 + sr_ * 128 + c * 8); \
            } } while (0)
    for (int base = 0; base < 1024; base += 4 * G) {
        B3Pre cur_;
        if (base + vcu < 1024) B3_LOAD(cur_, base + vcu);
        __syncthreads();
        { const int k = tid >> 7, s_ = tid & 127, it_ = base + vcu + G * k; const bool ok = it_ < 1024; const int itc = ok ? it_ : 0;
          const int bh = itc >> 6, ch = itc & 63, h = bh & 3; const size_t r = (size_t)(bh >> 2) * SEQ + ch * 128 + s_;
          const float lf = log_sigmoid_(GT[r * 8 + 4 + h] + par[PAR_FB + h]), li = GT[r * 8 + h] + par[PAR_IB + h];
          const float mprev = MSC[(size_t)itc * 256 + 130];
          float b_ = wave_scan_add(lf, lane);
          if (lane == 63) gsm[1664 + wave] = b_;
          __syncthreads();
          if (wave & 1) b_ += gsm[1664 + wave - 1];
          const float a_ = li - b_;
          float cm = wave_scan_max(a_, lane);
          if (lane == 63) gsm[1680 + wave] = cm;
          __syncthreads();
          if (wave & 1) cm = fmaxf(cm, gsm[1680 + wave - 1]);
          const float Mt = fmaxf(mprev, cm);
          gsm[k * 128 + s_] = a_; gsm[512 + k * 128 + s_] = Mt; gsm[1024 + k * 128 + s_] = b_ + Mt;
          if (s_ == 0) gsm[1696 + k] = mprev;
        }
        __syncthreads();
#pragma unroll 1
        for (int k = 0; k < 4; ++k) { const int item = base + vcu + G * k; if (item >= 1024) break;
            const int bh = item >> 6, ch = item & 63, h = bh & 3; const size_t row0 = (size_t)(bh >> 2) * SEQ + ch * 128;
            if (k > 0) __syncthreads();
            const float mprev = gsm[1696 + k];
            if (tid < 128) gsm[1536 + tid] = MSC[(size_t)item * 256 + tid];
            {
#pragma unroll
              for (int which = 0; which < 2; ++which) { float w[4][8], bs[8]; const int col = which * 512 + h * 128 + c * 8; LAS unsigned char* dt = which ? kt : qt; const float sc = which ? 0.08838834764831845f : 1.0f;
#pragma unroll
                for (int jt = 0; jt < 4; ++jt)
#pragma unroll
                    for (int u = 0; u < 8; ++u) w[jt][u] = par[PAR_CW + jt * 1024 + col + u];
#pragma unroll
                for (int u = 0; u < 8; ++u) bs[u] = par[PAR_CB + col + u];
#pragma unroll
                for (int i = 0; i < 4; ++i) { const int sr = srow + 32 * i; float o[8]; conv_piece(ML, row0 + sr, ch * 128 + sr, col, w, bs, o);
#pragma unroll
                    for (int u = 0; u < 8; ++u) o[u] *= sc;
                    *(LAS v4u*)(dt + sr * TP + c * 16) = pack8(o); } }
#pragma unroll
              for (int i = 0; i < 4; ++i) { const int sr = srow + 32 * i; *(LAS v4u*)(vt + sr * TP + c * 16) = cur_.vr[i]; *(LAS v4u*)(ct + sr * TP + c * 16) = cur_.cr[i]; } }
            { const int nitem = item + G; if (k < 3 && nitem < 1024) B3_LOAD(cur_, nitem); }
            __syncthreads();
            { const int trq = (lane & 15) >> 2, trp = lane & 3;
              bf16x8_t qf[4];
#pragma unroll
              for (int ds = 0; ds < 4; ++ds) qf[ds] = *(const LAS bf16x8_t*)(qt + (wave * 16 + fr) * TP + ds * 64 + fq * 16);
              const int t = wave * 16 + fr; const float Mt = gsm[512 + k * 128 + t], mt = gsm[1024 + k * 128 + t]; const float dec = __expf(mprev - Mt);
              const size_t orow = row0 + t;
              unsigned og[8];
#pragma unroll
              for (int fb = 0; fb < 8; ++fb) og[fb] = *(const unsigned*)(MO8 + orow * 512 + h * 128 + fb * 16 + 4 * fq);
              f32x4 acc[8];
#pragma unroll
              for (int fb = 0; fb < 8; ++fb) acc[fb] = (f32x4){0.f, 0.f, 0.f, 0.f};
#pragma unroll
              for (int ds = 0; ds < 4; ++ds) { const int ra = ds * 32 + 8 * fq + trq;
                  bf16x8_t cfr[8];
#pragma unroll
                  for (int fb = 0; fb < 8; ++fb) cfr[fb] = trpair(ct + ra * TP + (fb * 16 + 4 * trp) * 2, ct + (ra + 4) * TP + (fb * 16 + 4 * trp) * 2);
#pragma unroll
                  for (int fb = 0; fb < 8; ++fb) acc[fb] = __builtin_amdgcn_mfma_f32_16x16x32_bf16(cfr[fb], qf[ds], acc[fb], 0, 0, 0); }
              float qn = 0.f;
#pragma unroll
              for (int ds = 0; ds < 4; ++ds) { float qv[8]; unpack8(__builtin_bit_cast(v4u, qf[ds]), qv); const f32x4 n0 = *(const LAS f32x4*)(gsm + 1536 + ds * 32 + fq * 8), n1 = *(const LAS f32x4*)(gsm + 1536 + ds * 32 + fq * 8 + 4);
#pragma unroll
                  for (int u = 0; u < 4; ++u) qn += qv[u] * n0[u] + qv[4 + u] * n1[u]; }
              qn = pg8::xsum_16_32(qn);
#pragma unroll
              for (int fb = 0; fb < 8; ++fb) acc[fb] *= dec;
              f32x4 sacc[8]; float dsum = 0.f;
#pragma unroll
              for (int sb = 0; sb < 8; ++sb) { sacc[sb] = (f32x4){0.f, 0.f, 0.f, 0.f};
                  if (sb <= wave) {
                      bf16x8_t kfr[4];
#pragma unroll
                      for (int ds = 0; ds < 4; ++ds) kfr[ds] = *(const LAS bf16x8_t*)(kt + (sb * 16 + fr) * TP + ds * 64 + fq * 16);
#pragma unroll
                      for (int ds = 0; ds < 4; ++ds) sacc[sb] = __builtin_amdgcn_mfma_f32_16x16x32_bf16(kfr[ds], qf[ds], sacc[sb], 0, 0, 0);
                      const f32x4 a4 = *(const LAS f32x4*)(gsm + k * 128 + sb * 16 + 4 * fq);
#pragma unroll
                      for (int rg = 0; rg < 4; ++rg) { const int s_ = sb * 16 + 4 * fq + rg; const float p_ = (s_ <= t) ? sacc[sb][rg] * __expf(a4[rg] - Mt) : 0.f; sacc[sb][rg] = p_; dsum += p_; } } }
              dsum = pg8::xsum_16_32(dsum);
#pragma unroll
              for (int ks = 0; ks < 4; ++ks) { if (2 * ks <= wave) {
                  v4u pw; pw.x = pg8::cvt_pk_bf16(sacc[2 * ks][0], sacc[2 * ks][1]); pw.y = pg8::cvt_pk_bf16(sacc[2 * ks][2], sacc[2 * ks][3]);
                  pw.z = pg8::cvt_pk_bf16(sacc[2 * ks + 1][0], sacc[2 * ks + 1][1]); pw.w = pg8::cvt_pk_bf16(sacc[2 * ks + 1][2], sacc[2 * ks + 1][3]);
                  const bf16x8_t pf = __builtin_bit_cast(bf16x8_t, pw); const int ra = ks * 32 + 4 * fq + trq;
                  bf16x8_t vfr[8];
#pragma unroll
                  for (int fb = 0; fb < 8; ++fb) vfr[fb] = trpair(vt + ra * TP + (fb * 16 + 4 * trp) * 2, vt + (ra + 16) * TP + (fb * 16 + 4 * trp) * 2);
#pragma unroll
                  for (int fb = 0; fb < 8; ++fb) acc[fb] = __builtin_amdgcn_mfma_f32_16x16x32_bf16(vfr[fb], pf, acc[fb], 0, 0, 0); } }
              const float den = dec * qn + dsum; const float inv = __builtin_amdgcn_rcpf(fmaxf(fabsf(den), __expf(-mt)));
#pragma unroll
              for (int fb = 0; fb < 8; ++fb) {
                  const float i5 = inv * (1.0f / 255.0f); const unsigned o8 = og[fb];
                  v2u w_; w_.x = pg8::cvt_pk_bf16((float)(o8 & 255u) * acc[fb][0] * i5, (float)((o8 >> 8) & 255u) * acc[fb][1] * i5);
                  w_.y = pg8::cvt_pk_bf16((float)((o8 >> 16) & 255u) * acc[fb][2] * i5, (float)(o8 >> 24) * acc[fb][3] * i5);
                  *(v2u*)(BMo + orow * 512 + h * 128 + fb * 16 + 4 * fq) = w_; } }
        }
    }
    __syncthreads();
}

template <int NR> __device__ __forceinline__ void quant_rows_i8(const bf16* const (&src)[NR], unsigned char* const (&dst)[NR], float* const (&sc)[NR], int lane) {
    v4u ra[NR], rb[NR];
#pragma unroll
    for (int q = 0; q < NR; ++q) { ra[q] = *(const v4u*)(src[q] + lane * 16); rb[q] = *(const v4u*)(src[q] + lane * 16 + 8); }
#pragma unroll
    for (int q = 0; q < NR; ++q) { float f[16];
        { float t0[8], t1[8]; unpack8(ra[q], t0); unpack8(rb[q], t1);
#pragma unroll
          for (int u = 0; u < 8; ++u) { f[u] = t0[u]; f[8 + u] = t1[u]; } }
        float am = 0.f;
#pragma unroll
        for (int u = 0; u < 16; ++u) am = fmaxf(am, fabsf(f[u]));
        am = wave_max(am);
        const float inv = (am > 0.f) ? 127.0f / am : 0.f;
        unsigned w[4];
#pragma unroll
        for (int d4 = 0; d4 < 4; ++d4) { unsigned p = 0u;
#pragma unroll
            for (int u = 0; u < 4; ++u) { const int qi = (int)__builtin_rintf(f[d4 * 4 + u] * inv); p |= ((unsigned)qi & 255u) << (8 * u); }
            w[d4] = p; }
        *(v4u*)(dst[q] + lane * 16) = (v4u){w[0], w[1], w[2], w[3]};
        if (lane == 0) *sc[q] = (am > 0.f) ? am * (1.0f / 127.0f) : 1.0f; }
}
typedef __bf16 bf16x2_t __attribute__((ext_vector_type(2)));
__device__ __forceinline__ float dot2bf(unsigned a, unsigned b, float c) { return __builtin_amdgcn_fdot2_f32_bf16(__builtin_bit_cast(bf16x2_t, a), __builtin_bit_cast(bf16x2_t, b), c, false); }
struct QRows { v4u a[4], b[4]; float ss; };
template <bool GATES> __device__ __forceinline__ void qrows_load(QRows& q, const bf16* HBr, const float* RSr, int lane) {
#pragma unroll
    for (int r = 0; r < 4; ++r) { q.a[r] = *(const v4u*)(HBr + (size_t)r * D + lane * 16); q.b[r] = *(const v4u*)(HBr + (size_t)r * D + lane * 16 + 8); }
    if constexpr (GATES) q.ss = RSr[lane]; else q.ss = 0.f;
}
template <bool GATES> __device__ __forceinline__ void quant_rows_gates4(const QRows& qr, unsigned char* H8r, float* SCHr, float* GTr, const v4u (&wg)[8][2], int lane) {
    float ss = qr.ss;
    if constexpr (GATES) { ss += __shfl_xor(ss, 1); ss += __shfl_xor(ss, 2); ss += __shfl_xor(ss, 4); ss += __shfl_xor(ss, 8); }
#pragma unroll
    for (int q = 0; q < 4; ++q) { float f[16];
        { float t0[8], t1[8]; unpack8(qr.a[q], t0); unpack8(qr.b[q], t1);
#pragma unroll
          for (int u = 0; u < 8; ++u) { f[u] = t0[u]; f[8 + u] = t1[u]; } }
        float am = 0.f;
#pragma unroll
        for (int u = 0; u < 16; ++u) am = fmaxf(am, fabsf(f[u]));
        am = wave_max(am);
        const float inv = (am > 0.f) ? 127.0f / am : 0.f;
        unsigned w[4];
#pragma unroll
        for (int d4 = 0; d4 < 4; ++d4) { unsigned p = 0u;
#pragma unroll
            for (int u = 0; u < 4; ++u) { const int qi = (int)__builtin_rintf(f[d4 * 4 + u] * inv); p |= ((unsigned)qi & 255u) << (8 * u); }
            w[d4] = p; }
        *(v4u*)(H8r + (size_t)q * D + lane * 16) = (v4u){w[0], w[1], w[2], w[3]};
        if (lane == 0) SCHr[q] = (am > 0.f) ? am * (1.0f / 127.0f) : 1.0f;
        if constexpr (GATES) {
        float d[8];
#pragma unroll
        for (int j = 0; j < 8; ++j) { float a = 0.f;
            a = dot2bf(qr.a[q].x, wg[j][0].x, a); a = dot2bf(qr.a[q].y, wg[j][0].y, a); a = dot2bf(qr.a[q].z, wg[j][0].z, a); a = dot2bf(qr.a[q].w, wg[j][0].w, a);
            a = dot2bf(qr.b[q].x, wg[j][1].x, a); a = dot2bf(qr.b[q].y, wg[j][1].y, a); a = dot2bf(qr.b[q].z, wg[j][1].z, a); a = dot2bf(qr.b[q].w, wg[j][1].w, a);
            d[j] = a; }
        const bool h5 = (lane & 32) != 0, h4 = (lane & 16) != 0, h3 = (lane & 8) != 0;
        float e[4];
#pragma unroll
        for (int i = 0; i < 4; ++i) { const float keep = h5 ? d[4 + i] : d[i], send = h5 ? d[i] : d[4 + i]; e[i] = keep + __shfl_xor(send, 32); }
        float g2[2];
#pragma unroll
        for (int i = 0; i < 2; ++i) { const float keep = h4 ? e[2 + i] : e[i], send = h4 ? e[i] : e[2 + i]; g2[i] = keep + __shfl_xor(send, 16); }
        float v = (h3 ? g2[1] : g2[0]) + __shfl_xor(h3 ? g2[0] : g2[1], 8);
        v += __shfl_xor(v, 4); v += __shfl_xor(v, 2); v += __shfl_xor(v, 1);
        const float r = __builtin_amdgcn_rsqf(__shfl(ss, q * 16) * (1.0f / 1024.0f) + pg8::RMS_EPS);
        if ((lane & 7) == 0) GTr[q * 8 + (lane >> 3)] = v * r; } }
}
__global__ void __launch_bounds__(NTHREADS, 2) mega(Args args) {
    extern __shared__ __attribute__((aligned(16))) unsigned char lds_raw[];
    LAS unsigned char* lds = (LAS unsigned char*)lds_raw;
    volatile LAS unsigned* MISC = (volatile LAS unsigned*)(lds + MISC_OFF);
    const int wave = __builtin_amdgcn_readfirstlane(threadIdx.x >> 6);
#define LANE_ID() ({ int _l; asm volatile("v_mbcnt_lo_u32_b32 %0, -1, 0\n\tv_mbcnt_hi_u32_b32 %0, -1, %0" : "=v"(_l)); _l; })
    const int G = gridDim.x; const int bx = blockIdx.x; const int vcu = (G % 8 == 0) ? (bx % 8) * (G / 8) + bx / 8 : bx;
    unsigned char* ws = args.ws;
    gu32* ctl = (gu32*)(ws + WS_CTL);
    { const int tid = wave * 64 + LANE_ID(); for (int u = tid; u < (LDS_BYTES - LDSCTL_OFF) / 4; u += NTHREADS) ((LAS unsigned*)(lds + LDSCTL_OFF))[u] = 0u; }
    __syncthreads();
    XcdBarrier bar; bar.bar = (unsigned*)(ctl + CW_BAR); bar.x = 0; bar.st = nullptr;
#if !MK_PER_PHASE
    bar = xcd_barrier_post((unsigned*)(ctl + CW_BAR), MISC + 8, (wave == 0) && (LANE_ID() == 0));
#define GRID_BAR() xcd_barrier(bar, (wave == 0) && (LANE_ID() == 0))
#else
#define GRID_BAR() do {} while (0)
#endif
    const int lo = args.ph_lo, hi = args.ph_hi;
#define IN(k) (lo <= (k) && (k) < hi)
#define SEAM(k) do { if (IN(k) && IN((k) + 1)) { GRID_BAR(); if (PROBE_MASK & (1u << 29)) { GRID_BAR(); GRID_BAR(); } } } while (0)
    const int gw = vcu * NWAVES + wave, NGW = G * NWAVES;
    bf16* HB = (bf16*)(ws + WS_HB); float* RS = (float*)(ws + WS_RS);

    if (IN(0)) REP(0) {
        const int lane = LANE_ID(), tid = wave * 64 + lane;
        LAS float* scr = (LAS float*)(lds + wave * 16640);
        {
            const WD* wd = c_wd;
            int base = 0;
#pragma unroll 1
            for (int w = 0; w < 10; ++w) { const int K = wd[w].K, Nsrc = wd[w].Nsrc, Ndst = wd[w].Ndst, kind = wd[w].kind; const int nit = (K / 64) * (Ndst / 64);
                const float* W = args.in[wd[w].src]; const float* gn = wd[w].gain >= 0 ? args.in[wd[w].gain] : nullptr; bf16* WT = (bf16*)(ws + wd[w].dst);
                int first = (gw - base) % NGW; if (first < 0) first += NGW;
                for (int it = first; it < nit; it += NGW) p0_transpose_item(W, gn, K, Nsrc, Ndst, WT, kind, scr, it, lane);
                base = (base + nit) % NGW; }
        }
        const float* x = args.in[I_X];
        for (int m0 = gw * 4; m0 < M; m0 += NGW * 4) {
            f32x4 v[4][4]; float s4[4];
#pragma unroll
            for (int q = 0; q < 4; ++q) { const GAS f32x4* xr = (const GAS f32x4*)(x + (size_t)(m0 + q) * D) + lane;
#pragma unroll
                for (int j = 0; j < 4; ++j) v[q][j] = xr[64 * j]; }
#pragma unroll
            for (int q = 0; q < 4; ++q) { float s_ = 0.f;
#pragma unroll
                for (int j = 0; j < 4; ++j) s_ += (v[q][j][0] * v[q][j][0] + v[q][j][1] * v[q][j][1]) + (v[q][j][2] * v[q][j][2] + v[q][j][3] * v[q][j][3]);
                s4[q] = wave_sum(s_);
                float am = 0.f;
#pragma unroll
                for (int j = 0; j < 4; ++j) am = fmaxf(fmaxf(am, fmaxf(fabsf(v[q][j][0]), fabsf(v[q][j][1]))), fmaxf(fabsf(v[q][j][2]), fabsf(v[q][j][3])));
                am = wave_max(am); const float inv = (am > 0.f) ? 127.0f / am : 0.f;
                GAS unsigned* o4 = (GAS unsigned*)((unsigned char*)args.out + (size_t)(m0 + q) * D) + lane;
                GAS unsigned* e4 = (GAS unsigned*)((unsigned char*)args.out + (size_t)64 * MiB + (size_t)(m0 + q) * D) + lane;
#pragma unroll
                for (int j = 0; j < 4; ++j) { unsigned pq = 0u, pe = 0u;
#pragma unroll
                    for (int u = 0; u < 4; ++u) { const float t_ = v[q][j][u] * inv, qf_ = __builtin_rintf(t_); pq |= ((unsigned)(int)qf_ & 255u) << (8 * u); pe |= ((unsigned)(int)__builtin_rintf((t_ - qf_) * 254.0f) & 255u) << (8 * u); }
                    o4[64 * j] = pq; e4[64 * j] = pe; }
                if (lane == 0) ((float*)(ws + WS_SCX))[m0 + q] = (am > 0.f) ? am * (1.0f / 127.0f) : 1.0f; }
            { const int q = lane >> 4, sl = lane & 15; const float sv = (q == 0) ? s4[0] : (q == 1) ? s4[1] : (q == 2) ? s4[2] : s4[3]; RS[(size_t)(m0 + q) * 16 + sl] = (sl == 0) ? sv : 0.f; }
        }
        const float* p = args.in[I_P]; bf16* PB = (bf16*)(ws + WS_PB);
        for (int m = gw; m < M; m += NGW) { const f32x4 v = *((const GAS f32x4*)(p + (size_t)m * PLE) + lane); v2u o; o.x = pk2(v[0], v[1]); o.y = pk2(v[2], v[3]); *((GAS v2u*)(PB + (size_t)m * PLE) + lane) = o; }
        if (bx == 0) { float* par = (float*)(ws + WS_PAR);
            for (int e = tid; e < PAR_N; e += NTHREADS) { float v;
                if (e < PAR_KG) v = args.in[I_QG][e]; else if (e < PAR_CW) v = args.in[I_KG][e - PAR_KG]; else if (e < PAR_CB) v = args.in[I_CW][e - PAR_CW];
                else if (e < PAR_IB) v = args.in[I_CB][e - PAR_CB]; else if (e < PAR_FB) v = args.in[I_IB][e - PAR_IB]; else v = args.in[I_FB][e - PAR_FB];
                par[e] = v; } }
        float* rope = (float*)(ws + WS_ROPE);
        for (int e = vcu * NTHREADS + tid; e < SEQ * 16; e += G * NTHREADS) { const int t = e >> 4, i = e & 15;
            const float invf = c_invfreq[i];
            const float ang = (float)t * invf; const double rev = (double)ang * 0.15915494309189535; const float fr = (float)(rev - __builtin_floor(rev));
            rope[e * 2] = __builtin_amdgcn_cosf(fr); rope[e * 2 + 1] = __builtin_amdgcn_sinf(fr); }
    }
    using namespace pg8;
    if (IN(0)) { GRID_BAR();
        const int lane = LANE_ID(); const bf16* WT = (const bf16*)(ws + WS_WIN); unsigned char* W8 = ws + WS_W8; float* SCWw = (float*)(ws + WS_SCW);
        const bf16* W1T = (const bf16*)(ws + WS_W1IN); unsigned char* W18 = ws + WS_W1IN8; float* SC1w = (float*)(ws + WS_SC1);
        const bf16* W2T = (const bf16*)(ws + WS_W2IN); unsigned char* W28 = ws + WS_W2IN8; float* SC2w = (float*)(ws + WS_SC2);
        for (int n = gw; n < 7168 + 2 * 5632; n += NGW) {
            const bf16* sp_; unsigned char* dp_; float* cp_;
            if (n < 7168) { const int srow = (n < 4608) ? n : (n < 6656) ? n + (WIN_G - 4608) : n + (WIN_ML + 1536 - 6656); sp_ = WT + (size_t)srow * D; dp_ = W8 + (size_t)n * D; cp_ = SCWw + n; }
            else if (n < 7168 + 5632) { const int r_ = n - 7168; sp_ = W1T + (size_t)r_ * D; dp_ = W18 + (size_t)r_ * D; cp_ = SC1w + r_; }
            else { const int r_ = n - 7168 - 5632; sp_ = W2T + (size_t)r_ * D; dp_ = W28 + (size_t)r_ * D; cp_ = SC2w + r_; }
            const bf16* const src[1] = {sp_}; unsigned char* const dst[1] = {dp_}; float* const sc[1] = {cp_};
            quant_rows_i8<1>(src, dst, sc, lane); } }
    SEAM(0);
    if (IN(1)) REP(1) { Gemm g{(const bf16*)args.out, (const bf16*)(ws + WS_W1IN8), M, 2 * FF, D / 2, (const float*)(ws + WS_SC1), (const float*)(ws + WS_SCX)}; StaticOrder S; S.init(M, 2 * FF, G, bx);
        EpiSwiglu E{(bf16*)(ws + WS_HID), FF, RS}; gemm_phase<EpiSwiglu, StaticOrder, true, true, false, true>(lds, g, S, E, wave); }
    SEAM(1);
    if (IN(2)) REP(2) { Gemm g{(const bf16*)(ws + WS_HID), (const bf16*)(ws + WS_W1OUT), M, D, FF}; StaticOrder S; S.init(M, D, G, bx);
        EpiResidX E{(const unsigned char*)args.out, (const unsigned char*)args.out + (size_t)64 * MiB, (const float*)(ws + WS_SCX), HB, RS, 0.5f}; gemm_phase<EpiResidX, StaticOrder, true, true>(lds, g, S, E, wave); }
    SEAM(2);
    unsigned char* H8 = (unsigned char*)args.out; float* SCH = (float*)((unsigned char*)args.out + (size_t)32 * MiB);
    const float* SCW = (const float*)(ws + WS_SCW); const bf16* W8b = (const bf16*)(ws + WS_W8); const bf16* H8b = (const bf16*)H8;
    if (IN(3)) { { const int lane = LANE_ID();
            v4u wg[8][2];
#pragma unroll
            for (int j = 0; j < 8; ++j) { const bf16* wr_ = (const bf16*)(ws + WS_WIN) + (size_t)(WIN_GT + j) * D + lane * 16; wg[j][0] = *(const v4u*)wr_; wg[j][1] = *(const v4u*)(wr_ + 8); }
            QRows cur, nx; int m0 = gw * 4; qrows_load<true>(cur, HB + (size_t)m0 * D, RS + (size_t)m0 * 16, lane);
            for (; m0 < M; m0 += NGW * 4) { const int m1 = m0 + NGW * 4; nx = cur; if (m1 < M) qrows_load<true>(nx, HB + (size_t)m1 * D, RS + (size_t)m1 * 16, lane);
                quant_rows_gates4<true>(cur, H8 + (size_t)m0 * D, SCH + m0, (float*)(ws + WS_GATES) + (size_t)m0 * 8, wg, lane); cur = nx; } }
        REP(3) { Gemm g{HB, (const bf16*)(ws + WS_WIN) + (size_t)WIN_ML * D, M, 1536, D}; StaticOrder S; S.init(M, 1536, G, bx);
        EpiZ E{(bf16*)(ws + WS_ML), 2048, RS, -1, nullptr}; gemm_phase<EpiZ, StaticOrder, true, true>(lds, g, S, E, wave); } }
    SEAM(3);
    const bf16* QKV0 = (const bf16*)(ws + WS_QKV); const bf16* QKV1 = (const bf16*)(ws + WS_QKV1); bf16* GB = (bf16*)(ws + WS_G);
#define QKV_GEMM8(grp, dstp) do { Gemm g{H8b, W8b + (size_t)(grp) * 1536 * (D / 2), M, 1536, D / 2, SCW + (grp) * 1536, SCH}; StaticOrder S; S.init(M, 1536, G, bx); \
        EpiQKV E{(bf16*)(dstp), RS, (const float*)(ws + WS_PAR) + PAR_QG, (const float*)(ws + WS_PAR) + PAR_KG, (const float*)(ws + WS_ROPE), (PG8_LAS float*)(lds + QKP_OFF)}; \
        gemm_phase<EpiQKV, StaticOrder, true, true, false, true>(lds, g, S, E, wave); } while (0)
    if (IN(4)) { REP(5) QKV_GEMM8(0, ws + WS_QKV);
        { Gemm g{H8b, W8b + (size_t)6656 * (D / 2), M, 512, D / 2, SCW + 6656, SCH}; StaticOrder S; S.init(M, 512, G, bx);
        EpiSig8 E{(unsigned char*)args.out + (size_t)40 * MiB, RS}; gemm_phase<EpiSig8, StaticOrder, true, true, false, true>(lds, g, S, E, wave); }
        REP(24) mlstm_b1(ws, lds, wave, vcu, G); GRID_BAR(); mlstm_b2(ws, wave, vcu, G); GRID_BAR(); REP(25) mlstm_b3(ws, (const unsigned char*)args.out + (size_t)40 * MiB, lds, wave, vcu, G); }
    SEAM(4);
    if (IN(5)) { attn_fast(ws, QKV0, lds, 0, wave, vcu, G); REP(6) { if (rep_) attn_fast(ws, QKV0, lds, 0, wave, vcu, G); }
        REP(5) QKV_GEMM8(1, ws + WS_QKV1); }
    SEAM(5);
    if (IN(6)) { attn_fast(ws, QKV1, lds, 1, wave, vcu, G);
        REP(5) QKV_GEMM8(2, ws + WS_QKV); }
    SEAM(6);
    if (IN(7)) { attn_fast(ws, QKV0, lds, 2, wave, vcu, G);
        REP(11) { Gemm g{H8b, W8b + (size_t)4608 * (D / 2), M, 2048, D / 2, SCW + 4608, SCH}; StaticOrder S; S.init(M, 2048, G, bx);
        EpiGF E{(unsigned char*)GB, (unsigned char*)GB + (size_t)M * 1024, RS}; gemm_phase<EpiGF, StaticOrder, true, true, false, true>(lds, g, S, E, wave); } }
    SEAM(7);
#undef QKV_GEMM8
    if (IN(8)) REP(12) { Gemm g{(const bf16*)(ws + WS_A), (const bf16*)(ws + WS_WUPA), M, D, 512, nullptr, nullptr, (const bf16*)(ws + WS_BM), (const bf16*)(ws + WS_WUPB)}; PairOrder S; S.init(M, D, G, bx);
        EpiGate2 E{(const unsigned char*)GB, (const unsigned char*)GB + (size_t)M * 1024, (bf16*)(ws + WS_MERGED)}; gemm_phase<EpiGate2, PairOrder, true, true>(lds, g, S, E, wave); }
    SEAM(8);
    if (IN(9)) { Gemm g{(const bf16*)(ws + WS_MERGED), (const bf16*)(ws + WS_WO), M, D, D}; StaticOrder S; S.init(M, D, G, bx);
        EpiResidQ E{HB, RS, 1.0f, (unsigned*)(ws + WS_ROWMAX), (unsigned*)(ws + WS_PCNT), H8, SCH}; gemm_phase<EpiResidQ, StaticOrder, true, true>(lds, g, S, E, wave); }
    SEAM(9);
    if (IN(10)) {
        REP(15) { Gemm g{H8b, (const bf16*)(ws + WS_W2IN8), M, 2 * FF, D / 2, (const float*)(ws + WS_SC2), SCH}; StaticOrder S; S.init(M, 2 * FF, G, bx);
        EpiSwiglu E{(bf16*)(ws + WS_HID), FF, RS}; gemm_phase<EpiSwiglu, StaticOrder, true, true, false, true>(lds, g, S, E, wave); } }
    SEAM(10);
    if (IN(11)) { { Gemm g{(const bf16*)(ws + WS_HID), (const bf16*)(ws + WS_W2OUT), M, D, FF}; StaticOrder S; S.init(M, D, G, bx);
        EpiResid<false> E{nullptr, HB, HB, RS, 0.5f}; gemm_phase<EpiResid<false>, StaticOrder, true, true>(lds, g, S, E, wave); }
        }
    SEAM(11);
    if (IN(12)) { Gemm g{HB, (const bf16*)(ws + WS_WPG), M, D, D, nullptr, nullptr, (const bf16*)(ws + WS_PB), (const bf16*)(ws + WS_WPE), PLE}; PairOrder S; S.init(M, D, G, bx);
        EpiFinal2 E{args.out, HB, RS}; gemm_phase_dk<EpiFinal2>(lds, g, S, E, wave); }
#undef IN
#undef SEAM
}

extern "C" void kernel_launch(void* const* d_in, const int* in_sizes, int n_in, void* d_out, int out_size, void* d_ws, size_t ws_size, hipStream_t stream) {
    static int grid = 0;
    if (grid == 0) {
        if (n_in != 22 || in_sizes[0] != M * D || out_size != M * D || ws_size < WS_END) { fprintf(stderr, "kernel_launch: unexpected shapes (n_in %d, in0 %d, out %d, ws %zu)\n", n_in, n_in > 0 ? in_sizes[0] : -1, out_size, ws_size); grid = -1; return; }
        int dev = 0, cus = 0;
        if (hipGetDevice(&dev) != hipSuccess || hipDeviceGetAttribute(&cus, hipDeviceAttributeMultiprocessorCount, dev) != hipSuccess) { grid = -1; return; }
        if (hipFuncSetAttribute((const void*)mega, hipFuncAttributeMaxDynamicSharedMemorySize, LDS_BYTES) != hipSuccess) { fprintf(stderr, "kernel_launch: hipFuncSetAttribute failed\n"); grid = -1; return; }
        (void)hipGetLastError();
        grid = cus;
    }
    if (grid < 0) return;
    (void)hipMemsetAsync((char*)d_ws + WS_CTL, 0, CTL_ZERO_BYTES, stream);
    Args a{};
    for (int i = 0; i < 22; ++i) a.in[i] = (const float*)d_in[i];
    a.out = (float*)d_out; a.ws = (unsigned char*)d_ws;
#if MK_PER_PHASE
    for (int ph = 0; ph < NPHASE; ++ph) { a.ph_lo = ph; a.ph_hi = ph + 1; hipLaunchKernelGGL(mega, dim3(grid), dim3(NTHREADS), LDS_BYTES, stream, a); }
#else
    a.ph_lo = 0; a.ph_hi = NPHASE; hipLaunchKernelGGL(mega, dim3(grid), dim3(NTHREADS), LDS_BYTES, stream, a);
#endif
}
```

```cpp
#include <hip/hip_runtime.h>
#include <cstdio>
#include <cstdint>

#ifndef PROBE_MASK
#define PROBE_MASK 0u
#endif
#define REP(k) for (int rep_ = 0; rep_ < 1 + (int)((PROBE_MASK >> (k)) & 1u); ++rep_)
#ifndef MK_PER_PHASE
#define MK_PER_PHASE 0
#endif

namespace pg8 {
#define PG8_LAS __attribute__((address_space(3)))
typedef unsigned short bf16_t;
typedef short bf16x8 __attribute__((ext_vector_type(8)));
typedef float f32x4 __attribute__((ext_vector_type(4)));
typedef unsigned u32x4 __attribute__((ext_vector_type(4)));
constexpr int BM = 256, BK = 64, HALF = 128, HTB = HALF * BK * 2, STAGE_BYTES = 8 * HTB, NXCD = 8, WGM = 8;

__host__ __device__ __forceinline__ int lds_byte(int r, int c) { const int st = (r >> 4) * 2 + (c >> 5), rr = r & 15, cc = c & 31, ob = rr * 64 + cc * 2; return st * 1024 + (ob ^ (((ob >> 9) & 1) << 5)); }
__host__ __device__ __forceinline__ void stage_rc(int b, int& R, int& C) { const int st = b / 1024, sb = b % 1024, swz = sb ^ (((sb >> 9) & 1) << 5); R = (st >> 1) * 16 + swz / 64; C = (st & 1) * 32 + (swz % 64) / 2; }
__host__ __device__ __forceinline__ int perm32(int rho) { const int n = rho >> 4, i = rho & 15; return 8 * (i >> 2) + 4 * n + (i & 3); }

struct Unit { int pm, pn, w; };
struct Gemm { const bf16_t* A; const bf16_t* Bt; int M, N, K; const float* scw; const float* sch; const bf16_t* A2; const bf16_t* Bt2; int K2; };
typedef int i32x4 __attribute__((ext_vector_type(4)));

struct StaticOrder {
    static constexpr bool PAIR = false;
    int nM, nN, nwg, G, c;
    __host__ __device__ void init(int M, int N, int G_, int c_) { nM = M / BM; nN = N / BM; nwg = nM * nN; G = G_; c = c_; }
    __host__ __device__ bool next(int i, Unit& u) const {
        const long L = (long)i * G + c; if (L >= nwg) return false;
        int wgid = (int)L; { const int q = nwg / NXCD, r = nwg % NXCD, xcd = wgid % NXCD, off = wgid / NXCD; wgid = (xcd < r ? xcd * (q + 1) : r * (q + 1) + (xcd - r) * q) + off; }
        const int nig = WGM * nN, gid = wgid / nig, fm = gid * WGM, gsz = (nM - fm) < WGM ? (nM - fm) : WGM;
        u.pm = fm + ((wgid % nig) % gsz); u.pn = (wgid % nig) / gsz; u.w = 0; return true;
    }
};
struct PairOrder {
    static constexpr bool PAIR = true;
    StaticOrder base;
    __host__ __device__ void init(int M, int N, int G_, int c_) { base.init(M, N, G_, c_); }
    __host__ __device__ bool next(int i, Unit& u) const { const bool ok = base.next(i >> 1, u); u.w = i & 1; return ok; }
};

__device__ __forceinline__ unsigned cvt_pk_bf16(float lo, float hi) { unsigned r; asm volatile("v_cvt_pk_bf16_f32 %0, %1, %2" : "=v"(r) : "v"(lo), "v"(hi)); return r; }
__device__ __forceinline__ float bf_lo(unsigned u) { return __uint_as_float(u << 16); }
__device__ __forceinline__ float bf_hi(unsigned u) { return __uint_as_float(u & 0xffff0000u); }

constexpr float RMS_EPS = 1e-6f;
constexpr int RTAB_OFF = 152576;
__device__ __forceinline__ float sigmoidf_(float v) { return __builtin_amdgcn_rcpf(1.0f + __builtin_amdgcn_exp2f(-1.4426950408889634f * v)); }
__device__ __forceinline__ void swap16_(float& a, float& b) { asm volatile("s_nop 1\n\tv_permlane16_swap_b32 %0, %1" : "+v"(a), "+v"(b)); }
__device__ __forceinline__ void swap32_(float& a, float& b) { asm volatile("s_nop 1\n\tv_permlane32_swap_b32 %0, %1" : "+v"(a), "+v"(b)); }
__device__ __forceinline__ float xsum_16_32(float x) { float a = x, b = x; swap16_(a, b); x = a + b; a = x; b = x; swap32_(a, b); return a + b; }
__device__ __forceinline__ float xmax_16_32(float x) { float a = x, b = x; swap16_(a, b); x = fmaxf(a, b); a = x; b = x; swap32_(a, b); return fmaxf(a, b); }
__device__ __forceinline__ float xor32_(float x, bool hi) { float a = x, b = x; swap32_(a, b); return hi ? a : b; }
struct EpiSwiglu {
    static constexpr bool PERM = true, AFTER_DRAIN = false, NEED_R = true;
    bf16_t* O; int ldc; const float* RS;
    __device__ __forceinline__ void operator()(f32x4 (&acc)[2][2][4][2], const Unit& u, int wr, int wc, int fr, int fq, const PG8_LAS float* rtab) const {
        const int row0 = u.pm * BM + wr * 64 + fr, col0 = u.pn * HALF + wc * 32 + 8 * fq;
#pragma unroll
        for (int ai = 0; ai < 2; ++ai)
#pragma unroll
            for (int m = 0; m < 4; ++m) { const int row = row0 + ai * HALF + m * 16; const float r = rtab[ai * HALF + wr * 64 + m * 16 + fr];
                const float rl = r * -1.4426950408889634f, r2 = r * r; f32x4 hv[2];
#pragma unroll
                for (int n = 0; n < 2; ++n) { const f32x4 a = acc[ai][0][m][n], b = acc[ai][1][m][n]; const f32x4 t = a * rl; f32x4 e;
                    e[0] = __builtin_amdgcn_exp2f(t[0]); e[1] = __builtin_amdgcn_exp2f(t[1]); e[2] = __builtin_amdgcn_exp2f(t[2]); e[3] = __builtin_amdgcn_exp2f(t[3]);
                    const f32x4 d = e + 1.0f; f32x4 q;
                    q[0] = __builtin_amdgcn_rcpf(d[0]); q[1] = __builtin_amdgcn_rcpf(d[1]); q[2] = __builtin_amdgcn_rcpf(d[2]); q[3] = __builtin_amdgcn_rcpf(d[3]);
                    hv[n] = (a * b) * (q * r2); }
                u32x4 w; w.x = cvt_pk_bf16(hv[0][0], hv[0][1]); w.y = cvt_pk_bf16(hv[0][2], hv[0][3]); w.z = cvt_pk_bf16(hv[1][0], hv[1][1]); w.w = cvt_pk_bf16(hv[1][2], hv[1][3]);
                *(u32x4*)(O + (size_t)row * ldc + col0) = w; }
    }
};
template <bool BASE_F32> struct EpiResid {
    static constexpr bool PERM = true, AFTER_DRAIN = false, NEED_R = false;
    const float* basef; const bf16_t* baseh; bf16_t* HBo; float* RSo; float alpha;
    __device__ __forceinline__ void operator()(f32x4 (&acc)[2][2][4][2], const Unit& u, int wr, int wc, int fr, int fq, const PG8_LAS float*) const {
        const int row0 = u.pm * BM + wr * 64 + fr, col0 = u.pn * BM + wc * 32 + 8 * fq;
#pragma unroll
        for (int ai = 0; ai < 2; ++ai) {
            f32x4 bv[4][2][2];
#pragma unroll
            for (int m = 0; m < 4; ++m)
#pragma unroll
                for (int bj = 0; bj < 2; ++bj) { const size_t off = (size_t)(row0 + ai * HALF + m * 16) * 1024 + col0 + bj * HALF;
                    if constexpr (BASE_F32) { bv[m][bj][0] = *(const f32x4*)(basef + off); bv[m][bj][1] = *(const f32x4*)(basef + off + 4); }
                    else { const u32x4 p = *(const u32x4*)(baseh + off); bv[m][bj][0] = (f32x4){bf_lo(p.x), bf_hi(p.x), bf_lo(p.y), bf_hi(p.y)}; bv[m][bj][1] = (f32x4){bf_lo(p.z), bf_hi(p.z), bf_lo(p.w), bf_hi(p.w)}; } }
            asm volatile("" ::: "memory");
#pragma unroll
            for (int m = 0; m < 4; ++m) { const int row = row0 + ai * HALF + m * 16; float ssq = 0.f;
#pragma unroll
                for (int bj = 0; bj < 2; ++bj) { const size_t off = (size_t)row * 1024 + col0 + bj * HALF;
                    const f32x4 v0 = bv[m][bj][0] + acc[ai][bj][m][0] * alpha, v1 = bv[m][bj][1] + acc[ai][bj][m][1] * alpha;
                    u32x4 w; w.x = cvt_pk_bf16(v0[0], v0[1]); w.y = cvt_pk_bf16(v0[2], v0[3]); w.z = cvt_pk_bf16(v1[0], v1[1]); w.w = cvt_pk_bf16(v1[2], v1[3]);
                    *(u32x4*)(HBo + off) = w;
                    ssq += (v0[0] * v0[0] + v0[1] * v0[1]) + (v0[2] * v0[2] + v0[3] * v0[3]) + (v1[0] * v1[0] + v1[1] * v1[1]) + (v1[2] * v1[2] + v1[3] * v1[3]); }
                ssq = xsum_16_32(ssq);
                if (fq == 0) RSo[(size_t)row * 16 + u.pn * 4 + wc] = ssq; }
            asm volatile("" ::: "memory"); }
    }
};
struct EpiZ {
    static constexpr bool PERM = true, AFTER_DRAIN = false, NEED_R = true;
    bf16_t* O; int ldc; const float* RS; int gate_pn; float* GATES;
    __device__ __forceinline__ void operator()(f32x4 (&acc)[2][2][4][2], const Unit& u, int wr, int wc, int fr, int fq, const PG8_LAS float* rtab) const {
        const int row0 = u.pm * BM + wr * 64 + fr, col0 = u.pn * BM + wc * 32 + 8 * fq;
        const bool gate = (u.pn == gate_pn);
#pragma unroll
        for (int ai = 0; ai < 2; ++ai)
#pragma unroll
            for (int m = 0; m < 4; ++m) { const int row = row0 + ai * HALF + m * 16; const float r = rtab[ai * HALF + wr * 64 + m * 16 + fr];
                if (gate) { if (wc == 0 && fq == 0) { *(f32x4*)(GATES + (size_t)row * 8) = acc[ai][0][m][0] * r; *(f32x4*)(GATES + (size_t)row * 8 + 4) = acc[ai][0][m][1] * r; } }
                else {
#pragma unroll
                    for (int bj = 0; bj < 2; ++bj) { const f32x4 v0 = acc[ai][bj][m][0] * r, v1 = acc[ai][bj][m][1] * r;
                        u32x4 w; w.x = cvt_pk_bf16(v0[0], v0[1]); w.y = cvt_pk_bf16(v0[2], v0[3]); w.z = cvt_pk_bf16(v1[0], v1[1]); w.w = cvt_pk_bf16(v1[2], v1[3]);
                        *(u32x4*)(O + (size_t)row * ldc + col0 + bj * HALF) = w; } } }
    }
};
constexpr int QKP_OFF = 131072;
struct EpiQKV {
    static constexpr bool PERM = true, AFTER_DRAIN = false, NEED_R = true;
    bf16_t* O; const float* RS; const float* par_qg; const float* par_kg; const float* rope; PG8_LAS float* part;
    __device__ __forceinline__ void operator()(f32x4 (&acc)[2][2][4][2], const Unit& u, int wr, int wc, int fr_, int fq_, const PG8_LAS float* rtab) const {
        int lane_; asm volatile("v_mbcnt_lo_u32_b32 %0, -1, 0\n\tv_mbcnt_hi_u32_b32 %0, -1, %0" : "=v"(lane_));
        const int fr = lane_ & 15, fq = lane_ >> 4; (void)fr_; (void)fq_;
        const int row0 = u.pm * BM + wr * 64 + fr, col0 = u.pn * BM + wc * 32 + 8 * fq;
        const bool isq = u.pn < 2, isqk = u.pn < 4;
#pragma unroll
        for (int ai = 0; ai < 2; ++ai)
#pragma unroll
            for (int m = 0; m < 4; ++m) { const int rl = ai * HALF + wr * 64 + m * 16 + fr; const float r = rtab[rl];
#pragma unroll
                for (int bj = 0; bj < 2; ++bj) { acc[ai][bj][m][0] *= r; acc[ai][bj][m][1] *= r;
                    if (isqk) { const f32x4 a = acc[ai][bj][m][0], b = acc[ai][bj][m][1];
                        float ssq = (a[0] * a[0] + a[1] * a[1]) + (a[2] * a[2] + a[3] * a[3]) + (b[0] * b[0] + b[1] * b[1]) + (b[2] * b[2] + b[3] * b[3]);
                        ssq = xsum_16_32(ssq);
                        if (fq == 0) part[(rl * 2 + bj) * 4 + wc] = ssq; } } }
        if (isqk) {
            asm volatile("s_waitcnt lgkmcnt(0)" ::: "memory"); __builtin_amdgcn_s_barrier(); asm volatile("" ::: "memory");
            const float* G_ = isq ? par_qg : par_kg; const int L = 4 * wc + fq;
            const f32x4 g0 = (f32x4){G_[L], G_[16 + L], G_[32 + 6 * L], G_[33 + 6 * L]}, g1 = (f32x4){G_[34 + 6 * L], G_[35 + 6 * L], G_[36 + 6 * L], G_[37 + 6 * L]};
            const float qs = isq ? (0.08838834764831845f * 1.4426950408889634f) : 1.0f;
#pragma unroll
            for (int am = 0; am < 4; ++am) {
                float cs[2][2];
#pragma unroll
                for (int mm = 0; mm < 2; ++mm) { const int ai = am >> 1, m = (am & 1) * 2 + mm; const int pos = (row0 + ai * HALF + m * 16) & (8192 - 1); const float* rp = rope + (size_t)pos * 32 + 2 * L; cs[mm][0] = rp[0]; cs[mm][1] = rp[1]; }
                asm volatile("" ::: "memory");
#pragma unroll
                for (int mm = 0; mm < 2; ++mm) { const int ai = am >> 1, m = (am & 1) * 2 + mm; const int rl = ai * HALF + wr * 64 + m * 16 + fr;
#pragma unroll
                    for (int bj = 0; bj < 2; ++bj) { const f32x4 p4 = *(const PG8_LAS f32x4*)(part + (rl * 2 + bj) * 4);
                        const float rn = __builtin_amdgcn_rsqf(((p4[0] + p4[1]) + (p4[2] + p4[3])) * (1.0f / 128.0f) + RMS_EPS) * qs;
                        f32x4 a = acc[ai][bj][m][0] * g0 * rn, b = acc[ai][bj][m][1] * g1 * rn;
                        { const float x1 = a[0], x2 = a[1], c_ = cs[mm][0], s_ = cs[mm][1]; a[0] = x1 * c_ - x2 * s_; a[1] = x2 * c_ + x1 * s_; }
                        unsigned char* op_ = (unsigned char*)O + (size_t)(row0 + ai * HALF + m * 16) * 1536;
                        { typedef unsigned u32x2 __attribute__((ext_vector_type(2))); int w0 = 0, w1 = 0;
                            w0 = __builtin_amdgcn_cvt_pk_fp8_f32(a[0], a[1], w0, false); w0 = __builtin_amdgcn_cvt_pk_fp8_f32(a[2], a[3], w0, true);
                            w1 = __builtin_amdgcn_cvt_pk_fp8_f32(b[0], b[1], w1, false); w1 = __builtin_amdgcn_cvt_pk_fp8_f32(b[2], b[3], w1, true);
                            *(u32x2*)(op_ + col0 + bj * HALF) = (u32x2){(unsigned)w0, (unsigned)w1}; } } }
                asm volatile("" ::: "memory"); }
            return;
        }
#pragma unroll
        for (int ai = 0; ai < 2; ++ai)
#pragma unroll
            for (int m = 0; m < 4; ++m) { const int row = row0 + ai * HALF + m * 16;
#pragma unroll
                for (int bj = 0; bj < 2; ++bj) { const f32x4 v0 = acc[ai][bj][m][0], v1 = acc[ai][bj][m][1];
                    typedef unsigned u32x2 __attribute__((ext_vector_type(2))); int w0 = 0, w1 = 0;
                    w0 = __builtin_amdgcn_cvt_pk_fp8_f32(v0[0], v0[1], w0, false); w0 = __builtin_amdgcn_cvt_pk_fp8_f32(v0[2], v0[3], w0, true);
                    w1 = __builtin_amdgcn_cvt_pk_fp8_f32(v1[0], v1[1], w1, false); w1 = __builtin_amdgcn_cvt_pk_fp8_f32(v1[2], v1[3], w1, true);
                    *(u32x2*)((unsigned char*)O + (size_t)row * 1536 + col0 + bj * HALF) = (u32x2){(unsigned)w0, (unsigned)w1}; } }
    }
};
struct EpiGate {
    static constexpr bool PERM = true, AFTER_DRAIN = false, NEED_R = false;
    const bf16_t* G; int ldg; const bf16_t* prev; bf16_t* O;
    __device__ __forceinline__ void operator()(f32x4 (&acc)[2][2][4][2], const Unit& u, int wr, int wc, int fr, int fq, const PG8_LAS float*) const {
        const int row0 = u.pm * BM + wr * 64 + fr, col0 = u.pn * BM + wc * 32 + 8 * fq;
#pragma unroll
        for (int ai = 0; ai < 2; ++ai) {
            u32x4 gv[4][2], pv[4][2];
#pragma unroll
            for (int m = 0; m < 4; ++m)
#pragma unroll
                for (int bj = 0; bj < 2; ++bj) { const int row = row0 + ai * HALF + m * 16, col = col0 + bj * HALF;
                    gv[m][bj] = *(const u32x4*)(G + (size_t)row * ldg + col); pv[m][bj] = prev ? *(const u32x4*)(prev + (size_t)row * 1024 + col) : (u32x4){0u, 0u, 0u, 0u}; }
            asm volatile("" ::: "memory");
#pragma unroll
            for (int m = 0; m < 4; ++m)
#pragma unroll
                for (int bj = 0; bj < 2; ++bj) { const int row = row0 + ai * HALF + m * 16, col = col0 + bj * HALF; const u32x4 g = gv[m][bj], p = pv[m][bj];
                    float v[8];
                    v[0] = bf_lo(p.x) + sigmoidf_(bf_lo(g.x)) * acc[ai][bj][m][0][0]; v[1] = bf_hi(p.x) + sigmoidf_(bf_hi(g.x)) * acc[ai][bj][m][0][1];
                    v[2] = bf_lo(p.y) + sigmoidf_(bf_lo(g.y)) * acc[ai][bj][m][0][2]; v[3] = bf_hi(p.y) + sigmoidf_(bf_hi(g.y)) * acc[ai][bj][m][0][3];
                    v[4] = bf_lo(p.z) + sigmoidf_(bf_lo(g.z)) * acc[ai][bj][m][1][0]; v[5] = bf_hi(p.z) + sigmoidf_(bf_hi(g.z)) * acc[ai][bj][m][1][1];
                    v[6] = bf_lo(p.w) + sigmoidf_(bf_lo(g.w)) * acc[ai][bj][m][1][2]; v[7] = bf_hi(p.w) + sigmoidf_(bf_hi(g.w)) * acc[ai][bj][m][1][3];
                    u32x4 w; w.x = cvt_pk_bf16(v[0], v[1]); w.y = cvt_pk_bf16(v[2], v[3]); w.z = cvt_pk_bf16(v[4], v[5]); w.w = cvt_pk_bf16(v[6], v[7]);
                    *(u32x4*)(O + (size_t)row * 1024 + col) = w; }
            asm volatile("" ::: "memory"); }
    }
};
struct EpiGF {
    static constexpr bool PERM = true, AFTER_DRAIN = false, NEED_R = true;
    unsigned char* QA; unsigned char* QB; const float* RS;
    __device__ __forceinline__ void operator()(f32x4 (&acc)[2][2][4][2], const Unit& u, int wr, int wc, int fr, int fq, const PG8_LAS float* rtab) const {
        const int row0 = u.pm * BM + wr * 64 + fr, col0 = u.pn * HALF + wc * 32 + 8 * fq;
#pragma unroll
        for (int ai = 0; ai < 2; ++ai)
#pragma unroll
            for (int m = 0; m < 4; ++m) { const int row = row0 + ai * HALF + m * 16; const float rl = rtab[ai * HALF + wr * 64 + m * 16 + fr] * -1.4426950408889634f;
                unsigned qa[2] = {0u, 0u}, qb[2] = {0u, 0u};
#pragma unroll
                for (int n = 0; n < 2; ++n)
#pragma unroll
                    for (int j = 0; j < 4; ++j) { const float sa = __builtin_amdgcn_rcpf(1.0f + __builtin_amdgcn_exp2f(acc[ai][0][m][n][j] * rl)), sb = __builtin_amdgcn_rcpf(1.0f + __builtin_amdgcn_exp2f(acc[ai][1][m][n][j] * rl));
                        qa[n] |= (unsigned)__builtin_rintf(sa * 255.0f) << (8 * j); qb[n] |= (unsigned)fmaxf(__builtin_rintf(sb * 255.0f), 1.0f) << (8 * j); }
                typedef unsigned u32x2 __attribute__((ext_vector_type(2)));
                *(u32x2*)(QA + (size_t)row * 1024 + col0) = (u32x2){qa[0], qa[1]}; *(u32x2*)(QB + (size_t)row * 1024 + col0) = (u32x2){qb[0], qb[1]}; }
    }
};
struct EpiGate2 {
    static constexpr bool PERM = true, AFTER_DRAIN = false, NEED_R = false;
    const unsigned char* QA; const unsigned char* QB; bf16_t* O;
    __device__ __forceinline__ void operator()(f32x4 (&acc)[2][2][4][2], const Unit& u, int wr, int wc, int fr, int fq, const PG8_LAS float*) const {
        typedef unsigned u32x2 __attribute__((ext_vector_type(2)));
        const int row0 = u.pm * BM + wr * 64 + fr, col0 = u.pn * BM + wc * 32 + 8 * fq;
#pragma unroll
        for (int ai = 0; ai < 2; ++ai) {
            u32x2 av[4][2], bv[4][2];
#pragma unroll
            for (int m = 0; m < 4; ++m)
#pragma unroll
                for (int bj = 0; bj < 2; ++bj) { const size_t off = (size_t)(row0 + ai * HALF + m * 16) * 1024 + col0 + bj * HALF; bv[m][bj] = *(const u32x2*)(QB + off); av[m][bj] = u.w ? (u32x2){0u, 0u} : *(const u32x2*)(QA + off); }
            asm volatile("" ::: "memory");
#pragma unroll
            for (int m = 0; m < 4; ++m)
#pragma unroll
                for (int bj = 0; bj < 2; ++bj) {
#pragma unroll
                    for (int n = 0; n < 2; ++n)
#pragma unroll
                        for (int j = 0; j < 4; ++j) { const float b = (float)((bv[m][bj][n] >> (8 * j)) & 255u);
                            if (u.w) acc[ai][bj][m][n][j] *= b * (1.0f / 255.0f);
                            else acc[ai][bj][m][n][j] *= (float)((av[m][bj][n] >> (8 * j)) & 255u) * __builtin_amdgcn_rcpf(b); }
                    if (u.w) { const f32x4 v0 = acc[ai][bj][m][0], v1 = acc[ai][bj][m][1];
                        u32x4 w; w.x = cvt_pk_bf16(v0[0], v0[1]); w.y = cvt_pk_bf16(v0[2], v0[3]); w.z = cvt_pk_bf16(v1[0], v1[1]); w.w = cvt_pk_bf16(v1[2], v1[3]);
                        *(u32x4*)(O + (size_t)(row0 + ai * HALF + m * 16) * 1024 + col0 + bj * HALF) = w; } }
            asm volatile("" ::: "memory"); }
    }
};
struct EpiResidQ {
    static constexpr bool PERM = true, AFTER_DRAIN = false, NEED_R = false;
    bf16_t* HBio; float* RSo; float alpha; unsigned* ROWMAX; unsigned* CNT; unsigned char* Q8; float* SCq;
    __device__ __forceinline__ void operator()(f32x4 (&acc)[2][2][4][2], const Unit& u, int wr, int wc, int fr, int fq, const PG8_LAS float*) const {
        const int row0 = u.pm * BM + wr * 64 + fr, col0 = u.pn * BM + wc * 32 + 8 * fq;
#pragma unroll
        for (int ai = 0; ai < 2; ++ai) {
            u32x4 bv[4][2];
#pragma unroll
            for (int m = 0; m < 4; ++m)
#pragma unroll
                for (int bj = 0; bj < 2; ++bj) bv[m][bj] = *(const u32x4*)(HBio + (size_t)(row0 + ai * HALF + m * 16) * 1024 + col0 + bj * HALF);
            asm volatile("" ::: "memory");
#pragma unroll
            for (int m = 0; m < 4; ++m) { const int row = row0 + ai * HALF + m * 16; float ssq = 0.f, am = 0.f;
#pragma unroll
                for (int bj = 0; bj < 2; ++bj) { const size_t off = (size_t)row * 1024 + col0 + bj * HALF; const u32x4 p = bv[m][bj];
                    const f32x4 v0 = (f32x4){bf_lo(p.x), bf_hi(p.x), bf_lo(p.y), bf_hi(p.y)} + acc[ai][bj][m][0] * alpha, v1 = (f32x4){bf_lo(p.z), bf_hi(p.z), bf_lo(p.w), bf_hi(p.w)} + acc[ai][bj][m][1] * alpha;
                    acc[ai][bj][m][0] = v0; acc[ai][bj][m][1] = v1;
                    u32x4 w; w.x = cvt_pk_bf16(v0[0], v0[1]); w.y = cvt_pk_bf16(v0[2], v0[3]); w.z = cvt_pk_bf16(v1[0], v1[1]); w.w = cvt_pk_bf16(v1[2], v1[3]);
                    *(u32x4*)(HBio + off) = w;
                    ssq += (v0[0] * v0[0] + v0[1] * v0[1]) + (v0[2] * v0[2] + v0[3] * v0[3]) + (v1[0] * v1[0] + v1[1] * v1[1]) + (v1[2] * v1[2] + v1[3] * v1[3]);
                    am = fmaxf(am, fmaxf(fmaxf(fmaxf(fabsf(v0[0]), fabsf(v0[1])), fmaxf(fabsf(v0[2]), fabsf(v0[3]))), fmaxf(fmaxf(fabsf(v1[0]), fabsf(v1[1])), fmaxf(fabsf(v1[2]), fabsf(v1[3]))))); }
                ssq = xsum_16_32(ssq);
                am = xmax_16_32(am);
                if (fq == 0) { RSo[(size_t)row * 16 + u.pn * 4 + wc] = ssq; (void)__hip_atomic_fetch_max(ROWMAX + row, __builtin_bit_cast(unsigned, am), __ATOMIC_RELAXED, __HIP_MEMORY_SCOPE_AGENT); } }
            asm volatile("" ::: "memory"); }
        asm volatile("s_waitcnt vmcnt(0)" ::: "memory"); __builtin_amdgcn_s_barrier();
        if (wr == 0 && wc == 0 && fr == 0 && fq == 0) {
            (void)__hip_atomic_fetch_add(CNT + u.pm, 1u, __ATOMIC_RELAXED, __HIP_MEMORY_SCOPE_AGENT);
            unsigned sp = 0u; while (__hip_atomic_load(CNT + u.pm, __ATOMIC_RELAXED, __HIP_MEMORY_SCOPE_AGENT) < 4u) { __builtin_amdgcn_s_sleep(1); if (++sp > (1u << 22)) break; } }
        asm volatile("s_waitcnt vmcnt(0)" ::: "memory"); __builtin_amdgcn_s_barrier(); asm volatile("" ::: "memory");
        typedef unsigned u32x2 __attribute__((ext_vector_type(2)));
#pragma unroll
        for (int ai = 0; ai < 2; ++ai)
#pragma unroll
            for (int m = 0; m < 4; ++m) { const int row = row0 + ai * HALF + m * 16;
                const float amx = __builtin_bit_cast(float, __hip_atomic_load(ROWMAX + row, __ATOMIC_RELAXED, __HIP_MEMORY_SCOPE_AGENT)); const float inv = (amx > 0.f) ? 127.0f / amx : 0.f;
#pragma unroll
                for (int bj = 0; bj < 2; ++bj) { unsigned q[2];
#pragma unroll
                    for (int n = 0; n < 2; ++n) { unsigned pq = 0u;
#pragma unroll
                        for (int j = 0; j < 4; ++j) pq |= ((unsigned)(int)__builtin_rintf(acc[ai][bj][m][n][j] * inv) & 255u) << (8 * j);
                        q[n] = pq; }
                    *(u32x2*)(Q8 + (size_t)row * 1024 + col0 + bj * HALF) = (u32x2){q[0], q[1]}; }
                if (u.pn == 0 && wc == 0 && fq == 0) SCq[row] = (amx > 0.f) ? amx * (1.0f / 127.0f) : 1.0f; }
    }
};
struct EpiSig8 {
    static constexpr bool PERM = true, AFTER_DRAIN = false, NEED_R = true;
    unsigned char* O8; const float* RS;
    __device__ __forceinline__ void operator()(f32x4 (&acc)[2][2][4][2], const Unit& u, int wr, int wc, int fr, int fq, const PG8_LAS float* rtab) const {
        typedef unsigned u32x2 __attribute__((ext_vector_type(2)));
        const int row0 = u.pm * BM + wr * 64 + fr, col0 = u.pn * BM + wc * 32 + 8 * fq;
#pragma unroll
        for (int ai = 0; ai < 2; ++ai)
#pragma unroll
            for (int m = 0; m < 4; ++m) { const int row = row0 + ai * HALF + m * 16; const float rl = rtab[ai * HALF + wr * 64 + m * 16 + fr] * -1.4426950408889634f;
#pragma unroll
                for (int bj = 0; bj < 2; ++bj) { unsigned q[2];
#pragma unroll
                    for (int n = 0; n < 2; ++n) { unsigned pq = 0u;
#pragma unroll
                        for (int j = 0; j < 4; ++j) pq |= (unsigned)__builtin_rintf(255.0f * __builtin_amdgcn_rcpf(1.0f + __builtin_amdgcn_exp2f(acc[ai][bj][m][n][j] * rl))) << (8 * j);
                        q[n] = pq; }
                    *(u32x2*)(O8 + (size_t)row * 512 + col0 + bj * HALF) = (u32x2){q[0], q[1]}; } }
    }
};
struct EpiResidX {
    static constexpr bool PERM = true, AFTER_DRAIN = false, NEED_R = false;
    const unsigned char* Q8; const unsigned char* E8; const float* SC; bf16_t* HBo; float* RSo; float alpha;
    __device__ __forceinline__ void operator()(f32x4 (&acc)[2][2][4][2], const Unit& u, int wr, int wc, int fr, int fq, const PG8_LAS float*) const {
        typedef unsigned u32x2 __attribute__((ext_vector_type(2)));
        const int row0 = u.pm * BM + wr * 64 + fr, col0 = u.pn * BM + wc * 32 + 8 * fq;
#pragma unroll
        for (int ai = 0; ai < 2; ++ai) {
            u32x2 qv[4][2], ev[4][2]; float sv[4];
#pragma unroll
            for (int m = 0; m < 4; ++m) { const int row = row0 + ai * HALF + m * 16; sv[m] = SC[row];
#pragma unroll
                for (int bj = 0; bj < 2; ++bj) { const size_t off = (size_t)row * 1024 + col0 + bj * HALF; qv[m][bj] = *(const u32x2*)(Q8 + off); ev[m][bj] = *(const u32x2*)(E8 + off); } }
            asm volatile("" ::: "memory");
#pragma unroll
            for (int m = 0; m < 4; ++m) { const int row = row0 + ai * HALF + m * 16; float ssq = 0.f; const float s1 = sv[m], s2 = sv[m] * (1.0f / 254.0f);
#pragma unroll
                for (int bj = 0; bj < 2; ++bj) { const size_t off = (size_t)row * 1024 + col0 + bj * HALF; f32x4 v[2];
#pragma unroll
                    for (int n = 0; n < 2; ++n)
#pragma unroll
                        for (int j = 0; j < 4; ++j) { const float qf_ = (float)(int)(signed char)((qv[m][bj][n] >> (8 * j)) & 255u), ef_ = (float)(int)(signed char)((ev[m][bj][n] >> (8 * j)) & 255u);
                            v[n][j] = (qf_ * s1 + ef_ * s2) + acc[ai][bj][m][n][j] * alpha; }
                    u32x4 w; w.x = cvt_pk_bf16(v[0][0], v[0][1]); w.y = cvt_pk_bf16(v[0][2], v[0][3]); w.z = cvt_pk_bf16(v[1][0], v[1][1]); w.w = cvt_pk_bf16(v[1][2], v[1][3]);
                    *(u32x4*)(HBo + off) = w;
                    ssq += (v[0][0] * v[0][0] + v[0][1] * v[0][1]) + (v[0][2] * v[0][2] + v[0][3] * v[0][3]) + (v[1][0] * v[1][0] + v[1][1] * v[1][1]) + (v[1][2] * v[1][2] + v[1][3] * v[1][3]); }
                ssq = xsum_16_32(ssq);
                if (fq == 0) RSo[(size_t)row * 16 + u.pn * 4 + wc] = ssq; }
            asm volatile("" ::: "memory"); }
    }
};
struct EpiNull {
    static constexpr bool PERM = true, AFTER_DRAIN = false, NEED_R = false;
    float* O;
    __device__ __forceinline__ void operator()(f32x4 (&acc)[2][2][4][2], const Unit& u, int wr, int wc, int fr, int fq, const PG8_LAS float*) const {
        float s_ = 0.f;
#pragma unroll
        for (int ai = 0; ai < 2; ++ai)
#pragma unroll
            for (int bj = 0; bj < 2; ++bj)
#pragma unroll
                for (int m = 0; m < 4; ++m)
#pragma unroll
                    for (int n = 0; n < 2; ++n) s_ += (acc[ai][bj][m][n][0] + acc[ai][bj][m][n][1]) + (acc[ai][bj][m][n][2] + acc[ai][bj][m][n][3]);
        if (s_ == 12345.678f) O[u.pm * 7 + u.pn + wr + wc + fr + fq] = s_;
    }
};
struct EpiPlain {
    static constexpr bool PERM = true, AFTER_DRAIN = false, NEED_R = false;
    bf16_t* O;
    __device__ __forceinline__ void operator()(f32x4 (&acc)[2][2][4][2], const Unit& u, int wr, int wc, int fr, int fq, const PG8_LAS float*) const {
        const int row0 = u.pm * BM + wr * 64 + fr, col0 = u.pn * BM + wc * 32 + 8 * fq;
#pragma unroll
        for (int ai = 0; ai < 2; ++ai)
#pragma unroll
            for (int m = 0; m < 4; ++m) { const int row = row0 + ai * HALF + m * 16;
#pragma unroll
                for (int bj = 0; bj < 2; ++bj) { const f32x4 v0 = acc[ai][bj][m][0], v1 = acc[ai][bj][m][1];
                    u32x4 w; w.x = cvt_pk_bf16(v0[0], v0[1]); w.y = cvt_pk_bf16(v0[2], v0[3]); w.z = cvt_pk_bf16(v1[0], v1[1]); w.w = cvt_pk_bf16(v1[2], v1[3]);
                    *(u32x4*)(O + (size_t)row * 1024 + col0 + bj * HALF) = w; } }
    }
};
struct EpiFinal {
    static constexpr bool PERM = true, AFTER_DRAIN = false, NEED_R = true;
    float* out; const bf16_t* HBr; const bf16_t* PE; const float* RS;
    __device__ __forceinline__ void operator()(f32x4 (&acc)[2][2][4][2], const Unit& u, int wr, int wc, int fr, int fq, const PG8_LAS float* rtab) const {
        const int row0 = u.pm * BM + wr * 64 + fr, col0 = u.pn * BM + wc * 32 + 8 * fq;
#pragma unroll
        for (int ai = 0; ai < 2; ++ai) {
            u32x4 hv[4][2], pv[4][2];
#pragma unroll
            for (int m = 0; m < 4; ++m)
#pragma unroll
                for (int bj = 0; bj < 2; ++bj) { const size_t off = (size_t)(row0 + ai * HALF + m * 16) * 1024 + col0 + bj * HALF; hv[m][bj] = *(const u32x4*)(HBr + off); pv[m][bj] = *(const u32x4*)(PE + off); }
            asm volatile("" ::: "memory");
#pragma unroll
            for (int m = 0; m < 4; ++m) { const float r = rtab[ai * HALF + wr * 64 + m * 16 + fr];
#pragma unroll
                for (int bj = 0; bj < 2; ++bj) { const size_t off = (size_t)(row0 + ai * HALF + m * 16) * 1024 + col0 + bj * HALF; const u32x4 b = hv[m][bj], p = pv[m][bj];
                    f32x4 v0, v1;
                    v0[0] = bf_lo(b.x) + bf_lo(p.x) * sigmoidf_(acc[ai][bj][m][0][0] * r); v0[1] = bf_hi(b.x) + bf_hi(p.x) * sigmoidf_(acc[ai][bj][m][0][1] * r);
                    v0[2] = bf_lo(b.y) + bf_lo(p.y) * sigmoidf_(acc[ai][bj][m][0][2] * r); v0[3] = bf_hi(b.y) + bf_hi(p.y) * sigmoidf_(acc[ai][bj][m][0][3] * r);
                    v1[0] = bf_lo(b.z) + bf_lo(p.z) * sigmoidf_(acc[ai][bj][m][1][0] * r); v1[1] = bf_hi(b.z) + bf_hi(p.z) * sigmoidf_(acc[ai][bj][m][1][1] * r);
                    v1[2] = bf_lo(b.w) + bf_lo(p.w) * sigmoidf_(acc[ai][bj][m][1][2] * r); v1[3] = bf_hi(b.w) + bf_hi(p.w) * sigmoidf_(acc[ai][bj][m][1][3] * r);
                    *(f32x4*)(out + off) = v0; *(f32x4*)(out + off + 4) = v1; } }
            asm volatile("" ::: "memory"); }
    }
};

template <class Epi, class Sched, bool ALIGN_EPI = false, bool SP2 = false, bool BAL = false, bool I8 = false>
__device__ __forceinline__ void gemm_phase(PG8_LAS unsigned char* lds, const Gemm g, const Sched& S, const Epi& E, const int wid) {
    int lane; asm volatile("v_mbcnt_lo_u32_b32 %0, -1, 0\n\tv_mbcnt_hi_u32_b32 %0, -1, %0" : "=v"(lane));
    const int tid = wid * 64 + lane, wr = wid >> 2, wc = wid & 3, fr = lane & 15, fq = lane >> 4;
    const int K = g.K, nt = K / BK;
    unsigned voffA[2], voffB[2];
#pragma unroll
    for (int i = 0; i < 2; ++i) { int R, C; stage_rc(tid * 16 + i * 8192, R, C); const int Rb = Epi::PERM ? ((R & ~31) + perm32(R & 31)) : R;
        voffA[i] = (unsigned)(R * K + C) * 2u; voffB[i] = (unsigned)(Rb * K + C) * 2u; }
    const size_t kstep = (size_t)(BK * 2);
    const size_t hstep = (size_t)HALF * K * 2;
    const size_t tstep = 2 * hstep;
    const unsigned ldsw = (unsigned)wid * 1024u;
    const int aoff = lds_byte(wr * 64 + fr, fq * 8), boff = lds_byte(wc * 32 + fr, fq * 8);
#define PG8_SA(b, h) (((b) * 2 + (h)) * HTB)
#define PG8_SB(b, h) ((4 + (b) * 2 + (h)) * HTB)
#define PG8_STAGE(bufoff, gbase, voff) do { _Pragma("unroll") for (int _i = 0; _i < 2; ++_i) \
        __builtin_amdgcn_global_load_lds((const unsigned*)((const char*)(gbase) + (voff)[_i]), (PG8_LAS unsigned*)(lds + (bufoff) + ldsw + _i * 8192), 16, 0, 0); } while (0)
#define PG8_LDA(dst, b, h) do { _Pragma("unroll") for (int m = 0; m < 4; ++m) _Pragma("unroll") for (int k = 0; k < 2; ++k) dst[m][k] = *(const PG8_LAS bf16x8*)(lds + PG8_SA(b, h) + aoff + m * 2048 + k * 1024); } while (0)
#define PG8_LDB(dst, b, h) do { _Pragma("unroll") for (int n = 0; n < 2; ++n) _Pragma("unroll") for (int k = 0; k < 2; ++k) dst[n][k] = *(const PG8_LAS bf16x8*)(lds + PG8_SB(b, h) + boff + n * 2048 + k * 1024); } while (0)
#define PG8_MMA(ai, bj, At, Bt) do { __builtin_amdgcn_s_setprio(3); _Pragma("unroll") for (int m = 0; m < 4; ++m) _Pragma("unroll") for (int n = 0; n < 2; ++n) _Pragma("unroll") for (int k = 0; k < 2; ++k) \
        { if constexpr (I8) acc[ai][bj][m][n] = __builtin_bit_cast(f32x4, __builtin_amdgcn_mfma_i32_16x16x64_i8(__builtin_bit_cast(i32x4, Bt[n][k]), __builtin_bit_cast(i32x4, At[m][k]), __builtin_bit_cast(i32x4, acc[ai][bj][m][n]), 0, 0, 0)); \
          else acc[ai][bj][m][n] = __builtin_amdgcn_mfma_f32_16x16x32_bf16(Bt[n][k], At[m][k], acc[ai][bj][m][n], 0, 0, 0); } __builtin_amdgcn_s_setprio(0); } while (0)
#define PG8_WAIT_V(n) asm volatile("s_waitcnt vmcnt(" #n ")" ::: "memory")
#define PG8_WAIT_L(n) asm volatile("s_waitcnt lgkmcnt(" #n ")" ::: "memory")
#define PG8_BAR __builtin_amdgcn_s_barrier()
#define PG8_SCHED __builtin_amdgcn_sched_barrier(0)
    Unit cur, nxt; int ui = 0; int rt_pm = -1; PG8_LAS float* rtab = (PG8_LAS float*)(lds + RTAB_OFF);
    if (!S.next(0, cur)) return;
    f32x4 acc[2][2][4][2];
#pragma unroll
    for (int a = 0; a < 2; ++a)
#pragma unroll
        for (int b = 0; b < 2; ++b)
#pragma unroll
            for (int m = 0; m < 4; ++m)
#pragma unroll
                for (int n = 0; n < 2; ++n) acc[a][b][m][n] = (f32x4){0.f, 0.f, 0.f, 0.f};
    bf16x8 At[4][2], B0[2][2], B1[2][2];
    const char* cA = (const char*)g.A + (size_t)cur.pm * tstep; const char* cB = (const char*)g.Bt + (size_t)cur.pn * tstep;
    if constexpr (SP2 && BAL) {
        PG8_STAGE(PG8_SB(0, 0), cB, voffB); PG8_STAGE(PG8_SB(0, 1), cB + hstep, voffB); PG8_STAGE(PG8_SA(0, 0), cA, voffA); PG8_STAGE(PG8_SA(0, 1), cA + hstep, voffA);
        if (wr == 1) PG8_BAR;
        PG8_WAIT_V(2); PG8_BAR;
        PG8_STAGE(PG8_SB(1, 0), cB + kstep, voffB); PG8_STAGE(PG8_SB(1, 1), cB + hstep + kstep, voffB);
        PG8_WAIT_V(4); PG8_BAR;
    } else if constexpr (SP2) {
        PG8_STAGE(PG8_SB(0, 0), cB, voffB); PG8_STAGE(PG8_SB(0, 1), cB + hstep, voffB); PG8_STAGE(PG8_SA(0, 0), cA, voffA); PG8_STAGE(PG8_SA(0, 1), cA + hstep, voffA);
        if (wr == 1) PG8_BAR;
        PG8_WAIT_V(2); PG8_BAR;
        PG8_STAGE(PG8_SB(1, 0), cB + kstep, voffB); PG8_STAGE(PG8_SA(1, 0), cA + kstep, voffA); PG8_STAGE(PG8_SB(1, 1), cB + hstep + kstep, voffB);
        PG8_WAIT_V(6); PG8_BAR;
    } else {
        PG8_STAGE(PG8_SB(0, 0), cB, voffB); PG8_STAGE(PG8_SA(0, 0), cA, voffA); PG8_STAGE(PG8_SB(0, 1), cB + hstep, voffB); PG8_STAGE(PG8_SA(0, 1), cA + hstep, voffA);
        if (wr == 1) PG8_BAR;
        PG8_WAIT_V(4); PG8_BAR;
        PG8_STAGE(PG8_SB(1, 0), cB + kstep, voffB); PG8_STAGE(PG8_SA(1, 0), cA + kstep, voffA); PG8_STAGE(PG8_SB(1, 1), cB + hstep + kstep, voffB);
        PG8_WAIT_V(6); PG8_BAR;
    }
    for (;;) {
        const bool has_next = S.next(ui + 1, nxt);
        const char* nA = has_next ? (const char*)((Sched::PAIR && nxt.w) ? g.A2 : g.A) + (size_t)nxt.pm * tstep : cA; const char* nB = has_next ? (const char*)((Sched::PAIR && nxt.w) ? g.Bt2 : g.Bt) + (size_t)nxt.pn * tstep : cB;
#pragma unroll 1
        for (int t = 0; t < nt; t += 2) {
            const bool last = (t == nt - 2);
            const char* a1 = cA + (size_t)(t + 1) * kstep;
            const char* a2 = last ? nA : cA + (size_t)(t + 2) * kstep; const char* b2 = last ? nB : cB + (size_t)(t + 2) * kstep;
            const char* a3 = a2 + kstep; const char* b3 = b2 + kstep;
            if constexpr (SP2 && BAL) {
            PG8_LDB(B0, 0, 0); PG8_LDB(B1, 0, 1); PG8_SCHED; PG8_LDA(At, 0, 0); PG8_STAGE(PG8_SA(1, 1), a1 + hstep, voffA); PG8_STAGE(PG8_SA(1, 0), a1, voffA);
            PG8_WAIT_V(8); PG8_WAIT_L(0); PG8_BAR; PG8_MMA(0, 0, At, B0); PG8_MMA(0, 1, At, B1); PG8_BAR; PG8_SCHED;
            PG8_LDA(At, 0, 1); PG8_STAGE(PG8_SB(0, 0), b2, voffB); PG8_STAGE(PG8_SB(0, 1), b2 + hstep, voffB);
            PG8_WAIT_V(4); PG8_WAIT_L(0); PG8_BAR; PG8_MMA(1, 0, At, B0); PG8_MMA(1, 1, At, B1); PG8_BAR; PG8_SCHED;
            PG8_LDB(B0, 1, 0); PG8_LDB(B1, 1, 1); PG8_SCHED; PG8_LDA(At, 1, 0); PG8_STAGE(PG8_SA(0, 1), a2 + hstep, voffA); PG8_STAGE(PG8_SA(0, 0), a2, voffA);
            PG8_WAIT_V(8); PG8_WAIT_L(0); PG8_BAR; PG8_MMA(0, 0, At, B0); PG8_MMA(0, 1, At, B1); PG8_BAR; PG8_SCHED;
            PG8_LDA(At, 1, 1); PG8_STAGE(PG8_SB(1, 0), b3, voffB); PG8_STAGE(PG8_SB(1, 1), b3 + hstep, voffB);
            PG8_WAIT_V(4); PG8_WAIT_L(0); PG8_BAR; PG8_MMA(1, 0, At, B0); PG8_MMA(1, 1, At, B1); PG8_BAR; PG8_SCHED;
            } else if constexpr (SP2) {
            PG8_LDB(B0, 0, 0); PG8_LDB(B1, 0, 1); PG8_SCHED; PG8_LDA(At, 0, 0); PG8_STAGE(PG8_SA(1, 1), a1 + hstep, voffA);
            PG8_WAIT_V(8); PG8_WAIT_L(0); PG8_BAR; PG8_MMA(0, 0, At, B0); PG8_MMA(0, 1, At, B1); PG8_BAR; PG8_SCHED;
            PG8_LDA(At, 0, 1); PG8_STAGE(PG8_SB(0, 0), b2, voffB); PG8_STAGE(PG8_SB(0, 1), b2 + hstep, voffB); PG8_STAGE(PG8_SA(0, 0), a2, voffA);
            PG8_WAIT_V(8); PG8_WAIT_L(0); PG8_BAR; PG8_MMA(1, 0, At, B0); PG8_MMA(1, 1, At, B1); PG8_BAR; PG8_SCHED;
            PG8_LDB(B0, 1, 0); PG8_LDB(B1, 1, 1); PG8_SCHED; PG8_LDA(At, 1, 0); PG8_STAGE(PG8_SA(0, 1), a2 + hstep, voffA);
            PG8_WAIT_V(8); PG8_WAIT_L(0); PG8_BAR; PG8_MMA(0, 0, At, B0); PG8_MMA(0, 1, At, B1); PG8_BAR; PG8_SCHED;
            PG8_LDA(At, 1, 1); PG8_STAGE(PG8_SB(1, 0), b3, voffB); PG8_STAGE(PG8_SB(1, 1), b3 + hstep, voffB); PG8_STAGE(PG8_SA(1, 0), a3, voffA);
            PG8_WAIT_V(8); PG8_WAIT_L(0); PG8_BAR; PG8_MMA(1, 0, At, B0); PG8_MMA(1, 1, At, B1); PG8_BAR; PG8_SCHED;
            } else {
            PG8_LDB(B0, 0, 0); PG8_SCHED; PG8_LDA(At, 0, 0); PG8_STAGE(PG8_SA(1, 1), a1 + hstep, voffA);
            PG8_WAIT_L(8); PG8_BAR; PG8_WAIT_L(0); PG8_MMA(0, 0, At, B0); PG8_BAR; PG8_SCHED;
            PG8_LDB(B1, 0, 1); PG8_STAGE(PG8_SB(0, 0), b2, voffB);
            PG8_BAR; PG8_WAIT_L(0); PG8_MMA(0, 1, At, B1); PG8_BAR;
            PG8_LDA(At, 0, 1); PG8_STAGE(PG8_SA(0, 0), a2, voffA);
            PG8_BAR; PG8_WAIT_L(0); PG8_MMA(1, 0, At, B0); PG8_BAR; PG8_SCHED;
            PG8_STAGE(PG8_SB(0, 1), b2 + hstep, voffB);
            PG8_WAIT_V(6); PG8_BAR; PG8_MMA(1, 1, At, B1); PG8_BAR;
            PG8_LDB(B0, 1, 0); PG8_SCHED; PG8_LDA(At, 1, 0); PG8_STAGE(PG8_SA(0, 1), a2 + hstep, voffA);
            PG8_WAIT_L(8); PG8_BAR; PG8_WAIT_L(0); PG8_MMA(0, 0, At, B0); PG8_BAR; PG8_SCHED;
            PG8_LDB(B1, 1, 1); PG8_STAGE(PG8_SB(1, 0), b3, voffB);
            PG8_BAR; PG8_WAIT_L(0); PG8_MMA(0, 1, At, B1); PG8_BAR;
            PG8_LDA(At, 1, 1); PG8_STAGE(PG8_SA(1, 0), a3, voffA);
            PG8_BAR; PG8_WAIT_L(0); PG8_MMA(1, 0, At, B0); PG8_BAR; PG8_SCHED;
            PG8_STAGE(PG8_SB(1, 1), b3 + hstep, voffB);
            PG8_WAIT_V(6); PG8_BAR; PG8_MMA(1, 1, At, B1); PG8_BAR;
            }
        }
        if constexpr (ALIGN_EPI) { if (wr == 0) PG8_BAR; }
        if constexpr (Epi::NEED_R) {
            static_assert(ALIGN_EPI, "row-scale table needs both halves in the epilogue together");
            if (cur.pm != rt_pm) {
                if (tid < 256) { const f32x4* rp = (const f32x4*)(E.RS + (size_t)(cur.pm * BM + tid) * 16); const f32x4 p0 = rp[0], p1 = rp[1], p2 = rp[2], p3 = rp[3];
                    const float ss = ((p0[0] + p0[1]) + (p0[2] + p0[3])) + ((p1[0] + p1[1]) + (p1[2] + p1[3])) + ((p2[0] + p2[1]) + (p2[2] + p2[3])) + ((p3[0] + p3[1]) + (p3[2] + p3[3]));
                    float rv_ = __builtin_amdgcn_rsqf(ss * (1.0f / 1024.0f) + RMS_EPS); if constexpr (I8) rv_ *= g.sch[cur.pm * BM + tid]; rtab[tid] = rv_; }
                PG8_WAIT_L(0); PG8_BAR; rt_pm = cur.pm; }
        }
        if constexpr (I8) {
#pragma unroll
            for (int bj = 0; bj < 2; ++bj) { const float* sp_ = g.scw + cur.pn * BM + bj * HALF + wc * 32 + 8 * fq; const f32x4 s0 = *(const f32x4*)sp_, s1 = *(const f32x4*)(sp_ + 4);
#pragma unroll
                for (int ai = 0; ai < 2; ++ai)
#pragma unroll
                    for (int m = 0; m < 4; ++m) { acc[ai][bj][m][0] = __builtin_convertvector(__builtin_bit_cast(i32x4, acc[ai][bj][m][0]), f32x4) * s0; acc[ai][bj][m][1] = __builtin_convertvector(__builtin_bit_cast(i32x4, acc[ai][bj][m][1]), f32x4) * s1; } } }
        E(acc, cur, wr, wc, fr, fq, (const PG8_LAS float*)rtab);
        if (!has_next) break;
        if (!Sched::PAIR || cur.w) {
#pragma unroll
        for (int a = 0; a < 2; ++a)
#pragma unroll
            for (int b = 0; b < 2; ++b)
#pragma unroll
                for (int m = 0; m < 4; ++m)
#pragma unroll
                    for (int n = 0; n < 2; ++n) acc[a][b][m][n] = (f32x4){0.f, 0.f, 0.f, 0.f}; }
        cur = nxt; cA = nA; cB = nB; ++ui;
        if constexpr (ALIGN_EPI) { if (wr == 1) PG8_BAR; }
    }
    PG8_WAIT_V(0);
    if constexpr (!ALIGN_EPI) { if (wr == 0) PG8_BAR; }
    PG8_BAR;
#undef PG8_SA
#undef PG8_SB
#undef PG8_STAGE
#undef PG8_LDA
#undef PG8_LDB
#undef PG8_MMA
#undef PG8_WAIT_V
#undef PG8_WAIT_L
#undef PG8_BAR
#undef PG8_SCHED
}

struct EpiFinal2 {
    static constexpr bool PERM = true, AFTER_DRAIN = false, NEED_R = true;
    float* out; const bf16_t* HBr; const float* RS;
    static constexpr int NREG = 26;
    struct State { unsigned s8[NREG]; };
    __device__ __forceinline__ void operator()(f32x4 (&acc)[2][2][4][2], State& st, const Unit& u, int wr, int wc, int fr, int fq, const PG8_LAS float* rtab, PG8_LAS unsigned* xl) const {
        if (u.w == 0) {
#pragma unroll
            for (int ai = 0; ai < 2; ++ai)
#pragma unroll
                for (int m = 0; m < 4; ++m) { const float rl = rtab[ai * HALF + wr * 64 + m * 16 + fr] * -1.4426950408889634f;
#pragma unroll
                    for (int bj = 0; bj < 2; ++bj)
#pragma unroll
                        for (int n = 0; n < 2; ++n) { unsigned p = 0u;
#pragma unroll
                            for (int j = 0; j < 4; ++j) { const float sg = __builtin_amdgcn_rcpf(1.0f + __builtin_amdgcn_exp2f(acc[ai][bj][m][n][j] * rl)); p |= (unsigned)__builtin_rintf(sg * 255.0f) << (8 * j); }
                            asm volatile("" : "+v"(p));
                            { constexpr int dummy_ = 0; (void)dummy_; const int ix = ((ai * 2 + bj) * 4 + m) * 2 + n; if (ix < NREG) st.s8[ix < NREG ? ix : 0] = p; else xl[(ix - NREG) * 512] = p; }
                            acc[ai][bj][m][n] = (f32x4){0.f, 0.f, 0.f, 0.f}; } }
        } else {
            const int row0 = u.pm * BM + wr * 64 + fr, col0 = u.pn * BM + wc * 32 + 8 * fq;
#pragma unroll
            for (int ai = 0; ai < 2; ++ai) {
                u32x4 hv[4][2];
#pragma unroll
                for (int m = 0; m < 4; ++m)
#pragma unroll
                    for (int bj = 0; bj < 2; ++bj) hv[m][bj] = *(const u32x4*)(HBr + (size_t)(row0 + ai * HALF + m * 16) * 1024 + col0 + bj * HALF);
                asm volatile("" ::: "memory");
#pragma unroll
                for (int m = 0; m < 4; ++m)
#pragma unroll
                    for (int bj = 0; bj < 2; ++bj) { const size_t off = (size_t)(row0 + ai * HALF + m * 16) * 1024 + col0 + bj * HALF; const u32x4 b = hv[m][bj];
                        const int ix0 = ((ai * 2 + bj) * 4 + m) * 2, ix1 = ix0 + 1; constexpr float I255 = 1.0f / 255.0f;
                        const unsigned q0 = (ix0 < NREG) ? st.s8[ix0 < NREG ? ix0 : 0] : xl[(ix0 - NREG) * 512], q1 = (ix1 < NREG) ? st.s8[ix1 < NREG ? ix1 : 0] : xl[(ix1 - NREG) * 512];
                        f32x4 v0, v1;
                        v0[0] = bf_lo(b.x) + acc[ai][bj][m][0][0] * ((float)(q0 & 255u) * I255); v0[1] = bf_hi(b.x) + acc[ai][bj][m][0][1] * ((float)((q0 >> 8) & 255u) * I255);
                        v0[2] = bf_lo(b.y) + acc[ai][bj][m][0][2] * ((float)((q0 >> 16) & 255u) * I255); v0[3] = bf_hi(b.y) + acc[ai][bj][m][0][3] * ((float)(q0 >> 24) * I255);
                        v1[0] = bf_lo(b.z) + acc[ai][bj][m][1][0] * ((float)(q1 & 255u) * I255); v1[1] = bf_hi(b.z) + acc[ai][bj][m][1][1] * ((float)((q1 >> 8) & 255u) * I255);
                        v1[2] = bf_lo(b.w) + acc[ai][bj][m][1][2] * ((float)((q1 >> 16) & 255u) * I255); v1[3] = bf_hi(b.w) + acc[ai][bj][m][1][3] * ((float)(q1 >> 24) * I255);
                        *(f32x4*)(out + off) = v0; *(f32x4*)(out + off + 4) = v1; }
                asm volatile("" ::: "memory"); }
        }
    }
};
template <class Epi>
__device__ __forceinline__ void gemm_phase_dk(PG8_LAS unsigned char* lds, const Gemm g, const PairOrder& S, const Epi& E, const int wid) {
    int lane; asm volatile("v_mbcnt_lo_u32_b32 %0, -1, 0\n\tv_mbcnt_hi_u32_b32 %0, -1, %0" : "=v"(lane));
    const int tid = wid * 64 + lane, wr = wid >> 2, wc = wid & 3, fr = lane & 15, fq = lane >> 4;
    const int K0 = g.K, K1 = g.K2, nt0 = K0 / BK, nt1 = K1 / BK;
    unsigned vA0[2], vB0[2];
#pragma unroll
    for (int i = 0; i < 2; ++i) { int R, C; stage_rc(tid * 16 + i * 8192, R, C); const int Rb = (R & ~31) + perm32(R & 31);
        vA0[i] = (unsigned)(R * K0 + C) * 2u; vB0[i] = (unsigned)(Rb * K0 + C) * 2u; }
    const size_t kstep = (size_t)(BK * 2);
    const size_t hs0 = (size_t)HALF * K0 * 2, hs1 = (size_t)HALF * K1 * 2;
    const unsigned ldsw = (unsigned)wid * 1024u;
    const int aoff = lds_byte(wr * 64 + fr, fq * 8), boff = lds_byte(wc * 32 + fr, fq * 8);
#define PG8_SA(b, h) (((b) * 2 + (h)) * HTB)
#define PG8_SB(b, h) ((4 + (b) * 2 + (h)) * HTB)
#define PG8_STAGE(bufoff, gbase, voff) do { _Pragma("unroll") for (int _i = 0; _i < 2; ++_i) \
        __builtin_amdgcn_global_load_lds((const unsigned*)((const char*)(gbase) + (voff)[_i]), (PG8_LAS unsigned*)(lds + (bufoff) + ldsw + _i * 8192), 16, 0, 0); } while (0)
#define DK_V1(v) ((((v) >> 11) * (unsigned)K1 + (((v) >> 1) & 1023u)) * 2u)
#define DK_STA(bufoff, gbase, sel) do { if (sel) { unsigned t_[2] = {vA0[0], vA0[1]}; asm volatile("" : "+v"(t_[0]), "+v"(t_[1])); t_[0] = DK_V1(t_[0]); t_[1] = DK_V1(t_[1]); PG8_STAGE(bufoff, gbase, t_); } else PG8_STAGE(bufoff, gbase, vA0); } while (0)
#define DK_STB(bufoff, gbase, sel) do { if (sel) { unsigned t_[2] = {vB0[0], vB0[1]}; asm volatile("" : "+v"(t_[0]), "+v"(t_[1])); t_[0] = DK_V1(t_[0]); t_[1] = DK_V1(t_[1]); PG8_STAGE(bufoff, gbase, t_); } else PG8_STAGE(bufoff, gbase, vB0); } while (0)
#define PG8_LDA(dst, b, h) do { _Pragma("unroll") for (int m = 0; m < 4; ++m) _Pragma("unroll") for (int k = 0; k < 2; ++k) dst[m][k] = *(const PG8_LAS bf16x8*)(lds + PG8_SA(b, h) + aoff + m * 2048 + k * 1024); } while (0)
#define PG8_LDB(dst, b, h) do { _Pragma("unroll") for (int n = 0; n < 2; ++n) _Pragma("unroll") for (int k = 0; k < 2; ++k) dst[n][k] = *(const PG8_LAS bf16x8*)(lds + PG8_SB(b, h) + boff + n * 2048 + k * 1024); } while (0)
#define PG8_MMA(ai, bj, At, Bt) do { __builtin_amdgcn_s_setprio(3); _Pragma("unroll") for (int m = 0; m < 4; ++m) _Pragma("unroll") for (int n = 0; n < 2; ++n) _Pragma("unroll") for (int k = 0; k < 2; ++k) \
        acc[ai][bj][m][n] = __builtin_amdgcn_mfma_f32_16x16x32_bf16(Bt[n][k], At[m][k], acc[ai][bj][m][n], 0, 0, 0); __builtin_amdgcn_s_setprio(0); } while (0)
#define PG8_WAIT_V(n) asm volatile("s_waitcnt vmcnt(" #n ")" ::: "memory")
#define PG8_WAIT_L(n) asm volatile("s_waitcnt lgkmcnt(" #n ")" ::: "memory")
#define PG8_BAR __builtin_amdgcn_s_barrier()
#define PG8_SCHED __builtin_amdgcn_sched_barrier(0)
    Unit cur, nxt; int ui = 0; int rt_pm = -1; PG8_LAS float* rtab = (PG8_LAS float*)(lds + RTAB_OFF);
    if (!S.next(0, cur)) return;
    f32x4 acc[2][2][4][2];
#pragma unroll
    for (int a = 0; a < 2; ++a)
#pragma unroll
        for (int b = 0; b < 2; ++b)
#pragma unroll
            for (int m = 0; m < 4; ++m)
#pragma unroll
                for (int n = 0; n < 2; ++n) acc[a][b][m][n] = (f32x4){0.f, 0.f, 0.f, 0.f};
    typename Epi::State st;
    bf16x8 At[4][2], B0[2][2], B1[2][2];
    const char* cA = (const char*)g.A + (size_t)cur.pm * (2 * hs0); const char* cB = (const char*)g.Bt + (size_t)cur.pn * (2 * hs0);
    PG8_STAGE(PG8_SB(0, 0), cB, vB0); PG8_STAGE(PG8_SB(0, 1), cB + hs0, vB0); PG8_STAGE(PG8_SA(0, 0), cA, vA0); PG8_STAGE(PG8_SA(0, 1), cA + hs0, vA0);
    if (wr == 1) PG8_BAR;
    PG8_WAIT_V(2); PG8_BAR;
    PG8_STAGE(PG8_SB(1, 0), cB + kstep, vB0); PG8_STAGE(PG8_SA(1, 0), cA + kstep, vA0); PG8_STAGE(PG8_SB(1, 1), cB + hs0 + kstep, vB0);
    PG8_WAIT_V(6); PG8_BAR;
    for (;;) {
        const bool has_next = S.next(ui + 1, nxt);
        const bool cw = cur.w != 0, nw = has_next ? (nxt.w != 0) : cw;
        const size_t hsc = cw ? hs1 : hs0; const int ntc = cw ? nt1 : nt0;
        const char* nA = has_next ? (const char*)(nw ? g.A2 : g.A) + (size_t)nxt.pm * (2 * (nw ? hs1 : hs0)) : cA; const char* nB = has_next ? (const char*)(nw ? g.Bt2 : g.Bt) + (size_t)nxt.pn * (2 * (nw ? hs1 : hs0)) : cB;
#pragma unroll 1
        for (int t = 0; t < ntc; t += 2) {
            const bool last = (t == ntc - 2);
            const char* a1 = cA + (size_t)(t + 1) * kstep;
            const char* a2 = last ? nA : cA + (size_t)(t + 2) * kstep; const char* b2 = last ? nB : cB + (size_t)(t + 2) * kstep;
            const char* a3 = a2 + kstep; const char* b3 = b2 + kstep;
            const bool xs = last ? nw : cw; const size_t hx = xs ? hs1 : hs0;
            PG8_LDB(B0, 0, 0); PG8_LDB(B1, 0, 1); PG8_SCHED; PG8_LDA(At, 0, 0); DK_STA(PG8_SA(1, 1), a1 + hsc, cw);
            PG8_WAIT_V(8); PG8_WAIT_L(0); PG8_BAR; PG8_MMA(0, 0, At, B0); PG8_MMA(0, 1, At, B1); PG8_BAR; PG8_SCHED;
            PG8_LDA(At, 0, 1); DK_STB(PG8_SB(0, 0), b2, xs); DK_STB(PG8_SB(0, 1), b2 + hx, xs); DK_STA(PG8_SA(0, 0), a2, xs);
            PG8_WAIT_V(8); PG8_WAIT_L(0); PG8_BAR; PG8_MMA(1, 0, At, B0); PG8_MMA(1, 1, At, B1); PG8_BAR; PG8_SCHED;
            PG8_LDB(B0, 1, 0); PG8_LDB(B1, 1, 1); PG8_SCHED; PG8_LDA(At, 1, 0); DK_STA(PG8_SA(0, 1), a2 + hx, xs);
            PG8_WAIT_V(8); PG8_WAIT_L(0); PG8_BAR; PG8_MMA(0, 0, At, B0); PG8_MMA(0, 1, At, B1); PG8_BAR; PG8_SCHED;
            PG8_LDA(At, 1, 1); DK_STB(PG8_SB(1, 0), b3, xs); DK_STB(PG8_SB(1, 1), b3 + hx, xs); DK_STA(PG8_SA(1, 0), a3, xs);
            PG8_WAIT_V(8); PG8_WAIT_L(0); PG8_BAR; PG8_MMA(1, 0, At, B0); PG8_MMA(1, 1, At, B1); PG8_BAR; PG8_SCHED;
        }
        if (wr == 0) PG8_BAR;
        int l2_; asm volatile("v_mbcnt_lo_u32_b32 %0, -1, 0\n\tv_mbcnt_hi_u32_b32 %0, -1, %0" : "=v"(l2_));
        if (cur.pm != rt_pm) { const int tid2 = wid * 64 + l2_;
            if (tid2 < 256) { const f32x4* rp = (const f32x4*)(E.RS + (size_t)(cur.pm * BM + tid2) * 16); const f32x4 p0 = rp[0], p1 = rp[1], p2 = rp[2], p3 = rp[3];
                const float ss = ((p0[0] + p0[1]) + (p0[2] + p0[3])) + ((p1[0] + p1[1]) + (p1[2] + p1[3])) + ((p2[0] + p2[1]) + (p2[2] + p2[3])) + ((p3[0] + p3[1]) + (p3[2] + p3[3]));
                rtab[tid2] = __builtin_amdgcn_rsqf(ss * (1.0f / 1024.0f) + RMS_EPS); }
            PG8_WAIT_L(0); PG8_BAR; rt_pm = cur.pm; }
        E(acc, st, cur, wr, wc, l2_ & 15, l2_ >> 4, (const PG8_LAS float*)rtab, (PG8_LAS unsigned*)(lds + 139264) + (wid * 64 + l2_));
        if (!has_next) break;
        if (cur.w) {
#pragma unroll
        for (int a = 0; a < 2; ++a)
#pragma unroll
            for (int b = 0; b < 2; ++b)
#pragma unroll
                for (int m = 0; m < 4; ++m)
#pragma unroll
                    for (int n = 0; n < 2; ++n) acc[a][b][m][n] = (f32x4){0.f, 0.f, 0.f, 0.f}; }
        cur = nxt; cA = nA; cB = nB; ++ui;
        if (wr == 1) PG8_BAR;
    }
    PG8_WAIT_V(0);
    PG8_BAR;
#undef PG8_SA
#undef PG8_SB
#undef PG8_STAGE
#undef DK_STA
#undef DK_V1
#undef DK_STB
#undef PG8_LDA
#undef PG8_LDB
#undef PG8_MMA
#undef PG8_WAIT_V
#undef PG8_WAIT_L
#undef PG8_BAR
#undef PG8_SCHED
}
}

using pg8::sigmoidf_;
constexpr int NWAVES = 8, NTHREADS = NWAVES * 64;
constexpr int BATCH = 4, SEQ = 8192, D = 1024, M = BATCH * SEQ, FF = 2816, PLE = 256, D_IN = 8712;
constexpr int NHD = 128;
constexpr int WIN_ROWS = 8960;
constexpr int WIN_ML = 4608, WIN_GT = 6656, WIN_G = 6912;
constexpr int NPHASE = 13;

constexpr size_t MiB = 1u << 20;
constexpr size_t WS_CTL = 0, CTL_ZERO_BYTES = 1 * MiB;
constexpr size_t WS_ROPE = 1 * MiB;
constexpr size_t WS_GATES = 2 * MiB;
constexpr size_t WS_LSE = 3 * MiB;
constexpr size_t WS_RS = 4 * MiB;
constexpr size_t WS_W1IN = 6 * MiB;
constexpr size_t WS_W1OUT = 17 * MiB;
constexpr size_t WS_WIN = 22 * MiB + 512 * 1024;
constexpr size_t WS_WUPA = 40 * MiB, WS_WUPB = 41 * MiB, WS_WO = 42 * MiB;
constexpr size_t WS_W2IN = 44 * MiB, WS_W2OUT = 55 * MiB, WS_WPG = 60 * MiB + 512 * 1024, WS_WPE = 62 * MiB + 512 * 1024;
constexpr size_t WS_HB = 64 * MiB;
constexpr size_t WS_HID = 128 * MiB;
constexpr size_t WS_ML = 128 * MiB;
constexpr size_t WS_MST = 256 * MiB;
constexpr size_t WS_QKV1 = 128 * MiB;
constexpr size_t WS_QKV = 320 * MiB;
constexpr size_t WS_A = 416 * MiB, WS_BM = 448 * MiB;
constexpr size_t WS_PB = 480 * MiB;
constexpr size_t WS_G = 128 * MiB;
constexpr size_t WS_TMP = 256 * MiB, WS_MERGED = 320 * MiB;
constexpr size_t WS_PE = 320 * MiB;
constexpr size_t WS_W8 = 497 * MiB;
constexpr size_t WS_SCW = 504 * MiB;
constexpr size_t WS_SC1 = 504 * MiB + 256 * 1024;
constexpr size_t WS_SCX = 3 * MiB + 512 * 1024;
constexpr size_t WS_W1IN8 = 320 * MiB;
constexpr size_t WS_W2IN8 = 505 * MiB;
constexpr size_t WS_SC2 = 504 * MiB + 512 * 1024;
constexpr size_t WS_END = 511 * MiB;
constexpr int CW_BAR = 4096;
constexpr size_t WS_PCNT = 64 * 1024, WS_ROWMAX = 128 * 1024;
constexpr size_t WS_PAR = 512 * 1024;
constexpr int PAR_QG = 0, PAR_KG = 128, PAR_CW = 256, PAR_CB = 256 + 4096, PAR_IB = PAR_CB + 1024, PAR_FB = PAR_IB + 4, PAR_N = PAR_FB + 4;

constexpr int RING_BYTES = 131072, SCR_BYTES = 4 * 36864 + 8192, LDSCTL_OFF = SCR_BYTES, MISC_OFF = LDSCTL_OFF + 320, LDS_BYTES = 163840;

#define GAS __attribute__((address_space(1)))
#define LAS __attribute__((address_space(3)))
typedef unsigned short bf16;
typedef unsigned v4u __attribute__((ext_vector_type(4)));
typedef unsigned v2u __attribute__((ext_vector_type(2)));
typedef float f32x4 __attribute__((ext_vector_type(4)));
typedef GAS unsigned gu32;
#define RLX_AGENT __ATOMIC_RELAXED, __HIP_MEMORY_SCOPE_AGENT
#define LDS_WAIT() asm volatile("s_waitcnt lgkmcnt(0)" ::: "memory")
#define VM_WAIT() asm volatile("s_waitcnt vmcnt(0)" ::: "memory")
__device__ __forceinline__ unsigned f2bf(float f) { unsigned u = __builtin_bit_cast(unsigned, f); return (u + 0x7fffu + ((u >> 16) & 1u)) >> 16; }
__device__ __forceinline__ unsigned pk2(float lo, float hi) { return f2bf(lo) | (f2bf(hi) << 16); }
__device__ __forceinline__ float bfl(unsigned u) { return __uint_as_float(u << 16); }
__device__ __forceinline__ float bfh(unsigned u) { return __uint_as_float(u & 0xffff0000u); }
__device__ __forceinline__ float bf1(bf16 u) { return __uint_as_float((unsigned)u << 16); }

#define XB_TMO      128
#define XB_XCNT(j)  (256  + 64 * (j))
#define XB_XSUB(j)  (1280 + 64 * (j))
#define XB_XGEN(j)  (2304 + 64 * (j))
#define XB_TOP      3328
#define XB_TOPGEN   3392
#define XCD_BAR_WORDS 3456
#define XB_SPIN_CAP (1u << 20)
__device__ __forceinline__ unsigned xb_ld(unsigned* p)              { return __hip_atomic_load(p, __ATOMIC_RELAXED, __HIP_MEMORY_SCOPE_AGENT); }
__device__ __forceinline__ unsigned xb_add(unsigned* p, unsigned v) { return __hip_atomic_fetch_add(p, v, __ATOMIC_RELAXED, __HIP_MEMORY_SCOPE_AGENT); }
__device__ __forceinline__ unsigned xb_xcc_id() { return (unsigned)__builtin_amdgcn_s_getreg((3 << 11) | 20) & 0xFu; }
#define XB_SPIN(cond, bar) do { unsigned _sp = 0; while (cond) { __builtin_amdgcn_s_sleep(1); \
    if ((++_sp & 255u) == 0u) { if (xb_ld(&(bar)[XB_TMO])) break; if (_sp > XB_SPIN_CAP) { atomicAdd(&(bar)[XB_TMO], 1u); break; } } } } while (0)
struct XcdBarrier { unsigned* bar; unsigned x; volatile LAS unsigned* st; };
__device__ __forceinline__ XcdBarrier xcd_barrier_post(unsigned* bar, volatile LAS unsigned* st, bool leader) {
    XcdBarrier b; b.bar = bar; b.x = xb_xcc_id(); b.st = st;
    if (leader) (void)xb_add(&bar[XB_XCNT(b.x)], 1u);
    return b;
}
__device__ __forceinline__ void xcd_barrier_complete(unsigned* bar, unsigned x, unsigned& nloc, unsigned& nx) {
    const unsigned G = gridDim.x * gridDim.y * gridDim.z;
    unsigned sum, cnt, mine, sp = 0u;
    for (;;) {
        sum = 0u; cnt = 0u; mine = 0u;
#pragma unroll
        for (unsigned j = 0; j < 16; ++j) { const unsigned c = xb_ld(&bar[XB_XCNT(j)]); sum += c; cnt += (c > 0u) ? 1u : 0u; mine = (j == x) ? c : mine; }
        if (sum == G) break;
        __builtin_amdgcn_s_sleep(1);
        if ((++sp & 255u) == 0u) { if (xb_ld(&bar[XB_TMO])) break; if (sp > XB_SPIN_CAP) { atomicAdd(&bar[XB_TMO], 1u); break; } }
    }
    nloc = mine > 0u ? mine : 1u; nx = cnt > 0u ? cnt : 1u;
}
__device__ __forceinline__ void xcd_barrier(const XcdBarrier& b, bool leader) {
    asm volatile("s_waitcnt vmcnt(0)" ::: "memory");
    __syncthreads();
    if (leader) {
        unsigned* bar = b.bar;
        __builtin_amdgcn_s_waitcnt(0);
        unsigned nloc = b.st[0], nx = b.st[1];
        if (nloc == 0u) { xcd_barrier_complete(bar, b.x, nloc, nx); b.st[0] = nloc; b.st[1] = nx; }
        const unsigned old = xb_add(&bar[XB_XSUB(b.x)], 1u);
        const unsigned gen = old / nloc;
        if (old + 1u == (gen + 1u) * nloc) {
            __builtin_amdgcn_fence(__ATOMIC_RELEASE, "agent");
            asm volatile("s_waitcnt vmcnt(0)" ::: "memory");
            const unsigned og = xb_add(&bar[XB_TOP], 1u);
            const unsigned tg = og / nx;
            if (og + 1u == (tg + 1u) * nx) xb_add(&bar[XB_TOPGEN], 1u);
            else XB_SPIN(xb_ld(&bar[XB_TOPGEN]) == tg, bar);
            __builtin_amdgcn_fence(__ATOMIC_ACQUIRE, "agent");
            xb_add(&bar[XB_XGEN(b.x)], 1u);
            asm volatile("s_waitcnt vmcnt(0)" ::: "memory");
        } else {
            XB_SPIN(xb_ld(&bar[XB_XGEN(b.x)]) == gen, bar);
            __builtin_amdgcn_fence(__ATOMIC_ACQUIRE, "agent");
            asm volatile("s_waitcnt vmcnt(0)" ::: "memory");
        }
    }
    __syncthreads();
}

struct WD { int src; int gain; unsigned dst; int K, Nsrc, Ndst, kind; };
__constant__ float c_invfreq[16] = {1.000000000e+00f, 4.403666258e-01f, 1.939227581e-01f, 8.539710194e-02f, 3.760603070e-02f, 1.656044088e-02f, 7.292665076e-03f, 3.211446106e-03f,
    1.414213446e-03f, 6.227724371e-04f, 2.742481884e-04f, 1.207697424e-04f, 5.318296462e-05f, 2.341999789e-05f, 1.031338525e-05f, 4.541670478e-06f};
struct Args { const float* in[22]; float* out; unsigned char* ws; int ph_lo, ph_hi; };
enum { I_X = 0, I_P, I_F1N, I_F1WI, I_F1WO, I_MIXN, I_WIN, I_QG, I_KG, I_CW, I_CB, I_IB, I_FB, I_WUA, I_WUM, I_WOUT, I_F2N, I_F2WI, I_F2WO, I_PLN, I_WPG, I_WPE };

__constant__ WD c_wd[10] = {
    {I_F1WI, I_F1N, (unsigned)WS_W1IN, D, 2 * FF, 2 * FF, 1}, {I_F1WO, -1, (unsigned)WS_W1OUT, FF, D, D, 0}, {I_WIN, I_MIXN, (unsigned)WS_WIN, D, D_IN, WIN_ROWS, 2},
    {I_WUA, -1, (unsigned)WS_WUPA, 512, D, D, 0}, {I_WUM, -1, (unsigned)WS_WUPB, 512, D, D, 0}, {I_WOUT, -1, (unsigned)WS_WO, D, D, D, 0},
    {I_F2WI, I_F2N, (unsigned)WS_W2IN, D, 2 * FF, 2 * FF, 1}, {I_F2WO, -1, (unsigned)WS_W2OUT, FF, D, D, 0}, {I_WPG, I_PLN, (unsigned)WS_WPG, D, D, D, 0}, {I_WPE, -1, (unsigned)WS_WPE, PLE, D, D, 0}};
__device__ __forceinline__ float wave_sum(float v) {
#pragma unroll
    for (int o = 1; o < 64; o <<= 1) v += __shfl_xor(v, o);
    return v;
}
__device__ __forceinline__ float wave_max(float v) {
#pragma unroll
    for (int o = 1; o < 64; o <<= 1) v = fmaxf(v, __shfl_xor(v, o));
    return v;
}

__device__ __forceinline__ int wsrc_col(int kind, int n) {
    if (kind == 0) return n;
    if (kind == 1) { const int t = n >> 8, w = n & 255; return (w < 128) ? (128 * t + w) : (FF + 128 * t + (w - 128)); }
    if (n < WIN_ML) { const int g = n / 1536, w = n % 1536, part = w >> 9, c = w & 511; return part * 1536 + g * 512 + c; }
    if (n < WIN_GT + 8) return n;
    if (n < WIN_G) return -1;
    { const int e = n - WIN_G, t = e >> 8, w = e & 255; return (w < 128) ? (WIN_GT + 8) + 128 * t + w : (WIN_GT + 8) + 1024 + 128 * t + (w - 128); }
}
__device__ __forceinline__ void p0_transpose_item(const float* W, const float* gain, int K, int Nsrc, int Ndst, bf16* WT, int kind, LAS float* scr, int item, int lane) {
    const int nblk = Ndst / 64, kb = item / nblk, nb = item % nblk, k0 = 64 * kb, n0 = 64 * nb;
    const int n4 = lane & 15, kr = lane >> 4;
    const int sc = wsrc_col(kind, n0 + 4 * n4);
    f32x4 v[16];
#pragma unroll
    for (int i = 0; i < 16; ++i) { const int k = k0 + 4 * i + kr; v[i] = (sc >= 0) ? *(const f32x4*)(W + (size_t)k * Nsrc + sc) : (f32x4){0.f, 0.f, 0.f, 0.f}; }
#pragma unroll
    for (int i = 0; i < 16; ++i) { const int kk = 4 * i + kr; const float gsc = gain ? gain[k0 + kk] : 1.0f; LAS float* d_ = scr + kk * 65 + 4 * n4;
        d_[0] = v[i][0] * gsc; d_[1] = v[i][1] * gsc; d_[2] = v[i][2] * gsc; d_[3] = v[i][3] * gsc; }
    LDS_WAIT(); asm volatile("" ::: "memory");
#pragma unroll
    for (int j = 0; j < 8; ++j) { const int id = lane + 64 * j, n = id >> 3, c = id & 7; const LAS float* s_ = scr + (8 * c) * 65 + n;
        v4u o; o.x = pk2(s_[0 * 65], s_[1 * 65]); o.y = pk2(s_[2 * 65], s_[3 * 65]); o.z = pk2(s_[4 * 65], s_[5 * 65]); o.w = pk2(s_[6 * 65], s_[7 * 65]);
        *(GAS v4u*)(WT + (size_t)(n0 + n) * K + k0 + 8 * c) = o; }
    LDS_WAIT(); asm volatile("" ::: "memory");
}

__device__ __forceinline__ void mlstm_seq_v0(const Args& a, LAS unsigned char* lds, int bh, int tid) {
    const int f = tid & 127, eg = tid >> 7;
    const int b = bh >> 2, h = bh & 3;
    const bf16* ML = (const bf16*)(a.ws + WS_ML); const float* GT = (const float*)(a.ws + WS_GATES); bf16* BMo = (bf16*)(a.ws + WS_BM);
    LAS float* qs = (LAS float*)lds;
    LAS float* ks = qs + 256;
    LAS float* hp = ks + 256;
    LAS float* dp = hp + 1024;
    const float* par = (const float*)(a.ws + WS_PAR); const float* cw = par + PAR_CW; const float* cb = par + PAR_CB;
    const float ib = par[PAR_IB + h], fb = par[PAR_FB + h];
    const int cch = (tid < 128) ? (h * 128 + tid) : (512 + h * 128 + (tid - 128));
    float w0 = 0.f, w1 = 0.f, w2 = 0.f, w3 = 0.f, wb = 0.f;
    if (tid < 256) { w0 = cw[0 * 1024 + cch]; w1 = cw[1 * 1024 + cch]; w2 = cw[2 * 1024 + cch]; w3 = cw[3 * 1024 + cch]; wb = cb[cch]; }
    float x0 = 0.f, x1 = 0.f, x2 = 0.f;
    float C[32], n[32];
#pragma unroll
    for (int i = 0; i < 32; ++i) { C[i] = 0.f; n[i] = 0.f; }
    float mst = 0.f;
    const size_t row0 = (size_t)b * SEQ;
    float xn = 0.f, vn = 0.f, on = 0.f, lin = 0.f, lfn = 0.f;
    if (tid < 256) xn = bf1(ML[row0 * 2048 + cch]);
    vn = bf1(ML[row0 * 2048 + 1024 + h * 128 + f]); on = bf1(ML[row0 * 2048 + 1536 + h * 128 + f]); lin = GT[row0 * 8 + h]; lfn = GT[row0 * 8 + 4 + h];
    for (int t = 0; t < SEQ; ++t) {
        const int par = t & 1;
        const float x3 = xn, v = vn, og = on, lipre = lin, lfpre = lfn;
        if (t + 1 < SEQ) { const size_t r = row0 + t + 1;
            if (tid < 256) xn = bf1(ML[r * 2048 + cch]);
            vn = bf1(ML[r * 2048 + 1024 + h * 128 + f]); on = bf1(ML[r * 2048 + 1536 + h * 128 + f]); lin = GT[r * 8 + h]; lfn = GT[r * 8 + 4 + h]; }
        if (tid < 256) { float c = wb + w0 * x0 + w1 * x1 + w2 * x2 + w3 * x3; c = c * sigmoidf_(c); if (tid >= 128) c *= 0.08838834764831845f;
            if (tid < 128) qs[par * 128 + tid] = c; else ks[par * 128 + tid - 128] = c; x0 = x1; x1 = x2; x2 = x3; }
        __syncthreads();
        const float li = lipre + ib; const float fx = lfpre + fb;
        const float lf = fminf(fx, 0.f) - log1pf(expf(-fabsf(fx)));
        const float mnew = fmaxf(lf + mst, li);
        const float fp = expf(lf + mst - mnew), ip = expf(li - mnew);
        mst = mnew;
        float hacc = 0.f, dacc = 0.f;
#pragma unroll
        for (int i = 0; i < 32; ++i) { const float kk = ks[par * 128 + eg * 32 + i], qq = qs[par * 128 + eg * 32 + i];
            C[i] = fp * C[i] + ip * kk * v; n[i] = fp * n[i] + ip * kk; hacc += qq * C[i]; dacc += qq * n[i]; }
        hp[par * 512 + eg * 128 + f] = hacc; if (f == 0) dp[par * 4 + eg] = dacc;
        __syncthreads();
        if (tid < 128) { const float num = (hp[par * 512 + f] + hp[par * 512 + 128 + f]) + (hp[par * 512 + 256 + f] + hp[par * 512 + 384 + f]);
            const float den = (dp[par * 4] + dp[par * 4 + 1]) + (dp[par * 4 + 2] + dp[par * 4 + 3]);
            const float hv = num / fmaxf(fabsf(den), expf(-mnew));
            BMo[(row0 + t) * 512 + h * 128 + f] = (bf16)f2bf(sigmoidf_(og) * hv); }
    }
    __syncthreads();
}

__device__ __forceinline__ void attn_v0(const Args& a, LAS unsigned char* lds, int g, int gwave, int ngwave, int wave, int lane, int tid) {
    const int d = (g == 0) ? 1 : (g == 1 ? 4 : 16);
    const bf16* QKV = (const bf16*)(a.ws + WS_QKV); bf16* Ao = (bf16*)(a.ws + WS_A); float* LSE = (float*)(a.ws + WS_LSE);
    const float* rope = (const float*)(a.ws + WS_ROPE);
    const float* qg = (const float*)(a.ws + WS_PAR) + PAR_QG; const float* kg = (const float*)(a.ws + WS_PAR) + PAR_KG;
    LAS float* qsh = (LAS float*)lds + wave * 128;
    LAS float* kgs = (LAS float*)lds + 8 * 128;
    if (tid < 128) kgs[tid] = kg[tid];
    __syncthreads();
    for (int it = gwave; it < M * 4; it += ngwave) {
        const int row = it >> 2, j = it & 3, t = row & (SEQ - 1);
        { const unsigned qq = *(const unsigned*)(QKV + (size_t)row * 1536 + j * 128 + 2 * lane);
          float q0 = bfl(qq), q1 = bfh(qq);
          const float ss = wave_sum(q0 * q0 + q1 * q1); const float rn = __builtin_amdgcn_rsqf(ss * (1.f / 128.f) + 1e-6f);
          q0 *= rn * qg[2 * lane]; q1 *= rn * qg[2 * lane + 1];
          const float p0 = __shfl_xor(q0, 8), p1 = __shfl_xor(q1, 8);
          if (lane < 16) { const int i0 = (2 * lane) & 15; const float c0 = rope[(t * 16 + i0) * 2], s0 = rope[(t * 16 + i0) * 2 + 1], c1 = rope[(t * 16 + i0 + 1) * 2], s1 = rope[(t * 16 + i0 + 1) * 2 + 1];
              if (lane < 8) { q0 = q0 * c0 - p0 * s0; q1 = q1 * c1 - p1 * s1; } else { q0 = q0 * c0 + p0 * s0; q1 = q1 * c1 + p1 * s1; } }
          qsh[2 * lane] = q0; qsh[2 * lane + 1] = q1; }
        LDS_WAIT(); asm volatile("" ::: "memory");
        float sc[3];
#pragma unroll
        for (int c = 0; c < 3; ++c) { const int i = lane + 64 * c; const int s = t - i * d; sc[c] = -INFINITY;
            if (i <= 128 && s >= 0) { const bf16* kr = QKV + (size_t)(row - i * d) * 1536 + 512 + j * 128;
                float ss = 0.f, dot = 0.f; float kx[32];
#pragma unroll
                for (int e8 = 0; e8 < 16; ++e8) { const v4u kv = *(const v4u*)(kr + e8 * 8);
                    float kf[8] = {bfl(kv.x), bfh(kv.x), bfl(kv.y), bfh(kv.y), bfl(kv.z), bfh(kv.z), bfl(kv.w), bfh(kv.w)};
#pragma unroll
                    for (int u = 0; u < 8; ++u) { ss += kf[u] * kf[u]; const int e = e8 * 8 + u; if (e < 32) kx[e] = kf[u] * kgs[e]; else dot += qsh[e] * kf[u] * kgs[e]; } }
#pragma unroll
                for (int i2 = 0; i2 < 16; ++i2) { const float cs = rope[(s * 16 + i2) * 2], sn = rope[(s * 16 + i2) * 2 + 1];
                    dot += qsh[i2] * (kx[i2] * cs - kx[i2 + 16] * sn) + qsh[i2 + 16] * (kx[i2 + 16] * cs + kx[i2] * sn); }
                sc[c] = dot * __builtin_amdgcn_rsqf(ss * (1.f / 128.f) + 1e-6f) * 0.08838834764831845f; } }
        const float mx = wave_max(fmaxf(fmaxf(sc[0], sc[1]), sc[2]));
        float p[3]; float ls = 0.f;
#pragma unroll
        for (int c = 0; c < 3; ++c) { p[c] = expf(sc[c] - mx); ls += p[c]; }
        ls = wave_sum(ls);
        float lse = mx + logf(ls);
        float o0 = 0.f, o1 = 0.f;
        const int imax = (t / d < 128) ? (t / d) : 128;
        for (int i = 0; i <= imax; ++i) { const float psel = (i < 64) ? p[0] : ((i < 128) ? p[1] : p[2]); const float pi = __shfl(psel, i & 63);
            const unsigned vv = *(const unsigned*)(QKV + (size_t)(row - i * d) * 1536 + 1024 + j * 128 + 2 * lane);
            o0 += pi * bfl(vv); o1 += pi * bfh(vv); }
        const float il = 1.f / ls; o0 *= il; o1 *= il;
        if (g > 0) { const float lo = LSE[(size_t)row * 4 + j]; const unsigned ov = *(const unsigned*)(Ao + (size_t)row * 512 + j * 128 + 2 * lane);
            const float mm = fmaxf(lo, lse); const float wo = expf(lo - mm), wn = expf(lse - mm); const float inv = 1.f / (wo + wn);
            o0 = (wo * bfl(ov) + wn * o0) * inv; o1 = (wo * bfh(ov) + wn * o1) * inv; lse = mm + logf(wo + wn); }
        *(unsigned*)(Ao + (size_t)row * 512 + j * 128 + 2 * lane) = pk2(o0, o1);
        if (lane == 0) LSE[(size_t)row * 4 + j] = lse;
    }
    __syncthreads();
}


typedef short bf16x8_t __attribute__((ext_vector_type(8)));
typedef short v4i16_t __attribute__((ext_vector_type(4)));
constexpr int TP = 288, TILE_B = 128 * TP;
#define LANE_ID_F() ({ int _l; asm volatile("v_mbcnt_lo_u32_b32 %0, -1, 0\n\tv_mbcnt_hi_u32_b32 %0, -1, %0" : "=v"(_l)); _l; })
__device__ __forceinline__ bf16x8_t trpair(const LAS unsigned char* pa, const LAS unsigned char* pb) {
    const v4i16_t lo = __builtin_amdgcn_ds_read_tr16_b64_v4i16((LAS v4i16_t*)pa), hi = __builtin_amdgcn_ds_read_tr16_b64_v4i16((LAS v4i16_t*)pb);
    return (bf16x8_t){lo[0], lo[1], lo[2], lo[3], hi[0], hi[1], hi[2], hi[3]};
}
__device__ __forceinline__ void unpack8(const v4u v, float (&f)[8]) { f[0] = bfl(v.x); f[1] = bfh(v.x); f[2] = bfl(v.y); f[3] = bfh(v.y); f[4] = bfl(v.z); f[5] = bfh(v.z); f[6] = bfl(v.w); f[7] = bfh(v.w); }
__device__ __forceinline__ v4u pack8(const float (&f)[8]) { v4u w; w.x = pg8::cvt_pk_bf16(f[0], f[1]); w.y = pg8::cvt_pk_bf16(f[2], f[3]); w.z = pg8::cvt_pk_bf16(f[4], f[5]); w.w = pg8::cvt_pk_bf16(f[6], f[7]); return w; }

typedef float f2_t __attribute__((ext_vector_type(2)));
__device__ __forceinline__ v4u f8to16(const v2u q) {
    const f2_t a_ = __builtin_amdgcn_cvt_pk_f32_fp8((int)q.x, false), b_ = __builtin_amdgcn_cvt_pk_f32_fp8((int)q.x, true), c_ = __builtin_amdgcn_cvt_pk_f32_fp8((int)q.y, false), d_ = __builtin_amdgcn_cvt_pk_f32_fp8((int)q.y, true);
    v4u o_; o_.x = pg8::cvt_pk_bf16(a_[0], a_[1]); o_.y = pg8::cvt_pk_bf16(b_[0], b_[1]); o_.z = pg8::cvt_pk_bf16(c_[0], c_[1]); o_.w = pg8::cvt_pk_bf16(d_[0], d_[1]); return o_; }
__device__ __forceinline__ void attn_fast(unsigned char* ws, const unsigned short* QKV, LAS unsigned char* lds, const int g, const int wave, const int vcu, const int G) {
    const int lane = LANE_ID_F(), tid = wave * 64 + lane, fr = lane & 15, fq = lane >> 4;
    const int lgd = 2 * g, d = 1 << lgd, lgseg = 4 - lgd;
    bf16* Ao = (bf16*)(ws + WS_A); float* LSE = (float*)(ws + WS_LSE);
    const int srow = tid >> 4, c = tid & 15;
    for (int seg = vcu; seg < 256; seg += G) {
        const int stream = seg >> lgseg, n0 = (seg & ((1 << lgseg) - 1)) * 4;
        const int r = stream & (d - 1), j = (stream >> lgd) & 3, b = stream >> (lgd + 2);
        const size_t rowbase = (size_t)b * SEQ + r;
        v2u kreg[4], vreg[4], qraw[4]; bf16x8_t qf[4];
        v2u aold[8]; float lold = 0.f;
#define AT_LOADKV(n) do { _Pragma("unroll") for (int i = 0; i < 4; ++i) { const unsigned char* p_ = (const unsigned char*)QKV + (rowbase + (size_t)((n) * 128 + srow + 32 * i) * d) * 1536 + j * 128 + c * 8; \
            kreg[i] = *(const v2u*)(p_ + 512); vreg[i] = *(const v2u*)(p_ + 1024); } } while (0)
#define AT_LOADQ(n) do { const unsigned char* p_ = (const unsigned char*)QKV + (rowbase + (size_t)((n) * 128 + wave * 16 + fr) * d) * 1536 + j * 128 + fq * 8; \
            _Pragma("unroll") for (int ds = 0; ds < 4; ++ds) qraw[ds] = *(const v2u*)(p_ + ds * 32); } while (0)
        if (n0 > 0) AT_LOADKV(n0 - 1);
#pragma unroll 1
        for (int it = -1; it < 4; ++it) {
            const int n = n0 + it;
            __syncthreads();
            if (it >= 0) {
#pragma unroll
                for (int ds = 0; ds < 4; ++ds) qf[ds] = __builtin_bit_cast(bf16x8_t, f8to16(qraw[ds]));
            }
            { LAS unsigned char* kt = lds + (n & 1) * TILE_B; LAS unsigned char* vt = lds + (2 + (n & 1)) * TILE_B;
              if (n >= 0) {
#pragma unroll
                for (int i = 0; i < 4; ++i) { *(LAS v4u*)(kt + (srow + 32 * i) * TP + c * 16) = f8to16(kreg[i]); *(LAS v4u*)(vt + (srow + 32 * i) * TP + c * 16) = f8to16(vreg[i]); }
              } else {
#pragma unroll
                for (int i = 0; i < 4; ++i) { *(LAS v4u*)(kt + (srow + 32 * i) * TP + c * 16) = (v4u){0u, 0u, 0u, 0u}; *(LAS v4u*)(vt + (srow + 32 * i) * TP + c * 16) = (v4u){0u, 0u, 0u, 0u}; }
              } }
            const size_t qrow = rowbase + (size_t)(n * 128 + wave * 16 + fr) * d;
            bf16* ap = Ao + qrow * 512 + j * 128 + 4 * fq;
            if (it >= 0 && g > 0) {
#pragma unroll
                for (int db = 0; db < 8; ++db) aold[db] = *(const v2u*)(ap + db * 16);
                lold = LSE[qrow * 4 + j]; }
            if (it < 3) { AT_LOADKV(n + 1); AT_LOADQ(n + 1); }
            __syncthreads();
            if (it >= 0) {
                const int kb0 = (wave < 6) ? wave : 6;
                const int slot_prev = (n + 1) & 1, slot_cur = n & 1;
                f32x4 sacc[10];
#pragma unroll
                for (int bp = 0; bp < 5; ++bp) {
                    bf16x8_t kfr[2][4];
#pragma unroll
                    for (int h2 = 0; h2 < 2; ++h2) { const int kb = kb0 + 2 * bp + h2; const int slot = (kb < 8) ? slot_prev : slot_cur;
                        const LAS unsigned char* kp = lds + slot * TILE_B + ((kb & 7) * 16 + fr) * TP + fq * 16;
#pragma unroll
                        for (int ds = 0; ds < 4; ++ds) kfr[h2][ds] = *(const LAS bf16x8_t*)(kp + ds * 64); }
#pragma unroll
                    for (int h2 = 0; h2 < 2; ++h2) { f32x4 a_ = (f32x4){0.f, 0.f, 0.f, 0.f};
#pragma unroll
                        for (int ds = 0; ds < 4; ++ds) a_ = __builtin_amdgcn_mfma_f32_16x16x32_bf16(kfr[h2][ds], qf[ds], a_, 0, 0, 0);
                        sacc[2 * bp + h2] = a_; } }
                const int qi = wave * 16 + fr; float mx = -1e30f;
#pragma unroll
                for (int bb = 0; bb < 10; ++bb) {
                    if (bb < 2 || bb > 7) {
#pragma unroll
                        for (int rg = 0; rg < 4; ++rg) { const int kj = (kb0 + bb) * 16 + 4 * fq + rg; const bool ok = (kj >= qi) && (kj <= qi + 128); sacc[bb][rg] = ok ? sacc[bb][rg] : -1e30f; } }
                    if (n == 0) {
#pragma unroll
                        for (int rg = 0; rg < 4; ++rg) { const int kj = (kb0 + bb) * 16 + 4 * fq + rg; sacc[bb][rg] = (kj >= 128) ? sacc[bb][rg] : -1e30f; } }
#pragma unroll
                    for (int rg = 0; rg < 4; ++rg) mx = fmaxf(mx, sacc[bb][rg]); }
                mx = pg8::xmax_16_32(mx);
                float l = 0.f;
#pragma unroll
                for (int bb = 0; bb < 10; ++bb)
#pragma unroll
                    for (int rg = 0; rg < 4; ++rg) { const float p_ = __builtin_amdgcn_exp2f(sacc[bb][rg] - mx); sacc[bb][rg] = p_; l += p_; }
                l = pg8::xsum_16_32(l);
                f32x4 oacc[8];
#pragma unroll
                for (int db = 0; db < 8; ++db) oacc[db] = (f32x4){0.f, 0.f, 0.f, 0.f};
                const int trq = (lane & 15) >> 2, trp = lane & 3;
#pragma unroll
                for (int sg = 0; sg < 5; ++sg) { const int kbA = kb0 + 2 * sg, kbB = kbA + 1;
                    v4u pw; pw.x = pg8::cvt_pk_bf16(sacc[2 * sg][0], sacc[2 * sg][1]); pw.y = pg8::cvt_pk_bf16(sacc[2 * sg][2], sacc[2 * sg][3]);
                    pw.z = pg8::cvt_pk_bf16(sacc[2 * sg + 1][0], sacc[2 * sg + 1][1]); pw.w = pg8::cvt_pk_bf16(sacc[2 * sg + 1][2], sacc[2 * sg + 1][3]);
                    const bf16x8_t pf = __builtin_bit_cast(bf16x8_t, pw);
                    const LAS unsigned char* va = lds + (2 + ((kbA < 8) ? slot_prev : slot_cur)) * TILE_B + ((kbA & 7) * 16 + 4 * fq + trq) * TP + trp * 8;
                    const LAS unsigned char* vb = lds + (2 + ((kbB < 8) ? slot_prev : slot_cur)) * TILE_B + ((kbB & 7) * 16 + 4 * fq + trq) * TP + trp * 8;
                    bf16x8_t vfr[8];
#pragma unroll
                    for (int db = 0; db < 8; ++db) vfr[db] = trpair(va + db * 32, vb + db * 32);
#pragma unroll
                    for (int db = 0; db < 8; ++db) oacc[db] = __builtin_amdgcn_mfma_f32_16x16x32_bf16(vfr[db], pf, oacc[db], 0, 0, 0); }
                const float il = __builtin_amdgcn_rcpf(l); float lse = mx * 0.6931471805599453f + __logf(l);
                float wo = 0.f, wn = il;
                if (g > 0) { const float mm = fmaxf(lold, lse); const float eo = __expf(lold - mm), en = __expf(lse - mm); const float inv = __builtin_amdgcn_rcpf(eo + en);
                    wo = eo * inv; wn = en * inv * il; lse = mm + __logf(eo + en); }
#pragma unroll
                for (int db = 0; db < 8; ++db) { float o0 = oacc[db][0] * wn, o1 = oacc[db][1] * wn, o2 = oacc[db][2] * wn, o3 = oacc[db][3] * wn;
                    if (g > 0) { const v2u old = aold[db]; o0 += wo * bfl(old.x); o1 += wo * bfh(old.x); o2 += wo * bfl(old.y); o3 += wo * bfh(old.y); }
                    v2u w_; w_.x = pg8::cvt_pk_bf16(o0, o1); w_.y = pg8::cvt_pk_bf16(o2, o3); *(v2u*)(ap + db * 16) = w_; }
                if (fq == 0) LSE[qrow * 4 + j] = lse;
            }
        }
#undef AT_LOADKV
#undef AT_LOADQ
    }
    __syncthreads();
}

constexpr size_t WS_MSC = 496 * MiB;
constexpr size_t WS_CPB = WS_A;
constexpr int GSM_OFF = 4 * TILE_B;
__device__ __forceinline__ float log_sigmoid_(float x) { return fminf(x, 0.f) - log1pf(__expf(-fabsf(x))); }
__device__ __forceinline__ void conv_load(v4u (&raw)[4], const bf16* ML, size_t grow, int tpos, int col) {
#pragma unroll
    for (int jt = 0; jt < 4; ++jt) { const bool ok = (tpos - 3 + jt >= 0); raw[jt] = *(const v4u*)(ML + (ok ? (grow - 3 + jt) : grow) * 2048 + col); }
}
__device__ __forceinline__ void conv_apply(const v4u (&raw)[4], int tpos, const float (&w)[4][8], const float (&bs)[8], float (&o)[8]) {
#pragma unroll
    for (int u = 0; u < 8; ++u) o[u] = bs[u];
#pragma unroll
    for (int jt = 0; jt < 4; ++jt) { const float msk = (tpos - 3 + jt >= 0) ? 1.f : 0.f; float x[8]; unpack8(raw[jt], x);
#pragma unroll
        for (int u = 0; u < 8; ++u) o[u] += (w[jt][u] * msk) * x[u]; }
#pragma unroll
    for (int u = 0; u < 8; ++u) o[u] = o[u] * sigmoidf_(o[u]);
}
__device__ __forceinline__ void conv_piece(const bf16* ML, size_t grow, int tpos, int col, const float (&w)[4][8], const float (&bs)[8], float (&o)[8]) {
    v4u raw[4];
#pragma unroll
    for (int jt = 0; jt < 4; ++jt) { const bool ok = (tpos - 3 + jt >= 0); raw[jt] = *(const v4u*)(ML + (ok ? (grow - 3 + jt) : grow) * 2048 + col); }
#pragma unroll
    for (int u = 0; u < 8; ++u) o[u] = bs[u];
#pragma unroll
    for (int jt = 0; jt < 4; ++jt) { const float msk = (tpos - 3 + jt >= 0) ? 1.f : 0.f; float x[8]; unpack8(raw[jt], x);
#pragma unroll
        for (int u = 0; u < 8; ++u) o[u] += (w[jt][u] * msk) * x[u]; }
#pragma unroll
    for (int u = 0; u < 8; ++u) o[u] = o[u] * sigmoidf_(o[u]);
}
__device__ __forceinline__ float wave_scan_add(float v, int lane) {
#pragma unroll
    for (int o = 1; o < 64; o <<= 1) { const float t = __shfl_up(v, o); if (lane >= o) v += t; }
    return v;
}
__device__ __forceinline__ float wave_scan_max(float v, int lane) {
#pragma unroll
    for (int o = 1; o < 64; o <<= 1) { const float t = __shfl_up(v, o); if (lane >= o) v = fmaxf(v, t); }
    return v;
}
__device__ __forceinline__ void mlstm_b1(unsigned char* ws, LAS unsigned char* lds, const int wave, const int vcu, const int G) {
    const int lane = LANE_ID_F(), tid = wave * 64 + lane, fq = lane >> 4;
    const bf16* ML = (const bf16*)(ws + WS_ML); const float* GT = (const float*)(ws + WS_GATES); const float* par = (const float*)(ws + WS_PAR);
    float* MST = (float*)(ws + WS_MST); float* MSC = (float*)(ws + WS_MSC);
    LAS float* gsm = (LAS float*)(lds + GSM_OFF);
    LAS unsigned char* kt = lds; LAS unsigned char* vt = lds + TILE_B; LAS float* dnp = (LAS float*)(lds + 2 * TILE_B);
    const int srow = tid >> 4, c = tid & 15;
    struct B1Pre { v4u vr[4]; v4u raw[4][4]; };
#define B1_LOAD(P, item_) do { const int bh_ = (item_) >> 6, ch_ = (item_) & 63, h_ = bh_ & 3; const size_t r0_ = (size_t)(bh_ >> 2) * SEQ + ch_ * 128; \
        _Pragma("unroll") for (int i = 0; i < 4; ++i) { const int sr_ = srow + 32 * i; (P).vr[i] = *(const v4u*)(ML + (r0_ + sr_) * 2048 + 1024 + h_ * 128 + c * 8); conv_load((P).raw[i], ML, r0_ + sr_, ch_ * 128 + sr_, 512 + h_ * 128 + c * 8); } } while (0)
    for (int base = 0; base < 1024; base += 4 * G) {
        B1Pre cur_;
        if (base + vcu < 1024) B1_LOAD(cur_, base + vcu);
        __syncthreads();
        { const int k = tid >> 7, s_ = tid & 127, it_ = base + vcu + G * k; const bool ok = it_ < 1024; const int itc = ok ? it_ : 0;
          const int bh = itc >> 6, ch = itc & 63, h = bh & 3; const size_t r = (size_t)(bh >> 2) * SEQ + ch * 128 + s_;
          const float lf = log_sigmoid_(GT[r * 8 + 4 + h] + par[PAR_FB + h]), li = GT[r * 8 + h] + par[PAR_IB + h];
          float b_ = wave_scan_add(lf, lane);
          if (lane == 63) gsm[1664 + wave] = b_;
          __syncthreads();
          if (wave & 1) b_ += gsm[1664 + wave - 1];
          const float bL = gsm[1664 + 2 * k] + gsm[1664 + 2 * k + 1];
          const float g_ = bL - b_ + li;
          const float mw = wave_max(g_);
          if (lane == 0) gsm[1680 + wave] = mw;
          __syncthreads();
          const float mloc = fmaxf(gsm[1680 + 2 * k], gsm[1680 + 2 * k + 1]);
          gsm[k * 128 + s_] = __expf(g_ - mloc);
          if (s_ == 0) { gsm[1696 + k] = mloc; gsm[1700 + k] = bL; }
        }
        __syncthreads();
#pragma unroll 1
        for (int k = 0; k < 4; ++k) { const int item = base + vcu + G * k; if (item >= 1024) break;
            const int bh = item >> 6, ch = item & 63, h = bh & 3; const size_t row0 = (size_t)(bh >> 2) * SEQ + ch * 128;
            if (k > 0) __syncthreads();
            { float w[4][8], bs[8]; const int col = 512 + h * 128 + c * 8;
#pragma unroll
              for (int jt = 0; jt < 4; ++jt)
#pragma unroll
                  for (int u = 0; u < 8; ++u) w[jt][u] = par[PAR_CW + jt * 1024 + col + u];
#pragma unroll
              for (int u = 0; u < 8; ++u) bs[u] = par[PAR_CB + col + u];
              float dn[8];
#pragma unroll
              for (int u = 0; u < 8; ++u) dn[u] = 0.f;
#pragma unroll
              for (int i = 0; i < 4; ++i) { const int sr = srow + 32 * i; float o[8]; conv_apply(cur_.raw[i], ch * 128 + sr, w, bs, o);
                  const float sc = 0.08838834764831845f * gsm[k * 128 + sr];
#pragma unroll
                  for (int u = 0; u < 8; ++u) { o[u] *= sc; dn[u] += o[u]; }
                  *(LAS v4u*)(kt + sr * TP + c * 16) = pack8(o);
                  *(LAS v4u*)(vt + sr * TP + c * 16) = cur_.vr[i]; }
#pragma unroll
              for (int u = 0; u < 8; ++u) dnp[srow * 128 + c * 8 + u] = dn[u]; }
            __syncthreads();
            if (tid < 128) { float a_ = 0.f;
#pragma unroll 8
                for (int r = 0; r < 32; ++r) a_ += dnp[r * 128 + tid];
                MSC[(size_t)item * 256 + tid] = a_; }
            if (tid == 0) { MSC[(size_t)item * 256 + 128] = gsm[1696 + k]; MSC[(size_t)item * 256 + 129] = gsm[1700 + k]; }
            { const int nitem = item + G; if (k < 3 && nitem < 1024) B1_LOAD(cur_, nitem); }
            { const int trq = (lane & 15) >> 2, trp = lane & 3; f32x4 acc[8];
#pragma unroll
              for (int fb = 0; fb < 8; ++fb) acc[fb] = (f32x4){0.f, 0.f, 0.f, 0.f};
#pragma unroll
              for (int ks = 0; ks < 4; ++ks) { const int ra = ks * 32 + 4 * fq + trq;
                  const bf16x8_t kf = trpair(kt + ra * TP + (wave * 16 + 4 * trp) * 2, kt + (ra + 16) * TP + (wave * 16 + 4 * trp) * 2);
                  bf16x8_t vfr[8];
#pragma unroll
                  for (int fb = 0; fb < 8; ++fb) vfr[fb] = trpair(vt + ra * TP + (fb * 16 + 4 * trp) * 2, vt + (ra + 16) * TP + (fb * 16 + 4 * trp) * 2);
#pragma unroll
                  for (int fb = 0; fb < 8; ++fb) acc[fb] = __builtin_amdgcn_mfma_f32_16x16x32_bf16(vfr[fb], kf, acc[fb], 0, 0, 0); }
              float* dst = MST + (size_t)item * 16384 + (size_t)(wave * 16 + (lane & 15)) * 128 + 4 * fq;
#pragma unroll
              for (int fb = 0; fb < 8; ++fb) *(f32x4*)(dst + fb * 16) = acc[fb]; }
        }
    }
    __syncthreads();
}
__device__ __forceinline__ void mlstm_b2(unsigned char* ws, const int wave, const int vcu, const int G) {
    const int lane = LANE_ID_F(), tid = wave * 64 + lane;
    const float* MST = (const float*)(ws + WS_MST); float* MSC = (float*)(ws + WS_MSC); unsigned* CPB = (unsigned*)(ws + WS_CPB);
    typedef float f32x2 __attribute__((ext_vector_type(2)));
    for (int gid = vcu * NTHREADS + tid; gid < 16 * 8192; gid += G * NTHREADS) {
        const int bh = gid >> 13, rem = gid & 8191;
        float m = 0.f; f32x2 C = {0.f, 0.f}, nn = {0.f, 0.f};
        const f32x2* p = (const f32x2*)(MST + (size_t)bh * 64 * 16384) + rem; unsigned* cp = CPB + (size_t)bh * 64 * 8192 + rem; float* sc = MSC + (size_t)bh * 64 * 256;
#pragma unroll 1
        for (int c0 = 0; c0 < 64; c0 += 16) {
            f32x2 dv[16], dn[16]; float ml[16], bl[16];
#pragma unroll
            for (int k = 0; k < 16; ++k) { dv[k] = p[(size_t)(c0 + k) * 8192]; ml[k] = sc[(c0 + k) * 256 + 128]; bl[k] = sc[(c0 + k) * 256 + 129]; if (rem < 64) dn[k] = *(const f32x2*)(sc + (c0 + k) * 256 + 2 * rem); }
#pragma unroll
            for (int k = 0; k < 16; ++k) { const float mn = fmaxf(bl[k] + m, ml[k]); const float sp = __expf(bl[k] + m - mn), sn = __expf(ml[k] - mn);
                cp[(size_t)(c0 + k) * 8192] = pg8::cvt_pk_bf16(C[0], C[1]); C = C * sp + dv[k] * sn;
                if (rem < 64) { *(f32x2*)(sc + (c0 + k) * 256 + 2 * rem) = nn; nn = nn * sp + dn[k] * sn; }
                if (rem == 0) sc[(c0 + k) * 256 + 130] = m;
                m = mn; }
        }
    }
}
__device__ __forceinline__ void mlstm_b3(unsigned char* ws, const unsigned char* MO8, LAS unsigned char* lds, const int wave, const int vcu, const int G) {
    const int lane = LANE_ID_F(), tid = wave * 64 + lane, fr = lane & 15, fq = lane >> 4;
    const bf16* ML = (const bf16*)(ws + WS_ML); const float* GT = (const float*)(ws + WS_GATES); const float* par = (const float*)(ws + WS_PAR);
    const bf16* CPBr = (const bf16*)(ws + WS_CPB); const float* MSC = (const float*)(ws + WS_MSC); bf16* BMo = (bf16*)(ws + WS_BM);
    LAS float* gsm = (LAS float*)(lds + GSM_OFF);
    LAS unsigned char* qt = lds; LAS unsigned char* kt = lds + TILE_B; LAS unsigned char* vt = lds + 2 * TILE_B; LAS unsigned char* ct = lds + 3 * TILE_B;
    const int srow = tid >> 4, c = tid & 15;
    struct B3Pre { v4u vr[4], cr[4]; };
#define B3_LOAD(P, item_) do { const int bh_ = (item_) >> 6, ch_ = (item_) & 63, h_ = bh_ & 3; const size_t r0_ = (size_t)(bh_ >> 2) * SEQ + ch_ * 128; \
        _Pragma("unroll") for (int i = 0; i < 4; ++i) { const int sr_ = srow + 32 * i; (P).vr[i] = *(const v4u*)(ML + (r0_ + sr_) * 2048 + 1024 + h_ * 128 + c * 8); (P).cr[i] = *(const v4u*)(CPBr + (size_t)(item_) * 16384 + sr_ * 128 + c * 8); \
            } } while (0)
    for (int base = 0; base < 1024; base += 4 * G) {
        B3Pre cur_;
        if (base + vcu < 1024) B3_LOAD(cur_, base + vcu);
        __syncthreads();
        { const int k = tid >> 7, s_ = tid & 127, it_ = base + vcu + G * k; const bool ok = it_ < 1024; const int itc = ok ? it_ : 0;
          const int bh = itc >> 6, ch = itc & 63, h = bh & 3; const size_t r = (size_t)(bh >> 2) * SEQ + ch * 128 + s_;
          const float lf = log_sigmoid_(GT[r * 8 + 4 + h] + par[PAR_FB + h]), li = GT[r * 8 + h] + par[PAR_IB + h];
          const float mprev = MSC[(size_t)itc * 256 + 130];
          float b_ = wave_scan_add(lf, lane);
          if (lane == 63) gsm[1664 + wave] = b_;
          __syncthreads();
          if (wave & 1) b_ += gsm[1664 + wave - 1];
          const float a_ = li - b_;
          float cm = wave_scan_max(a_, lane);
          if (lane == 63) gsm[1680 + wave] = cm;
          __syncthreads();
          if (wave & 1) cm = fmaxf(cm, gsm[1680 + wave - 1]);
          const float Mt = fmaxf(mprev, cm);
          gsm[k * 128 + s_] = a_; gsm[512 + k * 128 + s_] = Mt; gsm[1024 + k * 128 + s_] = b_ + Mt;
          if (s_ == 0) gsm[1696 + k] = mprev;
        }
        __syncthreads();
#pragma unroll 1
        for (int k = 0; k < 4; ++k) { const int item = base + vcu + G * k; if (item >= 1024) break;
            const int bh = item >> 6, ch = item & 63, h = bh & 3; const size_t row0 = (size_t)(bh >> 2) * SEQ + ch * 128;
            if (k > 0) __syncthreads();
            const float mprev = gsm[1696 + k];
            if (tid < 128) gsm[1536 + tid] = MSC[(size_t)item * 256 + tid];
            {
#pragma unroll
              for (int which = 0; which < 2; ++which) { float w[4][8], bs[8]; const int col = which * 512 + h * 128 + c * 8; LAS unsigned char* dt = which ? kt : qt; const float sc = which ? 0.08838834764831845f : 1.0f;
#pragma unroll
                for (int jt = 0; jt < 4; ++jt)
#pragma unroll
                    for (int u = 0; u < 8; ++u) w[jt][u] = par[PAR_CW + jt * 1024 + col + u];
#pragma unroll
                for (int u = 0; u < 8; ++u) bs[u] = par[PAR_CB + col + u];
#pragma unroll
                for (int i = 0; i < 4; ++i) { const int sr = srow + 32 * i; float o[8]; conv_piece(ML, row0 + sr, ch * 128 + sr, col, w, bs, o);
#pragma unroll
                    for (int u = 0; u < 8; ++u) o[u] *= sc;
                    *(LAS v4u*)(dt + sr * TP + c * 16) = pack8(o); } }
#pragma unroll
              for (int i = 0; i < 4; ++i) { const int sr = srow + 32 * i; *(LAS v4u*)(vt + sr * TP + c * 16) = cur_.vr[i]; *(LAS v4u*)(ct + sr * TP + c * 16) = cur_.cr[i]; } }
            { const int nitem = item + G; if (k < 3 && nitem < 1024) B3_LOAD(cur_, nitem); }
            __syncthreads();
            { const int trq = (lane & 15) >> 2, trp = lane & 3;
              bf16x8_t qf[4];
#pragma unroll
              for (int ds = 0; ds < 4; ++ds) qf[ds] = *(const LAS bf16x8_t*)(qt + (wave * 16 + fr) * TP + ds * 64 + fq * 16);
              const int t = wave * 16 + fr; const float Mt = gsm[512 + k * 128 + t], mt = gsm[1024 + k * 128 + t]; const float dec = __expf(mprev - Mt);
              const size_t orow = row0 + t;
              unsigned og[8];
#pragma unroll
              for (int fb = 0; fb < 8; ++fb) og[fb] = *(const unsigned*)(MO8 + orow * 512 + h * 128 + fb * 16 + 4 * fq);
              f32x4 acc[8];
#pragma unroll
              for (int fb = 0; fb < 8; ++fb) acc[fb] = (f32x4){0.f, 0.f, 0.f, 0.f};
#pragma unroll
              for (int ds = 0; ds < 4; ++ds) { const int ra = ds * 32 + 8 * fq + trq;
                  bf16x8_t cfr[8];
#pragma unroll
                  for (int fb = 0; fb < 8; ++fb) cfr[fb] = trpair(ct + ra * TP + (fb * 16 + 4 * trp) * 2, ct + (ra + 4) * TP + (fb * 16 + 4 * trp) * 2);
#pragma unroll
                  for (int fb = 0; fb < 8; ++fb) acc[fb] = __builtin_amdgcn_mfma_f32_16x16x32_bf16(cfr[fb], qf[ds], acc[fb], 0, 0, 0); }
              float qn = 0.f;
#pragma unroll
              for (int ds = 0; ds < 4; ++ds) { float qv[8]; unpack8(__builtin_bit_cast(v4u, qf[ds]), qv); const f32x4 n0 = *(const LAS f32x4*)(gsm + 1536 + ds * 32 + fq * 8), n1 = *(const LAS f32x4*)(gsm + 1536 + ds * 32 + fq * 8 + 4);
#pragma unroll
                  for (int u = 0; u < 4; ++u) qn += qv[u] * n0[u] + qv[4 + u] * n1[u]; }
              qn = pg8::xsum_16_32(qn);
#pragma unroll
              for (int fb = 0; fb < 8; ++fb) acc[fb] *= dec;
              f32x4 sacc[8]; float dsum = 0.f;
#pragma unroll
              for (int sb = 0; sb < 8; ++sb) { sacc[sb] = (f32x4){0.f, 0.f, 0.f, 0.f};
                  if (sb <= wave) {
                      bf16x8_t kfr[4];
#pragma unroll
                      for (int ds = 0; ds < 4; ++ds) kfr[ds] = *(const LAS bf16x8_t*)(kt + (sb * 16 + fr) * TP + ds * 64 + fq * 16);
#pragma unroll
                      for (int ds = 0; ds < 4; ++ds) sacc[sb] = __builtin_amdgcn_mfma_f32_16x16x32_bf16(kfr[ds], qf[ds], sacc[sb], 0, 0, 0);
                      const f32x4 a4 = *(const LAS f32x4*)(gsm + k * 128 + sb * 16 + 4 * fq);
#pragma unroll
                      for (int rg = 0; rg < 4; ++rg) { const int s_ = sb * 16 + 4 * fq + rg; const float p_ = (s_ <= t) ? sacc[sb][rg] * __expf(a4[rg] - Mt) : 0.f; sacc[sb][rg] = p_; dsum += p_; } } }
              dsum = pg8::xsum_16_32(dsum);
#pragma unroll
              for (int ks = 0; ks < 4; ++ks) { if (2 * ks <= wave) {
                  v4u pw; pw.x = pg8::cvt_pk_bf16(sacc[2 * ks][0], sacc[2 * ks][1]); pw.y = pg8::cvt_pk_bf16(sacc[2 * ks][2], sacc[2 * ks][3]);
                  pw.z = pg8::cvt_pk_bf16(sacc[2 * ks + 1][0], sacc[2 * ks + 1][1]); pw.w = pg8::cvt_pk_bf16(sacc[2 * ks + 1][2], sacc[2 * ks + 1][3]);
                  const bf16x8_t pf = __builtin_bit_cast(bf16x8_t, pw); const int ra = ks * 32 + 4 * fq + trq;
                  bf16x8_t vfr[8];
#pragma unroll
                  for (int fb = 0; fb < 8; ++fb) vfr[fb] = trpair(vt + ra * TP + (fb * 16 + 4 * trp) * 2, vt + (ra + 16) * TP + (fb * 16 + 4 * trp) * 2);
#pragma unroll
                  for (int fb = 0; fb < 8; ++fb) acc[fb] = __builtin_amdgcn_mfma_f32_16x16x32_bf16(vfr[fb], pf, acc[fb], 0, 0, 0); } }
              const float den = dec * qn + dsum; const float inv = __builtin_amdgcn_rcpf(fmaxf(fabsf(den), __expf(-mt)));
#pragma unroll
              for (int fb = 0; fb < 8; ++fb) {
                  const float i5 = inv * (1.0f / 255.0f); const unsigned o8 = og[fb];
                  v2u w_; w_.x = pg8::cvt_pk_bf16((float)(o8 & 255u) * acc[fb][0] * i5, (float)((o8 >> 8) & 255u) * acc[fb][1] * i5);
                  w_.y = pg8::cvt_pk_bf16((float)((o8 >> 16) & 255u) * acc[fb][2] * i5, (float)(o8 >> 24) * acc[fb][3] * i5);
                  *(v2u*)(BMo + orow * 512 + h * 128 + fb * 16 + 4 * fq) = w_; } }
        }
    }
    __syncthreads();
}

template <int NR> __device__ __forceinline__ void quant_rows_i8(const bf16* const (&src)[NR], unsigned char* const (&dst)[NR], float* const (&sc)[NR], int lane) {
    v4u ra[NR], rb[NR];
#pragma unroll
    for (int q = 0; q < NR; ++q) { ra[q] = *(const v4u*)(src[q] + lane * 16); rb[q] = *(const v4u*)(src[q] + lane * 16 + 8); }
#pragma unroll
    for (int q = 0; q < NR; ++q) { float f[16];
        { float t0[8], t1[8]; unpack8(ra[q], t0); unpack8(rb[q], t1);
#pragma unroll
          for (int u = 0; u < 8; ++u) { f[u] = t0[u]; f[8 + u] = t1[u]; } }
        float am = 0.f;
#pragma unroll
        for (int u = 0; u < 16; ++u) am = fmaxf(am, fabsf(f[u]));
        am = wave_max(am);
        const float inv = (am > 0.f) ? 127.0f / am : 0.f;
        unsigned w[4];
#pragma unroll
        for (int d4 = 0; d4 < 4; ++d4) { unsigned p = 0u;
#pragma unroll
            for (int u = 0; u < 4; ++u) { const int qi = (int)__builtin_rintf(f[d4 * 4 + u] * inv); p |= ((unsigned)qi & 255u) << (8 * u); }
            w[d4] = p; }
        *(v4u*)(dst[q] + lane * 16) = (v4u){w[0], w[1], w[2], w[3]};
        if (lane == 0) *sc[q] = (am > 0.f) ? am * (1.0f / 127.0f) : 1.0f; }
}
typedef __bf16 bf16x2_t __attribute__((ext_vector_type(2)));
__device__ __forceinline__ float dot2bf(unsigned a, unsigned b, float c) { return __builtin_amdgcn_fdot2_f32_bf16(__builtin_bit_cast(bf16x2_t, a), __builtin_bit_cast(bf16x2_t, b), c, false); }
struct QRows { v4u a[4], b[4]; float ss; };
template <bool GATES> __device__ __forceinline__ void qrows_load(QRows& q, const bf16* HBr, const float* RSr, int lane) {
#pragma unroll
    for (int r = 0; r < 4; ++r) { q.a[r] = *(const v4u*)(HBr + (size_t)r * D + lane * 16); q.b[r] = *(const v4u*)(HBr + (size_t)r * D + lane * 16 + 8); }
    if constexpr (GATES) q.ss = RSr[lane]; else q.ss = 0.f;
}
template <bool GATES> __device__ __forceinline__ void quant_rows_gates4(const QRows& qr, unsigned char* H8r, float* SCHr, float* GTr, const v4u (&wg)[8][2], int lane) {
    float ss = qr.ss;
    if constexpr (GATES) { ss += __shfl_xor(ss, 1); ss += __shfl_xor(ss, 2); ss += __shfl_xor(ss, 4); ss += __shfl_xor(ss, 8); }
#pragma unroll
    for (int q = 0; q < 4; ++q) { float f[16];
        { float t0[8], t1[8]; unpack8(qr.a[q], t0); unpack8(qr.b[q], t1);
#pragma unroll
          for (int u = 0; u < 8; ++u) { f[u] = t0[u]; f[8 + u] = t1[u]; } }
        float am = 0.f;
#pragma unroll
        for (int u = 0; u < 16; ++u) am = fmaxf(am, fabsf(f[u]));
        am = wave_max(am);
        const float inv = (am > 0.f) ? 127.0f / am : 0.f;
        unsigned w[4];
#pragma unroll
        for (int d4 = 0; d4 < 4; ++d4) { unsigned p = 0u;
#pragma unroll
            for (int u = 0; u < 4; ++u) { const int qi = (int)__builtin_rintf(f[d4 * 4 + u] * inv); p |= ((unsigned)qi & 255u) << (8 * u); }
            w[d4] = p; }
        *(v4u*)(H8r + (size_t)q * D + lane * 16) = (v4u){w[0], w[1], w[2], w[3]};
        if (lane == 0) SCHr[q] = (am > 0.f) ? am * (1.0f / 127.0f) : 1.0f;
        if constexpr (GATES) {
        float d[8];
#pragma unroll
        for (int j = 0; j < 8; ++j) { float a = 0.f;
            a = dot2bf(qr.a[q].x, wg[j][0].x, a); a = dot2bf(qr.a[q].y, wg[j][0].y, a); a = dot2bf(qr.a[q].z, wg[j][0].z, a); a = dot2bf(qr.a[q].w, wg[j][0].w, a);
            a = dot2bf(qr.b[q].x, wg[j][1].x, a); a = dot2bf(qr.b[q].y, wg[j][1].y, a); a = dot2bf(qr.b[q].z, wg[j][1].z, a); a = dot2bf(qr.b[q].w, wg[j][1].w, a);
            d[j] = a; }
        const bool h5 = (lane & 32) != 0, h4 = (lane & 16) != 0, h3 = (lane & 8) != 0;
        float e[4];
#pragma unroll
        for (int i = 0; i < 4; ++i) { const float keep = h5 ? d[4 + i] : d[i], send = h5 ? d[i] : d[4 + i]; e[i] = keep + __shfl_xor(send, 32); }
        float g2[2];
#pragma unroll
        for (int i = 0; i < 2; ++i) { const float keep = h4 ? e[2 + i] : e[i], send = h4 ? e[i] : e[2 + i]; g2[i] = keep + __shfl_xor(send, 16); }
        float v = (h3 ? g2[1] : g2[0]) + __shfl_xor(h3 ? g2[0] : g2[1], 8);
        v += __shfl_xor(v, 4); v += __shfl_xor(v, 2); v += __shfl_xor(v, 1);
        const float r = __builtin_amdgcn_rsqf(__shfl(ss, q * 16) * (1.0f / 1024.0f) + pg8::RMS_EPS);
        if ((lane & 7) == 0) GTr[q * 8 + (lane >> 3)] = v * r; } }
}
__global__ void __launch_bounds__(NTHREADS, 2) mega(Args args) {
    extern __shared__ __attribute__((aligned(16))) unsigned char lds_raw[];
    LAS unsigned char* lds = (LAS unsigned char*)lds_raw;
    volatile LAS unsigned* MISC = (volatile LAS unsigned*)(lds + MISC_OFF);
    const int wave = __builtin_amdgcn_readfirstlane(threadIdx.x >> 6);
#define LANE_ID() ({ int _l; asm volatile("v_mbcnt_lo_u32_b32 %0, -1, 0\n\tv_mbcnt_hi_u32_b32 %0, -1, %0" : "=v"(_l)); _l; })
    const int G = gridDim.x; const int bx = blockIdx.x; const int vcu = (G % 8 == 0) ? (bx % 8) * (G / 8) + bx / 8 : bx;
    unsigned char* ws = args.ws;
    gu32* ctl = (gu32*)(ws + WS_CTL);
    { const int tid = wave * 64 + LANE_ID(); for (int u = tid; u < (LDS_BYTES - LDSCTL_OFF) / 4; u += NTHREADS) ((LAS unsigned*)(lds + LDSCTL_OFF))[u] = 0u; }
    __syncthreads();
    XcdBarrier bar; bar.bar = (unsigned*)(ctl + CW_BAR); bar.x = 0; bar.st = nullptr;
#if !MK_PER_PHASE
    bar = xcd_barrier_post((unsigned*)(ctl + CW_BAR), MISC + 8, (wave == 0) && (LANE_ID() == 0));
#define GRID_BAR() xcd_barrier(bar, (wave == 0) && (LANE_ID() == 0))
#else
#define GRID_BAR() do {} while (0)
#endif
    const int lo = args.ph_lo, hi = args.ph_hi;
#define IN(k) (lo <= (k) && (k) < hi)
#define SEAM(k) do { if (IN(k) && IN((k) + 1)) { GRID_BAR(); if (PROBE_MASK & (1u << 29)) { GRID_BAR(); GRID_BAR(); } } } while (0)
    const int gw = vcu * NWAVES + wave, NGW = G * NWAVES;
    bf16* HB = (bf16*)(ws + WS_HB); float* RS = (float*)(ws + WS_RS);

    if (IN(0)) REP(0) {
        const int lane = LANE_ID(), tid = wave * 64 + lane;
        LAS float* scr = (LAS float*)(lds + wave * 16640);
        {
            const WD* wd = c_wd;
            int base = 0;
#pragma unroll 1
            for (int w = 0; w < 10; ++w) { const int K = wd[w].K, Nsrc = wd[w].Nsrc, Ndst = wd[w].Ndst, kind = wd[w].kind; const int nit = (K / 64) * (Ndst / 64);
                const float* W = args.in[wd[w].src]; const float* gn = wd[w].gain >= 0 ? args.in[wd[w].gain] : nullptr; bf16* WT = (bf16*)(ws + wd[w].dst);
                int first = (gw - base) % NGW; if (first < 0) first += NGW;
                for (int it = first; it < nit; it += NGW) p0_transpose_item(W, gn, K, Nsrc, Ndst, WT, kind, scr, it, lane);
                base = (base + nit) % NGW; }
        }
        const float* x = args.in[I_X];
        for (int m0 = gw * 4; m0 < M; m0 += NGW * 4) {
            f32x4 v[4][4]; float s4[4];
#pragma unroll
            for (int q = 0; q < 4; ++q) { const GAS f32x4* xr = (const GAS f32x4*)(x + (size_t)(m0 + q) * D) + lane;
#pragma unroll
                for (int j = 0; j < 4; ++j) v[q][j] = xr[64 * j]; }
#pragma unroll
            for (int q = 0; q < 4; ++q) { float s_ = 0.f;
#pragma unroll
                for (int j = 0; j < 4; ++j) s_ += (v[q][j][0] * v[q][j][0] + v[q][j][1] * v[q][j][1]) + (v[q][j][2] * v[q][j][2] + v[q][j][3] * v[q][j][3]);
                s4[q] = wave_sum(s_);
                float am = 0.f;
#pragma unroll
                for (int j = 0; j < 4; ++j) am = fmaxf(fmaxf(am, fmaxf(fabsf(v[q][j][0]), fabsf(v[q][j][1]))), fmaxf(fabsf(v[q][j][2]), fabsf(v[q][j][3])));
                am = wave_max(am); const float inv = (am > 0.f) ? 127.0f / am : 0.f;
                GAS unsigned* o4 = (GAS unsigned*)((unsigned char*)args.out + (size_t)(m0 + q) * D) + lane;
                GAS unsigned* e4 = (GAS unsigned*)((unsigned char*)args.out + (size_t)64 * MiB + (size_t)(m0 + q) * D) + lane;
#pragma unroll
                for (int j = 0; j < 4; ++j) { unsigned pq = 0u, pe = 0u;
#pragma unroll
                    for (int u = 0; u < 4; ++u) { const float t_ = v[q][j][u] * inv, qf_ = __builtin_rintf(t_); pq |= ((unsigned)(int)qf_ & 255u) << (8 * u); pe |= ((unsigned)(int)__builtin_rintf((t_ - qf_) * 254.0f) & 255u) << (8 * u); }
                    o4[64 * j] = pq; e4[64 * j] = pe; }
                if (lane == 0) ((float*)(ws + WS_SCX))[m0 + q] = (am > 0.f) ? am * (1.0f / 127.0f) : 1.0f; }
            { const int q = lane >> 4, sl = lane & 15; const float sv = (q == 0) ? s4[0] : (q == 1) ? s4[1] : (q == 2) ? s4[2] : s4[3]; RS[(size_t)(m0 + q) * 16 + sl] = (sl == 0) ? sv : 0.f; }
        }
        const float* p = args.in[I_P]; bf16* PB = (bf16*)(ws + WS_PB);
        for (int m = gw; m < M; m += NGW) { const f32x4 v = *((const GAS f32x4*)(p + (size_t)m * PLE) + lane); v2u o; o.x = pk2(v[0], v[1]); o.y = pk2(v[2], v[3]); *((GAS v2u*)(PB + (size_t)m * PLE) + lane) = o; }
        if (bx == 0) { float* par = (float*)(ws + WS_PAR);
            for (int e = tid; e < PAR_N; e += NTHREADS) { float v;
                if (e < PAR_KG) v = args.in[I_QG][e]; else if (e < PAR_CW) v = args.in[I_KG][e - PAR_KG]; else if (e < PAR_CB) v = args.in[I_CW][e - PAR_CW];
                else if (e < PAR_IB) v = args.in[I_CB][e - PAR_CB]; else if (e < PAR_FB) v = args.in[I_IB][e - PAR_IB]; else v = args.in[I_FB][e - PAR_FB];
                par[e] = v; } }
        float* rope = (float*)(ws + WS_ROPE);
        for (int e = vcu * NTHREADS + tid; e < SEQ * 16; e += G * NTHREADS) { const int t = e >> 4, i = e & 15;
            const float invf = c_invfreq[i];
            const float ang = (float)t * invf; const double rev = (double)ang * 0.15915494309189535; const float fr = (float)(rev - __builtin_floor(rev));
            rope[e * 2] = __builtin_amdgcn_cosf(fr); rope[e * 2 + 1] = __builtin_amdgcn_sinf(fr); }
    }
    using namespace pg8;
    if (IN(0)) { GRID_BAR();
        const int lane = LANE_ID(); const bf16* WT = (const bf16*)(ws + WS_WIN); unsigned char* W8 = ws + WS_W8; float* SCWw = (float*)(ws + WS_SCW);
        const bf16* W1T = (const bf16*)(ws + WS_W1IN); unsigned char* W18 = ws + WS_W1IN8; float* SC1w = (float*)(ws + WS_SC1);
        const bf16* W2T = (const bf16*)(ws + WS_W2IN); unsigned char* W28 = ws + WS_W2IN8; float* SC2w = (float*)(ws + WS_SC2);
        for (int n = gw; n < 7168 + 2 * 5632; n += NGW) {
            const bf16* sp_; unsigned char* dp_; float* cp_;
            if (n < 7168) { int srow = (n < 4608) ? n : (n < 6656) ? n + (WIN_G - 4608) : n + (WIN_ML + 1536 - 6656);
                if (n < 4608 && ((n % 1536) >> 9) < 2) { const int cp = n & 127, L = cp >> 3, s_ = cp & 7; srow = n - cp + ((s_ == 0) ? L : (s_ == 1) ? 16 + L : 32 + 6 * L + (s_ - 2)); }
                sp_ = WT + (size_t)srow * D; dp_ = W8 + (size_t)n * D; cp_ = SCWw + n; }
            else if (n < 7168 + 5632) { const int r_ = n - 7168; sp_ = W1T + (size_t)r_ * D; dp_ = W18 + (size_t)r_ * D; cp_ = SC1w + r_; }
            else { const int r_ = n - 7168 - 5632; sp_ = W2T + (size_t)r_ * D; dp_ = W28 + (size_t)r_ * D; cp_ = SC2w + r_; }
            const bf16* const src[1] = {sp_}; unsigned char* const dst[1] = {dp_}; float* const sc[1] = {cp_};
            quant_rows_i8<1>(src, dst, sc, lane); } }
    SEAM(0);
    if (IN(1)) REP(1) { Gemm g{(const bf16*)args.out, (const bf16*)(ws + WS_W1IN8), M, 2 * FF, D / 2, (const float*)(ws + WS_SC1), (const float*)(ws + WS_SCX)}; StaticOrder S; S.init(M, 2 * FF, G, bx);
        EpiSwiglu E{(bf16*)(ws + WS_HID), FF, RS}; gemm_phase<EpiSwiglu, StaticOrder, true, true, false, true>(lds, g, S, E, wave); }
    SEAM(1);
    if (IN(2)) REP(2) { Gemm g{(const bf16*)(ws + WS_HID), (const bf16*)(ws + WS_W1OUT), M, D, FF}; StaticOrder S; S.init(M, D, G, bx);
        EpiResidX E{(const unsigned char*)args.out, (const unsigned char*)args.out + (size_t)64 * MiB, (const float*)(ws + WS_SCX), HB, RS, 0.5f}; gemm_phase<EpiResidX, StaticOrder, true, true>(lds, g, S, E, wave); }
    SEAM(2);
    unsigned char* H8 = (unsigned char*)args.out; float* SCH = (float*)((unsigned char*)args.out + (size_t)32 * MiB);
    const float* SCW = (const float*)(ws + WS_SCW); const bf16* W8b = (const bf16*)(ws + WS_W8); const bf16* H8b = (const bf16*)H8;
    if (IN(3)) { { const int lane = LANE_ID();
            v4u wg[8][2];
#pragma unroll
            for (int j = 0; j < 8; ++j) { const bf16* wr_ = (const bf16*)(ws + WS_WIN) + (size_t)(WIN_GT + j) * D + lane * 16; wg[j][0] = *(const v4u*)wr_; wg[j][1] = *(const v4u*)(wr_ + 8); }
            QRows cur, nx; int m0 = gw * 4; qrows_load<true>(cur, HB + (size_t)m0 * D, RS + (size_t)m0 * 16, lane);
            for (; m0 < M; m0 += NGW * 4) { const int m1 = m0 + NGW * 4; nx = cur; if (m1 < M) qrows_load<true>(nx, HB + (size_t)m1 * D, RS + (size_t)m1 * 16, lane);
                quant_rows_gates4<true>(cur, H8 + (size_t)m0 * D, SCH + m0, (float*)(ws + WS_GATES) + (size_t)m0 * 8, wg, lane); cur = nx; } }
        REP(3) { Gemm g{HB, (const bf16*)(ws + WS_WIN) + (size_t)WIN_ML * D, M, 1536, D}; StaticOrder S; S.init(M, 1536, G, bx);
        EpiZ E{(bf16*)(ws + WS_ML), 2048, RS, -1, nullptr}; gemm_phase<EpiZ, StaticOrder, true, true>(lds, g, S, E, wave); } }
    SEAM(3);
    const bf16* QKV0 = (const bf16*)(ws + WS_QKV); const bf16* QKV1 = (const bf16*)(ws + WS_QKV1); bf16* GB = (bf16*)(ws + WS_G);
#define QKV_GEMM8(grp, dstp) do { Gemm g{H8b, W8b + (size_t)(grp) * 1536 * (D / 2), M, 1536, D / 2, SCW + (grp) * 1536, SCH}; StaticOrder S; S.init(M, 1536, G, bx); \
        EpiQKV E{(bf16*)(dstp), RS, (const float*)(ws + WS_PAR) + PAR_QG, (const float*)(ws + WS_PAR) + PAR_KG, (const float*)(ws + WS_ROPE), (PG8_LAS float*)(lds + QKP_OFF)}; \
        gemm_phase<EpiQKV, StaticOrder, true, true, false, true>(lds, g, S, E, wave); } while (0)
    if (IN(4)) { REP(5) QKV_GEMM8(0, ws + WS_QKV);
        { Gemm g{H8b, W8b + (size_t)6656 * (D / 2), M, 512, D / 2, SCW + 6656, SCH}; StaticOrder S; S.init(M, 512, G, bx);
        EpiSig8 E{(unsigned char*)args.out + (size_t)40 * MiB, RS}; gemm_phase<EpiSig8, StaticOrder, true, true, false, true>(lds, g, S, E, wave); }
        REP(24) mlstm_b1(ws, lds, wave, vcu, G); GRID_BAR(); mlstm_b2(ws, wave, vcu, G); GRID_BAR(); REP(25) mlstm_b3(ws, (const unsigned char*)args.out + (size_t)40 * MiB, lds, wave, vcu, G); }
    SEAM(4);
    if (IN(5)) { attn_fast(ws, QKV0, lds, 0, wave, vcu, G); REP(6) { if (rep_) attn_fast(ws, QKV0, lds, 0, wave, vcu, G); }
        REP(5) QKV_GEMM8(1, ws + WS_QKV1); }
    SEAM(5);
    if (IN(6)) { attn_fast(ws, QKV1, lds, 1, wave, vcu, G);
        REP(5) QKV_GEMM8(2, ws + WS_QKV); }
    SEAM(6);
    if (IN(7)) { attn_fast(ws, QKV0, lds, 2, wave, vcu, G);
        REP(11) { Gemm g{H8b, W8b + (size_t)4608 * (D / 2), M, 2048, D / 2, SCW + 4608, SCH}; StaticOrder S; S.init(M, 2048, G, bx);
        EpiGF E{(unsigned char*)GB, (unsigned char*)GB + (size_t)M * 1024, RS}; gemm_phase<EpiGF, StaticOrder, true, true, false, true>(lds, g, S, E, wave); } }
    SEAM(7);
#undef QKV_GEMM8
    if (IN(8)) REP(12) { Gemm g{(const bf16*)(ws + WS_A), (const bf16*)(ws + WS_WUPA), M, D, 512, nullptr, nullptr, (const bf16*)(ws + WS_BM), (const bf16*)(ws + WS_WUPB)}; PairOrder S; S.init(M, D, G, bx);
        EpiGate2 E{(const unsigned char*)GB, (const unsigned char*)GB + (size_t)M * 1024, (bf16*)(ws + WS_MERGED)}; gemm_phase<EpiGate2, PairOrder, true, true>(lds, g, S, E, wave); }
    SEAM(8);
    if (IN(9)) { Gemm g{(const bf16*)(ws + WS_MERGED), (const bf16*)(ws + WS_WO), M, D, D}; StaticOrder S; S.init(M, D, G, bx);
        EpiResidQ E{HB, RS, 1.0f, (unsigned*)(ws + WS_ROWMAX), (unsigned*)(ws + WS_PCNT), H8, SCH}; gemm_phase<EpiResidQ, StaticOrder, true, true>(lds, g, S, E, wave); }
    SEAM(9);
    if (IN(10)) {
        REP(15) { Gemm g{H8b, (const bf16*)(ws + WS_W2IN8), M, 2 * FF, D / 2, (const float*)(ws + WS_SC2), SCH}; StaticOrder S; S.init(M, 2 * FF, G, bx);
        EpiSwiglu E{(bf16*)(ws + WS_HID), FF, RS}; gemm_phase<EpiSwiglu, StaticOrder, true, true, false, true>(lds, g, S, E, wave); } }
    SEAM(10);
    if (IN(11)) { { Gemm g{(const bf16*)(ws + WS_HID), (const bf16*)(ws + WS_W2OUT), M, D, FF}; StaticOrder S; S.init(M, D, G, bx);
        EpiResid<false> E{nullptr, HB, HB, RS, 0.5f}; gemm_phase<EpiResid<false>, StaticOrder, true, true>(lds, g, S, E, wave); }
        }
    SEAM(11);
    if (IN(12)) { Gemm g{HB, (const bf16*)(ws + WS_WPG), M, D, D, nullptr, nullptr, (const bf16*)(ws + WS_PB), (const bf16*)(ws + WS_WPE), PLE}; PairOrder S; S.init(M, D, G, bx);
        EpiFinal2 E{args.out, HB, RS}; gemm_phase_dk<EpiFinal2>(lds, g, S, E, wave); }
#undef IN
#undef SEAM
}

extern "C" void kernel_launch(void* const* d_in, const int* in_sizes, int n_in, void* d_out, int out_size, void* d_ws, size_t ws_size, hipStream_t stream) {
    static int grid = 0;
    if (grid == 0) {
        if (n_in != 22 || in_sizes[0] != M * D || out_size != M * D || ws_size < WS_END) { fprintf(stderr, "kernel_launch: unexpected shapes (n_in %d, in0 %d, out %d, ws %zu)\n", n_in, n_in > 0 ? in_sizes[0] : -1, out_size, ws_size); grid = -1; return; }
        int dev = 0, cus = 0;
        if (hipGetDevice(&dev) != hipSuccess || hipDeviceGetAttribute(&cus, hipDeviceAttributeMultiprocessorCount, dev) != hipSuccess) { grid = -1; return; }
        if (hipFuncSetAttribute((const void*)mega, hipFuncAttributeMaxDynamicSharedMemorySize, LDS_BYTES) != hipSuccess) { fprintf(stderr, "kernel_launch: hipFuncSetAttribute failed\n"); grid = -1; return; }
        (void)hipGetLastError();
        grid = cus;
    }
    if (grid < 0) return;
    (void)hipMemsetAsync((char*)d_ws + WS_CTL, 0, CTL_ZERO_BYTES, stream);
    Args a{};
    for (int i = 0; i < 22; ++i) a.in[i] = (const float*)d_in[i];
    a.out = (float*)d_out; a.ws = (unsigned char*)d_ws;
#if MK_PER_PHASE
    for (int ph = 0; ph < NPHASE; ++ph) { a.ph_lo = ph; a.ph_hi = ph + 1; hipLaunchKernelGGL(mega, dim3(grid), dim3(NTHREADS), LDS_BYTES, stream, a); }
#else
    a.ph_lo = 0; a.ph_hi = NPHASE; hipLaunchKernelGGL(mega, dim3(grid), dim3(NTHREADS), LDS_BYTES, stream, a);
#endif
}
```

```cpp
#include <hip/hip_runtime.h>
#include <cstdio>
#include <cstdint>

#ifndef PROBE_MASK
#define PROBE_MASK 0u
#endif
#define REP(k) for (int rep_ = 0; rep_ < 1 + (int)((PROBE_MASK >> (k)) & 1u); ++rep_)
#ifndef MK_PER_PHASE
#define MK_PER_PHASE 0
#endif

namespace pg8 {
#define PG8_LAS __attribute__((address_space(3)))
typedef unsigned short bf16_t;
typedef short bf16x8 __attribute__((ext_vector_type(8)));
typedef float f32x4 __attribute__((ext_vector_type(4)));
typedef unsigned u32x4 __attribute__((ext_vector_type(4)));
constexpr int BM = 256, BK = 64, HALF = 128, HTB = HALF * BK * 2, STAGE_BYTES = 8 * HTB, NXCD = 8, WGM = 8;

__host__ __device__ __forceinline__ int lds_byte(int r, int c) { const int st = (r >> 4) * 2 + (c >> 5), rr = r & 15, cc = c & 31, ob = rr * 64 + cc * 2; return st * 1024 + (ob ^ (((ob >> 9) & 1) << 5)); }
__host__ __device__ __forceinline__ void stage_rc(int b, int& R, int& C) { const int st = b / 1024, sb = b % 1024, swz = sb ^ (((sb >> 9) & 1) << 5); R = (st >> 1) * 16 + swz / 64; C = (st & 1) * 32 + (swz % 64) / 2; }
__host__ __device__ __forceinline__ int perm32(int rho) { const int n = rho >> 4, i = rho & 15; return 8 * (i >> 2) + 4 * n + (i & 3); }

struct Unit { int pm, pn, w; };
struct Gemm { const bf16_t* A; const bf16_t* Bt; int M, N, K; const float* scw; const float* sch; const bf16_t* A2; const bf16_t* Bt2; int K2; };
typedef int i32x4 __attribute__((ext_vector_type(4)));

struct StaticOrder {
    static constexpr bool PAIR = false;
    int nM, nN, nwg, G, c;
    __host__ __device__ void init(int M, int N, int G_, int c_) { nM = M / BM; nN = N / BM; nwg = nM * nN; G = G_; c = c_; }
    __host__ __device__ bool next(int i, Unit& u) const {
        const long L = (long)i * G + c; if (L >= nwg) return false;
        int wgid = (int)L; { const int q = nwg / NXCD, r = nwg % NXCD, xcd = wgid % NXCD, off = wgid / NXCD; wgid = (xcd < r ? xcd * (q + 1) : r * (q + 1) + (xcd - r) * q) + off; }
        const int nig = WGM * nN, gid = wgid / nig, fm = gid * WGM, gsz = (nM - fm) < WGM ? (nM - fm) : WGM;
        u.pm = fm + ((wgid % nig) % gsz); u.pn = (wgid % nig) / gsz; u.w = 0; return true;
    }
};
struct PairOrder {
    static constexpr bool PAIR = true;
    StaticOrder base;
    __host__ __device__ void init(int M, int N, int G_, int c_) { base.init(M, N, G_, c_); }
    __host__ __device__ bool next(int i, Unit& u) const { const bool ok = base.next(i >> 1, u); u.w = i & 1; return ok; }
};

__device__ __forceinline__ unsigned cvt_pk_bf16(float lo, float hi) { unsigned r; asm volatile("v_cvt_pk_bf16_f32 %0, %1, %2" : "=v"(r) : "v"(lo), "v"(hi)); return r; }
__device__ __forceinline__ float bf_lo(unsigned u) { return __uint_as_float(u << 16); }
__device__ __forceinline__ float bf_hi(unsigned u) { return __uint_as_float(u & 0xffff0000u); }

constexpr float RMS_EPS = 1e-6f;
constexpr int RTAB_OFF = 152576;
__device__ __forceinline__ float sigmoidf_(float v) { return __builtin_amdgcn_rcpf(1.0f + __builtin_amdgcn_exp2f(-1.4426950408889634f * v)); }
__device__ __forceinline__ void swap16_(float& a, float& b) { asm volatile("s_nop 1\n\tv_permlane16_swap_b32 %0, %1" : "+v"(a), "+v"(b)); }
__device__ __forceinline__ void swap32_(float& a, float& b) { asm volatile("s_nop 1\n\tv_permlane32_swap_b32 %0, %1" : "+v"(a), "+v"(b)); }
__device__ __forceinline__ float xsum_16_32(float x) { float a = x, b = x; swap16_(a, b); x = a + b; a = x; b = x; swap32_(a, b); return a + b; }
__device__ __forceinline__ float xmax_16_32(float x) { float a = x, b = x; swap16_(a, b); x = fmaxf(a, b); a = x; b = x; swap32_(a, b); return fmaxf(a, b); }
__device__ __forceinline__ float xor32_(float x, bool hi) { float a = x, b = x; swap32_(a, b); return hi ? a : b; }
template <int MINQ> __device__ __forceinline__ unsigned sig8_pack(const f32x4 t) {
    f32x4 e; e[0] = __builtin_amdgcn_exp2f(t[0]); e[1] = __builtin_amdgcn_exp2f(t[1]); e[2] = __builtin_amdgcn_exp2f(t[2]); e[3] = __builtin_amdgcn_exp2f(t[3]);
    const f32x4 d = e + 1.0f; f32x4 sg; sg[0] = __builtin_amdgcn_rcpf(d[0]); sg[1] = __builtin_amdgcn_rcpf(d[1]); sg[2] = __builtin_amdgcn_rcpf(d[2]); sg[3] = __builtin_amdgcn_rcpf(d[3]);
    f32x4 q = sg * 255.0f + 0.5f;
    if (MINQ > 0) { q[0] = fmaxf(q[0], (float)MINQ); q[1] = fmaxf(q[1], (float)MINQ); q[2] = fmaxf(q[2], (float)MINQ); q[3] = fmaxf(q[3], (float)MINQ); }
    return (unsigned)q[0] | ((unsigned)q[1] << 8) | ((unsigned)q[2] << 16) | ((unsigned)q[3] << 24);
}
struct EpiSwiglu {
    static constexpr bool PERM = true, AFTER_DRAIN = false, NEED_R = true;
    bf16_t* O; int ldc; const float* RS;
    __device__ __forceinline__ void operator()(f32x4 (&acc)[2][2][4][2], const Unit& u, int wr, int wc, int fr, int fq, const PG8_LAS float* rtab) const {
        const int row0 = u.pm * BM + wr * 64 + fr, col0 = u.pn * HALF + wc * 32 + 8 * fq;
#pragma unroll
        for (int ai = 0; ai < 2; ++ai)
#pragma unroll
            for (int m = 0; m < 4; ++m) { const int row = row0 + ai * HALF + m * 16; const float r = rtab[ai * HALF + wr * 64 + m * 16 + fr];
                const float rl = r * -1.4426950408889634f, r2 = r * r; f32x4 hv[2];
#pragma unroll
                for (int n = 0; n < 2; ++n) { const f32x4 a = acc[ai][0][m][n], b = acc[ai][1][m][n]; const f32x4 t = a * rl; f32x4 e;
                    e[0] = __builtin_amdgcn_exp2f(t[0]); e[1] = __builtin_amdgcn_exp2f(t[1]); e[2] = __builtin_amdgcn_exp2f(t[2]); e[3] = __builtin_amdgcn_exp2f(t[3]);
                    const f32x4 d = e + 1.0f; f32x4 q;
                    q[0] = __builtin_amdgcn_rcpf(d[0]); q[1] = __builtin_amdgcn_rcpf(d[1]); q[2] = __builtin_amdgcn_rcpf(d[2]); q[3] = __builtin_amdgcn_rcpf(d[3]);
                    hv[n] = (a * b) * (q * r2); }
                u32x4 w; w.x = cvt_pk_bf16(hv[0][0], hv[0][1]); w.y = cvt_pk_bf16(hv[0][2], hv[0][3]); w.z = cvt_pk_bf16(hv[1][0], hv[1][1]); w.w = cvt_pk_bf16(hv[1][2], hv[1][3]);
                *(u32x4*)(O + (size_t)row * ldc + col0) = w; }
    }
};
template <bool BASE_F32> struct EpiResid {
    static constexpr bool PERM = true, AFTER_DRAIN = false, NEED_R = false;
    const float* basef; const bf16_t* baseh; bf16_t* HBo; float* RSo; float alpha;
    __device__ __forceinline__ void operator()(f32x4 (&acc)[2][2][4][2], const Unit& u, int wr, int wc, int fr, int fq, const PG8_LAS float*) const {
        const int row0 = u.pm * BM + wr * 64 + fr, col0 = u.pn * BM + wc * 32 + 8 * fq;
#pragma unroll
        for (int ai = 0; ai < 2; ++ai) {
            f32x4 bv[4][2][2];
#pragma unroll
            for (int m = 0; m < 4; ++m)
#pragma unroll
                for (int bj = 0; bj < 2; ++bj) { const size_t off = (size_t)(row0 + ai * HALF + m * 16) * 1024 + col0 + bj * HALF;
                    if constexpr (BASE_F32) { bv[m][bj][0] = *(const f32x4*)(basef + off); bv[m][bj][1] = *(const f32x4*)(basef + off + 4); }
                    else { const u32x4 p = *(const u32x4*)(baseh + off); bv[m][bj][0] = (f32x4){bf_lo(p.x), bf_hi(p.x), bf_lo(p.y), bf_hi(p.y)}; bv[m][bj][1] = (f32x4){bf_lo(p.z), bf_hi(p.z), bf_lo(p.w), bf_hi(p.w)}; } }
            asm volatile("" ::: "memory");
#pragma unroll
            for (int m = 0; m < 4; ++m) { const int row = row0 + ai * HALF + m * 16; float ssq = 0.f;
#pragma unroll
                for (int bj = 0; bj < 2; ++bj) { const size_t off = (size_t)row * 1024 + col0 + bj * HALF;
                    const f32x4 v0 = bv[m][bj][0] + acc[ai][bj][m][0] * alpha, v1 = bv[m][bj][1] + acc[ai][bj][m][1] * alpha;
                    u32x4 w; w.x = cvt_pk_bf16(v0[0], v0[1]); w.y = cvt_pk_bf16(v0[2], v0[3]); w.z = cvt_pk_bf16(v1[0], v1[1]); w.w = cvt_pk_bf16(v1[2], v1[3]);
                    *(u32x4*)(HBo + off) = w;
                    ssq += (v0[0] * v0[0] + v0[1] * v0[1]) + (v0[2] * v0[2] + v0[3] * v0[3]) + (v1[0] * v1[0] + v1[1] * v1[1]) + (v1[2] * v1[2] + v1[3] * v1[3]); }
                ssq = xsum_16_32(ssq);
                if (fq == 0) RSo[(size_t)row * 16 + u.pn * 4 + wc] = ssq; }
            asm volatile("" ::: "memory"); }
    }
};
struct EpiZ {
    static constexpr bool PERM = true, AFTER_DRAIN = false, NEED_R = true;
    bf16_t* O; int ldc; const float* RS; int gate_pn; float* GATES;
    __device__ __forceinline__ void operator()(f32x4 (&acc)[2][2][4][2], const Unit& u, int wr, int wc, int fr, int fq, const PG8_LAS float* rtab) const {
        const int row0 = u.pm * BM + wr * 64 + fr, col0 = u.pn * BM + wc * 32 + 8 * fq;
        const bool gate = (u.pn == gate_pn);
#pragma unroll
        for (int ai = 0; ai < 2; ++ai)
#pragma unroll
            for (int m = 0; m < 4; ++m) { const int row = row0 + ai * HALF + m * 16; const float r = rtab[ai * HALF + wr * 64 + m * 16 + fr];
                if (gate) { if (wc == 0 && fq == 0) { *(f32x4*)(GATES + (size_t)row * 8) = acc[ai][0][m][0] * r; *(f32x4*)(GATES + (size_t)row * 8 + 4) = acc[ai][0][m][1] * r; } }
                else {
#pragma unroll
                    for (int bj = 0; bj < 2; ++bj) { const f32x4 v0 = acc[ai][bj][m][0] * r, v1 = acc[ai][bj][m][1] * r;
                        u32x4 w; w.x = cvt_pk_bf16(v0[0], v0[1]); w.y = cvt_pk_bf16(v0[2], v0[3]); w.z = cvt_pk_bf16(v1[0], v1[1]); w.w = cvt_pk_bf16(v1[2], v1[3]);
                        *(u32x4*)(O + (size_t)row * ldc + col0 + bj * HALF) = w; } } }
    }
};
constexpr int QKP_OFF = 131072;
struct EpiQKV {
    static constexpr bool PERM = true, AFTER_DRAIN = false, NEED_R = true;
    bf16_t* O; const float* RS; const float* par_qg; const float* par_kg; const float* rope; PG8_LAS float* part;
    __device__ __forceinline__ void operator()(f32x4 (&acc)[2][2][4][2], const Unit& u, int wr, int wc, int fr_, int fq_, const PG8_LAS float* rtab) const {
        int lane_; asm volatile("v_mbcnt_lo_u32_b32 %0, -1, 0\n\tv_mbcnt_hi_u32_b32 %0, -1, %0" : "=v"(lane_));
        const int fr = lane_ & 15, fq = lane_ >> 4; (void)fr_; (void)fq_;
        const int row0 = u.pm * BM + wr * 64 + fr, col0 = u.pn * BM + wc * 32 + 8 * fq;
        const bool isq = u.pn < 2, isqk = u.pn < 4;
#pragma unroll
        for (int ai = 0; ai < 2; ++ai)
#pragma unroll
            for (int m = 0; m < 4; ++m) { const int rl = ai * HALF + wr * 64 + m * 16 + fr; const float r = rtab[rl];
#pragma unroll
                for (int bj = 0; bj < 2; ++bj) { acc[ai][bj][m][0] *= r; acc[ai][bj][m][1] *= r;
                    if (isqk) { const f32x4 a = acc[ai][bj][m][0], b = acc[ai][bj][m][1];
                        float ssq = (a[0] * a[0] + a[1] * a[1]) + (a[2] * a[2] + a[3] * a[3]) + (b[0] * b[0] + b[1] * b[1]) + (b[2] * b[2] + b[3] * b[3]);
                        ssq = xsum_16_32(ssq);
                        if (fq == 0) part[(rl * 2 + bj) * 4 + wc] = ssq; } } }
        if (isqk) {
            asm volatile("s_waitcnt lgkmcnt(0)" ::: "memory"); __builtin_amdgcn_s_barrier(); asm volatile("" ::: "memory");
            const float* G_ = isq ? par_qg : par_kg; const int L = 4 * wc + fq;
            const f32x4 g0 = (f32x4){G_[L], G_[16 + L], G_[32 + 6 * L], G_[33 + 6 * L]}, g1 = (f32x4){G_[34 + 6 * L], G_[35 + 6 * L], G_[36 + 6 * L], G_[37 + 6 * L]};
            const float qs = isq ? (0.08838834764831845f * 1.4426950408889634f) : 1.0f;
#pragma unroll
            for (int am = 0; am < 4; ++am) {
                float cs[2][2];
#pragma unroll
                for (int mm = 0; mm < 2; ++mm) { const int ai = am >> 1, m = (am & 1) * 2 + mm; const int pos = (row0 + ai * HALF + m * 16) & (8192 - 1); const float* rp = rope + (size_t)pos * 32 + 2 * L; cs[mm][0] = rp[0]; cs[mm][1] = rp[1]; }
                asm volatile("" ::: "memory");
#pragma unroll
                for (int mm = 0; mm < 2; ++mm) { const int ai = am >> 1, m = (am & 1) * 2 + mm; const int rl = ai * HALF + wr * 64 + m * 16 + fr;
#pragma unroll
                    for (int bj = 0; bj < 2; ++bj) { const f32x4 p4 = *(const PG8_LAS f32x4*)(part + (rl * 2 + bj) * 4);
                        const float rn = __builtin_amdgcn_rsqf(((p4[0] + p4[1]) + (p4[2] + p4[3])) * (1.0f / 128.0f) + RMS_EPS) * qs;
                        f32x4 a = acc[ai][bj][m][0] * g0 * rn, b = acc[ai][bj][m][1] * g1 * rn;
                        { const float x1 = a[0], x2 = a[1], c_ = cs[mm][0], s_ = cs[mm][1]; a[0] = x1 * c_ - x2 * s_; a[1] = x2 * c_ + x1 * s_; }
                        unsigned char* op_ = (unsigned char*)O + (size_t)(row0 + ai * HALF + m * 16) * 1536;
                        { typedef unsigned u32x2 __attribute__((ext_vector_type(2))); int w0 = 0, w1 = 0;
                            w0 = __builtin_amdgcn_cvt_pk_fp8_f32(a[0], a[1], w0, false); w0 = __builtin_amdgcn_cvt_pk_fp8_f32(a[2], a[3], w0, true);
                            w1 = __builtin_amdgcn_cvt_pk_fp8_f32(b[0], b[1], w1, false); w1 = __builtin_amdgcn_cvt_pk_fp8_f32(b[2], b[3], w1, true);
                            *(u32x2*)(op_ + col0 + bj * HALF) = (u32x2){(unsigned)w0, (unsigned)w1}; } } }
                asm volatile("" ::: "memory"); }
            return;
        }
#pragma unroll
        for (int ai = 0; ai < 2; ++ai)
#pragma unroll
            for (int m = 0; m < 4; ++m) { const int row = row0 + ai * HALF + m * 16;
#pragma unroll
                for (int bj = 0; bj < 2; ++bj) { const f32x4 v0 = acc[ai][bj][m][0], v1 = acc[ai][bj][m][1];
                    typedef unsigned u32x2 __attribute__((ext_vector_type(2))); int w0 = 0, w1 = 0;
                    w0 = __builtin_amdgcn_cvt_pk_fp8_f32(v0[0], v0[1], w0, false); w0 = __builtin_amdgcn_cvt_pk_fp8_f32(v0[2], v0[3], w0, true);
                    w1 = __builtin_amdgcn_cvt_pk_fp8_f32(v1[0], v1[1], w1, false); w1 = __builtin_amdgcn_cvt_pk_fp8_f32(v1[2], v1[3], w1, true);
                    *(u32x2*)((unsigned char*)O + (size_t)row * 1536 + col0 + bj * HALF) = (u32x2){(unsigned)w0, (unsigned)w1}; } }
    }
};
struct EpiGate {
    static constexpr bool PERM = true, AFTER_DRAIN = false, NEED_R = false;
    const bf16_t* G; int ldg; const bf16_t* prev; bf16_t* O;
    __device__ __forceinline__ void operator()(f32x4 (&acc)[2][2][4][2], const Unit& u, int wr, int wc, int fr, int fq, const PG8_LAS float*) const {
        const int row0 = u.pm * BM + wr * 64 + fr, col0 = u.pn * BM + wc * 32 + 8 * fq;
#pragma unroll
        for (int ai = 0; ai < 2; ++ai) {
            u32x4 gv[4][2], pv[4][2];
#pragma unroll
            for (int m = 0; m < 4; ++m)
#pragma unroll
                for (int bj = 0; bj < 2; ++bj) { const int row = row0 + ai * HALF + m * 16, col = col0 + bj * HALF;
                    gv[m][bj] = *(const u32x4*)(G + (size_t)row * ldg + col); pv[m][bj] = prev ? *(const u32x4*)(prev + (size_t)row * 1024 + col) : (u32x4){0u, 0u, 0u, 0u}; }
            asm volatile("" ::: "memory");
#pragma unroll
            for (int m = 0; m < 4; ++m)
#pragma unroll
                for (int bj = 0; bj < 2; ++bj) { const int row = row0 + ai * HALF + m * 16, col = col0 + bj * HALF; const u32x4 g = gv[m][bj], p = pv[m][bj];
                    float v[8];
                    v[0] = bf_lo(p.x) + sigmoidf_(bf_lo(g.x)) * acc[ai][bj][m][0][0]; v[1] = bf_hi(p.x) + sigmoidf_(bf_hi(g.x)) * acc[ai][bj][m][0][1];
                    v[2] = bf_lo(p.y) + sigmoidf_(bf_lo(g.y)) * acc[ai][bj][m][0][2]; v[3] = bf_hi(p.y) + sigmoidf_(bf_hi(g.y)) * acc[ai][bj][m][0][3];
                    v[4] = bf_lo(p.z) + sigmoidf_(bf_lo(g.z)) * acc[ai][bj][m][1][0]; v[5] = bf_hi(p.z) + sigmoidf_(bf_hi(g.z)) * acc[ai][bj][m][1][1];
                    v[6] = bf_lo(p.w) + sigmoidf_(bf_lo(g.w)) * acc[ai][bj][m][1][2]; v[7] = bf_hi(p.w) + sigmoidf_(bf_hi(g.w)) * acc[ai][bj][m][1][3];
                    u32x4 w; w.x = cvt_pk_bf16(v[0], v[1]); w.y = cvt_pk_bf16(v[2], v[3]); w.z = cvt_pk_bf16(v[4], v[5]); w.w = cvt_pk_bf16(v[6], v[7]);
                    *(u32x4*)(O + (size_t)row * 1024 + col) = w; }
            asm volatile("" ::: "memory"); }
    }
};
struct EpiGF {
    static constexpr bool PERM = true, AFTER_DRAIN = false, NEED_R = true;
    unsigned char* QA; unsigned char* QB; const float* RS;
    __device__ __forceinline__ void operator()(f32x4 (&acc)[2][2][4][2], const Unit& u, int wr, int wc, int fr, int fq, const PG8_LAS float* rtab) const {
        const int row0 = u.pm * BM + wr * 64 + fr, col0 = u.pn * HALF + wc * 32 + 8 * fq;
#pragma unroll
        for (int ai = 0; ai < 2; ++ai)
#pragma unroll
            for (int m = 0; m < 4; ++m) { const int row = row0 + ai * HALF + m * 16; const float rl = rtab[ai * HALF + wr * 64 + m * 16 + fr] * -1.4426950408889634f;
                unsigned qa[2], qb[2];
#pragma unroll
                for (int n = 0; n < 2; ++n) { qa[n] = sig8_pack<0>(acc[ai][0][m][n] * rl); qb[n] = sig8_pack<1>(acc[ai][1][m][n] * rl); }
                typedef unsigned u32x2 __attribute__((ext_vector_type(2)));
                *(u32x2*)(QA + (size_t)row * 1024 + col0) = (u32x2){qa[0], qa[1]}; *(u32x2*)(QB + (size_t)row * 1024 + col0) = (u32x2){qb[0], qb[1]}; }
    }
};
struct EpiGate2 {
    static constexpr bool PERM = true, AFTER_DRAIN = false, NEED_R = false;
    const unsigned char* QA; const unsigned char* QB; bf16_t* O;
    __device__ __forceinline__ void operator()(f32x4 (&acc)[2][2][4][2], const Unit& u, int wr, int wc, int fr, int fq, const PG8_LAS float*) const {
        typedef unsigned u32x2 __attribute__((ext_vector_type(2)));
        const int row0 = u.pm * BM + wr * 64 + fr, col0 = u.pn * BM + wc * 32 + 8 * fq;
#pragma unroll
        for (int ai = 0; ai < 2; ++ai) {
            u32x2 av[4][2], bv[4][2];
#pragma unroll
            for (int m = 0; m < 4; ++m)
#pragma unroll
                for (int bj = 0; bj < 2; ++bj) { const size_t off = (size_t)(row0 + ai * HALF + m * 16) * 1024 + col0 + bj * HALF; bv[m][bj] = *(const u32x2*)(QB + off); av[m][bj] = u.w ? (u32x2){0u, 0u} : *(const u32x2*)(QA + off); }
            asm volatile("" ::: "memory");
#pragma unroll
            for (int m = 0; m < 4; ++m)
#pragma unroll
                for (int bj = 0; bj < 2; ++bj) {
#pragma unroll
                    for (int n = 0; n < 2; ++n)
#pragma unroll
                        for (int j = 0; j < 4; ++j) { const float b = (float)((bv[m][bj][n] >> (8 * j)) & 255u);
                            if (u.w) acc[ai][bj][m][n][j] *= b * (1.0f / 255.0f);
                            else acc[ai][bj][m][n][j] *= (float)((av[m][bj][n] >> (8 * j)) & 255u) * __builtin_amdgcn_rcpf(b); }
                    if (u.w) { const f32x4 v0 = acc[ai][bj][m][0], v1 = acc[ai][bj][m][1];
                        u32x4 w; w.x = cvt_pk_bf16(v0[0], v0[1]); w.y = cvt_pk_bf16(v0[2], v0[3]); w.z = cvt_pk_bf16(v1[0], v1[1]); w.w = cvt_pk_bf16(v1[2], v1[3]);
                        *(u32x4*)(O + (size_t)(row0 + ai * HALF + m * 16) * 1024 + col0 + bj * HALF) = w; } }
            asm volatile("" ::: "memory"); }
    }
};
struct EpiResidQ {
    static constexpr bool PERM = true, AFTER_DRAIN = false, NEED_R = false;
    bf16_t* HBio; float* RSo; float alpha; unsigned* ROWMAX; unsigned* CNT; unsigned char* Q8; float* SCq;
    __device__ __forceinline__ void operator()(f32x4 (&acc)[2][2][4][2], const Unit& u, int wr, int wc, int fr, int fq, const PG8_LAS float*) const {
        const int row0 = u.pm * BM + wr * 64 + fr, col0 = u.pn * BM + wc * 32 + 8 * fq;
#pragma unroll
        for (int ai = 0; ai < 2; ++ai) {
            u32x4 bv[4][2];
#pragma unroll
            for (int m = 0; m < 4; ++m)
#pragma unroll
                for (int bj = 0; bj < 2; ++bj) bv[m][bj] = *(const u32x4*)(HBio + (size_t)(row0 + ai * HALF + m * 16) * 1024 + col0 + bj * HALF);
            asm volatile("" ::: "memory");
#pragma unroll
            for (int m = 0; m < 4; ++m) { const int row = row0 + ai * HALF + m * 16; float ssq = 0.f, am = 0.f;
#pragma unroll
                for (int bj = 0; bj < 2; ++bj) { const size_t off = (size_t)row * 1024 + col0 + bj * HALF; const u32x4 p = bv[m][bj];
                    const f32x4 v0 = (f32x4){bf_lo(p.x), bf_hi(p.x), bf_lo(p.y), bf_hi(p.y)} + acc[ai][bj][m][0] * alpha, v1 = (f32x4){bf_lo(p.z), bf_hi(p.z), bf_lo(p.w), bf_hi(p.w)} + acc[ai][bj][m][1] * alpha;
                    acc[ai][bj][m][0] = v0; acc[ai][bj][m][1] = v1;
                    u32x4 w; w.x = cvt_pk_bf16(v0[0], v0[1]); w.y = cvt_pk_bf16(v0[2], v0[3]); w.z = cvt_pk_bf16(v1[0], v1[1]); w.w = cvt_pk_bf16(v1[2], v1[3]);
                    *(u32x4*)(HBio + off) = w;
                    ssq += (v0[0] * v0[0] + v0[1] * v0[1]) + (v0[2] * v0[2] + v0[3] * v0[3]) + (v1[0] * v1[0] + v1[1] * v1[1]) + (v1[2] * v1[2] + v1[3] * v1[3]);
                    am = fmaxf(am, fmaxf(fmaxf(fmaxf(fabsf(v0[0]), fabsf(v0[1])), fmaxf(fabsf(v0[2]), fabsf(v0[3]))), fmaxf(fmaxf(fabsf(v1[0]), fabsf(v1[1])), fmaxf(fabsf(v1[2]), fabsf(v1[3]))))); }
                ssq = xsum_16_32(ssq);
                am = xmax_16_32(am);
                if (fq == 0) { RSo[(size_t)row * 16 + u.pn * 4 + wc] = ssq; (void)__hip_atomic_fetch_max(ROWMAX + row, __builtin_bit_cast(unsigned, am), __ATOMIC_RELAXED, __HIP_MEMORY_SCOPE_AGENT); } }
            asm volatile("" ::: "memory"); }
        asm volatile("s_waitcnt vmcnt(0)" ::: "memory"); __builtin_amdgcn_s_barrier();
        if (wr == 0 && wc == 0 && fr == 0 && fq == 0) {
            (void)__hip_atomic_fetch_add(CNT + u.pm, 1u, __ATOMIC_RELAXED, __HIP_MEMORY_SCOPE_AGENT);
            unsigned sp = 0u; while (__hip_atomic_load(CNT + u.pm, __ATOMIC_RELAXED, __HIP_MEMORY_SCOPE_AGENT) < 4u) { __builtin_amdgcn_s_sleep(1); if (++sp > (1u << 22)) break; } }
        asm volatile("s_waitcnt vmcnt(0)" ::: "memory"); __builtin_amdgcn_s_barrier(); asm volatile("" ::: "memory");
        typedef unsigned u32x2 __attribute__((ext_vector_type(2)));
#pragma unroll
        for (int ai = 0; ai < 2; ++ai)
#pragma unroll
            for (int m = 0; m < 4; ++m) { const int row = row0 + ai * HALF + m * 16;
                const float amx = __builtin_bit_cast(float, __hip_atomic_load(ROWMAX + row, __ATOMIC_RELAXED, __HIP_MEMORY_SCOPE_AGENT)); const float inv = (amx > 0.f) ? 127.0f / amx : 0.f;
#pragma unroll
                for (int bj = 0; bj < 2; ++bj) { unsigned q[2];
#pragma unroll
                    for (int n = 0; n < 2; ++n) { unsigned pq = 0u;
#pragma unroll
                        for (int j = 0; j < 4; ++j) pq |= ((unsigned)(int)__builtin_rintf(acc[ai][bj][m][n][j] * inv) & 255u) << (8 * j);
                        q[n] = pq; }
                    *(u32x2*)(Q8 + (size_t)row * 1024 + col0 + bj * HALF) = (u32x2){q[0], q[1]}; }
                if (u.pn == 0 && wc == 0 && fq == 0) SCq[row] = (amx > 0.f) ? amx * (1.0f / 127.0f) : 1.0f; }
    }
};
struct EpiSig8 {
    static constexpr bool PERM = true, AFTER_DRAIN = false, NEED_R = true;
    unsigned char* O8; const float* RS;
    __device__ __forceinline__ void operator()(f32x4 (&acc)[2][2][4][2], const Unit& u, int wr, int wc, int fr, int fq, const PG8_LAS float* rtab) const {
        typedef unsigned u32x2 __attribute__((ext_vector_type(2)));
        const int row0 = u.pm * BM + wr * 64 + fr, col0 = u.pn * BM + wc * 32 + 8 * fq;
#pragma unroll
        for (int ai = 0; ai < 2; ++ai)
#pragma unroll
            for (int m = 0; m < 4; ++m) { const int row = row0 + ai * HALF + m * 16; const float rl = rtab[ai * HALF + wr * 64 + m * 16 + fr] * -1.4426950408889634f;
#pragma unroll
                for (int bj = 0; bj < 2; ++bj) { unsigned q[2];
#pragma unroll
                    for (int n = 0; n < 2; ++n) q[n] = sig8_pack<0>(acc[ai][bj][m][n] * rl);
                    *(u32x2*)(O8 + (size_t)row * 512 + col0 + bj * HALF) = (u32x2){q[0], q[1]}; } }
    }
};
struct EpiResidX {
    static constexpr bool PERM = true, AFTER_DRAIN = false, NEED_R = false;
    const unsigned char* Q8; const unsigned char* E8; const float* SC; bf16_t* HBo; float* RSo; float alpha;
    __device__ __forceinline__ void operator()(f32x4 (&acc)[2][2][4][2], const Unit& u, int wr, int wc, int fr, int fq, const PG8_LAS float*) const {
        typedef unsigned u32x2 __attribute__((ext_vector_type(2)));
        const int row0 = u.pm * BM + wr * 64 + fr, col0 = u.pn * BM + wc * 32 + 8 * fq;
#pragma unroll
        for (int ai = 0; ai < 2; ++ai) {
            u32x2 qv[4][2], ev[4][2]; float sv[4];
#pragma unroll
            for (int m = 0; m < 4; ++m) { const int row = row0 + ai * HALF + m * 16; sv[m] = SC[row];
#pragma unroll
                for (int bj = 0; bj < 2; ++bj) { const size_t off = (size_t)row * 1024 + col0 + bj * HALF; qv[m][bj] = *(const u32x2*)(Q8 + off); ev[m][bj] = *(const u32x2*)(E8 + off); } }
            asm volatile("" ::: "memory");
#pragma unroll
            for (int m = 0; m < 4; ++m) { const int row = row0 + ai * HALF + m * 16; float ssq = 0.f; const float s1 = sv[m], s2 = sv[m] * (1.0f / 254.0f);
#pragma unroll
                for (int bj = 0; bj < 2; ++bj) { const size_t off = (size_t)row * 1024 + col0 + bj * HALF; f32x4 v[2];
#pragma unroll
                    for (int n = 0; n < 2; ++n)
#pragma unroll
                        for (int j = 0; j < 4; ++j) { const float qf_ = (float)(int)(signed char)((qv[m][bj][n] >> (8 * j)) & 255u), ef_ = (float)(int)(signed char)((ev[m][bj][n] >> (8 * j)) & 255u);
                            v[n][j] = (qf_ * s1 + ef_ * s2) + acc[ai][bj][m][n][j] * alpha; }
                    u32x4 w; w.x = cvt_pk_bf16(v[0][0], v[0][1]); w.y = cvt_pk_bf16(v[0][2], v[0][3]); w.z = cvt_pk_bf16(v[1][0], v[1][1]); w.w = cvt_pk_bf16(v[1][2], v[1][3]);
                    *(u32x4*)(HBo + off) = w;
                    ssq += (v[0][0] * v[0][0] + v[0][1] * v[0][1]) + (v[0][2] * v[0][2] + v[0][3] * v[0][3]) + (v[1][0] * v[1][0] + v[1][1] * v[1][1]) + (v[1][2] * v[1][2] + v[1][3] * v[1][3]); }
                ssq = xsum_16_32(ssq);
                if (fq == 0) RSo[(size_t)row * 16 + u.pn * 4 + wc] = ssq; }
            asm volatile("" ::: "memory"); }
    }
};
struct EpiNull {
    static constexpr bool PERM = true, AFTER_DRAIN = false, NEED_R = false;
    float* O;
    __device__ __forceinline__ void operator()(f32x4 (&acc)[2][2][4][2], const Unit& u, int wr, int wc, int fr, int fq, const PG8_LAS float*) const {
        float s_ = 0.f;
#pragma unroll
        for (int ai = 0; ai < 2; ++ai)
#pragma unroll
            for (int bj = 0; bj < 2; ++bj)
#pragma unroll
                for (int m = 0; m < 4; ++m)
#pragma unroll
                    for (int n = 0; n < 2; ++n) s_ += (acc[ai][bj][m][n][0] + acc[ai][bj][m][n][1]) + (acc[ai][bj][m][n][2] + acc[ai][bj][m][n][3]);
        if (s_ == 12345.678f) O[u.pm * 7 + u.pn + wr + wc + fr + fq] = s_;
    }
};
struct EpiPlain {
    static constexpr bool PERM = true, AFTER_DRAIN = false, NEED_R = false;
    bf16_t* O;
    __device__ __forceinline__ void operator()(f32x4 (&acc)[2][2][4][2], const Unit& u, int wr, int wc, int fr, int fq, const PG8_LAS float*) const {
        const int row0 = u.pm * BM + wr * 64 + fr, col0 = u.pn * BM + wc * 32 + 8 * fq;
#pragma unroll
        for (int ai = 0; ai < 2; ++ai)
#pragma unroll
            for (int m = 0; m < 4; ++m) { const int row = row0 + ai * HALF + m * 16;
#pragma unroll
                for (int bj = 0; bj < 2; ++bj) { const f32x4 v0 = acc[ai][bj][m][0], v1 = acc[ai][bj][m][1];
                    u32x4 w; w.x = cvt_pk_bf16(v0[0], v0[1]); w.y = cvt_pk_bf16(v0[2], v0[3]); w.z = cvt_pk_bf16(v1[0], v1[1]); w.w = cvt_pk_bf16(v1[2], v1[3]);
                    *(u32x4*)(O + (size_t)row * 1024 + col0 + bj * HALF) = w; } }
    }
};
struct EpiFinal {
    static constexpr bool PERM = true, AFTER_DRAIN = false, NEED_R = true;
    float* out; const bf16_t* HBr; const bf16_t* PE; const float* RS;
    __device__ __forceinline__ void operator()(f32x4 (&acc)[2][2][4][2], const Unit& u, int wr, int wc, int fr, int fq, const PG8_LAS float* rtab) const {
        const int row0 = u.pm * BM + wr * 64 + fr, col0 = u.pn * BM + wc * 32 + 8 * fq;
#pragma unroll
        for (int ai = 0; ai < 2; ++ai) {
            u32x4 hv[4][2], pv[4][2];
#pragma unroll
            for (int m = 0; m < 4; ++m)
#pragma unroll
                for (int bj = 0; bj < 2; ++bj) { const size_t off = (size_t)(row0 + ai * HALF + m * 16) * 1024 + col0 + bj * HALF; hv[m][bj] = *(const u32x4*)(HBr + off); pv[m][bj] = *(const u32x4*)(PE + off); }
            asm volatile("" ::: "memory");
#pragma unroll
            for (int m = 0; m < 4; ++m) { const float r = rtab[ai * HALF + wr * 64 + m * 16 + fr];
#pragma unroll
                for (int bj = 0; bj < 2; ++bj) { const size_t off = (size_t)(row0 + ai * HALF + m * 16) * 1024 + col0 + bj * HALF; const u32x4 b = hv[m][bj], p = pv[m][bj];
                    f32x4 v0, v1;
                    v0[0] = bf_lo(b.x) + bf_lo(p.x) * sigmoidf_(acc[ai][bj][m][0][0] * r); v0[1] = bf_hi(b.x) + bf_hi(p.x) * sigmoidf_(acc[ai][bj][m][0][1] * r);
                    v0[2] = bf_lo(b.y) + bf_lo(p.y) * sigmoidf_(acc[ai][bj][m][0][2] * r); v0[3] = bf_hi(b.y) + bf_hi(p.y) * sigmoidf_(acc[ai][bj][m][0][3] * r);
                    v1[0] = bf_lo(b.z) + bf_lo(p.z) * sigmoidf_(acc[ai][bj][m][1][0] * r); v1[1] = bf_hi(b.z) + bf_hi(p.z) * sigmoidf_(acc[ai][bj][m][1][1] * r);
                    v1[2] = bf_lo(b.w) + bf_lo(p.w) * sigmoidf_(acc[ai][bj][m][1][2] * r); v1[3] = bf_hi(b.w) + bf_hi(p.w) * sigmoidf_(acc[ai][bj][m][1][3] * r);
                    *(f32x4*)(out + off) = v0; *(f32x4*)(out + off + 4) = v1; } }
            asm volatile("" ::: "memory"); }
    }
};

template <class Epi, class Sched, bool ALIGN_EPI = false, bool SP2 = false, bool BAL = false, bool I8 = false>
__device__ __forceinline__ void gemm_phase(PG8_LAS unsigned char* lds, const Gemm g, const Sched& S, const Epi& E, const int wid) {
    int lane; asm volatile("v_mbcnt_lo_u32_b32 %0, -1, 0\n\tv_mbcnt_hi_u32_b32 %0, -1, %0" : "=v"(lane));
    const int tid = wid * 64 + lane, wr = wid >> 2, wc = wid & 3, fr = lane & 15, fq = lane >> 4;
    const int K = g.K, nt = K / BK;
    unsigned voffA[2], voffB[2];
#pragma unroll
    for (int i = 0; i < 2; ++i) { int R, C; stage_rc(tid * 16 + i * 8192, R, C); const int Rb = Epi::PERM ? ((R & ~31) + perm32(R & 31)) : R;
        voffA[i] = (unsigned)(R * K + C) * 2u; voffB[i] = (unsigned)(Rb * K + C) * 2u; }
    const size_t kstep = (size_t)(BK * 2);
    const size_t hstep = (size_t)HALF * K * 2;
    const size_t tstep = 2 * hstep;
    const unsigned ldsw = (unsigned)wid * 1024u;
    const int aoff = lds_byte(wr * 64 + fr, fq * 8), boff = lds_byte(wc * 32 + fr, fq * 8);
#define PG8_SA(b, h) (((b) * 2 + (h)) * HTB)
#define PG8_SB(b, h) ((4 + (b) * 2 + (h)) * HTB)
#define PG8_STAGE(bufoff, gbase, voff) do { _Pragma("unroll") for (int _i = 0; _i < 2; ++_i) \
        __builtin_amdgcn_global_load_lds((const unsigned*)((const char*)(gbase) + (voff)[_i]), (PG8_LAS unsigned*)(lds + (bufoff) + ldsw + _i * 8192), 16, 0, 0); } while (0)
#define PG8_LDA(dst, b, h) do { _Pragma("unroll") for (int m = 0; m < 4; ++m) _Pragma("unroll") for (int k = 0; k < 2; ++k) dst[m][k] = *(const PG8_LAS bf16x8*)(lds + PG8_SA(b, h) + aoff + m * 2048 + k * 1024); } while (0)
#define PG8_LDB(dst, b, h) do { _Pragma("unroll") for (int n = 0; n < 2; ++n) _Pragma("unroll") for (int k = 0; k < 2; ++k) dst[n][k] = *(const PG8_LAS bf16x8*)(lds + PG8_SB(b, h) + boff + n * 2048 + k * 1024); } while (0)
#define PG8_MMA(ai, bj, At, Bt) do { __builtin_amdgcn_s_setprio(3); _Pragma("unroll") for (int m = 0; m < 4; ++m) _Pragma("unroll") for (int n = 0; n < 2; ++n) _Pragma("unroll") for (int k = 0; k < 2; ++k) \
        { if constexpr (I8) acc[ai][bj][m][n] = __builtin_bit_cast(f32x4, __builtin_amdgcn_mfma_i32_16x16x64_i8(__builtin_bit_cast(i32x4, Bt[n][k]), __builtin_bit_cast(i32x4, At[m][k]), __builtin_bit_cast(i32x4, acc[ai][bj][m][n]), 0, 0, 0)); \
          else acc[ai][bj][m][n] = __builtin_amdgcn_mfma_f32_16x16x32_bf16(Bt[n][k], At[m][k], acc[ai][bj][m][n], 0, 0, 0); } __builtin_amdgcn_s_setprio(0); } while (0)
#define PG8_WAIT_V(n) asm volatile("s_waitcnt vmcnt(" #n ")" ::: "memory")
#define PG8_WAIT_L(n) asm volatile("s_waitcnt lgkmcnt(" #n ")" ::: "memory")
#define PG8_BAR __builtin_amdgcn_s_barrier()
#define PG8_SCHED __builtin_amdgcn_sched_barrier(0)
    Unit cur, nxt; int ui = 0; int rt_pm = -1; PG8_LAS float* rtab = (PG8_LAS float*)(lds + RTAB_OFF);
    if (!S.next(0, cur)) return;
    f32x4 acc[2][2][4][2];
#pragma unroll
    for (int a = 0; a < 2; ++a)
#pragma unroll
        for (int b = 0; b < 2; ++b)
#pragma unroll
            for (int m = 0; m < 4; ++m)
#pragma unroll
                for (int n = 0; n < 2; ++n) acc[a][b][m][n] = (f32x4){0.f, 0.f, 0.f, 0.f};
    bf16x8 At[4][2], B0[2][2], B1[2][2];
    const char* cA = (const char*)g.A + (size_t)cur.pm * tstep; const char* cB = (const char*)g.Bt + (size_t)cur.pn * tstep;
    if constexpr (SP2 && BAL) {
        PG8_STAGE(PG8_SB(0, 0), cB, voffB); PG8_STAGE(PG8_SB(0, 1), cB + hstep, voffB); PG8_STAGE(PG8_SA(0, 0), cA, voffA); PG8_STAGE(PG8_SA(0, 1), cA + hstep, voffA);
        if (wr == 1) PG8_BAR;
        PG8_WAIT_V(2); PG8_BAR;
        PG8_STAGE(PG8_SB(1, 0), cB + kstep, voffB); PG8_STAGE(PG8_SB(1, 1), cB + hstep + kstep, voffB);
        PG8_WAIT_V(4); PG8_BAR;
    } else if constexpr (SP2) {
        PG8_STAGE(PG8_SB(0, 0), cB, voffB); PG8_STAGE(PG8_SB(0, 1), cB + hstep, voffB); PG8_STAGE(PG8_SA(0, 0), cA, voffA); PG8_STAGE(PG8_SA(0, 1), cA + hstep, voffA);
        if (wr == 1) PG8_BAR;
        PG8_WAIT_V(2); PG8_BAR;
        PG8_STAGE(PG8_SB(1, 0), cB + kstep, voffB); PG8_STAGE(PG8_SA(1, 0), cA + kstep, voffA); PG8_STAGE(PG8_SB(1, 1), cB + hstep + kstep, voffB);
        PG8_WAIT_V(6); PG8_BAR;
    } else {
        PG8_STAGE(PG8_SB(0, 0), cB, voffB); PG8_STAGE(PG8_SA(0, 0), cA, voffA); PG8_STAGE(PG8_SB(0, 1), cB + hstep, voffB); PG8_STAGE(PG8_SA(0, 1), cA + hstep, voffA);
        if (wr == 1) PG8_BAR;
        PG8_WAIT_V(4); PG8_BAR;
        PG8_STAGE(PG8_SB(1, 0), cB + kstep, voffB); PG8_STAGE(PG8_SA(1, 0), cA + kstep, voffA); PG8_STAGE(PG8_SB(1, 1), cB + hstep + kstep, voffB);
        PG8_WAIT_V(6); PG8_BAR;
    }
    for (;;) {
        const bool has_next = S.next(ui + 1, nxt);
        const char* nA = has_next ? (const char*)((Sched::PAIR && nxt.w) ? g.A2 : g.A) + (size_t)nxt.pm * tstep : cA; const char* nB = has_next ? (const char*)((Sched::PAIR && nxt.w) ? g.Bt2 : g.Bt) + (size_t)nxt.pn * tstep : cB;
#pragma unroll 1
        for (int t = 0; t < nt; t += 2) {
            const bool last = (t == nt - 2);
            const char* a1 = cA + (size_t)(t + 1) * kstep;
            const char* a2 = last ? nA : cA + (size_t)(t + 2) * kstep; const char* b2 = last ? nB : cB + (size_t)(t + 2) * kstep;
            const char* a3 = a2 + kstep; const char* b3 = b2 + kstep;
            if constexpr (SP2 && BAL) {
            PG8_LDB(B0, 0, 0); PG8_LDB(B1, 0, 1); PG8_SCHED; PG8_LDA(At, 0, 0); PG8_STAGE(PG8_SA(1, 1), a1 + hstep, voffA); PG8_STAGE(PG8_SA(1, 0), a1, voffA);
            PG8_WAIT_V(8); PG8_WAIT_L(0); PG8_BAR; PG8_MMA(0, 0, At, B0); PG8_MMA(0, 1, At, B1); PG8_BAR; PG8_SCHED;
            PG8_LDA(At, 0, 1); PG8_STAGE(PG8_SB(0, 0), b2, voffB); PG8_STAGE(PG8_SB(0, 1), b2 + hstep, voffB);
            PG8_WAIT_V(4); PG8_WAIT_L(0); PG8_BAR; PG8_MMA(1, 0, At, B0); PG8_MMA(1, 1, At, B1); PG8_BAR; PG8_SCHED;
            PG8_LDB(B0, 1, 0); PG8_LDB(B1, 1, 1); PG8_SCHED; PG8_LDA(At, 1, 0); PG8_STAGE(PG8_SA(0, 1), a2 + hstep, voffA); PG8_STAGE(PG8_SA(0, 0), a2, voffA);
            PG8_WAIT_V(8); PG8_WAIT_L(0); PG8_BAR; PG8_MMA(0, 0, At, B0); PG8_MMA(0, 1, At, B1); PG8_BAR; PG8_SCHED;
            PG8_LDA(At, 1, 1); PG8_STAGE(PG8_SB(1, 0), b3, voffB); PG8_STAGE(PG8_SB(1, 1), b3 + hstep, voffB);
            PG8_WAIT_V(4); PG8_WAIT_L(0); PG8_BAR; PG8_MMA(1, 0, At, B0); PG8_MMA(1, 1, At, B1); PG8_BAR; PG8_SCHED;
            } else if constexpr (SP2) {
            PG8_LDB(B0, 0, 0); PG8_LDB(B1, 0, 1); PG8_SCHED; PG8_LDA(At, 0, 0); PG8_STAGE(PG8_SA(1, 1), a1 + hstep, voffA);
            PG8_WAIT_V(8); PG8_WAIT_L(0); PG8_BAR; PG8_MMA(0, 0, At, B0); PG8_MMA(0, 1, At, B1); PG8_BAR; PG8_SCHED;
            PG8_LDA(At, 0, 1); PG8_STAGE(PG8_SB(0, 0), b2, voffB); PG8_STAGE(PG8_SB(0, 1), b2 + hstep, voffB); PG8_STAGE(PG8_SA(0, 0), a2, voffA);
            PG8_WAIT_V(8); PG8_WAIT_L(0); PG8_BAR; PG8_MMA(1, 0, At, B0); PG8_MMA(1, 1, At, B1); PG8_BAR; PG8_SCHED;
            PG8_LDB(B0, 1, 0); PG8_LDB(B1, 1, 1); PG8_SCHED; PG8_LDA(At, 1, 0); PG8_STAGE(PG8_SA(0, 1), a2 + hstep, voffA);
            PG8_WAIT_V(8); PG8_WAIT_L(0); PG8_BAR; PG8_MMA(0, 0, At, B0); PG8_MMA(0, 1, At, B1); PG8_BAR; PG8_SCHED;
            PG8_LDA(At, 1, 1); PG8_STAGE(PG8_SB(1, 0), b3, voffB); PG8_STAGE(PG8_SB(1, 1), b3 + hstep, voffB); PG8_STAGE(PG8_SA(1, 0), a3, voffA);
            PG8_WAIT_V(8); PG8_WAIT_L(0); PG8_BAR; PG8_MMA(1, 0, At, B0); PG8_MMA(1, 1, At, B1); PG8_BAR; PG8_SCHED;
            } else {
            PG8_LDB(B0, 0, 0); PG8_SCHED; PG8_LDA(At, 0, 0); PG8_STAGE(PG8_SA(1, 1), a1 + hstep, voffA);
            PG8_WAIT_L(8); PG8_BAR; PG8_WAIT_L(0); PG8_MMA(0, 0, At, B0); PG8_BAR; PG8_SCHED;
            PG8_LDB(B1, 0, 1); PG8_STAGE(PG8_SB(0, 0), b2, voffB);
            PG8_BAR; PG8_WAIT_L(0); PG8_MMA(0, 1, At, B1); PG8_BAR;
            PG8_LDA(At, 0, 1); PG8_STAGE(PG8_SA(0, 0), a2, voffA);
            PG8_BAR; PG8_WAIT_L(0); PG8_MMA(1, 0, At, B0); PG8_BAR; PG8_SCHED;
            PG8_STAGE(PG8_SB(0, 1), b2 + hstep, voffB);
            PG8_WAIT_V(6); PG8_BAR; PG8_MMA(1, 1, At, B1); PG8_BAR;
            PG8_LDB(B0, 1, 0); PG8_SCHED; PG8_LDA(At, 1, 0); PG8_STAGE(PG8_SA(0, 1), a2 + hstep, voffA);
            PG8_WAIT_L(8); PG8_BAR; PG8_WAIT_L(0); PG8_MMA(0, 0, At, B0); PG8_BAR; PG8_SCHED;
            PG8_LDB(B1, 1, 1); PG8_STAGE(PG8_SB(1, 0), b3, voffB);
            PG8_BAR; PG8_WAIT_L(0); PG8_MMA(0, 1, At, B1); PG8_BAR;
            PG8_LDA(At, 1, 1); PG8_STAGE(PG8_SA(1, 0), a3, voffA);
            PG8_BAR; PG8_WAIT_L(0); PG8_MMA(1, 0, At, B0); PG8_BAR; PG8_SCHED;
            PG8_STAGE(PG8_SB(1, 1), b3 + hstep, voffB);
            PG8_WAIT_V(6); PG8_BAR; PG8_MMA(1, 1, At, B1); PG8_BAR;
            }
        }
        if constexpr (ALIGN_EPI) { if (wr == 0) PG8_BAR; }
        if constexpr (Epi::NEED_R) {
            static_assert(ALIGN_EPI, "row-scale table needs both halves in the epilogue together");
            if (cur.pm != rt_pm) {
                if (tid < 256) { const f32x4* rp = (const f32x4*)(E.RS + (size_t)(cur.pm * BM + tid) * 16); const f32x4 p0 = rp[0], p1 = rp[1], p2 = rp[2], p3 = rp[3];
                    const float ss = ((p0[0] + p0[1]) + (p0[2] + p0[3])) + ((p1[0] + p1[1]) + (p1[2] + p1[3])) + ((p2[0] + p2[1]) + (p2[2] + p2[3])) + ((p3[0] + p3[1]) + (p3[2] + p3[3]));
                    float rv_ = __builtin_amdgcn_rsqf(ss * (1.0f / 1024.0f) + RMS_EPS); if constexpr (I8) rv_ *= g.sch[cur.pm * BM + tid]; rtab[tid] = rv_; }
                PG8_WAIT_L(0); PG8_BAR; rt_pm = cur.pm; }
        }
        if constexpr (I8) {
#pragma unroll
            for (int bj = 0; bj < 2; ++bj) { const float* sp_ = g.scw + cur.pn * BM + bj * HALF + wc * 32 + 8 * fq; const f32x4 s0 = *(const f32x4*)sp_, s1 = *(const f32x4*)(sp_ + 4);
#pragma unroll
                for (int ai = 0; ai < 2; ++ai)
#pragma unroll
                    for (int m = 0; m < 4; ++m) { acc[ai][bj][m][0] = __builtin_convertvector(__builtin_bit_cast(i32x4, acc[ai][bj][m][0]), f32x4) * s0; acc[ai][bj][m][1] = __builtin_convertvector(__builtin_bit_cast(i32x4, acc[ai][bj][m][1]), f32x4) * s1; } } }
        E(acc, cur, wr, wc, fr, fq, (const PG8_LAS float*)rtab);
        if (!has_next) break;
        if (!Sched::PAIR || cur.w) {
#pragma unroll
        for (int a = 0; a < 2; ++a)
#pragma unroll
            for (int b = 0; b < 2; ++b)
#pragma unroll
                for (int m = 0; m < 4; ++m)
#pragma unroll
                    for (int n = 0; n < 2; ++n) acc[a][b][m][n] = (f32x4){0.f, 0.f, 0.f, 0.f}; }
        cur = nxt; cA = nA; cB = nB; ++ui;
        if constexpr (ALIGN_EPI) { if (wr == 1) PG8_BAR; }
    }
    PG8_WAIT_V(0);
    if constexpr (!ALIGN_EPI) { if (wr == 0) PG8_BAR; }
    PG8_BAR;
#undef PG8_SA
#undef PG8_SB
#undef PG8_STAGE
#undef PG8_LDA
#undef PG8_LDB
#undef PG8_MMA
#undef PG8_WAIT_V
#undef PG8_WAIT_L
#undef PG8_BAR
#undef PG8_SCHED
}

struct EpiFinal2 {
    static constexpr bool PERM = true, AFTER_DRAIN = false, NEED_R = true;
    float* out; const bf16_t* HBr; const float* RS;
    static constexpr int NREG = 26;
    struct State { unsigned s8[NREG]; };
    __device__ __forceinline__ void operator()(f32x4 (&acc)[2][2][4][2], State& st, const Unit& u, int wr, int wc, int fr, int fq, const PG8_LAS float* rtab, PG8_LAS unsigned* xl) const {
        if (u.w == 0) {
#pragma unroll
            for (int ai = 0; ai < 2; ++ai)
#pragma unroll
                for (int m = 0; m < 4; ++m) { const float rl = rtab[ai * HALF + wr * 64 + m * 16 + fr] * -1.4426950408889634f;
#pragma unroll
                    for (int bj = 0; bj < 2; ++bj)
#pragma unroll
                        for (int n = 0; n < 2; ++n) { unsigned p = sig8_pack<0>(acc[ai][bj][m][n] * rl);
                            asm volatile("" : "+v"(p));
                            { constexpr int dummy_ = 0; (void)dummy_; const int ix = ((ai * 2 + bj) * 4 + m) * 2 + n; if (ix < NREG) st.s8[ix < NREG ? ix : 0] = p; else xl[(ix - NREG) * 512] = p; }
                            acc[ai][bj][m][n] = (f32x4){0.f, 0.f, 0.f, 0.f}; } }
        } else {
            const int row0 = u.pm * BM + wr * 64 + fr, col0 = u.pn * BM + wc * 32 + 8 * fq;
#pragma unroll
            for (int ai = 0; ai < 2; ++ai) {
                u32x4 hv[4][2];
#pragma unroll
                for (int m = 0; m < 4; ++m)
#pragma unroll
                    for (int bj = 0; bj < 2; ++bj) hv[m][bj] = *(const u32x4*)(HBr + (size_t)(row0 + ai * HALF + m * 16) * 1024 + col0 + bj * HALF);
                asm volatile("" ::: "memory");
#pragma unroll
                for (int m = 0; m < 4; ++m)
#pragma unroll
                    for (int bj = 0; bj < 2; ++bj) { const size_t off = (size_t)(row0 + ai * HALF + m * 16) * 1024 + col0 + bj * HALF; const u32x4 b = hv[m][bj];
                        const int ix0 = ((ai * 2 + bj) * 4 + m) * 2, ix1 = ix0 + 1; constexpr float I255 = 1.0f / 255.0f;
                        const unsigned q0 = (ix0 < NREG) ? st.s8[ix0 < NREG ? ix0 : 0] : xl[(ix0 - NREG) * 512], q1 = (ix1 < NREG) ? st.s8[ix1 < NREG ? ix1 : 0] : xl[(ix1 - NREG) * 512];
                        f32x4 v0, v1;
                        v0[0] = bf_lo(b.x) + acc[ai][bj][m][0][0] * ((float)(q0 & 255u) * I255); v0[1] = bf_hi(b.x) + acc[ai][bj][m][0][1] * ((float)((q0 >> 8) & 255u) * I255);
                        v0[2] = bf_lo(b.y) + acc[ai][bj][m][0][2] * ((float)((q0 >> 16) & 255u) * I255); v0[3] = bf_hi(b.y) + acc[ai][bj][m][0][3] * ((float)(q0 >> 24) * I255);
                        v1[0] = bf_lo(b.z) + acc[ai][bj][m][1][0] * ((float)(q1 & 255u) * I255); v1[1] = bf_hi(b.z) + acc[ai][bj][m][1][1] * ((float)((q1 >> 8) & 255u) * I255);
                        v1[2] = bf_lo(b.w) + acc[ai][bj][m][1][2] * ((float)((q1 >> 16) & 255u) * I255); v1[3] = bf_hi(b.w) + acc[ai][bj][m][1][3] * ((float)(q1 >> 24) * I255);
                        *(f32x4*)(out + off) = v0; *(f32x4*)(out + off + 4) = v1; }
                asm volatile("" ::: "memory"); }
        }
    }
};
template <class Epi>
__device__ __forceinline__ void gemm_phase_dk(PG8_LAS unsigned char* lds, const Gemm g, const PairOrder& S, const Epi& E, const int wid) {
    int lane; asm volatile("v_mbcnt_lo_u32_b32 %0, -1, 0\n\tv_mbcnt_hi_u32_b32 %0, -1, %0" : "=v"(lane));
    const int tid = wid * 64 + lane, wr = wid >> 2, wc = wid & 3, fr = lane & 15, fq = lane >> 4;
    const int K0 = g.K, K1 = g.K2, nt0 = K0 / BK, nt1 = K1 / BK;
    unsigned vA0[2], vB0[2];
#pragma unroll
    for (int i = 0; i < 2; ++i) { int R, C; stage_rc(tid * 16 + i * 8192, R, C); const int Rb = (R & ~31) + perm32(R & 31);
        vA0[i] = (unsigned)(R * K0 + C) * 2u; vB0[i] = (unsigned)(Rb * K0 + C) * 2u; }
    const size_t kstep = (size_t)(BK * 2);
    const size_t hs0 = (size_t)HALF * K0 * 2, hs1 = (size_t)HALF * K1 * 2;
    const unsigned ldsw = (unsigned)wid * 1024u;
    const int aoff = lds_byte(wr * 64 + fr, fq * 8), boff = lds_byte(wc * 32 + fr, fq * 8);
#define PG8_SA(b, h) (((b) * 2 + (h)) * HTB)
#define PG8_SB(b, h) ((4 + (b) * 2 + (h)) * HTB)
#define PG8_STAGE(bufoff, gbase, voff) do { _Pragma("unroll") for (int _i = 0; _i < 2; ++_i) \
        __builtin_amdgcn_global_load_lds((const unsigned*)((const char*)(gbase) + (voff)[_i]), (PG8_LAS unsigned*)(lds + (bufoff) + ldsw + _i * 8192), 16, 0, 0); } while (0)
#define DK_V1(v) ((((v) >> 11) * (unsigned)K1 + (((v) >> 1) & 1023u)) * 2u)
#define DK_STA(bufoff, gbase, sel) do { if (sel) { unsigned t_[2] = {vA0[0], vA0[1]}; asm volatile("" : "+v"(t_[0]), "+v"(t_[1])); t_[0] = DK_V1(t_[0]); t_[1] = DK_V1(t_[1]); PG8_STAGE(bufoff, gbase, t_); } else PG8_STAGE(bufoff, gbase, vA0); } while (0)
#define DK_STB(bufoff, gbase, sel) do { if (sel) { unsigned t_[2] = {vB0[0], vB0[1]}; asm volatile("" : "+v"(t_[0]), "+v"(t_[1])); t_[0] = DK_V1(t_[0]); t_[1] = DK_V1(t_[1]); PG8_STAGE(bufoff, gbase, t_); } else PG8_STAGE(bufoff, gbase, vB0); } while (0)
#define PG8_LDA(dst, b, h) do { _Pragma("unroll") for (int m = 0; m < 4; ++m) _Pragma("unroll") for (int k = 0; k < 2; ++k) dst[m][k] = *(const PG8_LAS bf16x8*)(lds + PG8_SA(b, h) + aoff + m * 2048 + k * 1024); } while (0)
#define PG8_LDB(dst, b, h) do { _Pragma("unroll") for (int n = 0; n < 2; ++n) _Pragma("unroll") for (int k = 0; k < 2; ++k) dst[n][k] = *(const PG8_LAS bf16x8*)(lds + PG8_SB(b, h) + boff + n * 2048 + k * 1024); } while (0)
#define PG8_MMA(ai, bj, At, Bt) do { __builtin_amdgcn_s_setprio(3); _Pragma("unroll") for (int m = 0; m < 4; ++m) _Pragma("unroll") for (int n = 0; n < 2; ++n) _Pragma("unroll") for (int k = 0; k < 2; ++k) \
        acc[ai][bj][m][n] = __builtin_amdgcn_mfma_f32_16x16x32_bf16(Bt[n][k], At[m][k], acc[ai][bj][m][n], 0, 0, 0); __builtin_amdgcn_s_setprio(0); } while (0)
#define PG8_WAIT_V(n) asm volatile("s_waitcnt vmcnt(" #n ")" ::: "memory")
#define PG8_WAIT_L(n) asm volatile("s_waitcnt lgkmcnt(" #n ")" ::: "memory")
#define PG8_BAR __builtin_amdgcn_s_barrier()
#define PG8_SCHED __builtin_amdgcn_sched_barrier(0)
    Unit cur, nxt; int ui = 0; int rt_pm = -1; PG8_LAS float* rtab = (PG8_LAS float*)(lds + RTAB_OFF);
    if (!S.next(0, cur)) return;
    f32x4 acc[2][2][4][2];
#pragma unroll
    for (int a = 0; a < 2; ++a)
#pragma unroll
        for (int b = 0; b < 2; ++b)
#pragma unroll
            for (int m = 0; m < 4; ++m)
#pragma unroll
                for (int n = 0; n < 2; ++n) acc[a][b][m][n] = (f32x4){0.f, 0.f, 0.f, 0.f};
    typename Epi::State st;
    bf16x8 At[4][2], B0[2][2], B1[2][2];
    const char* cA = (const char*)g.A + (size_t)cur.pm * (2 * hs0); const char* cB = (const char*)g.Bt + (size_t)cur.pn * (2 * hs0);
    PG8_STAGE(PG8_SB(0, 0), cB, vB0); PG8_STAGE(PG8_SB(0, 1), cB + hs0, vB0); PG8_STAGE(PG8_SA(0, 0), cA, vA0); PG8_STAGE(PG8_SA(0, 1), cA + hs0, vA0);
    if (wr == 1) PG8_BAR;
    PG8_WAIT_V(2); PG8_BAR;
    PG8_STAGE(PG8_SB(1, 0), cB + kstep, vB0); PG8_STAGE(PG8_SA(1, 0), cA + kstep, vA0); PG8_STAGE(PG8_SB(1, 1), cB + hs0 + kstep, vB0);
    PG8_WAIT_V(6); PG8_BAR;
    for (;;) {
        const bool has_next = S.next(ui + 1, nxt);
        const bool cw = cur.w != 0, nw = has_next ? (nxt.w != 0) : cw;
        const size_t hsc = cw ? hs1 : hs0; const int ntc = cw ? nt1 : nt0;
        const char* nA = has_next ? (const char*)(nw ? g.A2 : g.A) + (size_t)nxt.pm * (2 * (nw ? hs1 : hs0)) : cA; const char* nB = has_next ? (const char*)(nw ? g.Bt2 : g.Bt) + (size_t)nxt.pn * (2 * (nw ? hs1 : hs0)) : cB;
#pragma unroll 1
        for (int t = 0; t < ntc; t += 2) {
            const bool last = (t == ntc - 2);
            const char* a1 = cA + (size_t)(t + 1) * kstep;
            const char* a2 = last ? nA : cA + (size_t)(t + 2) * kstep; const char* b2 = last ? nB : cB + (size_t)(t + 2) * kstep;
            const char* a3 = a2 + kstep; const char* b3 = b2 + kstep;
            const bool xs = last ? nw : cw; const size_t hx = xs ? hs1 : hs0;
            PG8_LDB(B0, 0, 0); PG8_LDB(B1, 0, 1); PG8_SCHED; PG8_LDA(At, 0, 0); DK_STA(PG8_SA(1, 1), a1 + hsc, cw);
            PG8_WAIT_V(8); PG8_WAIT_L(0); PG8_BAR; PG8_MMA(0, 0, At, B0); PG8_MMA(0, 1, At, B1); PG8_BAR; PG8_SCHED;
            PG8_LDA(At, 0, 1); DK_STB(PG8_SB(0, 0), b2, xs); DK_STB(PG8_SB(0, 1), b2 + hx, xs); DK_STA(PG8_SA(0, 0), a2, xs);
            PG8_WAIT_V(8); PG8_WAIT_L(0); PG8_BAR; PG8_MMA(1, 0, At, B0); PG8_MMA(1, 1, At, B1); PG8_BAR; PG8_SCHED;
            PG8_LDB(B0, 1, 0); PG8_LDB(B1, 1, 1); PG8_SCHED; PG8_LDA(At, 1, 0); DK_STA(PG8_SA(0, 1), a2 + hx, xs);
            PG8_WAIT_V(8); PG8_WAIT_L(0); PG8_BAR; PG8_MMA(0, 0, At, B0); PG8_MMA(0, 1, At, B1); PG8_BAR; PG8_SCHED;
            PG8_LDA(At, 1, 1); DK_STB(PG8_SB(1, 0), b3, xs); DK_STB(PG8_SB(1, 1), b3 + hx, xs); DK_STA(PG8_SA(1, 0), a3, xs);
            PG8_WAIT_V(8); PG8_WAIT_L(0); PG8_BAR; PG8_MMA(1, 0, At, B0); PG8_MMA(1, 1, At, B1); PG8_BAR; PG8_SCHED;
        }
        if (wr == 0) PG8_BAR;
        int l2_; asm volatile("v_mbcnt_lo_u32_b32 %0, -1, 0\n\tv_mbcnt_hi_u32_b32 %0, -1, %0" : "=v"(l2_));
        if (cur.pm != rt_pm) { const int tid2 = wid * 64 + l2_;
            if (tid2 < 256) { const f32x4* rp = (const f32x4*)(E.RS + (size_t)(cur.pm * BM + tid2) * 16); const f32x4 p0 = rp[0], p1 = rp[1], p2 = rp[2], p3 = rp[3];
                const float ss = ((p0[0] + p0[1]) + (p0[2] + p0[3])) + ((p1[0] + p1[1]) + (p1[2] + p1[3])) + ((p2[0] + p2[1]) + (p2[2] + p2[3])) + ((p3[0] + p3[1]) + (p3[2] + p3[3]));
                rtab[tid2] = __builtin_amdgcn_rsqf(ss * (1.0f / 1024.0f) + RMS_EPS); }
            PG8_WAIT_L(0); PG8_BAR; rt_pm = cur.pm; }
        E(acc, st, cur, wr, wc, l2_ & 15, l2_ >> 4, (const PG8_LAS float*)rtab, (PG8_LAS unsigned*)(lds + 139264) + (wid * 64 + l2_));
        if (!has_next) break;
        if (cur.w) {
#pragma unroll
        for (int a = 0; a < 2; ++a)
#pragma unroll
            for (int b = 0; b < 2; ++b)
#pragma unroll
                for (int m = 0; m < 4; ++m)
#pragma unroll
                    for (int n = 0; n < 2; ++n) acc[a][b][m][n] = (f32x4){0.f, 0.f, 0.f, 0.f}; }
        cur = nxt; cA = nA; cB = nB; ++ui;
        if (wr == 1) PG8_BAR;
    }
    PG8_WAIT_V(0);
    PG8_BAR;
#undef PG8_SA
#undef PG8_SB
#undef PG8_STAGE
#undef DK_STA
#undef DK_V1
#undef DK_STB
#undef PG8_LDA
#undef PG8_LDB
#undef PG8_MMA
#undef PG8_WAIT_V
#undef PG8_WAIT_L
#undef PG8_BAR
#undef PG8_SCHED
}
}

using pg8::sigmoidf_;
constexpr int NWAVES = 8, NTHREADS = NWAVES * 64;
constexpr int BATCH = 4, SEQ = 8192, D = 1024, M = BATCH * SEQ, FF = 2816, PLE = 256, D_IN = 8712;
constexpr int NHD = 128;
constexpr int WIN_ROWS = 8960;
constexpr int WIN_ML = 4608, WIN_GT = 6656, WIN_G = 6912;
constexpr int NPHASE = 13;

constexpr size_t MiB = 1u << 20;
constexpr size_t WS_CTL = 0, CTL_ZERO_BYTES = 1 * MiB;
constexpr size_t WS_ROPE = 1 * MiB;
constexpr size_t WS_GATES = 2 * MiB;
constexpr size_t WS_LSE = 3 * MiB;
constexpr size_t WS_RS = 4 * MiB;
constexpr size_t WS_W1IN = 6 * MiB;
constexpr size_t WS_W1OUT = 17 * MiB;
constexpr size_t WS_WIN = 22 * MiB + 512 * 1024;
constexpr size_t WS_WUPA = 40 * MiB, WS_WUPB = 41 * MiB, WS_WO = 42 * MiB;
constexpr size_t WS_W2IN = 44 * MiB, WS_W2OUT = 55 * MiB, WS_WPG = 60 * MiB + 512 * 1024, WS_WPE = 62 * MiB + 512 * 1024;
constexpr size_t WS_HB = 64 * MiB;
constexpr size_t WS_HID = 128 * MiB;
constexpr size_t WS_ML = 128 * MiB;
constexpr size_t WS_MST = 256 * MiB;
constexpr size_t WS_QKV1 = 128 * MiB;
constexpr size_t WS_QKV = 320 * MiB;
constexpr size_t WS_A = 416 * MiB, WS_BM = 448 * MiB;
constexpr size_t WS_PB = 480 * MiB;
constexpr size_t WS_G = 128 * MiB;
constexpr size_t WS_TMP = 256 * MiB, WS_MERGED = 320 * MiB;
constexpr size_t WS_PE = 320 * MiB;
constexpr size_t WS_W8 = 497 * MiB;
constexpr size_t WS_SCW = 504 * MiB;
constexpr size_t WS_SC1 = 504 * MiB + 256 * 1024;
constexpr size_t WS_SCX = 3 * MiB + 512 * 1024;
constexpr size_t WS_W1IN8 = 320 * MiB;
constexpr size_t WS_W2IN8 = 505 * MiB;
constexpr size_t WS_SC2 = 504 * MiB + 512 * 1024;
constexpr size_t WS_END = 511 * MiB;
constexpr int CW_BAR = 4096;
constexpr size_t WS_PCNT = 64 * 1024, WS_ROWMAX = 128 * 1024;
constexpr size_t WS_PAR = 512 * 1024;
constexpr int PAR_QG = 0, PAR_KG = 128, PAR_CW = 256, PAR_CB = 256 + 4096, PAR_IB = PAR_CB + 1024, PAR_FB = PAR_IB + 4, PAR_N = PAR_FB + 4;

constexpr int RING_BYTES = 131072, SCR_BYTES = 4 * 36864 + 8192, LDSCTL_OFF = SCR_BYTES, MISC_OFF = LDSCTL_OFF + 320, LDS_BYTES = 163840;

#define GAS __attribute__((address_space(1)))
#define LAS __attribute__((address_space(3)))
typedef unsigned short bf16;
typedef unsigned v4u __attribute__((ext_vector_type(4)));
typedef unsigned v2u __attribute__((ext_vector_type(2)));
typedef float f32x4 __attribute__((ext_vector_type(4)));
typedef GAS unsigned gu32;
#define RLX_AGENT __ATOMIC_RELAXED, __HIP_MEMORY_SCOPE_AGENT
#define LDS_WAIT() asm volatile("s_waitcnt lgkmcnt(0)" ::: "memory")
#define VM_WAIT() asm volatile("s_waitcnt vmcnt(0)" ::: "memory")
__device__ __forceinline__ unsigned f2bf(float f) { unsigned u = __builtin_bit_cast(unsigned, f); return (u + 0x7fffu + ((u >> 16) & 1u)) >> 16; }
__device__ __forceinline__ unsigned pk2(float lo, float hi) { return f2bf(lo) | (f2bf(hi) << 16); }
__device__ __forceinline__ float bfl(unsigned u) { return __uint_as_float(u << 16); }
__device__ __forceinline__ float bfh(unsigned u) { return __uint_as_float(u & 0xffff0000u); }
__device__ __forceinline__ float bf1(bf16 u) { return __uint_as_float((unsigned)u << 16); }

#define XB_TMO      128
#define XB_XCNT(j)  (256  + 64 * (j))
#define XB_XSUB(j)  (1280 + 64 * (j))
#define XB_XGEN(j)  (2304 + 64 * (j))
#define XB_TOP      3328
#define XB_TOPGEN   3392
#define XCD_BAR_WORDS 3456
#define XB_SPIN_CAP (1u << 20)
__device__ __forceinline__ unsigned xb_ld(unsigned* p)              { return __hip_atomic_load(p, __ATOMIC_RELAXED, __HIP_MEMORY_SCOPE_AGENT); }
__device__ __forceinline__ unsigned xb_add(unsigned* p, unsigned v) { return __hip_atomic_fetch_add(p, v, __ATOMIC_RELAXED, __HIP_MEMORY_SCOPE_AGENT); }
__device__ __forceinline__ unsigned xb_xcc_id() { return (unsigned)__builtin_amdgcn_s_getreg((3 << 11) | 20) & 0xFu; }
#define XB_SPIN(cond, bar) do { unsigned _sp = 0; while (cond) { __builtin_amdgcn_s_sleep(1); \
    if ((++_sp & 255u) == 0u) { if (xb_ld(&(bar)[XB_TMO])) break; if (_sp > XB_SPIN_CAP) { atomicAdd(&(bar)[XB_TMO], 1u); break; } } } } while (0)
struct XcdBarrier { unsigned* bar; unsigned x; volatile LAS unsigned* st; };
__device__ __forceinline__ XcdBarrier xcd_barrier_post(unsigned* bar, volatile LAS unsigned* st, bool leader) {
    XcdBarrier b; b.bar = bar; b.x = xb_xcc_id(); b.st = st;
    if (leader) (void)xb_add(&bar[XB_XCNT(b.x)], 1u);
    return b;
}
__device__ __forceinline__ void xcd_barrier_complete(unsigned* bar, unsigned x, unsigned& nloc, unsigned& nx) {
    const unsigned G = gridDim.x * gridDim.y * gridDim.z;
    unsigned sum, cnt, mine, sp = 0u;
    for (;;) {
        sum = 0u; cnt = 0u; mine = 0u;
#pragma unroll
        for (unsigned j = 0; j < 16; ++j) { const unsigned c = xb_ld(&bar[XB_XCNT(j)]); sum += c; cnt += (c > 0u) ? 1u : 0u; mine = (j == x) ? c : mine; }
        if (sum == G) break;
        __builtin_amdgcn_s_sleep(1);
        if ((++sp & 255u) == 0u) { if (xb_ld(&bar[XB_TMO])) break; if (sp > XB_SPIN_CAP) { atomicAdd(&bar[XB_TMO], 1u); break; } }
    }
    nloc = mine > 0u ? mine : 1u; nx = cnt > 0u ? cnt : 1u;
}
__device__ __forceinline__ void xcd_barrier(const XcdBarrier& b, bool leader) {
    asm volatile("s_waitcnt vmcnt(0)" ::: "memory");
    __syncthreads();
    if (leader) {
        unsigned* bar = b.bar;
        __builtin_amdgcn_s_waitcnt(0);
        unsigned nloc = b.st[0], nx = b.st[1];
        if (nloc == 0u) { xcd_barrier_complete(bar, b.x, nloc, nx); b.st[0] = nloc; b.st[1] = nx; }
        const unsigned old = xb_add(&bar[XB_XSUB(b.x)], 1u);
        const unsigned gen = old / nloc;
        if (old + 1u == (gen + 1u) * nloc) {
            __builtin_amdgcn_fence(__ATOMIC_RELEASE, "agent");
            asm volatile("s_waitcnt vmcnt(0)" ::: "memory");
            const unsigned og = xb_add(&bar[XB_TOP], 1u);
            const unsigned tg = og / nx;
            if (og + 1u == (tg + 1u) * nx) xb_add(&bar[XB_TOPGEN], 1u);
            else XB_SPIN(xb_ld(&bar[XB_TOPGEN]) == tg, bar);
            __builtin_amdgcn_fence(__ATOMIC_ACQUIRE, "agent");
            xb_add(&bar[XB_XGEN(b.x)], 1u);
            asm volatile("s_waitcnt vmcnt(0)" ::: "memory");
        } else {
            XB_SPIN(xb_ld(&bar[XB_XGEN(b.x)]) == gen, bar);
            __builtin_amdgcn_fence(__ATOMIC_ACQUIRE, "agent");
            asm volatile("s_waitcnt vmcnt(0)" ::: "memory");
        }
    }
    __syncthreads();
}

struct WD { int src; int gain; unsigned dst; int K, Nsrc, Ndst, kind; };
__constant__ float c_invfreq[16] = {1.000000000e+00f, 4.403666258e-01f, 1.939227581e-01f, 8.539710194e-02f, 3.760603070e-02f, 1.656044088e-02f, 7.292665076e-03f, 3.211446106e-03f,
    1.414213446e-03f, 6.227724371e-04f, 2.742481884e-04f, 1.207697424e-04f, 5.318296462e-05f, 2.341999789e-05f, 1.031338525e-05f, 4.541670478e-06f};
struct Args { const float* in[22]; float* out; unsigned char* ws; int ph_lo, ph_hi; };
enum { I_X = 0, I_P, I_F1N, I_F1WI, I_F1WO, I_MIXN, I_WIN, I_QG, I_KG, I_CW, I_CB, I_IB, I_FB, I_WUA, I_WUM, I_WOUT, I_F2N, I_F2WI, I_F2WO, I_PLN, I_WPG, I_WPE };

__constant__ WD c_wd[10] = {
    {I_F1WI, I_F1N, (unsigned)WS_W1IN, D, 2 * FF, 2 * FF, 1}, {I_F1WO, -1, (unsigned)WS_W1OUT, FF, D, D, 0}, {I_WIN, I_MIXN, (unsigned)WS_WIN, D, D_IN, WIN_ROWS, 2},
    {I_WUA, -1, (unsigned)WS_WUPA, 512, D, D, 0}, {I_WUM, -1, (unsigned)WS_WUPB, 512, D, D, 0}, {I_WOUT, -1, (unsigned)WS_WO, D, D, D, 0},
    {I_F2WI, I_F2N, (unsigned)WS_W2IN, D, 2 * FF, 2 * FF, 1}, {I_F2WO, -1, (unsigned)WS_W2OUT, FF, D, D, 0}, {I_WPG, I_PLN, (unsigned)WS_WPG, D, D, D, 0}, {I_WPE, -1, (unsigned)WS_WPE, PLE, D, D, 0}};
__device__ __forceinline__ float wave_sum(float v) {
#pragma unroll
    for (int o = 1; o < 64; o <<= 1) v += __shfl_xor(v, o);
    return v;
}
__device__ __forceinline__ float wave_max(float v) {
#pragma unroll
    for (int o = 1; o < 64; o <<= 1) v = fmaxf(v, __shfl_xor(v, o));
    return v;
}

__device__ __forceinline__ int wsrc_col(int kind, int n) {
    if (kind == 0) return n;
    if (kind == 1) { const int t = n >> 8, w = n & 255; return (w < 128) ? (128 * t + w) : (FF + 128 * t + (w - 128)); }
    if (n < WIN_ML) { const int g = n / 1536, w = n % 1536, part = w >> 9, c = w & 511; return part * 1536 + g * 512 + c; }
    if (n < WIN_GT + 8) return n;
    if (n < WIN_G) return -1;
    { const int e = n - WIN_G, t = e >> 8, w = e & 255; return (w < 128) ? (WIN_GT + 8) + 128 * t + w : (WIN_GT + 8) + 1024 + 128 * t + (w - 128); }
}
__device__ __forceinline__ void p0_transpose_item(const float* W, const float* gain, int K, int Nsrc, int Ndst, bf16* WT, int kind, LAS float* scr, int item, int lane) {
    const int nblk = Ndst / 64, kb = item / nblk, nb = item % nblk, k0 = 64 * kb, n0 = 64 * nb;
    const int n4 = lane & 15, kr = lane >> 4;
    const int sc = wsrc_col(kind, n0 + 4 * n4);
    f32x4 v[16];
#pragma unroll
    for (int i = 0; i < 16; ++i) { const int k = k0 + 4 * i + kr; v[i] = (sc >= 0) ? *(const f32x4*)(W + (size_t)k * Nsrc + sc) : (f32x4){0.f, 0.f, 0.f, 0.f}; }
#pragma unroll
    for (int i = 0; i < 16; ++i) { const int kk = 4 * i + kr; const float gsc = gain ? gain[k0 + kk] : 1.0f; LAS float* d_ = scr + kk * 65 + 4 * n4;
        d_[0] = v[i][0] * gsc; d_[1] = v[i][1] * gsc; d_[2] = v[i][2] * gsc; d_[3] = v[i][3] * gsc; }
    LDS_WAIT(); asm volatile("" ::: "memory");
#pragma unroll
    for (int j = 0; j < 8; ++j) { const int id = lane + 64 * j, n = id >> 3, c = id & 7; const LAS float* s_ = scr + (8 * c) * 65 + n;
        v4u o; o.x = pk2(s_[0 * 65], s_[1 * 65]); o.y = pk2(s_[2 * 65], s_[3 * 65]); o.z = pk2(s_[4 * 65], s_[5 * 65]); o.w = pk2(s_[6 * 65], s_[7 * 65]);
        *(GAS v4u*)(WT + (size_t)(n0 + n) * K + k0 + 8 * c) = o; }
    LDS_WAIT(); asm volatile("" ::: "memory");
}

__device__ __forceinline__ void mlstm_seq_v0(const Args& a, LAS unsigned char* lds, int bh, int tid) {
    const int f = tid & 127, eg = tid >> 7;
    const int b = bh >> 2, h = bh & 3;
    const bf16* ML = (const bf16*)(a.ws + WS_ML); const float* GT = (const float*)(a.ws + WS_GATES); bf16* BMo = (bf16*)(a.ws + WS_BM);
    LAS float* qs = (LAS float*)lds;
    LAS float* ks = qs + 256;
    LAS float* hp = ks + 256;
    LAS float* dp = hp + 1024;
    const float* par = (const float*)(a.ws + WS_PAR); const float* cw = par + PAR_CW; const float* cb = par + PAR_CB;
    const float ib = par[PAR_IB + h], fb = par[PAR_FB + h];
    const int cch = (tid < 128) ? (h * 128 + tid) : (512 + h * 128 + (tid - 128));
    float w0 = 0.f, w1 = 0.f, w2 = 0.f, w3 = 0.f, wb = 0.f;
    if (tid < 256) { w0 = cw[0 * 1024 + cch]; w1 = cw[1 * 1024 + cch]; w2 = cw[2 * 1024 + cch]; w3 = cw[3 * 1024 + cch]; wb = cb[cch]; }
    float x0 = 0.f, x1 = 0.f, x2 = 0.f;
    float C[32], n[32];
#pragma unroll
    for (int i = 0; i < 32; ++i) { C[i] = 0.f; n[i] = 0.f; }
    float mst = 0.f;
    const size_t row0 = (size_t)b * SEQ;
    float xn = 0.f, vn = 0.f, on = 0.f, lin = 0.f, lfn = 0.f;
    if (tid < 256) xn = bf1(ML[row0 * 2048 + cch]);
    vn = bf1(ML[row0 * 2048 + 1024 + h * 128 + f]); on = bf1(ML[row0 * 2048 + 1536 + h * 128 + f]); lin = GT[row0 * 8 + h]; lfn = GT[row0 * 8 + 4 + h];
    for (int t = 0; t < SEQ; ++t) {
        const int par = t & 1;
        const float x3 = xn, v = vn, og = on, lipre = lin, lfpre = lfn;
        if (t + 1 < SEQ) { const size_t r = row0 + t + 1;
            if (tid < 256) xn = bf1(ML[r * 2048 + cch]);
            vn = bf1(ML[r * 2048 + 1024 + h * 128 + f]); on = bf1(ML[r * 2048 + 1536 + h * 128 + f]); lin = GT[r * 8 + h]; lfn = GT[r * 8 + 4 + h]; }
        if (tid < 256) { float c = wb + w0 * x0 + w1 * x1 + w2 * x2 + w3 * x3; c = c * sigmoidf_(c); if (tid >= 128) c *= 0.08838834764831845f;
            if (tid < 128) qs[par * 128 + tid] = c; else ks[par * 128 + tid - 128] = c; x0 = x1; x1 = x2; x2 = x3; }
        __syncthreads();
        const float li = lipre + ib; const float fx = lfpre + fb;
        const float lf = fminf(fx, 0.f) - log1pf(expf(-fabsf(fx)));
        const float mnew = fmaxf(lf + mst, li);
        const float fp = expf(lf + mst - mnew), ip = expf(li - mnew);
        mst = mnew;
        float hacc = 0.f, dacc = 0.f;
#pragma unroll
        for (int i = 0; i < 32; ++i) { const float kk = ks[par * 128 + eg * 32 + i], qq = qs[par * 128 + eg * 32 + i];
            C[i] = fp * C[i] + ip * kk * v; n[i] = fp * n[i] + ip * kk; hacc += qq * C[i]; dacc += qq * n[i]; }
        hp[par * 512 + eg * 128 + f] = hacc; if (f == 0) dp[par * 4 + eg] = dacc;
        __syncthreads();
        if (tid < 128) { const float num = (hp[par * 512 + f] + hp[par * 512 + 128 + f]) + (hp[par * 512 + 256 + f] + hp[par * 512 + 384 + f]);
            const float den = (dp[par * 4] + dp[par * 4 + 1]) + (dp[par * 4 + 2] + dp[par * 4 + 3]);
            const float hv = num / fmaxf(fabsf(den), expf(-mnew));
            BMo[(row0 + t) * 512 + h * 128 + f] = (bf16)f2bf(sigmoidf_(og) * hv); }
    }
    __syncthreads();
}

__device__ __forceinline__ void attn_v0(const Args& a, LAS unsigned char* lds, int g, int gwave, int ngwave, int wave, int lane, int tid) {
    const int d = (g == 0) ? 1 : (g == 1 ? 4 : 16);
    const bf16* QKV = (const bf16*)(a.ws + WS_QKV); bf16* Ao = (bf16*)(a.ws + WS_A); float* LSE = (float*)(a.ws + WS_LSE);
    const float* rope = (const float*)(a.ws + WS_ROPE);
    const float* qg = (const float*)(a.ws + WS_PAR) + PAR_QG; const float* kg = (const float*)(a.ws + WS_PAR) + PAR_KG;
    LAS float* qsh = (LAS float*)lds + wave * 128;
    LAS float* kgs = (LAS float*)lds + 8 * 128;
    if (tid < 128) kgs[tid] = kg[tid];
    __syncthreads();
    for (int it = gwave; it < M * 4; it += ngwave) {
        const int row = it >> 2, j = it & 3, t = row & (SEQ - 1);
        { const unsigned qq = *(const unsigned*)(QKV + (size_t)row * 1536 + j * 128 + 2 * lane);
          float q0 = bfl(qq), q1 = bfh(qq);
          const float ss = wave_sum(q0 * q0 + q1 * q1); const float rn = __builtin_amdgcn_rsqf(ss * (1.f / 128.f) + 1e-6f);
          q0 *= rn * qg[2 * lane]; q1 *= rn * qg[2 * lane + 1];
          const float p0 = __shfl_xor(q0, 8), p1 = __shfl_xor(q1, 8);
          if (lane < 16) { const int i0 = (2 * lane) & 15; const float c0 = rope[(t * 16 + i0) * 2], s0 = rope[(t * 16 + i0) * 2 + 1], c1 = rope[(t * 16 + i0 + 1) * 2], s1 = rope[(t * 16 + i0 + 1) * 2 + 1];
              if (lane < 8) { q0 = q0 * c0 - p0 * s0; q1 = q1 * c1 - p1 * s1; } else { q0 = q0 * c0 + p0 * s0; q1 = q1 * c1 + p1 * s1; } }
          qsh[2 * lane] = q0; qsh[2 * lane + 1] = q1; }
        LDS_WAIT(); asm volatile("" ::: "memory");
        float sc[3];
#pragma unroll
        for (int c = 0; c < 3; ++c) { const int i = lane + 64 * c; const int s = t - i * d; sc[c] = -INFINITY;
            if (i <= 128 && s >= 0) { const bf16* kr = QKV + (size_t)(row - i * d) * 1536 + 512 + j * 128;
                float ss = 0.f, dot = 0.f; float kx[32];
#pragma unroll
                for (int e8 = 0; e8 < 16; ++e8) { const v4u kv = *(const v4u*)(kr + e8 * 8);
                    float kf[8] = {bfl(kv.x), bfh(kv.x), bfl(kv.y), bfh(kv.y), bfl(kv.z), bfh(kv.z), bfl(kv.w), bfh(kv.w)};
#pragma unroll
                    for (int u = 0; u < 8; ++u) { ss += kf[u] * kf[u]; const int e = e8 * 8 + u; if (e < 32) kx[e] = kf[u] * kgs[e]; else dot += qsh[e] * kf[u] * kgs[e]; } }
#pragma unroll
                for (int i2 = 0; i2 < 16; ++i2) { const float cs = rope[(s * 16 + i2) * 2], sn = rope[(s * 16 + i2) * 2 + 1];
                    dot += qsh[i2] * (kx[i2] * cs - kx[i2 + 16] * sn) + qsh[i2 + 16] * (kx[i2 + 16] * cs + kx[i2] * sn); }
                sc[c] = dot * __builtin_amdgcn_rsqf(ss * (1.f / 128.f) + 1e-6f) * 0.08838834764831845f; } }
        const float mx = wave_max(fmaxf(fmaxf(sc[0], sc[1]), sc[2]));
        float p[3]; float ls = 0.f;
#pragma unroll
        for (int c = 0; c < 3; ++c) { p[c] = expf(sc[c] - mx); ls += p[c]; }
        ls = wave_sum(ls);
        float lse = mx + logf(ls);
        float o0 = 0.f, o1 = 0.f;
        const int imax = (t / d < 128) ? (t / d) : 128;
        for (int i = 0; i <= imax; ++i) { const float psel = (i < 64) ? p[0] : ((i < 128) ? p[1] : p[2]); const float pi = __shfl(psel, i & 63);
            const unsigned vv = *(const unsigned*)(QKV + (size_t)(row - i * d) * 1536 + 1024 + j * 128 + 2 * lane);
            o0 += pi * bfl(vv); o1 += pi * bfh(vv); }
        const float il = 1.f / ls; o0 *= il; o1 *= il;
        if (g > 0) { const float lo = LSE[(size_t)row * 4 + j]; const unsigned ov = *(const unsigned*)(Ao + (size_t)row * 512 + j * 128 + 2 * lane);
            const float mm = fmaxf(lo, lse); const float wo = expf(lo - mm), wn = expf(lse - mm); const float inv = 1.f / (wo + wn);
            o0 = (wo * bfl(ov) + wn * o0) * inv; o1 = (wo * bfh(ov) + wn * o1) * inv; lse = mm + logf(wo + wn); }
        *(unsigned*)(Ao + (size_t)row * 512 + j * 128 + 2 * lane) = pk2(o0, o1);
        if (lane == 0) LSE[(size_t)row * 4 + j] = lse;
    }
    __syncthreads();
}


typedef short bf16x8_t __attribute__((ext_vector_type(8)));
typedef short v4i16_t __attribute__((ext_vector_type(4)));
constexpr int TP = 288, TILE_B = 128 * TP;
#define LANE_ID_F() ({ int _l; asm volatile("v_mbcnt_lo_u32_b32 %0, -1, 0\n\tv_mbcnt_hi_u32_b32 %0, -1, %0" : "=v"(_l)); _l; })
__device__ __forceinline__ bf16x8_t trpair(const LAS unsigned char* pa, const LAS unsigned char* pb) {
    const v4i16_t lo = __builtin_amdgcn_ds_read_tr16_b64_v4i16((LAS v4i16_t*)pa), hi = __builtin_amdgcn_ds_read_tr16_b64_v4i16((LAS v4i16_t*)pb);
    return (bf16x8_t){lo[0], lo[1], lo[2], lo[3], hi[0], hi[1], hi[2], hi[3]};
}
__device__ __forceinline__ void unpack8(const v4u v, float (&f)[8]) { f[0] = bfl(v.x); f[1] = bfh(v.x); f[2] = bfl(v.y); f[3] = bfh(v.y); f[4] = bfl(v.z); f[5] = bfh(v.z); f[6] = bfl(v.w); f[7] = bfh(v.w); }
__device__ __forceinline__ v4u pack8(const float (&f)[8]) { v4u w; w.x = pg8::cvt_pk_bf16(f[0], f[1]); w.y = pg8::cvt_pk_bf16(f[2], f[3]); w.z = pg8::cvt_pk_bf16(f[4], f[5]); w.w = pg8::cvt_pk_bf16(f[6], f[7]); return w; }

typedef float f2_t __attribute__((ext_vector_type(2)));
__device__ __forceinline__ v4u f8to16(const v2u q) {
    const f2_t a_ = __builtin_amdgcn_cvt_pk_f32_fp8((int)q.x, false), b_ = __builtin_amdgcn_cvt_pk_f32_fp8((int)q.x, true), c_ = __builtin_amdgcn_cvt_pk_f32_fp8((int)q.y, false), d_ = __builtin_amdgcn_cvt_pk_f32_fp8((int)q.y, true);
    v4u o_; o_.x = pg8::cvt_pk_bf16(a_[0], a_[1]); o_.y = pg8::cvt_pk_bf16(b_[0], b_[1]); o_.z = pg8::cvt_pk_bf16(c_[0], c_[1]); o_.w = pg8::cvt_pk_bf16(d_[0], d_[1]); return o_; }
__device__ __forceinline__ void attn_fast(unsigned char* ws, const unsigned short* QKV, LAS unsigned char* lds, const int g, const int wave, const int vcu, const int G) {
    const int lane = LANE_ID_F(), tid = wave * 64 + lane, fr = lane & 15, fq = lane >> 4;
    const int lgd = 2 * g, d = 1 << lgd, lgseg = 4 - lgd;
    bf16* Ao = (bf16*)(ws + WS_A); float* LSE = (float*)(ws + WS_LSE);
    const int srow = tid >> 4, c = tid & 15;
    for (int seg = vcu; seg < 256; seg += G) {
        const int stream = seg >> lgseg, n0 = (seg & ((1 << lgseg) - 1)) * 4;
        const int r = stream & (d - 1), j = (stream >> lgd) & 3, b = stream >> (lgd + 2);
        const size_t rowbase = (size_t)b * SEQ + r;
        v2u kreg[4], vreg[4], qraw[4]; bf16x8_t qf[4];
        v2u aold[8]; float lold = 0.f;
#define AT_LOADKV(n) do { _Pragma("unroll") for (int i = 0; i < 4; ++i) { const unsigned char* p_ = (const unsigned char*)QKV + (rowbase + (size_t)((n) * 128 + srow + 32 * i) * d) * 1536 + j * 128 + c * 8; \
            kreg[i] = *(const v2u*)(p_ + 512); vreg[i] = *(const v2u*)(p_ + 1024); } } while (0)
#define AT_LOADQ(n) do { const unsigned char* p_ = (const unsigned char*)QKV + (rowbase + (size_t)((n) * 128 + wave * 16 + fr) * d) * 1536 + j * 128 + fq * 8; \
            _Pragma("unroll") for (int ds = 0; ds < 4; ++ds) qraw[ds] = *(const v2u*)(p_ + ds * 32); } while (0)
        if (n0 > 0) AT_LOADKV(n0 - 1);
#pragma unroll 1
        for (int it = -1; it < 4; ++it) {
            const int n = n0 + it;
            __syncthreads();
            if (it >= 0) {
#pragma unroll
                for (int ds = 0; ds < 4; ++ds) qf[ds] = __builtin_bit_cast(bf16x8_t, f8to16(qraw[ds]));
            }
            { LAS unsigned char* kt = lds + (n & 1) * TILE_B; LAS unsigned char* vt = lds + (2 + (n & 1)) * TILE_B;
              if (n >= 0) {
#pragma unroll
                for (int i = 0; i < 4; ++i) { *(LAS v4u*)(kt + (srow + 32 * i) * TP + c * 16) = f8to16(kreg[i]); *(LAS v4u*)(vt + (srow + 32 * i) * TP + c * 16) = f8to16(vreg[i]); }
              } else {
#pragma unroll
                for (int i = 0; i < 4; ++i) { *(LAS v4u*)(kt + (srow + 32 * i) * TP + c * 16) = (v4u){0u, 0u, 0u, 0u}; *(LAS v4u*)(vt + (srow + 32 * i) * TP + c * 16) = (v4u){0u, 0u, 0u, 0u}; }
              } }
            const size_t qrow = rowbase + (size_t)(n * 128 + wave * 16 + fr) * d;
            bf16* ap = Ao + qrow * 512 + j * 128 + 4 * fq;
            if (it >= 0 && g > 0) {
#pragma unroll
                for (int db = 0; db < 8; ++db) aold[db] = *(const v2u*)(ap + db * 16);
                lold = LSE[qrow * 4 + j]; }
            if (it < 3) { AT_LOADKV(n + 1); AT_LOADQ(n + 1); }
            __syncthreads();
            if (it >= 0) {
                const int kb0 = (wave < 6) ? wave : 6;
                const int slot_prev = (n + 1) & 1, slot_cur = n & 1;
                f32x4 sacc[10];
#pragma unroll
                for (int bp = 0; bp < 5; ++bp) {
                    bf16x8_t kfr[2][4];
#pragma unroll
                    for (int h2 = 0; h2 < 2; ++h2) { const int kb = kb0 + 2 * bp + h2; const int slot = (kb < 8) ? slot_prev : slot_cur;
                        const LAS unsigned char* kp = lds + slot * TILE_B + ((kb & 7) * 16 + fr) * TP + fq * 16;
#pragma unroll
                        for (int ds = 0; ds < 4; ++ds) kfr[h2][ds] = *(const LAS bf16x8_t*)(kp + ds * 64); }
#pragma unroll
                    for (int h2 = 0; h2 < 2; ++h2) { f32x4 a_ = (f32x4){0.f, 0.f, 0.f, 0.f};
#pragma unroll
                        for (int ds = 0; ds < 4; ++ds) a_ = __builtin_amdgcn_mfma_f32_16x16x32_bf16(kfr[h2][ds], qf[ds], a_, 0, 0, 0);
                        sacc[2 * bp + h2] = a_; } }
                const int qi = wave * 16 + fr; float mx = -1e30f;
#pragma unroll
                for (int bb = 0; bb < 10; ++bb) {
                    if (bb < 2 || bb > 7) {
#pragma unroll
                        for (int rg = 0; rg < 4; ++rg) { const int kj = (kb0 + bb) * 16 + 4 * fq + rg; const bool ok = (kj >= qi) && (kj <= qi + 128); sacc[bb][rg] = ok ? sacc[bb][rg] : -1e30f; } }
                    if (n == 0) {
#pragma unroll
                        for (int rg = 0; rg < 4; ++rg) { const int kj = (kb0 + bb) * 16 + 4 * fq + rg; sacc[bb][rg] = (kj >= 128) ? sacc[bb][rg] : -1e30f; } }
#pragma unroll
                    for (int rg = 0; rg < 4; ++rg) mx = fmaxf(mx, sacc[bb][rg]); }
                mx = pg8::xmax_16_32(mx);
                float l = 0.f;
#pragma unroll
                for (int bb = 0; bb < 10; ++bb)
#pragma unroll
                    for (int rg = 0; rg < 4; ++rg) { const float p_ = __builtin_amdgcn_exp2f(sacc[bb][rg] - mx); sacc[bb][rg] = p_; l += p_; }
                l = pg8::xsum_16_32(l);
                f32x4 oacc[8];
#pragma unroll
                for (int db = 0; db < 8; ++db) oacc[db] = (f32x4){0.f, 0.f, 0.f, 0.f};
                const int trq = (lane & 15) >> 2, trp = lane & 3;
#pragma unroll
                for (int sg = 0; sg < 5; ++sg) { const int kbA = kb0 + 2 * sg, kbB = kbA + 1;
                    v4u pw; pw.x = pg8::cvt_pk_bf16(sacc[2 * sg][0], sacc[2 * sg][1]); pw.y = pg8::cvt_pk_bf16(sacc[2 * sg][2], sacc[2 * sg][3]);
                    pw.z = pg8::cvt_pk_bf16(sacc[2 * sg + 1][0], sacc[2 * sg + 1][1]); pw.w = pg8::cvt_pk_bf16(sacc[2 * sg + 1][2], sacc[2 * sg + 1][3]);
                    const bf16x8_t pf = __builtin_bit_cast(bf16x8_t, pw);
                    const LAS unsigned char* va = lds + (2 + ((kbA < 8) ? slot_prev : slot_cur)) * TILE_B + ((kbA & 7) * 16 + 4 * fq + trq) * TP + trp * 8;
                    const LAS unsigned char* vb = lds + (2 + ((kbB < 8) ? slot_prev : slot_cur)) * TILE_B + ((kbB & 7) * 16 + 4 * fq + trq) * TP + trp * 8;
                    bf16x8_t vfr[8];
#pragma unroll
                    for (int db = 0; db < 8; ++db) vfr[db] = trpair(va + db * 32, vb + db * 32);
#pragma unroll
                    for (int db = 0; db < 8; ++db) oacc[db] = __builtin_amdgcn_mfma_f32_16x16x32_bf16(vfr[db], pf, oacc[db], 0, 0, 0); }
                const float il = __builtin_amdgcn_rcpf(l); float lse = mx * 0.6931471805599453f + __logf(l);
                float wo = 0.f, wn = il;
                if (g > 0) { const float mm = fmaxf(lold, lse); const float eo = __expf(lold - mm), en = __expf(lse - mm); const float inv = __builtin_amdgcn_rcpf(eo + en);
                    wo = eo * inv; wn = en * inv * il; lse = mm + __logf(eo + en); }
#pragma unroll
                for (int db = 0; db < 8; ++db) { float o0 = oacc[db][0] * wn, o1 = oacc[db][1] * wn, o2 = oacc[db][2] * wn, o3 = oacc[db][3] * wn;
                    if (g > 0) { const v2u old = aold[db]; o0 += wo * bfl(old.x); o1 += wo * bfh(old.x); o2 += wo * bfl(old.y); o3 += wo * bfh(old.y); }
                    v2u w_; w_.x = pg8::cvt_pk_bf16(o0, o1); w_.y = pg8::cvt_pk_bf16(o2, o3); *(v2u*)(ap + db * 16) = w_; }
                if (fq == 0) LSE[qrow * 4 + j] = lse;
            }
        }
#undef AT_LOADKV
#undef AT_LOADQ
    }
    __syncthreads();
}

constexpr size_t WS_MSC = 496 * MiB;
constexpr size_t WS_CPB = WS_A;
constexpr int GSM_OFF = 4 * TILE_B;
__device__ __forceinline__ float log_sigmoid_(float x) { return fminf(x, 0.f) - log1pf(__expf(-fabsf(x))); }
__device__ __forceinline__ void conv_load(v4u (&raw)[4], const bf16* ML, size_t grow, int tpos, int col) {
#pragma unroll
    for (int jt = 0; jt < 4; ++jt) { const bool ok = (tpos - 3 + jt >= 0); raw[jt] = *(const v4u*)(ML + (ok ? (grow - 3 + jt) : grow) * 2048 + col); }
}
__device__ __forceinline__ void conv_apply(const v4u (&raw)[4], int tpos, const float (&w)[4][8], const float (&bs)[8], float (&o)[8]) {
#pragma unroll
    for (int u = 0; u < 8; ++u) o[u] = bs[u];
#pragma unroll
    for (int jt = 0; jt < 4; ++jt) { const float msk = (tpos - 3 + jt >= 0) ? 1.f : 0.f; float x[8]; unpack8(raw[jt], x);
#pragma unroll
        for (int u = 0; u < 8; ++u) o[u] += (w[jt][u] * msk) * x[u]; }
#pragma unroll
    for (int u = 0; u < 8; ++u) o[u] = o[u] * sigmoidf_(o[u]);
}
__device__ __forceinline__ void conv_piece(const bf16* ML, size_t grow, int tpos, int col, const float (&w)[4][8], const float (&bs)[8], float (&o)[8]) {
    v4u raw[4];
#pragma unroll
    for (int jt = 0; jt < 4; ++jt) { const bool ok = (tpos - 3 + jt >= 0); raw[jt] = *(const v4u*)(ML + (ok ? (grow - 3 + jt) : grow) * 2048 + col); }
#pragma unroll
    for (int u = 0; u < 8; ++u) o[u] = bs[u];
#pragma unroll
    for (int jt = 0; jt < 4; ++jt) { const float msk = (tpos - 3 + jt >= 0) ? 1.f : 0.f; float x[8]; unpack8(raw[jt], x);
#pragma unroll
        for (int u = 0; u < 8; ++u) o[u] += (w[jt][u] * msk) * x[u]; }
#pragma unroll
    for (int u = 0; u < 8; ++u) o[u] = o[u] * sigmoidf_(o[u]);
}
__device__ __forceinline__ float wave_scan_add(float v, int lane) {
#pragma unroll
    for (int o = 1; o < 64; o <<= 1) { const float t = __shfl_up(v, o); if (lane >= o) v += t; }
    return v;
}
__device__ __forceinline__ float wave_scan_max(float v, int lane) {
#pragma unroll
    for (int o = 1; o < 64; o <<= 1) { const float t = __shfl_up(v, o); if (lane >= o) v = fmaxf(v, t); }
    return v;
}
__device__ __forceinline__ void mlstm_b1(unsigned char* ws, LAS unsigned char* lds, const int wave, const int vcu, const int G) {
    const int lane = LANE_ID_F(), tid = wave * 64 + lane, fq = lane >> 4;
    const bf16* ML = (const bf16*)(ws + WS_ML); const float* GT = (const float*)(ws + WS_GATES); const float* par = (const float*)(ws + WS_PAR);
    float* MST = (float*)(ws + WS_MST); float* MSC = (float*)(ws + WS_MSC);
    LAS float* gsm = (LAS float*)(lds + GSM_OFF);
    LAS unsigned char* kt = lds; LAS unsigned char* vt = lds + TILE_B; LAS float* dnp = (LAS float*)(lds + 2 * TILE_B);
    const int srow = tid >> 4, c = tid & 15;
    struct B1Pre { v4u vr[4]; v4u raw[4][4]; };
#define B1_LOAD(P, item_) do { const int bh_ = (item_) >> 6, ch_ = (item_) & 63, h_ = bh_ & 3; const size_t r0_ = (size_t)(bh_ >> 2) * SEQ + ch_ * 128; \
        _Pragma("unroll") for (int i = 0; i < 4; ++i) { const int sr_ = srow + 32 * i; (P).vr[i] = *(const v4u*)(ML + (r0_ + sr_) * 2048 + 1024 + h_ * 128 + c * 8); conv_load((P).raw[i], ML, r0_ + sr_, ch_ * 128 + sr_, 512 + h_ * 128 + c * 8); } } while (0)
    for (int base = 0; base < 1024; base += 4 * G) {
        B1Pre cur_;
        if (base + vcu < 1024) B1_LOAD(cur_, base + vcu);
        __syncthreads();
        { const int k = tid >> 7, s_ = tid & 127, it_ = base + vcu + G * k; const bool ok = it_ < 1024; const int itc = ok ? it_ : 0;
          const int bh = itc >> 6, ch = itc & 63, h = bh & 3; const size_t r = (size_t)(bh >> 2) * SEQ + ch * 128 + s_;
          const float lf = log_sigmoid_(GT[r * 8 + 4 + h] + par[PAR_FB + h]), li = GT[r * 8 + h] + par[PAR_IB + h];
          float b_ = wave_scan_add(lf, lane);
          if (lane == 63) gsm[1664 + wave] = b_;
          __syncthreads();
          if (wave & 1) b_ += gsm[1664 + wave - 1];
          const float bL = gsm[1664 + 2 * k] + gsm[1664 + 2 * k + 1];
          const float g_ = bL - b_ + li;
          const float mw = wave_max(g_);
          if (lane == 0) gsm[1680 + wave] = mw;
          __syncthreads();
          const float mloc = fmaxf(gsm[1680 + 2 * k], gsm[1680 + 2 * k + 1]);
          gsm[k * 128 + s_] = __expf(g_ - mloc);
          if (s_ == 0) { gsm[1696 + k] = mloc; gsm[1700 + k] = bL; }
        }
        __syncthreads();
#pragma unroll 1
        for (int k = 0; k < 4; ++k) { const int item = base + vcu + G * k; if (item >= 1024) break;
            const int bh = item >> 6, ch = item & 63, h = bh & 3; const size_t row0 = (size_t)(bh >> 2) * SEQ + ch * 128;
            if (k > 0) __syncthreads();
            { float w[4][8], bs[8]; const int col = 512 + h * 128 + c * 8;
#pragma unroll
              for (int jt = 0; jt < 4; ++jt)
#pragma unroll
                  for (int u = 0; u < 8; ++u) w[jt][u] = par[PAR_CW + jt * 1024 + col + u];
#pragma unroll
              for (int u = 0; u < 8; ++u) bs[u] = par[PAR_CB + col + u];
              float dn[8];
#pragma unroll
              for (int u = 0; u < 8; ++u) dn[u] = 0.f;
#pragma unroll
              for (int i = 0; i < 4; ++i) { const int sr = srow + 32 * i; float o[8]; conv_apply(cur_.raw[i], ch * 128 + sr, w, bs, o);
                  const float sc = 0.08838834764831845f * gsm[k * 128 + sr];
#pragma unroll
                  for (int u = 0; u < 8; ++u) { o[u] *= sc; dn[u] += o[u]; }
                  *(LAS v4u*)(kt + sr * TP + c * 16) = pack8(o);
                  *(LAS v4u*)(vt + sr * TP + c * 16) = cur_.vr[i]; }
#pragma unroll
              for (int u = 0; u < 8; ++u) dnp[srow * 128 + c * 8 + u] = dn[u]; }
            __syncthreads();
            if (tid < 128) { float a_ = 0.f;
#pragma unroll 8
                for (int r = 0; r < 32; ++r) a_ += dnp[r * 128 + tid];
                MSC[(size_t)item * 256 + tid] = a_; }
            if (tid == 0) { MSC[(size_t)item * 256 + 128] = gsm[1696 + k]; MSC[(size_t)item * 256 + 129] = gsm[1700 + k]; }
            { const int nitem = item + G; if (k < 3 && nitem < 1024) B1_LOAD(cur_, nitem); }
            { const int trq = (lane & 15) >> 2, trp = lane & 3; f32x4 acc[8];
#pragma unroll
              for (int fb = 0; fb < 8; ++fb) acc[fb] = (f32x4){0.f, 0.f, 0.f, 0.f};
#pragma unroll
              for (int ks = 0; ks < 4; ++ks) { const int ra = ks * 32 + 4 * fq + trq;
                  const bf16x8_t kf = trpair(kt + ra * TP + (wave * 16 + 4 * trp) * 2, kt + (ra + 16) * TP + (wave * 16 + 4 * trp) * 2);
                  bf16x8_t vfr[8];
#pragma unroll
                  for (int fb = 0; fb < 8; ++fb) vfr[fb] = trpair(vt + ra * TP + (fb * 16 + 4 * trp) * 2, vt + (ra + 16) * TP + (fb * 16 + 4 * trp) * 2);
#pragma unroll
                  for (int fb = 0; fb < 8; ++fb) acc[fb] = __builtin_amdgcn_mfma_f32_16x16x32_bf16(vfr[fb], kf, acc[fb], 0, 0, 0); }
              float* dst = MST + (size_t)item * 16384 + (size_t)(wave * 16 + (lane & 15)) * 128 + 4 * fq;
#pragma unroll
              for (int fb = 0; fb < 8; ++fb) *(f32x4*)(dst + fb * 16) = acc[fb]; }
        }
    }
    __syncthreads();
}
__device__ __forceinline__ void mlstm_b2(unsigned char* ws, const int wave, const int vcu, const int G) {
    const int lane = LANE_ID_F(), tid = wave * 64 + lane;
    const float* MST = (const float*)(ws + WS_MST); float* MSC = (float*)(ws + WS_MSC); unsigned* CPB = (unsigned*)(ws + WS_CPB);
    typedef float f32x2 __attribute__((ext_vector_type(2)));
    for (int gid = vcu * NTHREADS + tid; gid < 16 * 8192; gid += G * NTHREADS) {
        const int bh = gid >> 13, rem = gid & 8191;
        float m = 0.f; f32x2 C = {0.f, 0.f}, nn = {0.f, 0.f};
        const f32x2* p = (const f32x2*)(MST + (size_t)bh * 64 * 16384) + rem; unsigned* cp = CPB + (size_t)bh * 64 * 8192 + rem; float* sc = MSC + (size_t)bh * 64 * 256;
#pragma unroll 1
        for (int c0 = 0; c0 < 64; c0 += 16) {
            f32x2 dv[16], dn[16]; float ml[16], bl[16];
#pragma unroll
            for (int k = 0; k < 16; ++k) { dv[k] = p[(size_t)(c0 + k) * 8192]; ml[k] = sc[(c0 + k) * 256 + 128]; bl[k] = sc[(c0 + k) * 256 + 129]; if (rem < 64) dn[k] = *(const f32x2*)(sc + (c0 + k) * 256 + 2 * rem); }
#pragma unroll
            for (int k = 0; k < 16; ++k) { const float mn = fmaxf(bl[k] + m, ml[k]); const float sp = __expf(bl[k] + m - mn), sn = __expf(ml[k] - mn);
                cp[(size_t)(c0 + k) * 8192] = pg8::cvt_pk_bf16(C[0], C[1]); C = C * sp + dv[k] * sn;
                if (rem < 64) { *(f32x2*)(sc + (c0 + k) * 256 + 2 * rem) = nn; nn = nn * sp + dn[k] * sn; }
                if (rem == 0) sc[(c0 + k) * 256 + 130] = m;
                m = mn; }
        }
    }
}
__device__ __forceinline__ void mlstm_b3(unsigned char* ws, const unsigned char* MO8, LAS unsigned char* lds, const int wave, const int vcu, const int G) {
    const int lane = LANE_ID_F(), tid = wave * 64 + lane, fr = lane & 15, fq = lane >> 4;
    const bf16* ML = (const bf16*)(ws + WS_ML); const float* GT = (const float*)(ws + WS_GATES); const float* par = (const float*)(ws + WS_PAR);
    const bf16* CPBr = (const bf16*)(ws + WS_CPB); const float* MSC = (const float*)(ws + WS_MSC); bf16* BMo = (bf16*)(ws + WS_BM);
    LAS float* gsm = (LAS float*)(lds + GSM_OFF);
    LAS unsigned char* qt = lds; LAS unsigned char* kt = lds + TILE_B; LAS unsigned char* vt = lds + 2 * TILE_B; LAS unsigned char* ct = lds + 3 * TILE_B;
    const int srow = tid >> 4, c = tid & 15;
    struct B3Pre { v4u vr[4], cr[4]; };
#define B3_LOAD(P, item_) do { const int bh_ = (item_) >> 6, ch_ = (item_) & 63, h_ = bh_ & 3; const size_t r0_ = (size_t)(bh_ >> 2) * SEQ + ch_ * 128; \
        _Pragma("unroll") for (int i = 0; i < 4; ++i) { const int sr_ = srow + 32 * i; (P).vr[i] = *(const v4u*)(ML + (r0_ + sr_) * 2048 + 1024 + h_ * 128 + c * 8); (P).cr[i] = *(const v4u*)(CPBr + (size_t)(item_) * 16384 + sr_ * 128 + c * 8); \
            } } while (0)
    for (int base = 0; base < 1024; base += 4 * G) {
        B3Pre cur_;
        if (base + vcu < 1024) B3_LOAD(cur_, base + vcu);
        __syncthreads();
        { const int k = tid >> 7, s_ = tid & 127, it_ = base + vcu + G * k; const bool ok = it_ < 1024; const int itc = ok ? it_ : 0;
          const int bh = itc >> 6, ch = itc & 63, h = bh & 3; const size_t r = (size_t)(bh >> 2) * SEQ + ch * 128 + s_;
          const float lf = log_sigmoid_(GT[r * 8 + 4 + h] + par[PAR_FB + h]), li = GT[r * 8 + h] + par[PAR_IB + h];
          const float mprev = MSC[(size_t)itc * 256 + 130];
          float b_ = wave_scan_add(lf, lane);
          if (lane == 63) gsm[1664 + wave] = b_;
          __syncthreads();
          if (wave & 1) b_ += gsm[1664 + wave - 1];
          const float a_ = li - b_;
          float cm = wave_scan_max(a_, lane);
          if (lane == 63) gsm[1680 + wave] = cm;
          __syncthreads();
          if (wave & 1) cm = fmaxf(cm, gsm[1680 + wave - 1]);
          const float Mt = fmaxf(mprev, cm);
          gsm[k * 128 + s_] = a_; gsm[512 + k * 128 + s_] = Mt; gsm[1024 + k * 128 + s_] = b_ + Mt;
          if (s_ == 0) gsm[1696 + k] = mprev;
        }
        __syncthreads();
#pragma unroll 1
        for (int k = 0; k < 4; ++k) { const int item = base + vcu + G * k; if (item >= 1024) break;
            const int bh = item >> 6, ch = item & 63, h = bh & 3; const size_t row0 = (size_t)(bh >> 2) * SEQ + ch * 128;
            if (k > 0) __syncthreads();
            const float mprev = gsm[1696 + k];
            if (tid < 128) gsm[1536 + tid] = MSC[(size_t)item * 256 + tid];
            {
#pragma unroll
              for (int which = 0; which < 2; ++which) { float w[4][8], bs[8]; const int col = which * 512 + h * 128 + c * 8; LAS unsigned char* dt = which ? kt : qt; const float sc = which ? 0.08838834764831845f : 1.0f;
#pragma unroll
                for (int jt = 0; jt < 4; ++jt)
#pragma unroll
                    for (int u = 0; u < 8; ++u) w[jt][u] = par[PAR_CW + jt * 1024 + col + u];
#pragma unroll
                for (int u = 0; u < 8; ++u) bs[u] = par[PAR_CB + col + u];
#pragma unroll
                for (int i = 0; i < 4; ++i) { const int sr = srow + 32 * i; float o[8]; conv_piece(ML, row0 + sr, ch * 128 + sr, col, w, bs, o);
#pragma unroll
                    for (int u = 0; u < 8; ++u) o[u] *= sc;
                    *(LAS v4u*)(dt + sr * TP + c * 16) = pack8(o); } }
#pragma unroll
              for (int i = 0; i < 4; ++i) { const int sr = srow + 32 * i; *(LAS v4u*)(vt + sr * TP + c * 16) = cur_.vr[i]; *(LAS v4u*)(ct + sr * TP + c * 16) = cur_.cr[i]; } }
            { const int nitem = item + G; if (k < 3 && nitem < 1024) B3_LOAD(cur_, nitem); }
            __syncthreads();
            { const int trq = (lane & 15) >> 2, trp = lane & 3;
              bf16x8_t qf[4];
#pragma unroll
              for (int ds = 0; ds < 4; ++ds) qf[ds] = *(const LAS bf16x8_t*)(qt + (wave * 16 + fr) * TP + ds * 64 + fq * 16);
              const int t = wave * 16 + fr; const float Mt = gsm[512 + k * 128 + t], mt = gsm[1024 + k * 128 + t]; const float dec = __expf(mprev - Mt);
              const size_t orow = row0 + t;
              unsigned og[8];
#pragma unroll
              for (int fb = 0; fb < 8; ++fb) og[fb] = *(const unsigned*)(MO8 + orow * 512 + h * 128 + fb * 16 + 4 * fq);
              f32x4 acc[8];
#pragma unroll
              for (int fb = 0; fb < 8; ++fb) acc[fb] = (f32x4){0.f, 0.f, 0.f, 0.f};
#pragma unroll
              for (int ds = 0; ds < 4; ++ds) { const int ra = ds * 32 + 8 * fq + trq;
                  bf16x8_t cfr[8];
#pragma unroll
                  for (int fb = 0; fb < 8; ++fb) cfr[fb] = trpair(ct + ra * TP + (fb * 16 + 4 * trp) * 2, ct + (ra + 4) * TP + (fb * 16 + 4 * trp) * 2);
#pragma unroll
                  for (int fb = 0; fb < 8; ++fb) acc[fb] = __builtin_amdgcn_mfma_f32_16x16x32_bf16(cfr[fb], qf[ds], acc[fb], 0, 0, 0); }
              float qn = 0.f;
#pragma unroll
              for (int ds = 0; ds < 4; ++ds) { float qv[8]; unpack8(__builtin_bit_cast(v4u, qf[ds]), qv); const f32x4 n0 = *(const LAS f32x4*)(gsm + 1536 + ds * 32 + fq * 8), n1 = *(const LAS f32x4*)(gsm + 1536 + ds * 32 + fq * 8 + 4);
#pragma unroll
                  for (int u = 0; u < 4; ++u) qn += qv[u] * n0[u] + qv[4 + u] * n1[u]; }
              qn = pg8::xsum_16_32(qn);
#pragma unroll
              for (int fb = 0; fb < 8; ++fb) acc[fb] *= dec;
              f32x4 sacc[8]; float dsum = 0.f;
#pragma unroll
              for (int sb = 0; sb < 8; ++sb) { sacc[sb] = (f32x4){0.f, 0.f, 0.f, 0.f};
                  if (sb <= wave) {
                      bf16x8_t kfr[4];
#pragma unroll
                      for (int ds = 0; ds < 4; ++ds) kfr[ds] = *(const LAS bf16x8_t*)(kt + (sb * 16 + fr) * TP + ds * 64 + fq * 16);
#pragma unroll
                      for (int ds = 0; ds < 4; ++ds) sacc[sb] = __builtin_amdgcn_mfma_f32_16x16x32_bf16(kfr[ds], qf[ds], sacc[sb], 0, 0, 0);
                      const f32x4 a4 = *(const LAS f32x4*)(gsm + k * 128 + sb * 16 + 4 * fq);
#pragma unroll
                      for (int rg = 0; rg < 4; ++rg) { const int s_ = sb * 16 + 4 * fq + rg; const float p_ = (s_ <= t) ? sacc[sb][rg] * __expf(a4[rg] - Mt) : 0.f; sacc[sb][rg] = p_; dsum += p_; } } }
              dsum = pg8::xsum_16_32(dsum);
#pragma unroll
              for (int ks = 0; ks < 4; ++ks) { if (2 * ks <= wave) {
                  v4u pw; pw.x = pg8::cvt_pk_bf16(sacc[2 * ks][0], sacc[2 * ks][1]); pw.y = pg8::cvt_pk_bf16(sacc[2 * ks][2], sacc[2 * ks][3]);
                  pw.z = pg8::cvt_pk_bf16(sacc[2 * ks + 1][0], sacc[2 * ks + 1][1]); pw.w = pg8::cvt_pk_bf16(sacc[2 * ks + 1][2], sacc[2 * ks + 1][3]);
                  const bf16x8_t pf = __builtin_bit_cast(bf16x8_t, pw); const int ra = ks * 32 + 4 * fq + trq;
                  bf16x8_t vfr[8];
#pragma unroll
                  for (int fb = 0; fb < 8; ++fb) vfr[fb] = trpair(vt + ra * TP + (fb * 16 + 4 * trp) * 2, vt + (ra + 16) * TP + (fb * 16 + 4 * trp) * 2);
#pragma unroll
                  for (int fb = 0; fb < 8; ++fb) acc[fb] = __builtin_amdgcn_mfma_f32_16x16x32_bf16(vfr[fb], pf, acc[fb], 0, 0, 0); } }
              const float den = dec * qn + dsum; const float inv = __builtin_amdgcn_rcpf(fmaxf(fabsf(den), __expf(-mt)));
#pragma unroll
              for (int fb = 0; fb < 8; ++fb) {
                  const float i5 = inv * (1.0f / 255.0f); const unsigned o8 = og[fb];
                  v2u w_; w_.x = pg8::cvt_pk_bf16((float)(o8 & 255u) * acc[fb][0] * i5, (float)((o8 >> 8) & 255u) * acc[fb][1] * i5);
                  w_.y = pg8::cvt_pk_bf16((float)((o8 >> 16) & 255u) * acc[fb][2] * i5, (float)(o8 >> 24) * acc[fb][3] * i5);
                  *(v2u*)(BMo + orow * 512 + h * 128 + fb * 16 + 4 * fq) = w_; } }
        }
    }
    __syncthreads();
}

template <int NR> __device__ __forceinline__ void quant_rows_i8(const bf16* const (&src)[NR], unsigned char* const (&dst)[NR], float* const (&sc)[NR], int lane) {
    v4u ra[NR], rb[NR];
#pragma unroll
    for (int q = 0; q < NR; ++q) { ra[q] = *(const v4u*)(src[q] + lane * 16); rb[q] = *(const v4u*)(src[q] + lane * 16 + 8); }
#pragma unroll
    for (int q = 0; q < NR; ++q) { float f[16];
        { float t0[8], t1[8]; unpack8(ra[q], t0); unpack8(rb[q], t1);
#pragma unroll
          for (int u = 0; u < 8; ++u) { f[u] = t0[u]; f[8 + u] = t1[u]; } }
        float am = 0.f;
#pragma unroll
        for (int u = 0; u < 16; ++u) am = fmaxf(am, fabsf(f[u]));
        am = wave_max(am);
        const float inv = (am > 0.f) ? 127.0f / am : 0.f;
        unsigned w[4];
#pragma unroll
        for (int d4 = 0; d4 < 4; ++d4) { unsigned p = 0u;
#pragma unroll
            for (int u = 0; u < 4; ++u) { const int qi = (int)__builtin_rintf(f[d4 * 4 + u] * inv); p |= ((unsigned)qi & 255u) << (8 * u); }
            w[d4] = p; }
        *(v4u*)(dst[q] + lane * 16) = (v4u){w[0], w[1], w[2], w[3]};
        if (lane == 0) *sc[q] = (am > 0.f) ? am * (1.0f / 127.0f) : 1.0f; }
}
typedef __bf16 bf16x2_t __attribute__((ext_vector_type(2)));
__device__ __forceinline__ float dot2bf(unsigned a, unsigned b, float c) { return __builtin_amdgcn_fdot2_f32_bf16(__builtin_bit_cast(bf16x2_t, a), __builtin_bit_cast(bf16x2_t, b), c, false); }
struct QRows { v4u a[4], b[4]; float ss; };
template <bool GATES> __device__ __forceinline__ void qrows_load(QRows& q, const bf16* HBr, const float* RSr, int lane) {
#pragma unroll
    for (int r = 0; r < 4; ++r) { q.a[r] = *(const v4u*)(HBr + (size_t)r * D + lane * 16); q.b[r] = *(const v4u*)(HBr + (size_t)r * D + lane * 16 + 8); }
    if constexpr (GATES) q.ss = RSr[lane]; else q.ss = 0.f;
}
template <bool GATES> __device__ __forceinline__ void quant_rows_gates4(const QRows& qr, unsigned char* H8r, float* SCHr, float* GTr, const v4u (&wg)[8][2], int lane) {
    float ss = qr.ss;
    if constexpr (GATES) { ss += __shfl_xor(ss, 1); ss += __shfl_xor(ss, 2); ss += __shfl_xor(ss, 4); ss += __shfl_xor(ss, 8); }
#pragma unroll
    for (int q = 0; q < 4; ++q) { float f[16];
        { float t0[8], t1[8]; unpack8(qr.a[q], t0); unpack8(qr.b[q], t1);
#pragma unroll
          for (int u = 0; u < 8; ++u) { f[u] = t0[u]; f[8 + u] = t1[u]; } }
        float am = 0.f;
#pragma unroll
        for (int u = 0; u < 16; ++u) am = fmaxf(am, fabsf(f[u]));
        am = wave_max(am);
        const float inv = (am > 0.f) ? 127.0f / am : 0.f;
        unsigned w[4];
#pragma unroll
        for (int d4 = 0; d4 < 4; ++d4) { unsigned p = 0u;
#pragma unroll
            for (int u = 0; u < 4; ++u) { const int qi = (int)__builtin_rintf(f[d4 * 4 + u] * inv); p |= ((unsigned)qi & 255u) << (8 * u); }
            w[d4] = p; }
        *(v4u*)(H8r + (size_t)q * D + lane * 16) = (v4u){w[0], w[1], w[2], w[3]};
        if (lane == 0) SCHr[q] = (am > 0.f) ? am * (1.0f / 127.0f) : 1.0f;
        if constexpr (GATES) {
        float d[8];
#pragma unroll
        for (int j = 0; j < 8; ++j) { float a = 0.f;
            a = dot2bf(qr.a[q].x, wg[j][0].x, a); a = dot2bf(qr.a[q].y, wg[j][0].y, a); a = dot2bf(qr.a[q].z, wg[j][0].z, a); a = dot2bf(qr.a[q].w, wg[j][0].w, a);
            a = dot2bf(qr.b[q].x, wg[j][1].x, a); a = dot2bf(qr.b[q].y, wg[j][1].y, a); a = dot2bf(qr.b[q].z, wg[j][1].z, a); a = dot2bf(qr.b[q].w, wg[j][1].w, a);
            d[j] = a; }
        const bool h5 = (lane & 32) != 0, h4 = (lane & 16) != 0, h3 = (lane & 8) != 0;
        float e[4];
#pragma unroll
        for (int i = 0; i < 4; ++i) { const float keep = h5 ? d[4 + i] : d[i], send = h5 ? d[i] : d[4 + i]; e[i] = keep + __shfl_xor(send, 32); }
        float g2[2];
#pragma unroll
        for (int i = 0; i < 2; ++i) { const float keep = h4 ? e[2 + i] : e[i], send = h4 ? e[i] : e[2 + i]; g2[i] = keep + __shfl_xor(send, 16); }
        float v = (h3 ? g2[1] : g2[0]) + __shfl_xor(h3 ? g2[0] : g2[1], 8);
        v += __shfl_xor(v, 4); v += __shfl_xor(v, 2); v += __shfl_xor(v, 1);
        const float r = __builtin_amdgcn_rsqf(__shfl(ss, q * 16) * (1.0f / 1024.0f) + pg8::RMS_EPS);
        if ((lane & 7) == 0) GTr[q * 8 + (lane >> 3)] = v * r; } }
}
__global__ void __launch_bounds__(NTHREADS, 2) mega(Args args) {
    extern __shared__ __attribute__((aligned(16))) unsigned char lds_raw[];
    LAS unsigned char* lds = (LAS unsigned char*)lds_raw;
    volatile LAS unsigned* MISC = (volatile LAS unsigned*)(lds + MISC_OFF);
    const int wave = __builtin_amdgcn_readfirstlane(threadIdx.x >> 6);
#define LANE_ID() ({ int _l; asm volatile("v_mbcnt_lo_u32_b32 %0, -1, 0\n\tv_mbcnt_hi_u32_b32 %0, -1, %0" : "=v"(_l)); _l; })
    const int G = gridDim.x; const int bx = blockIdx.x; const int vcu = (G % 8 == 0) ? (bx % 8) * (G / 8) + bx / 8 : bx;
    unsigned char* ws = args.ws;
    gu32* ctl = (gu32*)(ws + WS_CTL);
    { const int tid = wave * 64 + LANE_ID(); for (int u = tid; u < (LDS_BYTES - LDSCTL_OFF) / 4; u += NTHREADS) ((LAS unsigned*)(lds + LDSCTL_OFF))[u] = 0u; }
    __syncthreads();
    XcdBarrier bar; bar.bar = (unsigned*)(ctl + CW_BAR); bar.x = 0; bar.st = nullptr;
#if !MK_PER_PHASE
    bar = xcd_barrier_post((unsigned*)(ctl + CW_BAR), MISC + 8, (wave == 0) && (LANE_ID() == 0));
#define GRID_BAR() xcd_barrier(bar, (wave == 0) && (LANE_ID() == 0))
#else
#define GRID_BAR() do {} while (0)
#endif
    const int lo = args.ph_lo, hi = args.ph_hi;
#define IN(k) (lo <= (k) && (k) < hi)
#define SEAM(k) do { if (IN(k) && IN((k) + 1)) { GRID_BAR(); if (PROBE_MASK & (1u << 29)) { GRID_BAR(); GRID_BAR(); } } } while (0)
    const int gw = vcu * NWAVES + wave, NGW = G * NWAVES;
    bf16* HB = (bf16*)(ws + WS_HB); float* RS = (float*)(ws + WS_RS);

    if (IN(0)) REP(0) {
        const int lane = LANE_ID(), tid = wave * 64 + lane;
        LAS float* scr = (LAS float*)(lds + wave * 16640);
        {
            const WD* wd = c_wd;
            int base = 0;
#pragma unroll 1
            for (int w = 0; w < 10; ++w) { const int K = wd[w].K, Nsrc = wd[w].Nsrc, Ndst = wd[w].Ndst, kind = wd[w].kind; const int nit = (K / 64) * (Ndst / 64);
                const float* W = args.in[wd[w].src]; const float* gn = wd[w].gain >= 0 ? args.in[wd[w].gain] : nullptr; bf16* WT = (bf16*)(ws + wd[w].dst);
                int first = (gw - base) % NGW; if (first < 0) first += NGW;
                for (int it = first; it < nit; it += NGW) p0_transpose_item(W, gn, K, Nsrc, Ndst, WT, kind, scr, it, lane);
                base = (base + nit) % NGW; }
        }
        const float* x = args.in[I_X];
        for (int m0 = gw * 4; m0 < M; m0 += NGW * 4) {
            f32x4 v[4][4]; float s4[4];
#pragma unroll
            for (int q = 0; q < 4; ++q) { const GAS f32x4* xr = (const GAS f32x4*)(x + (size_t)(m0 + q) * D) + lane;
#pragma unroll
                for (int j = 0; j < 4; ++j) v[q][j] = xr[64 * j]; }
#pragma unroll
            for (int q = 0; q < 4; ++q) { float s_ = 0.f;
#pragma unroll
                for (int j = 0; j < 4; ++j) s_ += (v[q][j][0] * v[q][j][0] + v[q][j][1] * v[q][j][1]) + (v[q][j][2] * v[q][j][2] + v[q][j][3] * v[q][j][3]);
                s4[q] = wave_sum(s_);
                float am = 0.f;
#pragma unroll
                for (int j = 0; j < 4; ++j) am = fmaxf(fmaxf(am, fmaxf(fabsf(v[q][j][0]), fabsf(v[q][j][1]))), fmaxf(fabsf(v[q][j][2]), fabsf(v[q][j][3])));
                am = wave_max(am); const float inv = (am > 0.f) ? 127.0f / am : 0.f;
                GAS unsigned* o4 = (GAS unsigned*)((unsigned char*)args.out + (size_t)(m0 + q) * D) + lane;
                GAS unsigned* e4 = (GAS unsigned*)((unsigned char*)args.out + (size_t)64 * MiB + (size_t)(m0 + q) * D) + lane;
#pragma unroll
                for (int j = 0; j < 4; ++j) { unsigned pq = 0u, pe = 0u;
#pragma unroll
                    for (int u = 0; u < 4; ++u) { const float t_ = v[q][j][u] * inv, qf_ = __builtin_rintf(t_); pq |= ((unsigned)(int)qf_ & 255u) << (8 * u); pe |= ((unsigned)(int)__builtin_rintf((t_ - qf_) * 254.0f) & 255u) << (8 * u); }
                    o4[64 * j] = pq; e4[64 * j] = pe; }
                if (lane == 0) ((float*)(ws + WS_SCX))[m0 + q] = (am > 0.f) ? am * (1.0f / 127.0f) : 1.0f; }
            { const int q = lane >> 4, sl = lane & 15; const float sv = (q == 0) ? s4[0] : (q == 1) ? s4[1] : (q == 2) ? s4[2] : s4[3]; RS[(size_t)(m0 + q) * 16 + sl] = (sl == 0) ? sv : 0.f; }
        }
        const float* p = args.in[I_P]; bf16* PB = (bf16*)(ws + WS_PB);
        for (int m = gw; m < M; m += NGW) { const f32x4 v = *((const GAS f32x4*)(p + (size_t)m * PLE) + lane); v2u o; o.x = pk2(v[0], v[1]); o.y = pk2(v[2], v[3]); *((GAS v2u*)(PB + (size_t)m * PLE) + lane) = o; }
        if (bx == 0) { float* par = (float*)(ws + WS_PAR);
            for (int e = tid; e < PAR_N; e += NTHREADS) { float v;
                if (e < PAR_KG) v = args.in[I_QG][e]; else if (e < PAR_CW) v = args.in[I_KG][e - PAR_KG]; else if (e < PAR_CB) v = args.in[I_CW][e - PAR_CW];
                else if (e < PAR_IB) v = args.in[I_CB][e - PAR_CB]; else if (e < PAR_FB) v = args.in[I_IB][e - PAR_IB]; else v = args.in[I_FB][e - PAR_FB];
                par[e] = v; } }
        float* rope = (float*)(ws + WS_ROPE);
        for (int e = vcu * NTHREADS + tid; e < SEQ * 16; e += G * NTHREADS) { const int t = e >> 4, i = e & 15;
            const float invf = c_invfreq[i];
            const float ang = (float)t * invf; const double rev = (double)ang * 0.15915494309189535; const float fr = (float)(rev - __builtin_floor(rev));
            rope[e * 2] = __builtin_amdgcn_cosf(fr); rope[e * 2 + 1] = __builtin_amdgcn_sinf(fr); }
    }
    using namespace pg8;
    if (IN(0)) { GRID_BAR();
        const int lane = LANE_ID(); const bf16* WT = (const bf16*)(ws + WS_WIN); unsigned char* W8 = ws + WS_W8; float* SCWw = (float*)(ws + WS_SCW);
        const bf16* W1T = (const bf16*)(ws + WS_W1IN); unsigned char* W18 = ws + WS_W1IN8; float* SC1w = (float*)(ws + WS_SC1);
        const bf16* W2T = (const bf16*)(ws + WS_W2IN); unsigned char* W28 = ws + WS_W2IN8; float* SC2w = (float*)(ws + WS_SC2);
        for (int n = gw; n < 7168 + 2 * 5632; n += NGW) {
            const bf16* sp_; unsigned char* dp_; float* cp_;
            if (n < 7168) { int srow = (n < 4608) ? n : (n < 6656) ? n + (WIN_G - 4608) : n + (WIN_ML + 1536 - 6656);
                if (n < 4608 && ((n % 1536) >> 9) < 2) { const int cp = n & 127, L = cp >> 3, s_ = cp & 7; srow = n - cp + ((s_ == 0) ? L : (s_ == 1) ? 16 + L : 32 + 6 * L + (s_ - 2)); }
                sp_ = WT + (size_t)srow * D; dp_ = W8 + (size_t)n * D; cp_ = SCWw + n; }
            else if (n < 7168 + 5632) { const int r_ = n - 7168; sp_ = W1T + (size_t)r_ * D; dp_ = W18 + (size_t)r_ * D; cp_ = SC1w + r_; }
            else { const int r_ = n - 7168 - 5632; sp_ = W2T + (size_t)r_ * D; dp_ = W28 + (size_t)r_ * D; cp_ = SC2w + r_; }
            const bf16* const src[1] = {sp_}; unsigned char* const dst[1] = {dp_}; float* const sc[1] = {cp_};
            quant_rows_i8<1>(src, dst, sc, lane); } }
    SEAM(0);
    if (IN(1)) REP(1) { Gemm g{(const bf16*)args.out, (const bf16*)(ws + WS_W1IN8), M, 2 * FF, D / 2, (const float*)(ws + WS_SC1), (const float*)(ws + WS_SCX)}; StaticOrder S; S.init(M, 2 * FF, G, bx);
        EpiSwiglu E{(bf16*)(ws + WS_HID), FF, RS}; gemm_phase<EpiSwiglu, StaticOrder, true, true, false, true>(lds, g, S, E, wave); }
    SEAM(1);
    if (IN(2)) REP(2) { Gemm g{(const bf16*)(ws + WS_HID), (const bf16*)(ws + WS_W1OUT), M, D, FF}; StaticOrder S; S.init(M, D, G, bx);
        EpiResidX E{(const unsigned char*)args.out, (const unsigned char*)args.out + (size_t)64 * MiB, (const float*)(ws + WS_SCX), HB, RS, 0.5f}; gemm_phase<EpiResidX, StaticOrder, true, true>(lds, g, S, E, wave); }
    SEAM(2);
    unsigned char* H8 = (unsigned char*)args.out; float* SCH = (float*)((unsigned char*)args.out + (size_t)32 * MiB);
    const float* SCW = (const float*)(ws + WS_SCW); const bf16* W8b = (const bf16*)(ws + WS_W8); const bf16* H8b = (const bf16*)H8;
    if (IN(3)) { { const int lane = LANE_ID();
            v4u wg[8][2];
#pragma unroll
            for (int j = 0; j < 8; ++j) { const bf16* wr_ = (const bf16*)(ws + WS_WIN) + (size_t)(WIN_GT + j) * D + lane * 16; wg[j][0] = *(const v4u*)wr_; wg[j][1] = *(const v4u*)(wr_ + 8); }
            QRows cur, nx; int m0 = gw * 4; qrows_load<true>(cur, HB + (size_t)m0 * D, RS + (size_t)m0 * 16, lane);
            for (; m0 < M; m0 += NGW * 4) { const int m1 = m0 + NGW * 4; nx = cur; if (m1 < M) qrows_load<true>(nx, HB + (size_t)m1 * D, RS + (size_t)m1 * 16, lane);
                quant_rows_gates4<true>(cur, H8 + (size_t)m0 * D, SCH + m0, (float*)(ws + WS_GATES) + (size_t)m0 * 8, wg, lane); cur = nx; } }
        REP(3) { Gemm g{HB, (const bf16*)(ws + WS_WIN) + (size_t)WIN_ML * D, M, 1536, D}; StaticOrder S; S.init(M, 1536, G, bx);
        EpiZ E{(bf16*)(ws + WS_ML), 2048, RS, -1, nullptr}; gemm_phase<EpiZ, StaticOrder, true, true>(lds, g, S, E, wave); } }
    SEAM(3);
    const bf16* QKV0 = (const bf16*)(ws + WS_QKV); const bf16* QKV1 = (const bf16*)(ws + WS_QKV1); bf16* GB = (bf16*)(ws + WS_G);
#define QKV_GEMM8(grp, dstp) do { Gemm g{H8b, W8b + (size_t)(grp) * 1536 * (D / 2), M, 1536, D / 2, SCW + (grp) * 1536, SCH}; StaticOrder S; S.init(M, 1536, G, bx); \
        EpiQKV E{(bf16*)(dstp), RS, (const float*)(ws + WS_PAR) + PAR_QG, (const float*)(ws + WS_PAR) + PAR_KG, (const float*)(ws + WS_ROPE), (PG8_LAS float*)(lds + QKP_OFF)}; \
        gemm_phase<EpiQKV, StaticOrder, true, true, false, true>(lds, g, S, E, wave); } while (0)
    if (IN(4)) { REP(5) QKV_GEMM8(0, ws + WS_QKV);
        { Gemm g{H8b, W8b + (size_t)6656 * (D / 2), M, 512, D / 2, SCW + 6656, SCH}; StaticOrder S; S.init(M, 512, G, bx);
        EpiSig8 E{(unsigned char*)args.out + (size_t)40 * MiB, RS}; gemm_phase<EpiSig8, StaticOrder, true, true, false, true>(lds, g, S, E, wave); }
        REP(24) mlstm_b1(ws, lds, wave, vcu, G); GRID_BAR(); mlstm_b2(ws, wave, vcu, G); GRID_BAR(); REP(25) mlstm_b3(ws, (const unsigned char*)args.out + (size_t)40 * MiB, lds, wave, vcu, G); }
    SEAM(4);
    if (IN(5)) { attn_fast(ws, QKV0, lds, 0, wave, vcu, G); REP(6) { if (rep_) attn_fast(ws, QKV0, lds, 0, wave, vcu, G); }
        REP(5) QKV_GEMM8(1, ws + WS_QKV1); }
    SEAM(5);
    if (IN(6)) { attn_fast(ws, QKV1, lds, 1, wave, vcu, G);
        REP(5) QKV_GEMM8(2, ws + WS_QKV); }
    SEAM(6);
    if (IN(7)) { attn_fast(ws, QKV0, lds, 2, wave, vcu, G);
        REP(11) { Gemm g{H8b, W8b + (size_t)4608 * (D / 2), M, 2048, D / 2, SCW + 4608, SCH}; StaticOrder S; S.init(M, 2048, G, bx);
        EpiGF E{(unsigned char*)GB, (unsigned char*)GB + (size_t)M * 1024, RS}; gemm_phase<EpiGF, StaticOrder, true, true, false, true>(lds, g, S, E, wave); } }
    SEAM(7);
#undef QKV_GEMM8
    if (IN(8)) REP(12) { Gemm g{(const bf16*)(ws + WS_A), (const bf16*)(ws + WS_WUPA), M, D, 512, nullptr, nullptr, (const bf16*)(ws + WS_BM), (const bf16*)(ws + WS_WUPB)}; PairOrder S; S.init(M, D, G, bx);
        EpiGate2 E{(const unsigned char*)GB, (const unsigned char*)GB + (size_t)M * 1024, (bf16*)(ws + WS_MERGED)}; gemm_phase<EpiGate2, PairOrder, true, true>(lds, g, S, E, wave); }
    SEAM(8);
    if (IN(9)) { Gemm g{(const bf16*)(ws + WS_MERGED), (const bf16*)(ws + WS_WO), M, D, D}; StaticOrder S; S.init(M, D, G, bx);
        EpiResidQ E{HB, RS, 1.0f, (unsigned*)(ws + WS_ROWMAX), (unsigned*)(ws + WS_PCNT), H8, SCH}; gemm_phase<EpiResidQ, StaticOrder, true, true>(lds, g, S, E, wave); }
    SEAM(9);
    if (IN(10)) {
        REP(15) { Gemm g{H8b, (const bf16*)(ws + WS_W2IN8), M, 2 * FF, D / 2, (const float*)(ws + WS_SC2), SCH}; StaticOrder S; S.init(M, 2 * FF, G, bx);
        EpiSwiglu E{(bf16*)(ws + WS_HID), FF, RS}; gemm_phase<EpiSwiglu, StaticOrder, true, true, false, true>(lds, g, S, E, wave); } }
    SEAM(10);
    if (IN(11)) { { Gemm g{(const bf16*)(ws + WS_HID), (const bf16*)(ws + WS_W2OUT), M, D, FF}; StaticOrder S; S.init(M, D, G, bx);
        EpiResid<false> E{nullptr, HB, HB, RS, 0.5f}; gemm_phase<EpiResid<false>, StaticOrder, true, true>(lds, g, S, E, wave); }
        }
    SEAM(11);
    if (IN(12)) { Gemm g{HB, (const bf16*)(ws + WS_WPG), M, D, D, nullptr, nullptr, (const bf16*)(ws + WS_PB), (const bf16*)(ws + WS_WPE), PLE}; PairOrder S; S.init(M, D, G, bx);
        EpiFinal2 E{args.out, HB, RS}; gemm_phase_dk<EpiFinal2>(lds, g, S, E, wave); }
#undef IN
#undef SEAM
}

extern "C" void kernel_launch(void* const* d_in, const int* in_sizes, int n_in, void* d_out, int out_size, void* d_ws, size_t ws_size, hipStream_t stream) {
    static int grid = 0;
    if (grid == 0) {
        if (n_in != 22 || in_sizes[0] != M * D || out_size != M * D || ws_size < WS_END) { fprintf(stderr, "kernel_launch: unexpected shapes (n_in %d, in0 %d, out %d, ws %zu)\n", n_in, n_in > 0 ? in_sizes[0] : -1, out_size, ws_size); grid = -1; return; }
        int dev = 0, cus = 0;
        if (hipGetDevice(&dev) != hipSuccess || hipDeviceGetAttribute(&cus, hipDeviceAttributeMultiprocessorCount, dev) != hipSuccess) { grid = -1; return; }
        if (hipFuncSetAttribute((const void*)mega, hipFuncAttributeMaxDynamicSharedMemorySize, LDS_BYTES) != hipSuccess) { fprintf(stderr, "kernel_launch: hipFuncSetAttribute failed\n"); grid = -1; return; }
        (void)hipGetLastError();
        grid = cus;
    }
    if (grid < 0) return;
    (void)hipMemsetAsync((char*)d_ws + WS_CTL, 0, CTL_ZERO_BYTES, stream);
    Args a{};
    for (int i = 0; i < 22; ++i) a.in[i] = (const float*)d_in[i];
    a.out = (float*)d_out; a.ws = (unsigned char*)d_ws;
#if MK_PER_PHASE
    for (int ph = 0; ph < NPHASE; ++ph) { a.ph_lo = ph; a.ph_hi = ph + 1; hipLaunchKernelGGL(mega, dim3(grid), dim3(NTHREADS), LDS_BYTES, stream, a); }
#else
    a.ph_lo = 0; a.ph_hi = NPHASE; hipLaunchKernelGGL(mega, dim3(grid), dim3(NTHREADS), LDS_BYTES, stream, a);
#endif
}
```

```cpp
#include <hip/hip_runtime.h>
#include <cstdio>
#include <cstdint>

#ifndef PROBE_MASK
#define PROBE_MASK 0u
#endif
#define REP(k) for (int rep_ = 0; rep_ < 1 + (int)((PROBE_MASK >> (k)) & 1u); ++rep_)
#ifndef MK_PER_PHASE
#define MK_PER_PHASE 0
#endif

namespace pg8 {
#define PG8_LAS __attribute__((address_space(3)))
typedef unsigned short bf16_t;
typedef short bf16x8 __attribute__((ext_vector_type(8)));
typedef float f32x4 __attribute__((ext_vector_type(4)));
typedef unsigned u32x4 __attribute__((ext_vector_type(4)));
constexpr int BM = 256, BK = 64, HALF = 128, HTB = HALF * BK * 2, STAGE_BYTES = 8 * HTB, NXCD = 8, WGM = 8;

__host__ __device__ __forceinline__ int lds_byte(int r, int c) { const int st = (r >> 4) * 2 + (c >> 5), rr = r & 15, cc = c & 31, ob = rr * 64 + cc * 2; return st * 1024 + (ob ^ (((ob >> 9) & 1) << 5)); }
__host__ __device__ __forceinline__ void stage_rc(int b, int& R, int& C) { const int st = b / 1024, sb = b % 1024, swz = sb ^ (((sb >> 9) & 1) << 5); R = (st >> 1) * 16 + swz / 64; C = (st & 1) * 32 + (swz % 64) / 2; }
__host__ __device__ __forceinline__ int perm32(int rho) { const int n = rho >> 4, i = rho & 15; return 8 * (i >> 2) + 4 * n + (i & 3); }

struct Unit { int pm, pn, w; };
struct Gemm { const bf16_t* A; const bf16_t* Bt; int M, N, K; const float* scw; const float* sch; const bf16_t* A2; const bf16_t* Bt2; int K2; };
typedef int i32x4 __attribute__((ext_vector_type(4)));

struct StaticOrder {
    static constexpr bool PAIR = false;
    int nM, nN, nwg, G, c;
    __host__ __device__ void init(int M, int N, int G_, int c_) { nM = M / BM; nN = N / BM; nwg = nM * nN; G = G_; c = c_; }
    __host__ __device__ bool next(int i, Unit& u) const {
        const long L = (long)i * G + c; if (L >= nwg) return false;
        int wgid = (int)L; { const int q = nwg / NXCD, r = nwg % NXCD, xcd = wgid % NXCD, off = wgid / NXCD; wgid = (xcd < r ? xcd * (q + 1) : r * (q + 1) + (xcd - r) * q) + off; }
        const int nig = WGM * nN, gid = wgid / nig, fm = gid * WGM, gsz = (nM - fm) < WGM ? (nM - fm) : WGM;
        u.pm = fm + ((wgid % nig) % gsz); u.pn = (wgid % nig) / gsz; u.w = 0; return true;
    }
};
struct PairOrder {
    static constexpr bool PAIR = true;
    StaticOrder base;
    __host__ __device__ void init(int M, int N, int G_, int c_) { base.init(M, N, G_, c_); }
    __host__ __device__ bool next(int i, Unit& u) const { const bool ok = base.next(i >> 1, u); u.w = i & 1; return ok; }
};

__device__ __forceinline__ unsigned cvt_pk_bf16(float lo, float hi) { unsigned r; asm volatile("v_cvt_pk_bf16_f32 %0, %1, %2" : "=v"(r) : "v"(lo), "v"(hi)); return r; }
__device__ __forceinline__ float bf_lo(unsigned u) { return __uint_as_float(u << 16); }
__device__ __forceinline__ float bf_hi(unsigned u) { return __uint_as_float(u & 0xffff0000u); }

constexpr float RMS_EPS = 1e-6f;
constexpr int RTAB_OFF = 152576;
__device__ __forceinline__ float sigmoidf_(float v) { return __builtin_amdgcn_rcpf(1.0f + __builtin_amdgcn_exp2f(-1.4426950408889634f * v)); }
__device__ __forceinline__ void swap16_(float& a, float& b) { asm volatile("s_nop 1\n\tv_permlane16_swap_b32 %0, %1" : "+v"(a), "+v"(b)); }
__device__ __forceinline__ void swap32_(float& a, float& b) { asm volatile("s_nop 1\n\tv_permlane32_swap_b32 %0, %1" : "+v"(a), "+v"(b)); }
__device__ __forceinline__ float xsum_16_32(float x) { float a = x, b = x; swap16_(a, b); x = a + b; a = x; b = x; swap32_(a, b); return a + b; }
__device__ __forceinline__ float xmax_16_32(float x) { float a = x, b = x; swap16_(a, b); x = fmaxf(a, b); a = x; b = x; swap32_(a, b); return fmaxf(a, b); }
__device__ __forceinline__ float xor32_(float x, bool hi) { float a = x, b = x; swap32_(a, b); return hi ? a : b; }
template <int MINQ> __device__ __forceinline__ unsigned sig8_pack(const f32x4 t) {
    f32x4 e; e[0] = __builtin_amdgcn_exp2f(t[0]); e[1] = __builtin_amdgcn_exp2f(t[1]); e[2] = __builtin_amdgcn_exp2f(t[2]); e[3] = __builtin_amdgcn_exp2f(t[3]);
    const f32x4 d = e + 1.0f; f32x4 sg; sg[0] = __builtin_amdgcn_rcpf(d[0]); sg[1] = __builtin_amdgcn_rcpf(d[1]); sg[2] = __builtin_amdgcn_rcpf(d[2]); sg[3] = __builtin_amdgcn_rcpf(d[3]);
    f32x4 q = sg * 255.0f + 0.5f;
    if (MINQ > 0) { q[0] = fmaxf(q[0], (float)MINQ); q[1] = fmaxf(q[1], (float)MINQ); q[2] = fmaxf(q[2], (float)MINQ); q[3] = fmaxf(q[3], (float)MINQ); }
    return (unsigned)q[0] | ((unsigned)q[1] << 8) | ((unsigned)q[2] << 16) | ((unsigned)q[3] << 24);
}
struct EpiSwiglu {
    static constexpr bool PERM = true, AFTER_DRAIN = false, NEED_R = true;
    bf16_t* O; int ldc; const float* RS;
    __device__ __forceinline__ void operator()(f32x4 (&acc)[2][2][4][2], const Unit& u, int wr, int wc, int fr, int fq, const PG8_LAS float* rtab) const {
        const int row0 = u.pm * BM + wr * 64 + fr, col0 = u.pn * HALF + wc * 32 + 8 * fq;
#pragma unroll
        for (int ai = 0; ai < 2; ++ai)
#pragma unroll
            for (int m = 0; m < 4; ++m) { const int row = row0 + ai * HALF + m * 16; const float r = rtab[ai * HALF + wr * 64 + m * 16 + fr];
                const float rl = r * -1.4426950408889634f, r2 = r * r; f32x4 hv[2];
#pragma unroll
                for (int n = 0; n < 2; ++n) { const f32x4 a = acc[ai][0][m][n], b = acc[ai][1][m][n]; const f32x4 t = a * rl; f32x4 e;
                    e[0] = __builtin_amdgcn_exp2f(t[0]); e[1] = __builtin_amdgcn_exp2f(t[1]); e[2] = __builtin_amdgcn_exp2f(t[2]); e[3] = __builtin_amdgcn_exp2f(t[3]);
                    const f32x4 d = e + 1.0f; f32x4 q;
                    q[0] = __builtin_amdgcn_rcpf(d[0]); q[1] = __builtin_amdgcn_rcpf(d[1]); q[2] = __builtin_amdgcn_rcpf(d[2]); q[3] = __builtin_amdgcn_rcpf(d[3]);
                    hv[n] = (a * b) * (q * r2); }
                u32x4 w; w.x = cvt_pk_bf16(hv[0][0], hv[0][1]); w.y = cvt_pk_bf16(hv[0][2], hv[0][3]); w.z = cvt_pk_bf16(hv[1][0], hv[1][1]); w.w = cvt_pk_bf16(hv[1][2], hv[1][3]);
                *(u32x4*)(O + (size_t)row * ldc + col0) = w; }
    }
};
template <bool BASE_F32> struct EpiResid {
    static constexpr bool PERM = true, AFTER_DRAIN = false, NEED_R = false;
    const float* basef; const bf16_t* baseh; bf16_t* HBo; float* RSo; float alpha;
    __device__ __forceinline__ void operator()(f32x4 (&acc)[2][2][4][2], const Unit& u, int wr, int wc, int fr, int fq, const PG8_LAS float*) const {
        const int row0 = u.pm * BM + wr * 64 + fr, col0 = u.pn * BM + wc * 32 + 8 * fq;
#pragma unroll
        for (int ai = 0; ai < 2; ++ai) {
            f32x4 bv[4][2][2];
#pragma unroll
            for (int m = 0; m < 4; ++m)
#pragma unroll
                for (int bj = 0; bj < 2; ++bj) { const size_t off = (size_t)(row0 + ai * HALF + m * 16) * 1024 + col0 + bj * HALF;
                    if constexpr (BASE_F32) { bv[m][bj][0] = *(const f32x4*)(basef + off); bv[m][bj][1] = *(const f32x4*)(basef + off + 4); }
                    else { const u32x4 p = *(const u32x4*)(baseh + off); bv[m][bj][0] = (f32x4){bf_lo(p.x), bf_hi(p.x), bf_lo(p.y), bf_hi(p.y)}; bv[m][bj][1] = (f32x4){bf_lo(p.z), bf_hi(p.z), bf_lo(p.w), bf_hi(p.w)}; } }
            asm volatile("" ::: "memory");
#pragma unroll
            for (int m = 0; m < 4; ++m) { const int row = row0 + ai * HALF + m * 16; float ssq = 0.f;
#pragma unroll
                for (int bj = 0; bj < 2; ++bj) { const size_t off = (size_t)row * 1024 + col0 + bj * HALF;
                    const f32x4 v0 = bv[m][bj][0] + acc[ai][bj][m][0] * alpha, v1 = bv[m][bj][1] + acc[ai][bj][m][1] * alpha;
                    u32x4 w; w.x = cvt_pk_bf16(v0[0], v0[1]); w.y = cvt_pk_bf16(v0[2], v0[3]); w.z = cvt_pk_bf16(v1[0], v1[1]); w.w = cvt_pk_bf16(v1[2], v1[3]);
                    *(u32x4*)(HBo + off) = w;
                    ssq += (v0[0] * v0[0] + v0[1] * v0[1]) + (v0[2] * v0[2] + v0[3] * v0[3]) + (v1[0] * v1[0] + v1[1] * v1[1]) + (v1[2] * v1[2] + v1[3] * v1[3]); }
                ssq = xsum_16_32(ssq);
                if (fq == 0) RSo[(size_t)row * 16 + u.pn * 4 + wc] = ssq; }
            asm volatile("" ::: "memory"); }
    }
};
struct EpiZ {
    static constexpr bool PERM = true, AFTER_DRAIN = false, NEED_R = true;
    bf16_t* O; int ldc; const float* RS; int gate_pn; float* GATES;
    __device__ __forceinline__ void operator()(f32x4 (&acc)[2][2][4][2], const Unit& u, int wr, int wc, int fr, int fq, const PG8_LAS float* rtab) const {
        const int row0 = u.pm * BM + wr * 64 + fr, col0 = u.pn * BM + wc * 32 + 8 * fq;
        const bool gate = (u.pn == gate_pn);
#pragma unroll
        for (int ai = 0; ai < 2; ++ai)
#pragma unroll
            for (int m = 0; m < 4; ++m) { const int row = row0 + ai * HALF + m * 16; const float r = rtab[ai * HALF + wr * 64 + m * 16 + fr];
                if (gate) { if (wc == 0 && fq == 0) { *(f32x4*)(GATES + (size_t)row * 8) = acc[ai][0][m][0] * r; *(f32x4*)(GATES + (size_t)row * 8 + 4) = acc[ai][0][m][1] * r; } }
                else {
#pragma unroll
                    for (int bj = 0; bj < 2; ++bj) { const f32x4 v0 = acc[ai][bj][m][0] * r, v1 = acc[ai][bj][m][1] * r;
                        u32x4 w; w.x = cvt_pk_bf16(v0[0], v0[1]); w.y = cvt_pk_bf16(v0[2], v0[3]); w.z = cvt_pk_bf16(v1[0], v1[1]); w.w = cvt_pk_bf16(v1[2], v1[3]);
                        *(u32x4*)(O + (size_t)row * ldc + col0 + bj * HALF) = w; } } }
    }
};
constexpr int QKP_OFF = 131072;
struct EpiQKV {
    static constexpr bool PERM = true, AFTER_DRAIN = false, NEED_R = true;
    bf16_t* O; const float* RS; const float* par_qg; const float* par_kg; const float* rope; PG8_LAS float* part;
    __device__ __forceinline__ void operator()(f32x4 (&acc)[2][2][4][2], const Unit& u, int wr, int wc, int fr_, int fq_, const PG8_LAS float* rtab) const {
        int lane_; asm volatile("v_mbcnt_lo_u32_b32 %0, -1, 0\n\tv_mbcnt_hi_u32_b32 %0, -1, %0" : "=v"(lane_));
        const int fr = lane_ & 15, fq = lane_ >> 4; (void)fr_; (void)fq_;
        const int row0 = u.pm * BM + wr * 64 + fr, col0 = u.pn * BM + wc * 32 + 8 * fq;
        const bool isq = u.pn < 2, isqk = u.pn < 4;
#pragma unroll
        for (int ai = 0; ai < 2; ++ai)
#pragma unroll
            for (int m = 0; m < 4; ++m) { const int rl = ai * HALF + wr * 64 + m * 16 + fr; const float r = rtab[rl];
#pragma unroll
                for (int bj = 0; bj < 2; ++bj) { acc[ai][bj][m][0] *= r; acc[ai][bj][m][1] *= r;
                    if (isqk) { const f32x4 a = acc[ai][bj][m][0], b = acc[ai][bj][m][1];
                        float ssq = (a[0] * a[0] + a[1] * a[1]) + (a[2] * a[2] + a[3] * a[3]) + (b[0] * b[0] + b[1] * b[1]) + (b[2] * b[2] + b[3] * b[3]);
                        ssq = xsum_16_32(ssq);
                        if (fq == 0) part[(rl * 2 + bj) * 4 + wc] = ssq; } } }
        if (isqk) {
            asm volatile("s_waitcnt lgkmcnt(0)" ::: "memory"); __builtin_amdgcn_s_barrier(); asm volatile("" ::: "memory");
            const float* G_ = isq ? par_qg : par_kg; const int L = 4 * wc + fq;
            const f32x4 g0 = (f32x4){G_[L], G_[16 + L], G_[32 + 6 * L], G_[33 + 6 * L]}, g1 = (f32x4){G_[34 + 6 * L], G_[35 + 6 * L], G_[36 + 6 * L], G_[37 + 6 * L]};
            const float qs = isq ? (0.08838834764831845f * 1.4426950408889634f) : 1.0f;
#pragma unroll
            for (int am = 0; am < 4; ++am) {
                float cs[2][2];
#pragma unroll
                for (int mm = 0; mm < 2; ++mm) { const int ai = am >> 1, m = (am & 1) * 2 + mm; const int pos = (row0 + ai * HALF + m * 16) & (8192 - 1); const float* rp = rope + (size_t)pos * 32 + 2 * L; cs[mm][0] = rp[0]; cs[mm][1] = rp[1]; }
                asm volatile("" ::: "memory");
#pragma unroll
                for (int mm = 0; mm < 2; ++mm) { const int ai = am >> 1, m = (am & 1) * 2 + mm; const int rl = ai * HALF + wr * 64 + m * 16 + fr;
#pragma unroll
                    for (int bj = 0; bj < 2; ++bj) { const f32x4 p4 = *(const PG8_LAS f32x4*)(part + (rl * 2 + bj) * 4);
                        const float rn = __builtin_amdgcn_rsqf(((p4[0] + p4[1]) + (p4[2] + p4[3])) * (1.0f / 128.0f) + RMS_EPS) * qs;
                        f32x4 a = acc[ai][bj][m][0] * g0 * rn, b = acc[ai][bj][m][1] * g1 * rn;
                        { const float x1 = a[0], x2 = a[1], c_ = cs[mm][0], s_ = cs[mm][1]; a[0] = x1 * c_ - x2 * s_; a[1] = x2 * c_ + x1 * s_; }
                        unsigned char* op_ = (unsigned char*)O + (size_t)(row0 + ai * HALF + m * 16) * 1536;
                        { typedef unsigned u32x2 __attribute__((ext_vector_type(2))); int w0 = 0, w1 = 0;
                            w0 = __builtin_amdgcn_cvt_pk_fp8_f32(a[0], a[1], w0, false); w0 = __builtin_amdgcn_cvt_pk_fp8_f32(a[2], a[3], w0, true);
                            w1 = __builtin_amdgcn_cvt_pk_fp8_f32(b[0], b[1], w1, false); w1 = __builtin_amdgcn_cvt_pk_fp8_f32(b[2], b[3], w1, true);
                            *(u32x2*)(op_ + col0 + bj * HALF) = (u32x2){(unsigned)w0, (unsigned)w1}; } } }
                asm volatile("" ::: "memory"); }
            return;
        }
#pragma unroll
        for (int ai = 0; ai < 2; ++ai)
#pragma unroll
            for (int m = 0; m < 4; ++m) { const int row = row0 + ai * HALF + m * 16;
#pragma unroll
                for (int bj = 0; bj < 2; ++bj) { const f32x4 v0 = acc[ai][bj][m][0], v1 = acc[ai][bj][m][1];
                    typedef unsigned u32x2 __attribute__((ext_vector_type(2))); int w0 = 0, w1 = 0;
                    w0 = __builtin_amdgcn_cvt_pk_fp8_f32(v0[0], v0[1], w0, false); w0 = __builtin_amdgcn_cvt_pk_fp8_f32(v0[2], v0[3], w0, true);
                    w1 = __builtin_amdgcn_cvt_pk_fp8_f32(v1[0], v1[1], w1, false); w1 = __builtin_amdgcn_cvt_pk_fp8_f32(v1[2], v1[3], w1, true);
                    *(u32x2*)((unsigned char*)O + (size_t)row * 1536 + col0 + bj * HALF) = (u32x2){(unsigned)w0, (unsigned)w1}; } }
    }
};
struct EpiGate {
    static constexpr bool PERM = true, AFTER_DRAIN = false, NEED_R = false;
    const bf16_t* G; int ldg; const bf16_t* prev; bf16_t* O;
    __device__ __forceinline__ void operator()(f32x4 (&acc)[2][2][4][2], const Unit& u, int wr, int wc, int fr, int fq, const PG8_LAS float*) const {
        const int row0 = u.pm * BM + wr * 64 + fr, col0 = u.pn * BM + wc * 32 + 8 * fq;
#pragma unroll
        for (int ai = 0; ai < 2; ++ai) {
            u32x4 gv[4][2], pv[4][2];
#pragma unroll
            for (int m = 0; m < 4; ++m)
#pragma unroll
                for (int bj = 0; bj < 2; ++bj) { const int row = row0 + ai * HALF + m * 16, col = col0 + bj * HALF;
                    gv[m][bj] = *(const u32x4*)(G + (size_t)row * ldg + col); pv[m][bj] = prev ? *(const u32x4*)(prev + (size_t)row * 1024 + col) : (u32x4){0u, 0u, 0u, 0u}; }
            asm volatile("" ::: "memory");
#pragma unroll
            for (int m = 0; m < 4; ++m)
#pragma unroll
                for (int bj = 0; bj < 2; ++bj) { const int row = row0 + ai * HALF + m * 16, col = col0 + bj * HALF; const u32x4 g = gv[m][bj], p = pv[m][bj];
                    float v[8];
                    v[0] = bf_lo(p.x) + sigmoidf_(bf_lo(g.x)) * acc[ai][bj][m][0][0]; v[1] = bf_hi(p.x) + sigmoidf_(bf_hi(g.x)) * acc[ai][bj][m][0][1];
                    v[2] = bf_lo(p.y) + sigmoidf_(bf_lo(g.y)) * acc[ai][bj][m][0][2]; v[3] = bf_hi(p.y) + sigmoidf_(bf_hi(g.y)) * acc[ai][bj][m][0][3];
                    v[4] = bf_lo(p.z) + sigmoidf_(bf_lo(g.z)) * acc[ai][bj][m][1][0]; v[5] = bf_hi(p.z) + sigmoidf_(bf_hi(g.z)) * acc[ai][bj][m][1][1];
                    v[6] = bf_lo(p.w) + sigmoidf_(bf_lo(g.w)) * acc[ai][bj][m][1][2]; v[7] = bf_hi(p.w) + sigmoidf_(bf_hi(g.w)) * acc[ai][bj][m][1][3];
                    u32x4 w; w.x = cvt_pk_bf16(v[0], v[1]); w.y = cvt_pk_bf16(v[2], v[3]); w.z = cvt_pk_bf16(v[4], v[5]); w.w = cvt_pk_bf16(v[6], v[7]);
                    *(u32x4*)(O + (size_t)row * 1024 + col) = w; }
            asm volatile("" ::: "memory"); }
    }
};
struct EpiGF {
    static constexpr bool PERM = true, AFTER_DRAIN = false, NEED_R = true;
    unsigned char* QA; unsigned char* QB; const float* RS;
    __device__ __forceinline__ void operator()(f32x4 (&acc)[2][2][4][2], const Unit& u, int wr, int wc, int fr, int fq, const PG8_LAS float* rtab) const {
        const int row0 = u.pm * BM + wr * 64 + fr, col0 = u.pn * HALF + wc * 32 + 8 * fq;
#pragma unroll
        for (int ai = 0; ai < 2; ++ai)
#pragma unroll
            for (int m = 0; m < 4; ++m) { const int row = row0 + ai * HALF + m * 16; const float rl = rtab[ai * HALF + wr * 64 + m * 16 + fr] * -1.4426950408889634f;
                unsigned qa[2], qb[2];
#pragma unroll
                for (int n = 0; n < 2; ++n) { qa[n] = sig8_pack<0>(acc[ai][0][m][n] * rl); qb[n] = sig8_pack<1>(acc[ai][1][m][n] * rl); }
                typedef unsigned u32x2 __attribute__((ext_vector_type(2)));
                *(u32x2*)(QA + (size_t)row * 1024 + col0) = (u32x2){qa[0], qa[1]}; *(u32x2*)(QB + (size_t)row * 1024 + col0) = (u32x2){qb[0], qb[1]}; }
    }
};
struct EpiGate2 {
    static constexpr bool PERM = true, AFTER_DRAIN = false, NEED_R = false;
    const unsigned char* QA; const unsigned char* QB; bf16_t* O;
    __device__ __forceinline__ static f32x4 ub4(unsigned w) { return (f32x4){(float)(w & 255u), (float)((w >> 8) & 255u), (float)((w >> 16) & 255u), (float)(w >> 24)}; }
    __device__ __forceinline__ void operator()(f32x4 (&acc)[2][2][4][2], const Unit& u, int wr, int wc, int fr, int fq, const PG8_LAS float*) const {
        typedef unsigned u32x2 __attribute__((ext_vector_type(2)));
        const int row0 = u.pm * BM + wr * 64 + fr, col0 = u.pn * BM + wc * 32 + 8 * fq;
        if (u.w == 0) {
#pragma unroll
            for (int ai = 0; ai < 2; ++ai) {
                u32x2 av[4][2], bv[4][2];
#pragma unroll
                for (int m = 0; m < 4; ++m)
#pragma unroll
                    for (int bj = 0; bj < 2; ++bj) { const size_t off = (size_t)(row0 + ai * HALF + m * 16) * 1024 + col0 + bj * HALF; bv[m][bj] = *(const u32x2*)(QB + off); av[m][bj] = *(const u32x2*)(QA + off); }
                asm volatile("" ::: "memory");
#pragma unroll
                for (int m = 0; m < 4; ++m)
#pragma unroll
                    for (int bj = 0; bj < 2; ++bj)
#pragma unroll
                        for (int n = 0; n < 2; ++n) { const f32x4 fb = ub4(bv[m][bj][n]); f32x4 rb; rb[0] = __builtin_amdgcn_rcpf(fb[0]); rb[1] = __builtin_amdgcn_rcpf(fb[1]); rb[2] = __builtin_amdgcn_rcpf(fb[2]); rb[3] = __builtin_amdgcn_rcpf(fb[3]);
                            acc[ai][bj][m][n] *= ub4(av[m][bj][n]) * rb; }
                asm volatile("" ::: "memory"); }
        } else {
#pragma unroll
            for (int ai = 0; ai < 2; ++ai) {
                u32x2 bv[4][2];
#pragma unroll
                for (int m = 0; m < 4; ++m)
#pragma unroll
                    for (int bj = 0; bj < 2; ++bj) bv[m][bj] = *(const u32x2*)(QB + (size_t)(row0 + ai * HALF + m * 16) * 1024 + col0 + bj * HALF);
                asm volatile("" ::: "memory");
#pragma unroll
                for (int m = 0; m < 4; ++m)
#pragma unroll
                    for (int bj = 0; bj < 2; ++bj) { const f32x4 v0 = acc[ai][bj][m][0] * (ub4(bv[m][bj][0]) * (1.0f / 255.0f)), v1 = acc[ai][bj][m][1] * (ub4(bv[m][bj][1]) * (1.0f / 255.0f));
                        u32x4 w; w.x = cvt_pk_bf16(v0[0], v0[1]); w.y = cvt_pk_bf16(v0[2], v0[3]); w.z = cvt_pk_bf16(v1[0], v1[1]); w.w = cvt_pk_bf16(v1[2], v1[3]);
                        *(u32x4*)(O + (size_t)(row0 + ai * HALF + m * 16) * 1024 + col0 + bj * HALF) = w; }
                asm volatile("" ::: "memory"); }
        }
    }
};
struct EpiResidQ {
    static constexpr bool PERM = true, AFTER_DRAIN = false, NEED_R = false;
    bf16_t* HBio; float* RSo; float alpha; unsigned* ROWMAX; unsigned* CNT; unsigned char* Q8; float* SCq;
    __device__ __forceinline__ void operator()(f32x4 (&acc)[2][2][4][2], const Unit& u, int wr, int wc, int fr, int fq, const PG8_LAS float*) const {
        const int row0 = u.pm * BM + wr * 64 + fr, col0 = u.pn * BM + wc * 32 + 8 * fq;
#pragma unroll
        for (int ai = 0; ai < 2; ++ai) {
            u32x4 bv[4][2];
#pragma unroll
            for (int m = 0; m < 4; ++m)
#pragma unroll
                for (int bj = 0; bj < 2; ++bj) bv[m][bj] = *(const u32x4*)(HBio + (size_t)(row0 + ai * HALF + m * 16) * 1024 + col0 + bj * HALF);
            asm volatile("" ::: "memory");
#pragma unroll
            for (int m = 0; m < 4; ++m) { const int row = row0 + ai * HALF + m * 16; float ssq = 0.f, am = 0.f;
#pragma unroll
                for (int bj = 0; bj < 2; ++bj) { const size_t off = (size_t)row * 1024 + col0 + bj * HALF; const u32x4 p = bv[m][bj];
                    const f32x4 v0 = (f32x4){bf_lo(p.x), bf_hi(p.x), bf_lo(p.y), bf_hi(p.y)} + acc[ai][bj][m][0] * alpha, v1 = (f32x4){bf_lo(p.z), bf_hi(p.z), bf_lo(p.w), bf_hi(p.w)} + acc[ai][bj][m][1] * alpha;
                    acc[ai][bj][m][0] = v0; acc[ai][bj][m][1] = v1;
                    u32x4 w; w.x = cvt_pk_bf16(v0[0], v0[1]); w.y = cvt_pk_bf16(v0[2], v0[3]); w.z = cvt_pk_bf16(v1[0], v1[1]); w.w = cvt_pk_bf16(v1[2], v1[3]);
                    *(u32x4*)(HBio + off) = w;
                    ssq += (v0[0] * v0[0] + v0[1] * v0[1]) + (v0[2] * v0[2] + v0[3] * v0[3]) + (v1[0] * v1[0] + v1[1] * v1[1]) + (v1[2] * v1[2] + v1[3] * v1[3]);
                    am = fmaxf(am, fmaxf(fmaxf(fmaxf(fabsf(v0[0]), fabsf(v0[1])), fmaxf(fabsf(v0[2]), fabsf(v0[3]))), fmaxf(fmaxf(fabsf(v1[0]), fabsf(v1[1])), fmaxf(fabsf(v1[2]), fabsf(v1[3]))))); }
                ssq = xsum_16_32(ssq);
                am = xmax_16_32(am);
                if (fq == 0) { RSo[(size_t)row * 16 + u.pn * 4 + wc] = ssq; (void)__hip_atomic_fetch_max(ROWMAX + row, __builtin_bit_cast(unsigned, am), __ATOMIC_RELAXED, __HIP_MEMORY_SCOPE_AGENT); } }
            asm volatile("" ::: "memory"); }
        asm volatile("s_waitcnt vmcnt(0)" ::: "memory"); __builtin_amdgcn_s_barrier();
        if (wr == 0 && wc == 0 && fr == 0 && fq == 0) {
            (void)__hip_atomic_fetch_add(CNT + u.pm, 1u, __ATOMIC_RELAXED, __HIP_MEMORY_SCOPE_AGENT);
            unsigned sp = 0u; while (__hip_atomic_load(CNT + u.pm, __ATOMIC_RELAXED, __HIP_MEMORY_SCOPE_AGENT) < 4u) { __builtin_amdgcn_s_sleep(1); if (++sp > (1u << 22)) break; } }
        asm volatile("s_waitcnt vmcnt(0)" ::: "memory"); __builtin_amdgcn_s_barrier(); asm volatile("" ::: "memory");
        typedef unsigned u32x2 __attribute__((ext_vector_type(2)));
#pragma unroll
        for (int ai = 0; ai < 2; ++ai)
#pragma unroll
            for (int m = 0; m < 4; ++m) { const int row = row0 + ai * HALF + m * 16;
                const float amx = __builtin_bit_cast(float, __hip_atomic_load(ROWMAX + row, __ATOMIC_RELAXED, __HIP_MEMORY_SCOPE_AGENT)); const float inv = (amx > 0.f) ? 127.0f / amx : 0.f;
#pragma unroll
                for (int bj = 0; bj < 2; ++bj) { unsigned q[2];
#pragma unroll
                    for (int n = 0; n < 2; ++n) { unsigned pq = 0u;
#pragma unroll
                        for (int j = 0; j < 4; ++j) pq |= ((unsigned)(int)__builtin_rintf(acc[ai][bj][m][n][j] * inv) & 255u) << (8 * j);
                        q[n] = pq; }
                    *(u32x2*)(Q8 + (size_t)row * 1024 + col0 + bj * HALF) = (u32x2){q[0], q[1]}; }
                if (u.pn == 0 && wc == 0 && fq == 0) SCq[row] = (amx > 0.f) ? amx * (1.0f / 127.0f) : 1.0f; }
    }
};
struct EpiSig8 {
    static constexpr bool PERM = true, AFTER_DRAIN = false, NEED_R = true;
    unsigned char* O8; const float* RS;
    __device__ __forceinline__ void operator()(f32x4 (&acc)[2][2][4][2], const Unit& u, int wr, int wc, int fr, int fq, const PG8_LAS float* rtab) const {
        typedef unsigned u32x2 __attribute__((ext_vector_type(2)));
        const int row0 = u.pm * BM + wr * 64 + fr, col0 = u.pn * BM + wc * 32 + 8 * fq;
#pragma unroll
        for (int ai = 0; ai < 2; ++ai)
#pragma unroll
            for (int m = 0; m < 4; ++m) { const int row = row0 + ai * HALF + m * 16; const float rl = rtab[ai * HALF + wr * 64 + m * 16 + fr] * -1.4426950408889634f;
#pragma unroll
                for (int bj = 0; bj < 2; ++bj) { unsigned q[2];
#pragma unroll
                    for (int n = 0; n < 2; ++n) q[n] = sig8_pack<0>(acc[ai][bj][m][n] * rl);
                    *(u32x2*)(O8 + (size_t)row * 512 + col0 + bj * HALF) = (u32x2){q[0], q[1]}; } }
    }
};
struct EpiResidX {
    static constexpr bool PERM = true, AFTER_DRAIN = false, NEED_R = false;
    const unsigned char* Q8; const unsigned char* E8; const float* SC; bf16_t* HBo; float* RSo; float alpha;
    __device__ __forceinline__ void operator()(f32x4 (&acc)[2][2][4][2], const Unit& u, int wr, int wc, int fr, int fq, const PG8_LAS float*) const {
        typedef unsigned u32x2 __attribute__((ext_vector_type(2)));
        const int row0 = u.pm * BM + wr * 64 + fr, col0 = u.pn * BM + wc * 32 + 8 * fq;
#pragma unroll
        for (int ai = 0; ai < 2; ++ai) {
            u32x2 qv[4][2], ev[4][2]; float sv[4];
#pragma unroll
            for (int m = 0; m < 4; ++m) { const int row = row0 + ai * HALF + m * 16; sv[m] = SC[row];
#pragma unroll
                for (int bj = 0; bj < 2; ++bj) { const size_t off = (size_t)row * 1024 + col0 + bj * HALF; qv[m][bj] = *(const u32x2*)(Q8 + off); ev[m][bj] = *(const u32x2*)(E8 + off); } }
            asm volatile("" ::: "memory");
#pragma unroll
            for (int m = 0; m < 4; ++m) { const int row = row0 + ai * HALF + m * 16; float ssq = 0.f; const float s1 = sv[m], s2 = sv[m] * (1.0f / 254.0f);
#pragma unroll
                for (int bj = 0; bj < 2; ++bj) { const size_t off = (size_t)row * 1024 + col0 + bj * HALF; f32x4 v[2];
#pragma unroll
                    for (int n = 0; n < 2; ++n)
#pragma unroll
                        for (int j = 0; j < 4; ++j) { const float qf_ = (float)(int)(signed char)((qv[m][bj][n] >> (8 * j)) & 255u), ef_ = (float)(int)(signed char)((ev[m][bj][n] >> (8 * j)) & 255u);
                            v[n][j] = (qf_ * s1 + ef_ * s2) + acc[ai][bj][m][n][j] * alpha; }
                    u32x4 w; w.x = cvt_pk_bf16(v[0][0], v[0][1]); w.y = cvt_pk_bf16(v[0][2], v[0][3]); w.z = cvt_pk_bf16(v[1][0], v[1][1]); w.w = cvt_pk_bf16(v[1][2], v[1][3]);
                    *(u32x4*)(HBo + off) = w;
                    ssq += (v[0][0] * v[0][0] + v[0][1] * v[0][1]) + (v[0][2] * v[0][2] + v[0][3] * v[0][3]) + (v[1][0] * v[1][0] + v[1][1] * v[1][1]) + (v[1][2] * v[1][2] + v[1][3] * v[1][3]); }
                ssq = xsum_16_32(ssq);
                if (fq == 0) RSo[(size_t)row * 16 + u.pn * 4 + wc] = ssq; }
            asm volatile("" ::: "memory"); }
    }
};
struct EpiNull {
    static constexpr bool PERM = true, AFTER_DRAIN = false, NEED_R = false;
    float* O;
    __device__ __forceinline__ void operator()(f32x4 (&acc)[2][2][4][2], const Unit& u, int wr, int wc, int fr, int fq, const PG8_LAS float*) const {
        float s_ = 0.f;
#pragma unroll
        for (int ai = 0; ai < 2; ++ai)
#pragma unroll
            for (int bj = 0; bj < 2; ++bj)
#pragma unroll
                for (int m = 0; m < 4; ++m)
#pragma unroll
                    for (int n = 0; n < 2; ++n) s_ += (acc[ai][bj][m][n][0] + acc[ai][bj][m][n][1]) + (acc[ai][bj][m][n][2] + acc[ai][bj][m][n][3]);
        if (s_ == 12345.678f) O[u.pm * 7 + u.pn + wr + wc + fr + fq] = s_;
    }
};
struct EpiPlain {
    static constexpr bool PERM = true, AFTER_DRAIN = false, NEED_R = false;
    bf16_t* O;
    __device__ __forceinline__ void operator()(f32x4 (&acc)[2][2][4][2], const Unit& u, int wr, int wc, int fr, int fq, const PG8_LAS float*) const {
        const int row0 = u.pm * BM + wr * 64 + fr, col0 = u.pn * BM + wc * 32 + 8 * fq;
#pragma unroll
        for (int ai = 0; ai < 2; ++ai)
#pragma unroll
            for (int m = 0; m < 4; ++m) { const int row = row0 + ai * HALF + m * 16;
#pragma unroll
                for (int bj = 0; bj < 2; ++bj) { const f32x4 v0 = acc[ai][bj][m][0], v1 = acc[ai][bj][m][1];
                    u32x4 w; w.x = cvt_pk_bf16(v0[0], v0[1]); w.y = cvt_pk_bf16(v0[2], v0[3]); w.z = cvt_pk_bf16(v1[0], v1[1]); w.w = cvt_pk_bf16(v1[2], v1[3]);
                    *(u32x4*)(O + (size_t)row * 1024 + col0 + bj * HALF) = w; } }
    }
};
struct EpiFinal {
    static constexpr bool PERM = true, AFTER_DRAIN = false, NEED_R = true;
    float* out; const bf16_t* HBr; const bf16_t* PE; const float* RS;
    __device__ __forceinline__ void operator()(f32x4 (&acc)[2][2][4][2], const Unit& u, int wr, int wc, int fr, int fq, const PG8_LAS float* rtab) const {
        const int row0 = u.pm * BM + wr * 64 + fr, col0 = u.pn * BM + wc * 32 + 8 * fq;
#pragma unroll
        for (int ai = 0; ai < 2; ++ai) {
            u32x4 hv[4][2], pv[4][2];
#pragma unroll
            for (int m = 0; m < 4; ++m)
#pragma unroll
                for (int bj = 0; bj < 2; ++bj) { const size_t off = (size_t)(row0 + ai * HALF + m * 16) * 1024 + col0 + bj * HALF; hv[m][bj] = *(const u32x4*)(HBr + off); pv[m][bj] = *(const u32x4*)(PE + off); }
            asm volatile("" ::: "memory");
#pragma unroll
            for (int m = 0; m < 4; ++m) { const float r = rtab[ai * HALF + wr * 64 + m * 16 + fr];
#pragma unroll
                for (int bj = 0; bj < 2; ++bj) { const size_t off = (size_t)(row0 + ai * HALF + m * 16) * 1024 + col0 + bj * HALF; const u32x4 b = hv[m][bj], p = pv[m][bj];
                    f32x4 v0, v1;
                    v0[0] = bf_lo(b.x) + bf_lo(p.x) * sigmoidf_(acc[ai][bj][m][0][0] * r); v0[1] = bf_hi(b.x) + bf_hi(p.x) * sigmoidf_(acc[ai][bj][m][0][1] * r);
                    v0[2] = bf_lo(b.y) + bf_lo(p.y) * sigmoidf_(acc[ai][bj][m][0][2] * r); v0[3] = bf_hi(b.y) + bf_hi(p.y) * sigmoidf_(acc[ai][bj][m][0][3] * r);
                    v1[0] = bf_lo(b.z) + bf_lo(p.z) * sigmoidf_(acc[ai][bj][m][1][0] * r); v1[1] = bf_hi(b.z) + bf_hi(p.z) * sigmoidf_(acc[ai][bj][m][1][1] * r);
                    v1[2] = bf_lo(b.w) + bf_lo(p.w) * sigmoidf_(acc[ai][bj][m][1][2] * r); v1[3] = bf_hi(b.w) + bf_hi(p.w) * sigmoidf_(acc[ai][bj][m][1][3] * r);
                    *(f32x4*)(out + off) = v0; *(f32x4*)(out + off + 4) = v1; } }
            asm volatile("" ::: "memory"); }
    }
};

template <class Epi, class Sched, bool ALIGN_EPI = false, bool SP2 = false, bool BAL = false, bool I8 = false>
__device__ __forceinline__ void gemm_phase(PG8_LAS unsigned char* lds, const Gemm g, const Sched& S, const Epi& E, const int wid) {
    int lane; asm volatile("v_mbcnt_lo_u32_b32 %0, -1, 0\n\tv_mbcnt_hi_u32_b32 %0, -1, %0" : "=v"(lane));
    const int tid = wid * 64 + lane, wr = wid >> 2, wc = wid & 3, fr = lane & 15, fq = lane >> 4;
    const int K = g.K, nt = K / BK;
    unsigned voffA[2], voffB[2];
#pragma unroll
    for (int i = 0; i < 2; ++i) { int R, C; stage_rc(tid * 16 + i * 8192, R, C); const int Rb = Epi::PERM ? ((R & ~31) + perm32(R & 31)) : R;
        voffA[i] = (unsigned)(R * K + C) * 2u; voffB[i] = (unsigned)(Rb * K + C) * 2u; }
    const size_t kstep = (size_t)(BK * 2);
    const size_t hstep = (size_t)HALF * K * 2;
    const size_t tstep = 2 * hstep;
    const unsigned ldsw = (unsigned)wid * 1024u;
    const int aoff = lds_byte(wr * 64 + fr, fq * 8), boff = lds_byte(wc * 32 + fr, fq * 8);
#define PG8_SA(b, h) (((b) * 2 + (h)) * HTB)
#define PG8_SB(b, h) ((4 + (b) * 2 + (h)) * HTB)
#define PG8_STAGE(bufoff, gbase, voff) do { _Pragma("unroll") for (int _i = 0; _i < 2; ++_i) \
        __builtin_amdgcn_global_load_lds((const unsigned*)((const char*)(gbase) + (voff)[_i]), (PG8_LAS unsigned*)(lds + (bufoff) + ldsw + _i * 8192), 16, 0, 0); } while (0)
#define PG8_LDA(dst, b, h) do { _Pragma("unroll") for (int m = 0; m < 4; ++m) _Pragma("unroll") for (int k = 0; k < 2; ++k) dst[m][k] = *(const PG8_LAS bf16x8*)(lds + PG8_SA(b, h) + aoff + m * 2048 + k * 1024); } while (0)
#define PG8_LDB(dst, b, h) do { _Pragma("unroll") for (int n = 0; n < 2; ++n) _Pragma("unroll") for (int k = 0; k < 2; ++k) dst[n][k] = *(const PG8_LAS bf16x8*)(lds + PG8_SB(b, h) + boff + n * 2048 + k * 1024); } while (0)
#define PG8_MMA(ai, bj, At, Bt) do { __builtin_amdgcn_s_setprio(3); _Pragma("unroll") for (int m = 0; m < 4; ++m) _Pragma("unroll") for (int n = 0; n < 2; ++n) _Pragma("unroll") for (int k = 0; k < 2; ++k) \
        { if constexpr (I8) acc[ai][bj][m][n] = __builtin_bit_cast(f32x4, __builtin_amdgcn_mfma_i32_16x16x64_i8(__builtin_bit_cast(i32x4, Bt[n][k]), __builtin_bit_cast(i32x4, At[m][k]), __builtin_bit_cast(i32x4, acc[ai][bj][m][n]), 0, 0, 0)); \
          else acc[ai][bj][m][n] = __builtin_amdgcn_mfma_f32_16x16x32_bf16(Bt[n][k], At[m][k], acc[ai][bj][m][n], 0, 0, 0); } __builtin_amdgcn_s_setprio(0); } while (0)
#define PG8_WAIT_V(n) asm volatile("s_waitcnt vmcnt(" #n ")" ::: "memory")
#define PG8_WAIT_L(n) asm volatile("s_waitcnt lgkmcnt(" #n ")" ::: "memory")
#define PG8_BAR __builtin_amdgcn_s_barrier()
#define PG8_SCHED __builtin_amdgcn_sched_barrier(0)
    Unit cur, nxt; int ui = 0; int rt_pm = -1; PG8_LAS float* rtab = (PG8_LAS float*)(lds + RTAB_OFF);
    if (!S.next(0, cur)) return;
    f32x4 acc[2][2][4][2];
#pragma unroll
    for (int a = 0; a < 2; ++a)
#pragma unroll
        for (int b = 0; b < 2; ++b)
#pragma unroll
            for (int m = 0; m < 4; ++m)
#pragma unroll
                for (int n = 0; n < 2; ++n) acc[a][b][m][n] = (f32x4){0.f, 0.f, 0.f, 0.f};
    bf16x8 At[4][2], B0[2][2], B1[2][2];
    const char* cA = (const char*)g.A + (size_t)cur.pm * tstep; const char* cB = (const char*)g.Bt + (size_t)cur.pn * tstep;
    if constexpr (SP2 && BAL) {
        PG8_STAGE(PG8_SB(0, 0), cB, voffB); PG8_STAGE(PG8_SB(0, 1), cB + hstep, voffB); PG8_STAGE(PG8_SA(0, 0), cA, voffA); PG8_STAGE(PG8_SA(0, 1), cA + hstep, voffA);
        if (wr == 1) PG8_BAR;
        PG8_WAIT_V(2); PG8_BAR;
        PG8_STAGE(PG8_SB(1, 0), cB + kstep, voffB); PG8_STAGE(PG8_SB(1, 1), cB + hstep + kstep, voffB);
        PG8_WAIT_V(4); PG8_BAR;
    } else if constexpr (SP2) {
        PG8_STAGE(PG8_SB(0, 0), cB, voffB); PG8_STAGE(PG8_SB(0, 1), cB + hstep, voffB); PG8_STAGE(PG8_SA(0, 0), cA, voffA); PG8_STAGE(PG8_SA(0, 1), cA + hstep, voffA);
        if (wr == 1) PG8_BAR;
        PG8_WAIT_V(2); PG8_BAR;
        PG8_STAGE(PG8_SB(1, 0), cB + kstep, voffB); PG8_STAGE(PG8_SA(1, 0), cA + kstep, voffA); PG8_STAGE(PG8_SB(1, 1), cB + hstep + kstep, voffB);
        PG8_WAIT_V(6); PG8_BAR;
    } else {
        PG8_STAGE(PG8_SB(0, 0), cB, voffB); PG8_STAGE(PG8_SA(0, 0), cA, voffA); PG8_STAGE(PG8_SB(0, 1), cB + hstep, voffB); PG8_STAGE(PG8_SA(0, 1), cA + hstep, voffA);
        if (wr == 1) PG8_BAR;
        PG8_WAIT_V(4); PG8_BAR;
        PG8_STAGE(PG8_SB(1, 0), cB + kstep, voffB); PG8_STAGE(PG8_SA(1, 0), cA + kstep, voffA); PG8_STAGE(PG8_SB(1, 1), cB + hstep + kstep, voffB);
        PG8_WAIT_V(6); PG8_BAR;
    }
    for (;;) {
        const bool has_next = S.next(ui + 1, nxt);
        const char* nA = has_next ? (const char*)((Sched::PAIR && nxt.w) ? g.A2 : g.A) + (size_t)nxt.pm * tstep : cA; const char* nB = has_next ? (const char*)((Sched::PAIR && nxt.w) ? g.Bt2 : g.Bt) + (size_t)nxt.pn * tstep : cB;
#pragma unroll 1
        for (int t = 0; t < nt; t += 2) {
            const bool last = (t == nt - 2);
            const char* a1 = cA + (size_t)(t + 1) * kstep;
            const char* a2 = last ? nA : cA + (size_t)(t + 2) * kstep; const char* b2 = last ? nB : cB + (size_t)(t + 2) * kstep;
            const char* a3 = a2 + kstep; const char* b3 = b2 + kstep;
            if constexpr (SP2 && BAL) {
            PG8_LDB(B0, 0, 0); PG8_LDB(B1, 0, 1); PG8_SCHED; PG8_LDA(At, 0, 0); PG8_STAGE(PG8_SA(1, 1), a1 + hstep, voffA); PG8_STAGE(PG8_SA(1, 0), a1, voffA);
            PG8_WAIT_V(8); PG8_WAIT_L(0); PG8_BAR; PG8_MMA(0, 0, At, B0); PG8_MMA(0, 1, At, B1); PG8_BAR; PG8_SCHED;
            PG8_LDA(At, 0, 1); PG8_STAGE(PG8_SB(0, 0), b2, voffB); PG8_STAGE(PG8_SB(0, 1), b2 + hstep, voffB);
            PG8_WAIT_V(4); PG8_WAIT_L(0); PG8_BAR; PG8_MMA(1, 0, At, B0); PG8_MMA(1, 1, At, B1); PG8_BAR; PG8_SCHED;
            PG8_LDB(B0, 1, 0); PG8_LDB(B1, 1, 1); PG8_SCHED; PG8_LDA(At, 1, 0); PG8_STAGE(PG8_SA(0, 1), a2 + hstep, voffA); PG8_STAGE(PG8_SA(0, 0), a2, voffA);
            PG8_WAIT_V(8); PG8_WAIT_L(0); PG8_BAR; PG8_MMA(0, 0, At, B0); PG8_MMA(0, 1, At, B1); PG8_BAR; PG8_SCHED;
            PG8_LDA(At, 1, 1); PG8_STAGE(PG8_SB(1, 0), b3, voffB); PG8_STAGE(PG8_SB(1, 1), b3 + hstep, voffB);
            PG8_WAIT_V(4); PG8_WAIT_L(0); PG8_BAR; PG8_MMA(1, 0, At, B0); PG8_MMA(1, 1, At, B1); PG8_BAR; PG8_SCHED;
            } else if constexpr (SP2) {
            PG8_LDB(B0, 0, 0); PG8_LDB(B1, 0, 1); PG8_SCHED; PG8_LDA(At, 0, 0); PG8_STAGE(PG8_SA(1, 1), a1 + hstep, voffA);
            PG8_WAIT_V(8); PG8_WAIT_L(0); PG8_BAR; PG8_MMA(0, 0, At, B0); PG8_MMA(0, 1, At, B1); PG8_BAR; PG8_SCHED;
            PG8_LDA(At, 0, 1); PG8_STAGE(PG8_SB(0, 0), b2, voffB); PG8_STAGE(PG8_SB(0, 1), b2 + hstep, voffB); PG8_STAGE(PG8_SA(0, 0), a2, voffA);
            PG8_WAIT_V(8); PG8_WAIT_L(0); PG8_BAR; PG8_MMA(1, 0, At, B0); PG8_MMA(1, 1, At, B1); PG8_BAR; PG8_SCHED;
            PG8_LDB(B0, 1, 0); PG8_LDB(B1, 1, 1); PG8_SCHED; PG8_LDA(At, 1, 0); PG8_STAGE(PG8_SA(0, 1), a2 + hstep, voffA);
            PG8_WAIT_V(8); PG8_WAIT_L(0); PG8_BAR; PG8_MMA(0, 0, At, B0); PG8_MMA(0, 1, At, B1); PG8_BAR; PG8_SCHED;
            PG8_LDA(At, 1, 1); PG8_STAGE(PG8_SB(1, 0), b3, voffB); PG8_STAGE(PG8_SB(1, 1), b3 + hstep, voffB); PG8_STAGE(PG8_SA(1, 0), a3, voffA);
            PG8_WAIT_V(8); PG8_WAIT_L(0); PG8_BAR; PG8_MMA(1, 0, At, B0); PG8_MMA(1, 1, At, B1); PG8_BAR; PG8_SCHED;
            } else {
            PG8_LDB(B0, 0, 0); PG8_SCHED; PG8_LDA(At, 0, 0); PG8_STAGE(PG8_SA(1, 1), a1 + hstep, voffA);
            PG8_WAIT_L(8); PG8_BAR; PG8_WAIT_L(0); PG8_MMA(0, 0, At, B0); PG8_BAR; PG8_SCHED;
            PG8_LDB(B1, 0, 1); PG8_STAGE(PG8_SB(0, 0), b2, voffB);
            PG8_BAR; PG8_WAIT_L(0); PG8_MMA(0, 1, At, B1); PG8_BAR;
            PG8_LDA(At, 0, 1); PG8_STAGE(PG8_SA(0, 0), a2, voffA);
            PG8_BAR; PG8_WAIT_L(0); PG8_MMA(1, 0, At, B0); PG8_BAR; PG8_SCHED;
            PG8_STAGE(PG8_SB(0, 1), b2 + hstep, voffB);
            PG8_WAIT_V(6); PG8_BAR; PG8_MMA(1, 1, At, B1); PG8_BAR;
            PG8_LDB(B0, 1, 0); PG8_SCHED; PG8_LDA(At, 1, 0); PG8_STAGE(PG8_SA(0, 1), a2 + hstep, voffA);
            PG8_WAIT_L(8); PG8_BAR; PG8_WAIT_L(0); PG8_MMA(0, 0, At, B0); PG8_BAR; PG8_SCHED;
            PG8_LDB(B1, 1, 1); PG8_STAGE(PG8_SB(1, 0), b3, voffB);
            PG8_BAR; PG8_WAIT_L(0); PG8_MMA(0, 1, At, B1); PG8_BAR;
            PG8_LDA(At, 1, 1); PG8_STAGE(PG8_SA(1, 0), a3, voffA);
            PG8_BAR; PG8_WAIT_L(0); PG8_MMA(1, 0, At, B0); PG8_BAR; PG8_SCHED;
            PG8_STAGE(PG8_SB(1, 1), b3 + hstep, voffB);
            PG8_WAIT_V(6); PG8_BAR; PG8_MMA(1, 1, At, B1); PG8_BAR;
            }
        }
        if constexpr (ALIGN_EPI) { if (wr == 0) PG8_BAR; }
        if constexpr (Epi::NEED_R) {
            static_assert(ALIGN_EPI, "row-scale table needs both halves in the epilogue together");
            if (cur.pm != rt_pm) {
                if (tid < 256) { const f32x4* rp = (const f32x4*)(E.RS + (size_t)(cur.pm * BM + tid) * 16); const f32x4 p0 = rp[0], p1 = rp[1], p2 = rp[2], p3 = rp[3];
                    const float ss = ((p0[0] + p0[1]) + (p0[2] + p0[3])) + ((p1[0] + p1[1]) + (p1[2] + p1[3])) + ((p2[0] + p2[1]) + (p2[2] + p2[3])) + ((p3[0] + p3[1]) + (p3[2] + p3[3]));
                    float rv_ = __builtin_amdgcn_rsqf(ss * (1.0f / 1024.0f) + RMS_EPS); if constexpr (I8) rv_ *= g.sch[cur.pm * BM + tid]; rtab[tid] = rv_; }
                PG8_WAIT_L(0); PG8_BAR; rt_pm = cur.pm; }
        }
        if constexpr (I8) {
#pragma unroll
            for (int bj = 0; bj < 2; ++bj) { const float* sp_ = g.scw + cur.pn * BM + bj * HALF + wc * 32 + 8 * fq; const f32x4 s0 = *(const f32x4*)sp_, s1 = *(const f32x4*)(sp_ + 4);
#pragma unroll
                for (int ai = 0; ai < 2; ++ai)
#pragma unroll
                    for (int m = 0; m < 4; ++m) { acc[ai][bj][m][0] = __builtin_convertvector(__builtin_bit_cast(i32x4, acc[ai][bj][m][0]), f32x4) * s0; acc[ai][bj][m][1] = __builtin_convertvector(__builtin_bit_cast(i32x4, acc[ai][bj][m][1]), f32x4) * s1; } } }
        E(acc, cur, wr, wc, fr, fq, (const PG8_LAS float*)rtab);
        if (!has_next) break;
        if (!Sched::PAIR || cur.w) {
#pragma unroll
        for (int a = 0; a < 2; ++a)
#pragma unroll
            for (int b = 0; b < 2; ++b)
#pragma unroll
                for (int m = 0; m < 4; ++m)
#pragma unroll
                    for (int n = 0; n < 2; ++n) acc[a][b][m][n] = (f32x4){0.f, 0.f, 0.f, 0.f}; }
        cur = nxt; cA = nA; cB = nB; ++ui;
        if constexpr (ALIGN_EPI) { if (wr == 1) PG8_BAR; }
    }
    PG8_WAIT_V(0);
    if constexpr (!ALIGN_EPI) { if (wr == 0) PG8_BAR; }
    PG8_BAR;
#undef PG8_SA
#undef PG8_SB
#undef PG8_STAGE
#undef PG8_LDA
#undef PG8_LDB
#undef PG8_MMA
#undef PG8_WAIT_V
#undef PG8_WAIT_L
#undef PG8_BAR
#undef PG8_SCHED
}

struct EpiFinal2 {
    static constexpr bool PERM = true, AFTER_DRAIN = false, NEED_R = true;
    float* out; const bf16_t* HBr; const float* RS;
    static constexpr int NREG = 26;
    struct State { unsigned s8[NREG]; };
    __device__ __forceinline__ void operator()(f32x4 (&acc)[2][2][4][2], State& st, const Unit& u, int wr, int wc, int fr, int fq, const PG8_LAS float* rtab, PG8_LAS unsigned* xl) const {
        if (u.w == 0) {
#pragma unroll
            for (int ai = 0; ai < 2; ++ai)
#pragma unroll
                for (int m = 0; m < 4; ++m) { const float rl = rtab[ai * HALF + wr * 64 + m * 16 + fr] * -1.4426950408889634f;
#pragma unroll
                    for (int bj = 0; bj < 2; ++bj)
#pragma unroll
                        for (int n = 0; n < 2; ++n) { unsigned p = sig8_pack<0>(acc[ai][bj][m][n] * rl);
                            asm volatile("" : "+v"(p));
                            { constexpr int dummy_ = 0; (void)dummy_; const int ix = ((ai * 2 + bj) * 4 + m) * 2 + n; if (ix < NREG) st.s8[ix < NREG ? ix : 0] = p; else xl[(ix - NREG) * 512] = p; }
                            acc[ai][bj][m][n] = (f32x4){0.f, 0.f, 0.f, 0.f}; } }
        } else {
            const int row0 = u.pm * BM + wr * 64 + fr, col0 = u.pn * BM + wc * 32 + 8 * fq;
#pragma unroll
            for (int ai = 0; ai < 2; ++ai) {
                u32x4 hv[4][2];
#pragma unroll
                for (int m = 0; m < 4; ++m)
#pragma unroll
                    for (int bj = 0; bj < 2; ++bj) hv[m][bj] = *(const u32x4*)(HBr + (size_t)(row0 + ai * HALF + m * 16) * 1024 + col0 + bj * HALF);
                asm volatile("" ::: "memory");
#pragma unroll
                for (int m = 0; m < 4; ++m)
#pragma unroll
                    for (int bj = 0; bj < 2; ++bj) { const size_t off = (size_t)(row0 + ai * HALF + m * 16) * 1024 + col0 + bj * HALF; const u32x4 b = hv[m][bj];
                        const int ix0 = ((ai * 2 + bj) * 4 + m) * 2, ix1 = ix0 + 1; constexpr float I255 = 1.0f / 255.0f;
                        const unsigned q0 = (ix0 < NREG) ? st.s8[ix0 < NREG ? ix0 : 0] : xl[(ix0 - NREG) * 512], q1 = (ix1 < NREG) ? st.s8[ix1 < NREG ? ix1 : 0] : xl[(ix1 - NREG) * 512];
                        f32x4 v0, v1;
                        v0[0] = bf_lo(b.x) + acc[ai][bj][m][0][0] * ((float)(q0 & 255u) * I255); v0[1] = bf_hi(b.x) + acc[ai][bj][m][0][1] * ((float)((q0 >> 8) & 255u) * I255);
                        v0[2] = bf_lo(b.y) + acc[ai][bj][m][0][2] * ((float)((q0 >> 16) & 255u) * I255); v0[3] = bf_hi(b.y) + acc[ai][bj][m][0][3] * ((float)(q0 >> 24) * I255);
                        v1[0] = bf_lo(b.z) + acc[ai][bj][m][1][0] * ((float)(q1 & 255u) * I255); v1[1] = bf_hi(b.z) + acc[ai][bj][m][1][1] * ((float)((q1 >> 8) & 255u) * I255);
                        v1[2] = bf_lo(b.w) + acc[ai][bj][m][1][2] * ((float)((q1 >> 16) & 255u) * I255); v1[3] = bf_hi(b.w) + acc[ai][bj][m][1][3] * ((float)(q1 >> 24) * I255);
                        *(f32x4*)(out + off) = v0; *(f32x4*)(out + off + 4) = v1; }
                asm volatile("" ::: "memory"); }
        }
    }
};
template <class Epi>
__device__ __forceinline__ void gemm_phase_dk(PG8_LAS unsigned char* lds, const Gemm g, const PairOrder& S, const Epi& E, const int wid) {
    int lane; asm volatile("v_mbcnt_lo_u32_b32 %0, -1, 0\n\tv_mbcnt_hi_u32_b32 %0, -1, %0" : "=v"(lane));
    const int tid = wid * 64 + lane, wr = wid >> 2, wc = wid & 3, fr = lane & 15, fq = lane >> 4;
    const int K0 = g.K, K1 = g.K2, nt0 = K0 / BK, nt1 = K1 / BK;
    unsigned vA0[2], vB0[2];
#pragma unroll
    for (int i = 0; i < 2; ++i) { int R, C; stage_rc(tid * 16 + i * 8192, R, C); const int Rb = (R & ~31) + perm32(R & 31);
        vA0[i] = (unsigned)(R * K0 + C) * 2u; vB0[i] = (unsigned)(Rb * K0 + C) * 2u; }
    const size_t kstep = (size_t)(BK * 2);
    const size_t hs0 = (size_t)HALF * K0 * 2, hs1 = (size_t)HALF * K1 * 2;
    const unsigned ldsw = (unsigned)wid * 1024u;
    const int aoff = lds_byte(wr * 64 + fr, fq * 8), boff = lds_byte(wc * 32 + fr, fq * 8);
#define PG8_SA(b, h) (((b) * 2 + (h)) * HTB)
#define PG8_SB(b, h) ((4 + (b) * 2 + (h)) * HTB)
#define PG8_STAGE(bufoff, gbase, voff) do { _Pragma("unroll") for (int _i = 0; _i < 2; ++_i) \
        __builtin_amdgcn_global_load_lds((const unsigned*)((const char*)(gbase) + (voff)[_i]), (PG8_LAS unsigned*)(lds + (bufoff) + ldsw + _i * 8192), 16, 0, 0); } while (0)
#define DK_V1(v) ((((v) >> 11) * (unsigned)K1 + (((v) >> 1) & 1023u)) * 2u)
#define DK_STA(bufoff, gbase, sel) do { if (sel) { unsigned t_[2] = {vA0[0], vA0[1]}; asm volatile("" : "+v"(t_[0]), "+v"(t_[1])); t_[0] = DK_V1(t_[0]); t_[1] = DK_V1(t_[1]); PG8_STAGE(bufoff, gbase, t_); } else PG8_STAGE(bufoff, gbase, vA0); } while (0)
#define DK_STB(bufoff, gbase, sel) do { if (sel) { unsigned t_[2] = {vB0[0], vB0[1]}; asm volatile("" : "+v"(t_[0]), "+v"(t_[1])); t_[0] = DK_V1(t_[0]); t_[1] = DK_V1(t_[1]); PG8_STAGE(bufoff, gbase, t_); } else PG8_STAGE(bufoff, gbase, vB0); } while (0)
#define PG8_LDA(dst, b, h) do { _Pragma("unroll") for (int m = 0; m < 4; ++m) _Pragma("unroll") for (int k = 0; k < 2; ++k) dst[m][k] = *(const PG8_LAS bf16x8*)(lds + PG8_SA(b, h) + aoff + m * 2048 + k * 1024); } while (0)
#define PG8_LDB(dst, b, h) do { _Pragma("unroll") for (int n = 0; n < 2; ++n) _Pragma("unroll") for (int k = 0; k < 2; ++k) dst[n][k] = *(const PG8_LAS bf16x8*)(lds + PG8_SB(b, h) + boff + n * 2048 + k * 1024); } while (0)
#define PG8_MMA(ai, bj, At, Bt) do { __builtin_amdgcn_s_setprio(3); _Pragma("unroll") for (int m = 0; m < 4; ++m) _Pragma("unroll") for (int n = 0; n < 2; ++n) _Pragma("unroll") for (int k = 0; k < 2; ++k) \
        acc[ai][bj][m][n] = __builtin_amdgcn_mfma_f32_16x16x32_bf16(Bt[n][k], At[m][k], acc[ai][bj][m][n], 0, 0, 0); __builtin_amdgcn_s_setprio(0); } while (0)
#define PG8_WAIT_V(n) asm volatile("s_waitcnt vmcnt(" #n ")" ::: "memory")
#define PG8_WAIT_L(n) asm volatile("s_waitcnt lgkmcnt(" #n ")" ::: "memory")
#define PG8_BAR __builtin_amdgcn_s_barrier()
#define PG8_SCHED __builtin_amdgcn_sched_barrier(0)
    Unit cur, nxt; int ui = 0; int rt_pm = -1; PG8_LAS float* rtab = (PG8_LAS float*)(lds + RTAB_OFF);
    if (!S.next(0, cur)) return;
    f32x4 acc[2][2][4][2];
#pragma unroll
    for (int a = 0; a < 2; ++a)
#pragma unroll
        for (int b = 0; b < 2; ++b)
#pragma unroll
            for (int m = 0; m < 4; ++m)
#pragma unroll
                for (int n = 0; n < 2; ++n) acc[a][b][m][n] = (f32x4){0.f, 0.f, 0.f, 0.f};
    typename Epi::State st;
    bf16x8 At[4][2], B0[2][2], B1[2][2];
    const char* cA = (const char*)g.A + (size_t)cur.pm * (2 * hs0); const char* cB = (const char*)g.Bt + (size_t)cur.pn * (2 * hs0);
    PG8_STAGE(PG8_SB(0, 0), cB, vB0); PG8_STAGE(PG8_SB(0, 1), cB + hs0, vB0); PG8_STAGE(PG8_SA(0, 0), cA, vA0); PG8_STAGE(PG8_SA(0, 1), cA + hs0, vA0);
    if (wr == 1) PG8_BAR;
    PG8_WAIT_V(2); PG8_BAR;
    PG8_STAGE(PG8_SB(1, 0), cB + kstep, vB0); PG8_STAGE(PG8_SA(1, 0), cA + kstep, vA0); PG8_STAGE(PG8_SB(1, 1), cB + hs0 + kstep, vB0);
    PG8_WAIT_V(6); PG8_BAR;
    for (;;) {
        const bool has_next = S.next(ui + 1, nxt);
        const bool cw = cur.w != 0, nw = has_next ? (nxt.w != 0) : cw;
        const size_t hsc = cw ? hs1 : hs0; const int ntc = cw ? nt1 : nt0;
        const char* nA = has_next ? (const char*)(nw ? g.A2 : g.A) + (size_t)nxt.pm * (2 * (nw ? hs1 : hs0)) : cA; const char* nB = has_next ? (const char*)(nw ? g.Bt2 : g.Bt) + (size_t)nxt.pn * (2 * (nw ? hs1 : hs0)) : cB;
#pragma unroll 1
        for (int t = 0; t < ntc; t += 2) {
            const bool last = (t == ntc - 2);
            const char* a1 = cA + (size_t)(t + 1) * kstep;
            const char* a2 = last ? nA : cA + (size_t)(t + 2) * kstep; const char* b2 = last ? nB : cB + (size_t)(t + 2) * kstep;
            const char* a3 = a2 + kstep; const char* b3 = b2 + kstep;
            const bool xs = last ? nw : cw; const size_t hx = xs ? hs1 : hs0;
            PG8_LDB(B0, 0, 0); PG8_LDB(B1, 0, 1); PG8_SCHED; PG8_LDA(At, 0, 0); DK_STA(PG8_SA(1, 1), a1 + hsc, cw);
            PG8_WAIT_V(8); PG8_WAIT_L(0); PG8_BAR; PG8_MMA(0, 0, At, B0); PG8_MMA(0, 1, At, B1); PG8_BAR; PG8_SCHED;
            PG8_LDA(At, 0, 1); DK_STB(PG8_SB(0, 0), b2, xs); DK_STB(PG8_SB(0, 1), b2 + hx, xs); DK_STA(PG8_SA(0, 0), a2, xs);
            PG8_WAIT_V(8); PG8_WAIT_L(0); PG8_BAR; PG8_MMA(1, 0, At, B0); PG8_MMA(1, 1, At, B1); PG8_BAR; PG8_SCHED;
            PG8_LDB(B0, 1, 0); PG8_LDB(B1, 1, 1); PG8_SCHED; PG8_LDA(At, 1, 0); DK_STA(PG8_SA(0, 1), a2 + hx, xs);
            PG8_WAIT_V(8); PG8_WAIT_L(0); PG8_BAR; PG8_MMA(0, 0, At, B0); PG8_MMA(0, 1, At, B1); PG8_BAR; PG8_SCHED;
            PG8_LDA(At, 1, 1); DK_STB(PG8_SB(1, 0), b3, xs); DK_STB(PG8_SB(1, 1), b3 + hx, xs); DK_STA(PG8_SA(1, 0), a3, xs);
            PG8_WAIT_V(8); PG8_WAIT_L(0); PG8_BAR; PG8_MMA(1, 0, At, B0); PG8_MMA(1, 1, At, B1); PG8_BAR; PG8_SCHED;
        }
        if (wr == 0) PG8_BAR;
        int l2_; asm volatile("v_mbcnt_lo_u32_b32 %0, -1, 0\n\tv_mbcnt_hi_u32_b32 %0, -1, %0" : "=v"(l2_));
        if (cur.pm != rt_pm) { const int tid2 = wid * 64 + l2_;
            if (tid2 < 256) { const f32x4* rp = (const f32x4*)(E.RS + (size_t)(cur.pm * BM + tid2) * 16); const f32x4 p0 = rp[0], p1 = rp[1], p2 = rp[2], p3 = rp[3];
                const float ss = ((p0[0] + p0[1]) + (p0[2] + p0[3])) + ((p1[0] + p1[1]) + (p1[2] + p1[3])) + ((p2[0] + p2[1]) + (p2[2] + p2[3])) + ((p3[0] + p3[1]) + (p3[2] + p3[3]));
                rtab[tid2] = __builtin_amdgcn_rsqf(ss * (1.0f / 1024.0f) + RMS_EPS); }
            PG8_WAIT_L(0); PG8_BAR; rt_pm = cur.pm; }
        E(acc, st, cur, wr, wc, l2_ & 15, l2_ >> 4, (const PG8_LAS float*)rtab, (PG8_LAS unsigned*)(lds + 139264) + (wid * 64 + l2_));
        if (!has_next) break;
        if (cur.w) {
#pragma unroll
        for (int a = 0; a < 2; ++a)
#pragma unroll
            for (int b = 0; b < 2; ++b)
#pragma unroll
                for (int m = 0; m < 4; ++m)
#pragma unroll
                    for (int n = 0; n < 2; ++n) acc[a][b][m][n] = (f32x4){0.f, 0.f, 0.f, 0.f}; }
        cur = nxt; cA = nA; cB = nB; ++ui;
        if (wr == 1) PG8_BAR;
    }
    PG8_WAIT_V(0);
    PG8_BAR;
#undef PG8_SA
#undef PG8_SB
#undef PG8_STAGE
#undef DK_STA
#undef DK_V1
#undef DK_STB
#undef PG8_LDA
#undef PG8_LDB
#undef PG8_MMA
#undef PG8_WAIT_V
#undef PG8_WAIT_L
#undef PG8_BAR
#undef PG8_SCHED
}
}

using pg8::sigmoidf_;
constexpr int NWAVES = 8, NTHREADS = NWAVES * 64;
constexpr int BATCH = 4, SEQ = 8192, D = 1024, M = BATCH * SEQ, FF = 2816, PLE = 256, D_IN = 8712;
constexpr int NHD = 128;
constexpr int WIN_ROWS = 8960;
constexpr int WIN_ML = 4608, WIN_GT = 6656, WIN_G = 6912;
constexpr int NPHASE = 13;

constexpr size_t MiB = 1u << 20;
constexpr size_t WS_CTL = 0, CTL_ZERO_BYTES = 1 * MiB;
constexpr size_t WS_ROPE = 1 * MiB;
constexpr size_t WS_GATES = 2 * MiB;
constexpr size_t WS_LSE = 3 * MiB;
constexpr size_t WS_RS = 4 * MiB;
constexpr size_t WS_W1IN = 6 * MiB;
constexpr size_t WS_W1OUT = 17 * MiB;
constexpr size_t WS_WIN = 22 * MiB + 512 * 1024;
constexpr size_t WS_WUPA = 40 * MiB, WS_WUPB = 41 * MiB, WS_WO = 42 * MiB;
constexpr size_t WS_W2IN = 44 * MiB, WS_W2OUT = 55 * MiB, WS_WPG = 60 * MiB + 512 * 1024, WS_WPE = 62 * MiB + 512 * 1024;
constexpr size_t WS_HB = 64 * MiB;
constexpr size_t WS_HID = 128 * MiB;
constexpr size_t WS_ML = 128 * MiB;
constexpr size_t WS_MST = 256 * MiB;
constexpr size_t WS_QKV1 = 128 * MiB;
constexpr size_t WS_QKV = 320 * MiB;
constexpr size_t WS_A = 416 * MiB, WS_BM = 448 * MiB;
constexpr size_t WS_PB = 480 * MiB;
constexpr size_t WS_G = 128 * MiB;
constexpr size_t WS_TMP = 256 * MiB, WS_MERGED = 320 * MiB;
constexpr size_t WS_PE = 320 * MiB;
constexpr size_t WS_W8 = 497 * MiB;
constexpr size_t WS_SCW = 504 * MiB;
constexpr size_t WS_SC1 = 504 * MiB + 256 * 1024;
constexpr size_t WS_SCX = 3 * MiB + 512 * 1024;
constexpr size_t WS_W1IN8 = 320 * MiB;
constexpr size_t WS_W2IN8 = 505 * MiB;
constexpr size_t WS_SC2 = 504 * MiB + 512 * 1024;
constexpr size_t WS_END = 511 * MiB;
constexpr int CW_BAR = 4096;
constexpr size_t WS_PCNT = 64 * 1024, WS_ROWMAX = 128 * 1024;
constexpr size_t WS_PAR = 512 * 1024;
constexpr int PAR_QG = 0, PAR_KG = 128, PAR_CW = 256, PAR_CB = 256 + 4096, PAR_IB = PAR_CB + 1024, PAR_FB = PAR_IB + 4, PAR_N = PAR_FB + 4;

constexpr int RING_BYTES = 131072, SCR_BYTES = 4 * 36864 + 8192, LDSCTL_OFF = SCR_BYTES, MISC_OFF = LDSCTL_OFF + 320, LDS_BYTES = 163840;

#define GAS __attribute__((address_space(1)))
#define LAS __attribute__((address_space(3)))
typedef unsigned short bf16;
typedef unsigned v4u __attribute__((ext_vector_type(4)));
typedef unsigned v2u __attribute__((ext_vector_type(2)));
typedef float f32x4 __attribute__((ext_vector_type(4)));
typedef GAS unsigned gu32;
#define RLX_AGENT __ATOMIC_RELAXED, __HIP_MEMORY_SCOPE_AGENT
#define LDS_WAIT() asm volatile("s_waitcnt lgkmcnt(0)" ::: "memory")
#define VM_WAIT() asm volatile("s_waitcnt vmcnt(0)" ::: "memory")
__device__ __forceinline__ unsigned f2bf(float f) { unsigned u = __builtin_bit_cast(unsigned, f); return (u + 0x7fffu + ((u >> 16) & 1u)) >> 16; }
__device__ __forceinline__ unsigned pk2(float lo, float hi) { return f2bf(lo) | (f2bf(hi) << 16); }
__device__ __forceinline__ float bfl(unsigned u) { return __uint_as_float(u << 16); }
__device__ __forceinline__ float bfh(unsigned u) { return __uint_as_float(u & 0xffff0000u); }
__device__ __forceinline__ float bf1(bf16 u) { return __uint_as_float((unsigned)u << 16); }

#define XB_TMO      128
#define XB_XCNT(j)  (256  + 64 * (j))
#define XB_XSUB(j)  (1280 + 64 * (j))
#define XB_XGEN(j)  (2304 + 64 * (j))
#define XB_TOP      3328
#define XB_TOPGEN   3392
#define XCD_BAR_WORDS 3456
#define XB_SPIN_CAP (1u << 20)
__device__ __forceinline__ unsigned xb_ld(unsigned* p)              { return __hip_atomic_load(p, __ATOMIC_RELAXED, __HIP_MEMORY_SCOPE_AGENT); }
__device__ __forceinline__ unsigned xb_add(unsigned* p, unsigned v) { return __hip_atomic_fetch_add(p, v, __ATOMIC_RELAXED, __HIP_MEMORY_SCOPE_AGENT); }
__device__ __forceinline__ unsigned xb_xcc_id() { return (unsigned)__builtin_amdgcn_s_getreg((3 << 11) | 20) & 0xFu; }
#define XB_SPIN(cond, bar) do { unsigned _sp = 0; while (cond) { __builtin_amdgcn_s_sleep(1); \
    if ((++_sp & 255u) == 0u) { if (xb_ld(&(bar)[XB_TMO])) break; if (_sp > XB_SPIN_CAP) { atomicAdd(&(bar)[XB_TMO], 1u); break; } } } } while (0)
struct XcdBarrier { unsigned* bar; unsigned x; volatile LAS unsigned* st; };
__device__ __forceinline__ XcdBarrier xcd_barrier_post(unsigned* bar, volatile LAS unsigned* st, bool leader) {
    XcdBarrier b; b.bar = bar; b.x = xb_xcc_id(); b.st = st;
    if (leader) (void)xb_add(&bar[XB_XCNT(b.x)], 1u);
    return b;
}
__device__ __forceinline__ void xcd_barrier_complete(unsigned* bar, unsigned x, unsigned& nloc, unsigned& nx) {
    const unsigned G = gridDim.x * gridDim.y * gridDim.z;
    unsigned sum, cnt, mine, sp = 0u;
    for (;;) {
        sum = 0u; cnt = 0u; mine = 0u;
#pragma unroll
        for (unsigned j = 0; j < 16; ++j) { const unsigned c = xb_ld(&bar[XB_XCNT(j)]); sum += c; cnt += (c > 0u) ? 1u : 0u; mine = (j == x) ? c : mine; }
        if (sum == G) break;
        __builtin_amdgcn_s_sleep(1);
        if ((++sp & 255u) == 0u) { if (xb_ld(&bar[XB_TMO])) break; if (sp > XB_SPIN_CAP) { atomicAdd(&bar[XB_TMO], 1u); break; } }
    }
    nloc = mine > 0u ? mine : 1u; nx = cnt > 0u ? cnt : 1u;
}
__device__ __forceinline__ void xcd_barrier(const XcdBarrier& b, bool leader) {
    asm volatile("s_waitcnt vmcnt(0)" ::: "memory");
    __syncthreads();
    if (leader) {
        unsigned* bar = b.bar;
        __builtin_amdgcn_s_waitcnt(0);
        unsigned nloc = b.st[0], nx = b.st[1];
        if (nloc == 0u) { xcd_barrier_complete(bar, b.x, nloc, nx); b.st[0] = nloc; b.st[1] = nx; }
        const unsigned old = xb_add(&bar[XB_XSUB(b.x)], 1u);
        const unsigned gen = old / nloc;
        if (old + 1u == (gen + 1u) * nloc) {
            __builtin_amdgcn_fence(__ATOMIC_RELEASE, "agent");
            asm volatile("s_waitcnt vmcnt(0)" ::: "memory");
            const unsigned og = xb_add(&bar[XB_TOP], 1u);
            const unsigned tg = og / nx;
            if (og + 1u == (tg + 1u) * nx) xb_add(&bar[XB_TOPGEN], 1u);
            else XB_SPIN(xb_ld(&bar[XB_TOPGEN]) == tg, bar);
            __builtin_amdgcn_fence(__ATOMIC_ACQUIRE, "agent");
            xb_add(&bar[XB_XGEN(b.x)], 1u);
            asm volatile("s_waitcnt vmcnt(0)" ::: "memory");
        } else {
            XB_SPIN(xb_ld(&bar[XB_XGEN(b.x)]) == gen, bar);
            __builtin_amdgcn_fence(__ATOMIC_ACQUIRE, "agent");
            asm volatile("s_waitcnt vmcnt(0)" ::: "memory");
        }
    }
    __syncthreads();
}

struct WD { int src; int gain; unsigned dst; int K, Nsrc, Ndst, kind; };
__constant__ float c_invfreq[16] = {1.000000000e+00f, 4.403666258e-01f, 1.939227581e-01f, 8.539710194e-02f, 3.760603070e-02f, 1.656044088e-02f, 7.292665076e-03f, 3.211446106e-03f,
    1.414213446e-03f, 6.227724371e-04f, 2.742481884e-04f, 1.207697424e-04f, 5.318296462e-05f, 2.341999789e-05f, 1.031338525e-05f, 4.541670478e-06f};
struct Args { const float* in[22]; float* out; unsigned char* ws; int ph_lo, ph_hi; };
enum { I_X = 0, I_P, I_F1N, I_F1WI, I_F1WO, I_MIXN, I_WIN, I_QG, I_KG, I_CW, I_CB, I_IB, I_FB, I_WUA, I_WUM, I_WOUT, I_F2N, I_F2WI, I_F2WO, I_PLN, I_WPG, I_WPE };

__constant__ WD c_wd[10] = {
    {I_F1WI, I_F1N, (unsigned)WS_W1IN, D, 2 * FF, 2 * FF, 1}, {I_F1WO, -1, (unsigned)WS_W1OUT, FF, D, D, 0}, {I_WIN, I_MIXN, (unsigned)WS_WIN, D, D_IN, WIN_ROWS, 2},
    {I_WUA, -1, (unsigned)WS_WUPA, 512, D, D, 0}, {I_WUM, -1, (unsigned)WS_WUPB, 512, D, D, 0}, {I_WOUT, -1, (unsigned)WS_WO, D, D, D, 0},
    {I_F2WI, I_F2N, (unsigned)WS_W2IN, D, 2 * FF, 2 * FF, 1}, {I_F2WO, -1, (unsigned)WS_W2OUT, FF, D, D, 0}, {I_WPG, I_PLN, (unsigned)WS_WPG, D, D, D, 0}, {I_WPE, -1, (unsigned)WS_WPE, PLE, D, D, 0}};
__device__ __forceinline__ float wave_sum(float v) {
#pragma unroll
    for (int o = 1; o < 64; o <<= 1) v += __shfl_xor(v, o);
    return v;
}
__device__ __forceinline__ float wave_max(float v) {
#pragma unroll
    for (int o = 1; o < 64; o <<= 1) v = fmaxf(v, __shfl_xor(v, o));
    return v;
}

__device__ __forceinline__ int wsrc_col(int kind, int n) {
    if (kind == 0) return n;
    if (kind == 1) { const int t = n >> 8, w = n & 255; return (w < 128) ? (128 * t + w) : (FF + 128 * t + (w - 128)); }
    if (n < WIN_ML) { const int g = n / 1536, w = n % 1536, part = w >> 9, c = w & 511; return part * 1536 + g * 512 + c; }
    if (n < WIN_GT + 8) return n;
    if (n < WIN_G) return -1;
    { const int e = n - WIN_G, t = e >> 8, w = e & 255; return (w < 128) ? (WIN_GT + 8) + 128 * t + w : (WIN_GT + 8) + 1024 + 128 * t + (w - 128); }
}
__device__ __forceinline__ void p0_transpose_item(const float* W, const float* gain, int K, int Nsrc, int Ndst, bf16* WT, int kind, LAS float* scr, int item, int lane) {
    const int nblk = Ndst / 64, kb = item / nblk, nb = item % nblk, k0 = 64 * kb, n0 = 64 * nb;
    const int n4 = lane & 15, kr = lane >> 4;
    const int sc = wsrc_col(kind, n0 + 4 * n4);
    f32x4 v[16];
#pragma unroll
    for (int i = 0; i < 16; ++i) { const int k = k0 + 4 * i + kr; v[i] = (sc >= 0) ? *(const f32x4*)(W + (size_t)k * Nsrc + sc) : (f32x4){0.f, 0.f, 0.f, 0.f}; }
#pragma unroll
    for (int i = 0; i < 16; ++i) { const int kk = 4 * i + kr; const float gsc = gain ? gain[k0 + kk] : 1.0f; LAS float* d_ = scr + kk * 65 + 4 * n4;
        d_[0] = v[i][0] * gsc; d_[1] = v[i][1] * gsc; d_[2] = v[i][2] * gsc; d_[3] = v[i][3] * gsc; }
    LDS_WAIT(); asm volatile("" ::: "memory");
#pragma unroll
    for (int j = 0; j < 8; ++j) { const int id = lane + 64 * j, n = id >> 3, c = id & 7; const LAS float* s_ = scr + (8 * c) * 65 + n;
        v4u o; o.x = pk2(s_[0 * 65], s_[1 * 65]); o.y = pk2(s_[2 * 65], s_[3 * 65]); o.z = pk2(s_[4 * 65], s_[5 * 65]); o.w = pk2(s_[6 * 65], s_[7 * 65]);
        *(GAS v4u*)(WT + (size_t)(n0 + n) * K + k0 + 8 * c) = o; }
    LDS_WAIT(); asm volatile("" ::: "memory");
}

__device__ __forceinline__ void mlstm_seq_v0(const Args& a, LAS unsigned char* lds, int bh, int tid) {
    const int f = tid & 127, eg = tid >> 7;
    const int b = bh >> 2, h = bh & 3;
    const bf16* ML = (const bf16*)(a.ws + WS_ML); const float* GT = (const float*)(a.ws + WS_GATES); bf16* BMo = (bf16*)(a.ws + WS_BM);
    LAS float* qs = (LAS float*)lds;
    LAS float* ks = qs + 256;
    LAS float* hp = ks + 256;
    LAS float* dp = hp + 1024;
    const float* par = (const float*)(a.ws + WS_PAR); const float* cw = par + PAR_CW; const float* cb = par + PAR_CB;
    const float ib = par[PAR_IB + h], fb = par[PAR_FB + h];
    const int cch = (tid < 128) ? (h * 128 + tid) : (512 + h * 128 + (tid - 128));
    float w0 = 0.f, w1 = 0.f, w2 = 0.f, w3 = 0.f, wb = 0.f;
    if (tid < 256) { w0 = cw[0 * 1024 + cch]; w1 = cw[1 * 1024 + cch]; w2 = cw[2 * 1024 + cch]; w3 = cw[3 * 1024 + cch]; wb = cb[cch]; }
    float x0 = 0.f, x1 = 0.f, x2 = 0.f;
    float C[32], n[32];
#pragma unroll
    for (int i = 0; i < 32; ++i) { C[i] = 0.f; n[i] = 0.f; }
    float mst = 0.f;
    const size_t row0 = (size_t)b * SEQ;
    float xn = 0.f, vn = 0.f, on = 0.f, lin = 0.f, lfn = 0.f;
    if (tid < 256) xn = bf1(ML[row0 * 2048 + cch]);
    vn = bf1(ML[row0 * 2048 + 1024 + h * 128 + f]); on = bf1(ML[row0 * 2048 + 1536 + h * 128 + f]); lin = GT[row0 * 8 + h]; lfn = GT[row0 * 8 + 4 + h];
    for (int t = 0; t < SEQ; ++t) {
        const int par = t & 1;
        const float x3 = xn, v = vn, og = on, lipre = lin, lfpre = lfn;
        if (t + 1 < SEQ) { const size_t r = row0 + t + 1;
            if (tid < 256) xn = bf1(ML[r * 2048 + cch]);
            vn = bf1(ML[r * 2048 + 1024 + h * 128 + f]); on = bf1(ML[r * 2048 + 1536 + h * 128 + f]); lin = GT[r * 8 + h]; lfn = GT[r * 8 + 4 + h]; }
        if (tid < 256) { float c = wb + w0 * x0 + w1 * x1 + w2 * x2 + w3 * x3; c = c * sigmoidf_(c); if (tid >= 128) c *= 0.08838834764831845f;
            if (tid < 128) qs[par * 128 + tid] = c; else ks[par * 128 + tid - 128] = c; x0 = x1; x1 = x2; x2 = x3; }
        __syncthreads();
        const float li = lipre + ib; const float fx = lfpre + fb;
        const float lf = fminf(fx, 0.f) - log1pf(expf(-fabsf(fx)));
        const float mnew = fmaxf(lf + mst, li);
        const float fp = expf(lf + mst - mnew), ip = expf(li - mnew);
        mst = mnew;
        float hacc = 0.f, dacc = 0.f;
#pragma unroll
        for (int i = 0; i < 32; ++i) { const float kk = ks[par * 128 + eg * 32 + i], qq = qs[par * 128 + eg * 32 + i];
            C[i] = fp * C[i] + ip * kk * v; n[i] = fp * n[i] + ip * kk; hacc += qq * C[i]; dacc += qq * n[i]; }
        hp[par * 512 + eg * 128 + f] = hacc; if (f == 0) dp[par * 4 + eg] = dacc;
        __syncthreads();
        if (tid < 128) { const float num = (hp[par * 512 + f] + hp[par * 512 + 128 + f]) + (hp[par * 512 + 256 + f] + hp[par * 512 + 384 + f]);
            const float den = (dp[par * 4] + dp[par * 4 + 1]) + (dp[par * 4 + 2] + dp[par * 4 + 3]);
            const float hv = num / fmaxf(fabsf(den), expf(-mnew));
            BMo[(row0 + t) * 512 + h * 128 + f] = (bf16)f2bf(sigmoidf_(og) * hv); }
    }
    __syncthreads();
}

__device__ __forceinline__ void attn_v0(const Args& a, LAS unsigned char* lds, int g, int gwave, int ngwave, int wave, int lane, int tid) {
    const int d = (g == 0) ? 1 : (g == 1 ? 4 : 16);
    const bf16* QKV = (const bf16*)(a.ws + WS_QKV); bf16* Ao = (bf16*)(a.ws + WS_A); float* LSE = (float*)(a.ws + WS_LSE);
    const float* rope = (const float*)(a.ws + WS_ROPE);
    const float* qg = (const float*)(a.ws + WS_PAR) + PAR_QG; const float* kg = (const float*)(a.ws + WS_PAR) + PAR_KG;
    LAS float* qsh = (LAS float*)lds + wave * 128;
    LAS float* kgs = (LAS float*)lds + 8 * 128;
    if (tid < 128) kgs[tid] = kg[tid];
    __syncthreads();
    for (int it = gwave; it < M * 4; it += ngwave) {
        const int row = it >> 2, j = it & 3, t = row & (SEQ - 1);
        { const unsigned qq = *(const unsigned*)(QKV + (size_t)row * 1536 + j * 128 + 2 * lane);
          float q0 = bfl(qq), q1 = bfh(qq);
          const float ss = wave_sum(q0 * q0 + q1 * q1); const float rn = __builtin_amdgcn_rsqf(ss * (1.f / 128.f) + 1e-6f);
          q0 *= rn * qg[2 * lane]; q1 *= rn * qg[2 * lane + 1];
          const float p0 = __shfl_xor(q0, 8), p1 = __shfl_xor(q1, 8);
          if (lane < 16) { const int i0 = (2 * lane) & 15; const float c0 = rope[(t * 16 + i0) * 2], s0 = rope[(t * 16 + i0) * 2 + 1], c1 = rope[(t * 16 + i0 + 1) * 2], s1 = rope[(t * 16 + i0 + 1) * 2 + 1];
              if (lane < 8) { q0 = q0 * c0 - p0 * s0; q1 = q1 * c1 - p1 * s1; } else { q0 = q0 * c0 + p0 * s0; q1 = q1 * c1 + p1 * s1; } }
          qsh[2 * lane] = q0; qsh[2 * lane + 1] = q1; }
        LDS_WAIT(); asm volatile("" ::: "memory");
        float sc[3];
#pragma unroll
        for (int c = 0; c < 3; ++c) { const int i = lane + 64 * c; const int s = t - i * d; sc[c] = -INFINITY;
            if (i <= 128 && s >= 0) { const bf16* kr = QKV + (size_t)(row - i * d) * 1536 + 512 + j * 128;
                float ss = 0.f, dot = 0.f; float kx[32];
#pragma unroll
                for (int e8 = 0; e8 < 16; ++e8) { const v4u kv = *(const v4u*)(kr + e8 * 8);
                    float kf[8] = {bfl(kv.x), bfh(kv.x), bfl(kv.y), bfh(kv.y), bfl(kv.z), bfh(kv.z), bfl(kv.w), bfh(kv.w)};
#pragma unroll
                    for (int u = 0; u < 8; ++u) { ss += kf[u] * kf[u]; const int e = e8 * 8 + u; if (e < 32) kx[e] = kf[u] * kgs[e]; else dot += qsh[e] * kf[u] * kgs[e]; } }
#pragma unroll
                for (int i2 = 0; i2 < 16; ++i2) { const float cs = rope[(s * 16 + i2) * 2], sn = rope[(s * 16 + i2) * 2 + 1];
                    dot += qsh[i2] * (kx[i2] * cs - kx[i2 + 16] * sn) + qsh[i2 + 16] * (kx[i2 + 16] * cs + kx[i2] * sn); }
                sc[c] = dot * __builtin_amdgcn_rsqf(ss * (1.f / 128.f) + 1e-6f) * 0.08838834764831845f; } }
        const float mx = wave_max(fmaxf(fmaxf(sc[0], sc[1]), sc[2]));
        float p[3]; float ls = 0.f;
#pragma unroll
        for (int c = 0; c < 3; ++c) { p[c] = expf(sc[c] - mx); ls += p[c]; }
        ls = wave_sum(ls);
        float lse = mx + logf(ls);
        float o0 = 0.f, o1 = 0.f;
        const int imax = (t / d < 128) ? (t / d) : 128;
        for (int i = 0; i <= imax; ++i) { const float psel = (i < 64) ? p[0] : ((i < 128) ? p[1] : p[2]); const float pi = __shfl(psel, i & 63);
            const unsigned vv = *(const unsigned*)(QKV + (size_t)(row - i * d) * 1536 + 1024 + j * 128 + 2 * lane);
            o0 += pi * bfl(vv); o1 += pi * bfh(vv); }
        const float il = 1.f / ls; o0 *= il; o1 *= il;
        if (g > 0) { const float lo = LSE[(size_t)row * 4 + j]; const unsigned ov = *(const unsigned*)(Ao + (size_t)row * 512 + j * 128 + 2 * lane);
            const float mm = fmaxf(lo, lse); const float wo = expf(lo - mm), wn = expf(lse - mm); const float inv = 1.f / (wo + wn);
            o0 = (wo * bfl(ov) + wn * o0) * inv; o1 = (wo * bfh(ov) + wn * o1) * inv; lse = mm + logf(wo + wn); }
        *(unsigned*)(Ao + (size_t)row * 512 + j * 128 + 2 * lane) = pk2(o0, o1);
        if (lane == 0) LSE[(size_t)row * 4 + j] = lse;
    }
    __syncthreads();
}


typedef short bf16x8_t __attribute__((ext_vector_type(8)));
typedef short v4i16_t __attribute__((ext_vector_type(4)));
constexpr int TP = 288, TILE_B = 128 * TP;
#define LANE_ID_F() ({ int _l; asm volatile("v_mbcnt_lo_u32_b32 %0, -1, 0\n\tv_mbcnt_hi_u32_b32 %0, -1, %0" : "=v"(_l)); _l; })
__device__ __forceinline__ bf16x8_t trpair(const LAS unsigned char* pa, const LAS unsigned char* pb) {
    const v4i16_t lo = __builtin_amdgcn_ds_read_tr16_b64_v4i16((LAS v4i16_t*)pa), hi = __builtin_amdgcn_ds_read_tr16_b64_v4i16((LAS v4i16_t*)pb);
    return (bf16x8_t){lo[0], lo[1], lo[2], lo[3], hi[0], hi[1], hi[2], hi[3]};
}
__device__ __forceinline__ void unpack8(const v4u v, float (&f)[8]) { f[0] = bfl(v.x); f[1] = bfh(v.x); f[2] = bfl(v.y); f[3] = bfh(v.y); f[4] = bfl(v.z); f[5] = bfh(v.z); f[6] = bfl(v.w); f[7] = bfh(v.w); }
__device__ __forceinline__ v4u pack8(const float (&f)[8]) { v4u w; w.x = pg8::cvt_pk_bf16(f[0], f[1]); w.y = pg8::cvt_pk_bf16(f[2], f[3]); w.z = pg8::cvt_pk_bf16(f[4], f[5]); w.w = pg8::cvt_pk_bf16(f[6], f[7]); return w; }

typedef float f2_t __attribute__((ext_vector_type(2)));
__device__ __forceinline__ v4u f8to16(const v2u q) {
    const f2_t a_ = __builtin_amdgcn_cvt_pk_f32_fp8((int)q.x, false), b_ = __builtin_amdgcn_cvt_pk_f32_fp8((int)q.x, true), c_ = __builtin_amdgcn_cvt_pk_f32_fp8((int)q.y, false), d_ = __builtin_amdgcn_cvt_pk_f32_fp8((int)q.y, true);
    v4u o_; o_.x = pg8::cvt_pk_bf16(a_[0], a_[1]); o_.y = pg8::cvt_pk_bf16(b_[0], b_[1]); o_.z = pg8::cvt_pk_bf16(c_[0], c_[1]); o_.w = pg8::cvt_pk_bf16(d_[0], d_[1]); return o_; }
__device__ __forceinline__ void attn_fast(unsigned char* ws, const unsigned short* QKV, LAS unsigned char* lds, const int g, const int wave, const int vcu, const int G) {
    const int lane = LANE_ID_F(), tid = wave * 64 + lane, fr = lane & 15, fq = lane >> 4;
    const int lgd = 2 * g, d = 1 << lgd, lgseg = 4 - lgd;
    bf16* Ao = (bf16*)(ws + WS_A); float* LSE = (float*)(ws + WS_LSE);
    const int srow = tid >> 4, c = tid & 15;
    for (int seg = vcu; seg < 256; seg += G) {
        const int stream = seg >> lgseg, n0 = (seg & ((1 << lgseg) - 1)) * 4;
        const int r = stream & (d - 1), j = (stream >> lgd) & 3, b = stream >> (lgd + 2);
        const size_t rowbase = (size_t)b * SEQ + r;
        v2u kreg[4], vreg[4], qraw[4]; bf16x8_t qf[4];
        v2u aold[8]; float lold = 0.f;
#define AT_LOADKV(n) do { _Pragma("unroll") for (int i = 0; i < 4; ++i) { const unsigned char* p_ = (const unsigned char*)QKV + (rowbase + (size_t)((n) * 128 + srow + 32 * i) * d) * 1536 + j * 128 + c * 8; \
            kreg[i] = *(const v2u*)(p_ + 512); vreg[i] = *(const v2u*)(p_ + 1024); } } while (0)
#define AT_LOADQ(n) do { const unsigned char* p_ = (const unsigned char*)QKV + (rowbase + (size_t)((n) * 128 + wave * 16 + fr) * d) * 1536 + j * 128 + fq * 8; \
            _Pragma("unroll") for (int ds = 0; ds < 4; ++ds) qraw[ds] = *(const v2u*)(p_ + ds * 32); } while (0)
        if (n0 > 0) AT_LOADKV(n0 - 1);
#pragma unroll 1
        for (int it = -1; it < 4; ++it) {
            const int n = n0 + it;
            __syncthreads();
            if (it >= 0) {
#pragma unroll
                for (int ds = 0; ds < 4; ++ds) qf[ds] = __builtin_bit_cast(bf16x8_t, f8to16(qraw[ds]));
            }
            { LAS unsigned char* kt = lds + (n & 1) * TILE_B; LAS unsigned char* vt = lds + (2 + (n & 1)) * TILE_B;
              if (n >= 0) {
#pragma unroll
                for (int i = 0; i < 4; ++i) { *(LAS v4u*)(kt + (srow + 32 * i) * TP + c * 16) = f8to16(kreg[i]); *(LAS v4u*)(vt + (srow + 32 * i) * TP + c * 16) = f8to16(vreg[i]); }
              } else {
#pragma unroll
                for (int i = 0; i < 4; ++i) { *(LAS v4u*)(kt + (srow + 32 * i) * TP + c * 16) = (v4u){0u, 0u, 0u, 0u}; *(LAS v4u*)(vt + (srow + 32 * i) * TP + c * 16) = (v4u){0u, 0u, 0u, 0u}; }
              } }
            const size_t qrow = rowbase + (size_t)(n * 128 + wave * 16 + fr) * d;
            bf16* ap = Ao + qrow * 512 + j * 128 + 4 * fq;
            if (it >= 0 && g > 0) {
#pragma unroll
                for (int db = 0; db < 8; ++db) aold[db] = *(const v2u*)(ap + db * 16);
                lold = LSE[qrow * 4 + j]; }
            if (it < 3) { AT_LOADKV(n + 1); AT_LOADQ(n + 1); }
            __syncthreads();
            if (it >= 0) {
                const int kb0 = (wave < 6) ? wave : 6;
                const int slot_prev = (n + 1) & 1, slot_cur = n & 1;
                f32x4 sacc[10];
#pragma unroll
                for (int bp = 0; bp < 5; ++bp) {
                    bf16x8_t kfr[2][4];
#pragma unroll
                    for (int h2 = 0; h2 < 2; ++h2) { const int kb = kb0 + 2 * bp + h2; const int slot = (kb < 8) ? slot_prev : slot_cur;
                        const LAS unsigned char* kp = lds + slot * TILE_B + ((kb & 7) * 16 + fr) * TP + fq * 16;
#pragma unroll
                        for (int ds = 0; ds < 4; ++ds) kfr[h2][ds] = *(const LAS bf16x8_t*)(kp + ds * 64); }
#pragma unroll
                    for (int h2 = 0; h2 < 2; ++h2) { f32x4 a_ = (f32x4){0.f, 0.f, 0.f, 0.f};
#pragma unroll
                        for (int ds = 0; ds < 4; ++ds) a_ = __builtin_amdgcn_mfma_f32_16x16x32_bf16(kfr[h2][ds], qf[ds], a_, 0, 0, 0);
                        sacc[2 * bp + h2] = a_; } }
                const int qi = wave * 16 + fr; float mx = -1e30f;
#pragma unroll
                for (int bb = 0; bb < 10; ++bb) {
                    if (bb < 2 || bb > 7) {
#pragma unroll
                        for (int rg = 0; rg < 4; ++rg) { const int kj = (kb0 + bb) * 16 + 4 * fq + rg; const bool ok = (kj >= qi) && (kj <= qi + 128); sacc[bb][rg] = ok ? sacc[bb][rg] : -1e30f; } }
                    if (n == 0) {
#pragma unroll
                        for (int rg = 0; rg < 4; ++rg) { const int kj = (kb0 + bb) * 16 + 4 * fq + rg; sacc[bb][rg] = (kj >= 128) ? sacc[bb][rg] : -1e30f; } }
#pragma unroll
                    for (int rg = 0; rg < 4; ++rg) mx = fmaxf(mx, sacc[bb][rg]); }
                mx = pg8::xmax_16_32(mx);
                float l = 0.f;
#pragma unroll
                for (int bb = 0; bb < 10; ++bb)
#pragma unroll
                    for (int rg = 0; rg < 4; ++rg) { const float p_ = __builtin_amdgcn_exp2f(sacc[bb][rg] - mx); sacc[bb][rg] = p_; l += p_; }
                l = pg8::xsum_16_32(l);
                f32x4 oacc[8];
#pragma unroll
                for (int db = 0; db < 8; ++db) oacc[db] = (f32x4){0.f, 0.f, 0.f, 0.f};
                const int trq = (lane & 15) >> 2, trp = lane & 3;
#pragma unroll
                for (int sg = 0; sg < 5; ++sg) { const int kbA = kb0 + 2 * sg, kbB = kbA + 1;
                    v4u pw; pw.x = pg8::cvt_pk_bf16(sacc[2 * sg][0], sacc[2 * sg][1]); pw.y = pg8::cvt_pk_bf16(sacc[2 * sg][2], sacc[2 * sg][3]);
                    pw.z = pg8::cvt_pk_bf16(sacc[2 * sg + 1][0], sacc[2 * sg + 1][1]); pw.w = pg8::cvt_pk_bf16(sacc[2 * sg + 1][2], sacc[2 * sg + 1][3]);
                    const bf16x8_t pf = __builtin_bit_cast(bf16x8_t, pw);
                    const LAS unsigned char* va = lds + (2 + ((kbA < 8) ? slot_prev : slot_cur)) * TILE_B + ((kbA & 7) * 16 + 4 * fq + trq) * TP + trp * 8;
                    const LAS unsigned char* vb = lds + (2 + ((kbB < 8) ? slot_prev : slot_cur)) * TILE_B + ((kbB & 7) * 16 + 4 * fq + trq) * TP + trp * 8;
                    bf16x8_t vfr[8];
#pragma unroll
                    for (int db = 0; db < 8; ++db) vfr[db] = trpair(va + db * 32, vb + db * 32);
#pragma unroll
                    for (int db = 0; db < 8; ++db) oacc[db] = __builtin_amdgcn_mfma_f32_16x16x32_bf16(vfr[db], pf, oacc[db], 0, 0, 0); }
                const float il = __builtin_amdgcn_rcpf(l); float lse = mx * 0.6931471805599453f + __logf(l);
                float wo = 0.f, wn = il;
                if (g > 0) { const float mm = fmaxf(lold, lse); const float eo = __expf(lold - mm), en = __expf(lse - mm); const float inv = __builtin_amdgcn_rcpf(eo + en);
                    wo = eo * inv; wn = en * inv * il; lse = mm + __logf(eo + en); }
#pragma unroll
                for (int db = 0; db < 8; ++db) { float o0 = oacc[db][0] * wn, o1 = oacc[db][1] * wn, o2 = oacc[db][2] * wn, o3 = oacc[db][3] * wn;
                    if (g > 0) { const v2u old = aold[db]; o0 += wo * bfl(old.x); o1 += wo * bfh(old.x); o2 += wo * bfl(old.y); o3 += wo * bfh(old.y); }
                    v2u w_; w_.x = pg8::cvt_pk_bf16(o0, o1); w_.y = pg8::cvt_pk_bf16(o2, o3); *(v2u*)(ap + db * 16) = w_; }
                if (fq == 0) LSE[qrow * 4 + j] = lse;
            }
        }
#undef AT_LOADKV
#undef AT_LOADQ
    }
    __syncthreads();
}

constexpr size_t WS_MSC = 496 * MiB;
constexpr size_t WS_CPB = WS_A;
constexpr int GSM_OFF = 4 * TILE_B;
__device__ __forceinline__ float log_sigmoid_(float x) { return fminf(x, 0.f) - log1pf(__expf(-fabsf(x))); }
__device__ __forceinline__ void conv_load(v4u (&raw)[4], const bf16* ML, size_t grow, int tpos, int col) {
#pragma unroll
    for (int jt = 0; jt < 4; ++jt) { const bool ok = (tpos - 3 + jt >= 0); raw[jt] = *(const v4u*)(ML + (ok ? (grow - 3 + jt) : grow) * 2048 + col); }
}
__device__ __forceinline__ void conv_apply(const v4u (&raw)[4], int tpos, const float (&w)[4][8], const float (&bs)[8], float (&o)[8]) {
#pragma unroll
    for (int u = 0; u < 8; ++u) o[u] = bs[u];
#pragma unroll
    for (int jt = 0; jt < 4; ++jt) { const float msk = (tpos - 3 + jt >= 0) ? 1.f : 0.f; float x[8]; unpack8(raw[jt], x);
#pragma unroll
        for (int u = 0; u < 8; ++u) o[u] += (w[jt][u] * msk) * x[u]; }
#pragma unroll
    for (int u = 0; u < 8; ++u) o[u] = o[u] * sigmoidf_(o[u]);
}
__device__ __forceinline__ void conv_piece(const bf16* ML, size_t grow, int tpos, int col, const float (&w)[4][8], const float (&bs)[8], float (&o)[8]) {
    v4u raw[4];
#pragma unroll
    for (int jt = 0; jt < 4; ++jt) { const bool ok = (tpos - 3 + jt >= 0); raw[jt] = *(const v4u*)(ML + (ok ? (grow - 3 + jt) : grow) * 2048 + col); }
#pragma unroll
    for (int u = 0; u < 8; ++u) o[u] = bs[u];
#pragma unroll
    for (int jt = 0; jt < 4; ++jt) { const float msk = (tpos - 3 + jt >= 0) ? 1.f : 0.f; float x[8]; unpack8(raw[jt], x);
#pragma unroll
        for (int u = 0; u < 8; ++u) o[u] += (w[jt][u] * msk) * x[u]; }
#pragma unroll
    for (int u = 0; u < 8; ++u) o[u] = o[u] * sigmoidf_(o[u]);
}
__device__ __forceinline__ float wave_scan_add(float v, int lane) {
#pragma unroll
    for (int o = 1; o < 64; o <<= 1) { const float t = __shfl_up(v, o); if (lane >= o) v += t; }
    return v;
}
__device__ __forceinline__ float wave_scan_max(float v, int lane) {
#pragma unroll
    for (int o = 1; o < 64; o <<= 1) { const float t = __shfl_up(v, o); if (lane >= o) v = fmaxf(v, t); }
    return v;
}
__device__ __forceinline__ void mlstm_b1(unsigned char* ws, LAS unsigned char* lds, const int wave, const int vcu, const int G) {
    const int lane = LANE_ID_F(), tid = wave * 64 + lane, fq = lane >> 4;
    const bf16* ML = (const bf16*)(ws + WS_ML); const float* GT = (const float*)(ws + WS_GATES); const float* par = (const float*)(ws + WS_PAR);
    float* MST = (float*)(ws + WS_MST); float* MSC = (float*)(ws + WS_MSC);
    LAS float* gsm = (LAS float*)(lds + GSM_OFF);
    LAS unsigned char* kt = lds; LAS unsigned char* vt = lds + TILE_B; LAS float* dnp = (LAS float*)(lds + 2 * TILE_B);
    const int srow = tid >> 4, c = tid & 15;
    struct B1Pre { v4u vr[4]; v4u raw[4][4]; };
#define B1_LOAD(P, item_) do { const int bh_ = (item_) >> 6, ch_ = (item_) & 63, h_ = bh_ & 3; const size_t r0_ = (size_t)(bh_ >> 2) * SEQ + ch_ * 128; \
        _Pragma("unroll") for (int i = 0; i < 4; ++i) { const int sr_ = srow + 32 * i; (P).vr[i] = *(const v4u*)(ML + (r0_ + sr_) * 2048 + 1024 + h_ * 128 + c * 8); conv_load((P).raw[i], ML, r0_ + sr_, ch_ * 128 + sr_, 512 + h_ * 128 + c * 8); } } while (0)
    for (int base = 0; base < 1024; base += 4 * G) {
        B1Pre cur_;
        if (base + vcu < 1024) B1_LOAD(cur_, base + vcu);
        __syncthreads();
        { const int k = tid >> 7, s_ = tid & 127, it_ = base + vcu + G * k; const bool ok = it_ < 1024; const int itc = ok ? it_ : 0;
          const int bh = itc >> 6, ch = itc & 63, h = bh & 3; const size_t r = (size_t)(bh >> 2) * SEQ + ch * 128 + s_;
          const float lf = log_sigmoid_(GT[r * 8 + 4 + h] + par[PAR_FB + h]), li = GT[r * 8 + h] + par[PAR_IB + h];
          float b_ = wave_scan_add(lf, lane);
          if (lane == 63) gsm[1664 + wave] = b_;
          __syncthreads();
          if (wave & 1) b_ += gsm[1664 + wave - 1];
          const float bL = gsm[1664 + 2 * k] + gsm[1664 + 2 * k + 1];
          const float g_ = bL - b_ + li;
          const float mw = wave_max(g_);
          if (lane == 0) gsm[1680 + wave] = mw;
          __syncthreads();
          const float mloc = fmaxf(gsm[1680 + 2 * k], gsm[1680 + 2 * k + 1]);
          gsm[k * 128 + s_] = __expf(g_ - mloc);
          if (s_ == 0) { gsm[1696 + k] = mloc; gsm[1700 + k] = bL; }
        }
        __syncthreads();
#pragma unroll 1
        for (int k = 0; k < 4; ++k) { const int item = base + vcu + G * k; if (item >= 1024) break;
            const int bh = item >> 6, ch = item & 63, h = bh & 3; const size_t row0 = (size_t)(bh >> 2) * SEQ + ch * 128;
            if (k > 0) __syncthreads();
            { float w[4][8], bs[8]; const int col = 512 + h * 128 + c * 8;
#pragma unroll
              for (int jt = 0; jt < 4; ++jt)
#pragma unroll
                  for (int u = 0; u < 8; ++u) w[jt][u] = par[PAR_CW + jt * 1024 + col + u];
#pragma unroll
              for (int u = 0; u < 8; ++u) bs[u] = par[PAR_CB + col + u];
              float dn[8];
#pragma unroll
              for (int u = 0; u < 8; ++u) dn[u] = 0.f;
#pragma unroll
              for (int i = 0; i < 4; ++i) { const int sr = srow + 32 * i; float o[8]; conv_apply(cur_.raw[i], ch * 128 + sr, w, bs, o);
                  const float sc = 0.08838834764831845f * gsm[k * 128 + sr];
#pragma unroll
                  for (int u = 0; u < 8; ++u) { o[u] *= sc; dn[u] += o[u]; }
                  *(LAS v4u*)(kt + sr * TP + c * 16) = pack8(o);
                  *(LAS v4u*)(vt + sr * TP + c * 16) = cur_.vr[i]; }
#pragma unroll
              for (int u = 0; u < 8; ++u) dnp[srow * 128 + c * 8 + u] = dn[u]; }
            __syncthreads();
            if (tid < 128) { float a_ = 0.f;
#pragma unroll 8
                for (int r = 0; r < 32; ++r) a_ += dnp[r * 128 + tid];
                MSC[(size_t)item * 256 + tid] = a_; }
            if (tid == 0) { MSC[(size_t)item * 256 + 128] = gsm[1696 + k]; MSC[(size_t)item * 256 + 129] = gsm[1700 + k]; }
            { const int nitem = item + G; if (k < 3 && nitem < 1024) B1_LOAD(cur_, nitem); }
            { const int trq = (lane & 15) >> 2, trp = lane & 3; f32x4 acc[8];
#pragma unroll
              for (int fb = 0; fb < 8; ++fb) acc[fb] = (f32x4){0.f, 0.f, 0.f, 0.f};
#pragma unroll
              for (int ks = 0; ks < 4; ++ks) { const int ra = ks * 32 + 4 * fq + trq;
                  const bf16x8_t kf = trpair(kt + ra * TP + (wave * 16 + 4 * trp) * 2, kt + (ra + 16) * TP + (wave * 16 + 4 * trp) * 2);
                  bf16x8_t vfr[8];
#pragma unroll
                  for (int fb = 0; fb < 8; ++fb) vfr[fb] = trpair(vt + ra * TP + (fb * 16 + 4 * trp) * 2, vt + (ra + 16) * TP + (fb * 16 + 4 * trp) * 2);
#pragma unroll
                  for (int fb = 0; fb < 8; ++fb) acc[fb] = __builtin_amdgcn_mfma_f32_16x16x32_bf16(vfr[fb], kf, acc[fb], 0, 0, 0); }
              float* dst = MST + (size_t)item * 16384 + (size_t)(wave * 16 + (lane & 15)) * 128 + 4 * fq;
#pragma unroll
              for (int fb = 0; fb < 8; ++fb) *(f32x4*)(dst + fb * 16) = acc[fb]; }
        }
    }
    __syncthreads();
}
__device__ __forceinline__ void mlstm_b2(unsigned char* ws, const int wave, const int vcu, const int G) {
    const int lane = LANE_ID_F(), tid = wave * 64 + lane;
    const float* MST = (const float*)(ws + WS_MST); float* MSC = (float*)(ws + WS_MSC); unsigned* CPB = (unsigned*)(ws + WS_CPB);
    typedef float f32x2 __attribute__((ext_vector_type(2)));
    for (int gid = vcu * NTHREADS + tid; gid < 16 * 8192; gid += G * NTHREADS) {
        const int bh = gid >> 13, rem = gid & 8191;
        float m = 0.f; f32x2 C = {0.f, 0.f}, nn = {0.f, 0.f};
        const f32x2* p = (const f32x2*)(MST + (size_t)bh * 64 * 16384) + rem; unsigned* cp = CPB + (size_t)bh * 64 * 8192 + rem; float* sc = MSC + (size_t)bh * 64 * 256;
#pragma unroll 1
        for (int c0 = 0; c0 < 64; c0 += 16) {
            f32x2 dv[16], dn[16]; float ml[16], bl[16];
#pragma unroll
            for (int k = 0; k < 16; ++k) { dv[k] = p[(size_t)(c0 + k) * 8192]; ml[k] = sc[(c0 + k) * 256 + 128]; bl[k] = sc[(c0 + k) * 256 + 129]; if (rem < 64) dn[k] = *(const f32x2*)(sc + (c0 + k) * 256 + 2 * rem); }
#pragma unroll
            for (int k = 0; k < 16; ++k) { const float mn = fmaxf(bl[k] + m, ml[k]); const float sp = __expf(bl[k] + m - mn), sn = __expf(ml[k] - mn);
                cp[(size_t)(c0 + k) * 8192] = pg8::cvt_pk_bf16(C[0], C[1]); C = C * sp + dv[k] * sn;
                if (rem < 64) { *(f32x2*)(sc + (c0 + k) * 256 + 2 * rem) = nn; nn = nn * sp + dn[k] * sn; }
                if (rem == 0) sc[(c0 + k) * 256 + 130] = m;
                m = mn; }
        }
    }
}
__device__ __forceinline__ void mlstm_b3(unsigned char* ws, const unsigned char* MO8, LAS unsigned char* lds, const int wave, const int vcu, const int G) {
    const int lane = LANE_ID_F(), tid = wave * 64 + lane, fr = lane & 15, fq = lane >> 4;
    const bf16* ML = (const bf16*)(ws + WS_ML); const float* GT = (const float*)(ws + WS_GATES); const float* par = (const float*)(ws + WS_PAR);
    const bf16* CPBr = (const bf16*)(ws + WS_CPB); const float* MSC = (const float*)(ws + WS_MSC); bf16* BMo = (bf16*)(ws + WS_BM);
    LAS float* gsm = (LAS float*)(lds + GSM_OFF);
    LAS unsigned char* qt = lds; LAS unsigned char* kt = lds + TILE_B; LAS unsigned char* vt = lds + 2 * TILE_B; LAS unsigned char* ct = lds + 3 * TILE_B;
    const int srow = tid >> 4, c = tid & 15;
    struct B3Pre { v4u vr[4], cr[4]; };
#define B3_LOAD(P, item_) do { const int bh_ = (item_) >> 6, ch_ = (item_) & 63, h_ = bh_ & 3; const size_t r0_ = (size_t)(bh_ >> 2) * SEQ + ch_ * 128; \
        _Pragma("unroll") for (int i = 0; i < 4; ++i) { const int sr_ = srow + 32 * i; (P).vr[i] = *(const v4u*)(ML + (r0_ + sr_) * 2048 + 1024 + h_ * 128 + c * 8); (P).cr[i] = *(const v4u*)(CPBr + (size_t)(item_) * 16384 + sr_ * 128 + c * 8); \
            } } while (0)
    for (int base = 0; base < 1024; base += 4 * G) {
        B3Pre cur_;
        if (base + vcu < 1024) B3_LOAD(cur_, base + vcu);
        __syncthreads();
        { const int k = tid >> 7, s_ = tid & 127, it_ = base + vcu + G * k; const bool ok = it_ < 1024; const int itc = ok ? it_ : 0;
          const int bh = itc >> 6, ch = itc & 63, h = bh & 3; const size_t r = (size_t)(bh >> 2) * SEQ + ch * 128 + s_;
          const float lf = log_sigmoid_(GT[r * 8 + 4 + h] + par[PAR_FB + h]), li = GT[r * 8 + h] + par[PAR_IB + h];
          const float mprev = MSC[(size_t)itc * 256 + 130];
          float b_ = wave_scan_add(lf, lane);
          if (lane == 63) gsm[1664 + wave] = b_;
          __syncthreads();
          if (wave & 1) b_ += gsm[1664 + wave - 1];
          const float a_ = li - b_;
          float cm = wave_scan_max(a_, lane);
          if (lane == 63) gsm[1680 + wave] = cm;
          __syncthreads();
          if (wave & 1) cm = fmaxf(cm, gsm[1680 + wave - 1]);
          const float Mt = fmaxf(mprev, cm);
          gsm[k * 128 + s_] = a_; gsm[512 + k * 128 + s_] = Mt; gsm[1024 + k * 128 + s_] = b_ + Mt;
          if (s_ == 0) gsm[1696 + k] = mprev;
        }
        __syncthreads();
#pragma unroll 1
        for (int k = 0; k < 4; ++k) { const int item = base + vcu + G * k; if (item >= 1024) break;
            const int bh = item >> 6, ch = item & 63, h = bh & 3; const size_t row0 = (size_t)(bh >> 2) * SEQ + ch * 128;
            if (k > 0) __syncthreads();
            const float mprev = gsm[1696 + k];
            if (tid < 128) gsm[1536 + tid] = MSC[(size_t)item * 256 + tid];
            {
#pragma unroll
              for (int which = 0; which < 2; ++which) { float w[4][8], bs[8]; const int col = which * 512 + h * 128 + c * 8; LAS unsigned char* dt = which ? kt : qt; const float sc = which ? 0.08838834764831845f : 1.0f;
#pragma unroll
                for (int jt = 0; jt < 4; ++jt)
#pragma unroll
                    for (int u = 0; u < 8; ++u) w[jt][u] = par[PAR_CW + jt * 1024 + col + u];
#pragma unroll
                for (int u = 0; u < 8; ++u) bs[u] = par[PAR_CB + col + u];
#pragma unroll
                for (int i = 0; i < 4; ++i) { const int sr = srow + 32 * i; float o[8]; conv_piece(ML, row0 + sr, ch * 128 + sr, col, w, bs, o);
#pragma unroll
                    for (int u = 0; u < 8; ++u) o[u] *= sc;
                    *(LAS v4u*)(dt + sr * TP + c * 16) = pack8(o); } }
#pragma unroll
              for (int i = 0; i < 4; ++i) { const int sr = srow + 32 * i; *(LAS v4u*)(vt + sr * TP + c * 16) = cur_.vr[i]; *(LAS v4u*)(ct + sr * TP + c * 16) = cur_.cr[i]; } }
            { const int nitem = item + G; if (k < 3 && nitem < 1024) B3_LOAD(cur_, nitem); }
            __syncthreads();
            { const int trq = (lane & 15) >> 2, trp = lane & 3;
              bf16x8_t qf[4];
#pragma unroll
              for (int ds = 0; ds < 4; ++ds) qf[ds] = *(const LAS bf16x8_t*)(qt + (wave * 16 + fr) * TP + ds * 64 + fq * 16);
              const int t = wave * 16 + fr; const float Mt = gsm[512 + k * 128 + t], mt = gsm[1024 + k * 128 + t]; const float dec = __expf(mprev - Mt);
              const size_t orow = row0 + t;
              unsigned og[8];
#pragma unroll
              for (int fb = 0; fb < 8; ++fb) og[fb] = *(const unsigned*)(MO8 + orow * 512 + h * 128 + fb * 16 + 4 * fq);
              f32x4 acc[8];
#pragma unroll
              for (int fb = 0; fb < 8; ++fb) acc[fb] = (f32x4){0.f, 0.f, 0.f, 0.f};
#pragma unroll
              for (int ds = 0; ds < 4; ++ds) { const int ra = ds * 32 + 8 * fq + trq;
                  bf16x8_t cfr[8];
#pragma unroll
                  for (int fb = 0; fb < 8; ++fb) cfr[fb] = trpair(ct + ra * TP + (fb * 16 + 4 * trp) * 2, ct + (ra + 4) * TP + (fb * 16 + 4 * trp) * 2);
#pragma unroll
                  for (int fb = 0; fb < 8; ++fb) acc[fb] = __builtin_amdgcn_mfma_f32_16x16x32_bf16(cfr[fb], qf[ds], acc[fb], 0, 0, 0); }
              float qn = 0.f;
#pragma unroll
              for (int ds = 0; ds < 4; ++ds) { float qv[8]; unpack8(__builtin_bit_cast(v4u, qf[ds]), qv); const f32x4 n0 = *(const LAS f32x4*)(gsm + 1536 + ds * 32 + fq * 8), n1 = *(const LAS f32x4*)(gsm + 1536 + ds * 32 + fq * 8 + 4);
#pragma unroll
                  for (int u = 0; u < 4; ++u) qn += qv[u] * n0[u] + qv[4 + u] * n1[u]; }
              qn = pg8::xsum_16_32(qn);
#pragma unroll
              for (int fb = 0; fb < 8; ++fb) acc[fb] *= dec;
              f32x4 sacc[8]; float dsum = 0.f;
#pragma unroll
              for (int sb = 0; sb < 8; ++sb) { sacc[sb] = (f32x4){0.f, 0.f, 0.f, 0.f};
                  if (sb <= wave) {
                      bf16x8_t kfr[4];
#pragma unroll
                      for (int ds = 0; ds < 4; ++ds) kfr[ds] = *(const LAS bf16x8_t*)(kt + (sb * 16 + fr) * TP + ds * 64 + fq * 16);
#pragma unroll
                      for (int ds = 0; ds < 4; ++ds) sacc[sb] = __builtin_amdgcn_mfma_f32_16x16x32_bf16(kfr[ds], qf[ds], sacc[sb], 0, 0, 0);
                      const f32x4 a4 = *(const LAS f32x4*)(gsm + k * 128 + sb * 16 + 4 * fq);
#pragma unroll
                      for (int rg = 0; rg < 4; ++rg) { const int s_ = sb * 16 + 4 * fq + rg; const float p_ = (s_ <= t) ? sacc[sb][rg] * __expf(a4[rg] - Mt) : 0.f; sacc[sb][rg] = p_; dsum += p_; } } }
              dsum = pg8::xsum_16_32(dsum);
#pragma unroll
              for (int ks = 0; ks < 4; ++ks) { if (2 * ks <= wave) {
                  v4u pw; pw.x = pg8::cvt_pk_bf16(sacc[2 * ks][0], sacc[2 * ks][1]); pw.y = pg8::cvt_pk_bf16(sacc[2 * ks][2], sacc[2 * ks][3]);
                  pw.z = pg8::cvt_pk_bf16(sacc[2 * ks + 1][0], sacc[2 * ks + 1][1]); pw.w = pg8::cvt_pk_bf16(sacc[2 * ks + 1][2], sacc[2 * ks + 1][3]);
                  const bf16x8_t pf = __builtin_bit_cast(bf16x8_t, pw); const int ra = ks * 32 + 4 * fq + trq;
                  bf16x8_t vfr[8];
#pragma unroll
                  for (int fb = 0; fb < 8; ++fb) vfr[fb] = trpair(vt + ra * TP + (fb * 16 + 4 * trp) * 2, vt + (ra + 16) * TP + (fb * 16 + 4 * trp) * 2);
#pragma unroll
                  for (int fb = 0; fb < 8; ++fb) acc[fb] = __builtin_amdgcn_mfma_f32_16x16x32_bf16(vfr[fb], pf, acc[fb], 0, 0, 0); } }
              const float den = dec * qn + dsum; const float inv = __builtin_amdgcn_rcpf(fmaxf(fabsf(den), __expf(-mt)));
#pragma unroll
              for (int fb = 0; fb < 8; ++fb) {
                  const float i5 = inv * (1.0f / 255.0f); const unsigned o8 = og[fb];
                  v2u w_; w_.x = pg8::cvt_pk_bf16((float)(o8 & 255u) * acc[fb][0] * i5, (float)((o8 >> 8) & 255u) * acc[fb][1] * i5);
                  w_.y = pg8::cvt_pk_bf16((float)((o8 >> 16) & 255u) * acc[fb][2] * i5, (float)(o8 >> 24) * acc[fb][3] * i5);
                  *(v2u*)(BMo + orow * 512 + h * 128 + fb * 16 + 4 * fq) = w_; } }
        }
    }
    __syncthreads();
}

template <int NR> __device__ __forceinline__ void quant_rows_i8(const bf16* const (&src)[NR], unsigned char* const (&dst)[NR], float* const (&sc)[NR], int lane) {
    v4u ra[NR], rb[NR];
#pragma unroll
    for (int q = 0; q < NR; ++q) { ra[q] = *(const v4u*)(src[q] + lane * 16); rb[q] = *(const v4u*)(src[q] + lane * 16 + 8); }
#pragma unroll
    for (int q = 0; q < NR; ++q) { float f[16];
        { float t0[8], t1[8]; unpack8(ra[q], t0); unpack8(rb[q], t1);
#pragma unroll
          for (int u = 0; u < 8; ++u) { f[u] = t0[u]; f[8 + u] = t1[u]; } }
        float am = 0.f;
#pragma unroll
        for (int u = 0; u < 16; ++u) am = fmaxf(am, fabsf(f[u]));
        am = wave_max(am);
        const float inv = (am > 0.f) ? 127.0f / am : 0.f;
        unsigned w[4];
#pragma unroll
        for (int d4 = 0; d4 < 4; ++d4) { unsigned p = 0u;
#pragma unroll
            for (int u = 0; u < 4; ++u) { const int qi = (int)__builtin_rintf(f[d4 * 4 + u] * inv); p |= ((unsigned)qi & 255u) << (8 * u); }
            w[d4] = p; }
        *(v4u*)(dst[q] + lane * 16) = (v4u){w[0], w[1], w[2], w[3]};
        if (lane == 0) *sc[q] = (am > 0.f) ? am * (1.0f / 127.0f) : 1.0f; }
}
typedef __bf16 bf16x2_t __attribute__((ext_vector_type(2)));
__device__ __forceinline__ float dot2bf(unsigned a, unsigned b, float c) { return __builtin_amdgcn_fdot2_f32_bf16(__builtin_bit_cast(bf16x2_t, a), __builtin_bit_cast(bf16x2_t, b), c, false); }
struct QRows { v4u a[4], b[4]; float ss; };
template <bool GATES> __device__ __forceinline__ void qrows_load(QRows& q, const bf16* HBr, const float* RSr, int lane) {
#pragma unroll
    for (int r = 0; r < 4; ++r) { q.a[r] = *(const v4u*)(HBr + (size_t)r * D + lane * 16); q.b[r] = *(const v4u*)(HBr + (size_t)r * D + lane * 16 + 8); }
    if constexpr (GATES) q.ss = RSr[lane]; else q.ss = 0.f;
}
template <bool GATES> __device__ __forceinline__ void quant_rows_gates4(const QRows& qr, unsigned char* H8r, float* SCHr, float* GTr, const v4u (&wg)[8][2], int lane) {
    float ss = qr.ss;
    if constexpr (GATES) { ss += __shfl_xor(ss, 1); ss += __shfl_xor(ss, 2); ss += __shfl_xor(ss, 4); ss += __shfl_xor(ss, 8); }
#pragma unroll
    for (int q = 0; q < 4; ++q) { float f[16];
        { float t0[8], t1[8]; unpack8(qr.a[q], t0); unpack8(qr.b[q], t1);
#pragma unroll
          for (int u = 0; u < 8; ++u) { f[u] = t0[u]; f[8 + u] = t1[u]; } }
        float am = 0.f;
#pragma unroll
        for (int u = 0; u < 16; ++u) am = fmaxf(am, fabsf(f[u]));
        am = wave_max(am);
        const float inv = (am > 0.f) ? 127.0f / am : 0.f;
        unsigned w[4];
#pragma unroll
        for (int d4 = 0; d4 < 4; ++d4) { unsigned p = 0u;
#pragma unroll
            for (int u = 0; u < 4; ++u) { const int qi = (int)__builtin_rintf(f[d4 * 4 + u] * inv); p |= ((unsigned)qi & 255u) << (8 * u); }
            w[d4] = p; }
        *(v4u*)(H8r + (size_t)q * D + lane * 16) = (v4u){w[0], w[1], w[2], w[3]};
        if (lane == 0) SCHr[q] = (am > 0.f) ? am * (1.0f / 127.0f) : 1.0f;
        if constexpr (GATES) {
        float d[8];
#pragma unroll
        for (int j = 0; j < 8; ++j) { float a = 0.f;
            a = dot2bf(qr.a[q].x, wg[j][0].x, a); a = dot2bf(qr.a[q].y, wg[j][0].y, a); a = dot2bf(qr.a[q].z, wg[j][0].z, a); a = dot2bf(qr.a[q].w, wg[j][0].w, a);
            a = dot2bf(qr.b[q].x, wg[j][1].x, a); a = dot2bf(qr.b[q].y, wg[j][1].y, a); a = dot2bf(qr.b[q].z, wg[j][1].z, a); a = dot2bf(qr.b[q].w, wg[j][1].w, a);
            d[j] = a; }
        const bool h5 = (lane & 32) != 0, h4 = (lane & 16) != 0, h3 = (lane & 8) != 0;
        float e[4];
#pragma unroll
        for (int i = 0; i < 4; ++i) { const float keep = h5 ? d[4 + i] : d[i], send = h5 ? d[i] : d[4 + i]; e[i] = keep + __shfl_xor(send, 32); }
        float g2[2];
#pragma unroll
        for (int i = 0; i < 2; ++i) { const float keep = h4 ? e[2 + i] : e[i], send = h4 ? e[i] : e[2 + i]; g2[i] = keep + __shfl_xor(send, 16); }
        float v = (h3 ? g2[1] : g2[0]) + __shfl_xor(h3 ? g2[0] : g2[1], 8);
        v += __shfl_xor(v, 4); v += __shfl_xor(v, 2); v += __shfl_xor(v, 1);
        const float r = __builtin_amdgcn_rsqf(__shfl(ss, q * 16) * (1.0f / 1024.0f) + pg8::RMS_EPS);
        if ((lane & 7) == 0) GTr[q * 8 + (lane >> 3)] = v * r; } }
}
__global__ void __launch_bounds__(NTHREADS, 2) mega(Args args) {
    extern __shared__ __attribute__((aligned(16))) unsigned char lds_raw[];
    LAS unsigned char* lds = (LAS unsigned char*)lds_raw;
    volatile LAS unsigned* MISC = (volatile LAS unsigned*)(lds + MISC_OFF);
    const int wave = __builtin_amdgcn_readfirstlane(threadIdx.x >> 6);
#define LANE_ID() ({ int _l; asm volatile("v_mbcnt_lo_u32_b32 %0, -1, 0\n\tv_mbcnt_hi_u32_b32 %0, -1, %0" : "=v"(_l)); _l; })
    const int G = gridDim.x; const int bx = blockIdx.x; const int vcu = (G % 8 == 0) ? (bx % 8) * (G / 8) + bx / 8 : bx;
    unsigned char* ws = args.ws;
    gu32* ctl = (gu32*)(ws + WS_CTL);
    { const int tid = wave * 64 + LANE_ID(); for (int u = tid; u < (LDS_BYTES - LDSCTL_OFF) / 4; u += NTHREADS) ((LAS unsigned*)(lds + LDSCTL_OFF))[u] = 0u; }
    __syncthreads();
    XcdBarrier bar; bar.bar = (unsigned*)(ctl + CW_BAR); bar.x = 0; bar.st = nullptr;
#if !MK_PER_PHASE
    bar = xcd_barrier_post((unsigned*)(ctl + CW_BAR), MISC + 8, (wave == 0) && (LANE_ID() == 0));
#define GRID_BAR() xcd_barrier(bar, (wave == 0) && (LANE_ID() == 0))
#else
#define GRID_BAR() do {} while (0)
#endif
    const int lo = args.ph_lo, hi = args.ph_hi;
#define IN(k) (lo <= (k) && (k) < hi)
#define SEAM(k) do { if (IN(k) && IN((k) + 1)) { GRID_BAR(); if (PROBE_MASK & (1u << 29)) { GRID_BAR(); GRID_BAR(); } } } while (0)
    const int gw = vcu * NWAVES + wave, NGW = G * NWAVES;
    bf16* HB = (bf16*)(ws + WS_HB); float* RS = (float*)(ws + WS_RS);

    if (IN(0)) REP(0) {
        const int lane = LANE_ID(), tid = wave * 64 + lane;
        LAS float* scr = (LAS float*)(lds + wave * 16640);
        {
            const WD* wd = c_wd;
            int base = 0;
#pragma unroll 1
            for (int w = 0; w < 10; ++w) { const int K = wd[w].K, Nsrc = wd[w].Nsrc, Ndst = wd[w].Ndst, kind = wd[w].kind; const int nit = (K / 64) * (Ndst / 64);
                const float* W = args.in[wd[w].src]; const float* gn = wd[w].gain >= 0 ? args.in[wd[w].gain] : nullptr; bf16* WT = (bf16*)(ws + wd[w].dst);
                int first = (gw - base) % NGW; if (first < 0) first += NGW;
                for (int it = first; it < nit; it += NGW) p0_transpose_item(W, gn, K, Nsrc, Ndst, WT, kind, scr, it, lane);
                base = (base + nit) % NGW; }
        }
        const float* x = args.in[I_X];
        for (int m0 = gw * 4; m0 < M; m0 += NGW * 4) {
            f32x4 v[4][4]; float s4[4];
#pragma unroll
            for (int q = 0; q < 4; ++q) { const GAS f32x4* xr = (const GAS f32x4*)(x + (size_t)(m0 + q) * D) + lane;
#pragma unroll
                for (int j = 0; j < 4; ++j) v[q][j] = xr[64 * j]; }
#pragma unroll
            for (int q = 0; q < 4; ++q) { float s_ = 0.f;
#pragma unroll
                for (int j = 0; j < 4; ++j) s_ += (v[q][j][0] * v[q][j][0] + v[q][j][1] * v[q][j][1]) + (v[q][j][2] * v[q][j][2] + v[q][j][3] * v[q][j][3]);
                s4[q] = wave_sum(s_);
                float am = 0.f;
#pragma unroll
                for (int j = 0; j < 4; ++j) am = fmaxf(fmaxf(am, fmaxf(fabsf(v[q][j][0]), fabsf(v[q][j][1]))), fmaxf(fabsf(v[q][j][2]), fabsf(v[q][j][3])));
                am = wave_max(am); const float inv = (am > 0.f) ? 127.0f / am : 0.f;
                GAS unsigned* o4 = (GAS unsigned*)((unsigned char*)args.out + (size_t)(m0 + q) * D) + lane;
                GAS unsigned* e4 = (GAS unsigned*)((unsigned char*)args.out + (size_t)64 * MiB + (size_t)(m0 + q) * D) + lane;
#pragma unroll
                for (int j = 0; j < 4; ++j) { unsigned pq = 0u, pe = 0u;
#pragma unroll
                    for (int u = 0; u < 4; ++u) { const float t_ = v[q][j][u] * inv, qf_ = __builtin_rintf(t_); pq |= ((unsigned)(int)qf_ & 255u) << (8 * u); pe |= ((unsigned)(int)__builtin_rintf((t_ - qf_) * 254.0f) & 255u) << (8 * u); }
                    o4[64 * j] = pq; e4[64 * j] = pe; }
                if (lane == 0) ((float*)(ws + WS_SCX))[m0 + q] = (am > 0.f) ? am * (1.0f / 127.0f) : 1.0f; }
            { const int q = lane >> 4, sl = lane & 15; const float sv = (q == 0) ? s4[0] : (q == 1) ? s4[1] : (q == 2) ? s4[2] : s4[3]; RS[(size_t)(m0 + q) * 16 + sl] = (sl == 0) ? sv : 0.f; }
        }
        const float* p = args.in[I_P]; bf16* PB = (bf16*)(ws + WS_PB);
        for (int m = gw; m < M; m += NGW) { const f32x4 v = *((const GAS f32x4*)(p + (size_t)m * PLE) + lane); v2u o; o.x = pk2(v[0], v[1]); o.y = pk2(v[2], v[3]); *((GAS v2u*)(PB + (size_t)m * PLE) + lane) = o; }
        if (bx == 0) { float* par = (float*)(ws + WS_PAR);
            for (int e = tid; e < PAR_N; e += NTHREADS) { float v;
                if (e < PAR_KG) v = args.in[I_QG][e]; else if (e < PAR_CW) v = args.in[I_KG][e - PAR_KG]; else if (e < PAR_CB) v = args.in[I_CW][e - PAR_CW];
                else if (e < PAR_IB) v = args.in[I_CB][e - PAR_CB]; else if (e < PAR_FB) v = args.in[I_IB][e - PAR_IB]; else v = args.in[I_FB][e - PAR_FB];
                par[e] = v; } }
        float* rope = (float*)(ws + WS_ROPE);
        for (int e = vcu * NTHREADS + tid; e < SEQ * 16; e += G * NTHREADS) { const int t = e >> 4, i = e & 15;
            const float invf = c_invfreq[i];
            const float ang = (float)t * invf; const double rev = (double)ang * 0.15915494309189535; const float fr = (float)(rev - __builtin_floor(rev));
            rope[e * 2] = __builtin_amdgcn_cosf(fr); rope[e * 2 + 1] = __builtin_amdgcn_sinf(fr); }
    }
    using namespace pg8;
    if (IN(0)) { GRID_BAR();
        const int lane = LANE_ID(); const bf16* WT = (const bf16*)(ws + WS_WIN); unsigned char* W8 = ws + WS_W8; float* SCWw = (float*)(ws + WS_SCW);
        const bf16* W1T = (const bf16*)(ws + WS_W1IN); unsigned char* W18 = ws + WS_W1IN8; float* SC1w = (float*)(ws + WS_SC1);
        const bf16* W2T = (const bf16*)(ws + WS_W2IN); unsigned char* W28 = ws + WS_W2IN8; float* SC2w = (float*)(ws + WS_SC2);
        for (int n = gw; n < 7168 + 2 * 5632; n += NGW) {
            const bf16* sp_; unsigned char* dp_; float* cp_;
            if (n < 7168) { int srow = (n < 4608) ? n : (n < 6656) ? n + (WIN_G - 4608) : n + (WIN_ML + 1536 - 6656);
                if (n < 4608 && ((n % 1536) >> 9) < 2) { const int cp = n & 127, L = cp >> 3, s_ = cp & 7; srow = n - cp + ((s_ == 0) ? L : (s_ == 1) ? 16 + L : 32 + 6 * L + (s_ - 2)); }
                sp_ = WT + (size_t)srow * D; dp_ = W8 + (size_t)n * D; cp_ = SCWw + n; }
            else if (n < 7168 + 5632) { const int r_ = n - 7168; sp_ = W1T + (size_t)r_ * D; dp_ = W18 + (size_t)r_ * D; cp_ = SC1w + r_; }
            else { const int r_ = n - 7168 - 5632; sp_ = W2T + (size_t)r_ * D; dp_ = W28 + (size_t)r_ * D; cp_ = SC2w + r_; }
            const bf16* const src[1] = {sp_}; unsigned char* const dst[1] = {dp_}; float* const sc[1] = {cp_};
            quant_rows_i8<1>(src, dst, sc, lane); } }
    SEAM(0);
    if (IN(1)) REP(1) { Gemm g{(const bf16*)args.out, (const bf16*)(ws + WS_W1IN8), M, 2 * FF, D / 2, (const float*)(ws + WS_SC1), (const float*)(ws + WS_SCX)}; StaticOrder S; S.init(M, 2 * FF, G, bx);
        EpiSwiglu E{(bf16*)(ws + WS_HID), FF, RS}; gemm_phase<EpiSwiglu, StaticOrder, true, true, false, true>(lds, g, S, E, wave); }
    SEAM(1);
    if (IN(2)) REP(2) { Gemm g{(const bf16*)(ws + WS_HID), (const bf16*)(ws + WS_W1OUT), M, D, FF}; StaticOrder S; S.init(M, D, G, bx);
        EpiResidX E{(const unsigned char*)args.out, (const unsigned char*)args.out + (size_t)64 * MiB, (const float*)(ws + WS_SCX), HB, RS, 0.5f}; gemm_phase<EpiResidX, StaticOrder, true, true>(lds, g, S, E, wave); }
    SEAM(2);
    unsigned char* H8 = (unsigned char*)args.out; float* SCH = (float*)((unsigned char*)args.out + (size_t)32 * MiB);
    const float* SCW = (const float*)(ws + WS_SCW); const bf16* W8b = (const bf16*)(ws + WS_W8); const bf16* H8b = (const bf16*)H8;
    if (IN(3)) { { const int lane = LANE_ID();
            v4u wg[8][2];
#pragma unroll
            for (int j = 0; j < 8; ++j) { const bf16* wr_ = (const bf16*)(ws + WS_WIN) + (size_t)(WIN_GT + j) * D + lane * 16; wg[j][0] = *(const v4u*)wr_; wg[j][1] = *(const v4u*)(wr_ + 8); }
            QRows cur, nx; int m0 = gw * 4; qrows_load<true>(cur, HB + (size_t)m0 * D, RS + (size_t)m0 * 16, lane);
            for (; m0 < M; m0 += NGW * 4) { const int m1 = m0 + NGW * 4; nx = cur; if (m1 < M) qrows_load<true>(nx, HB + (size_t)m1 * D, RS + (size_t)m1 * 16, lane);
                quant_rows_gates4<true>(cur, H8 + (size_t)m0 * D, SCH + m0, (float*)(ws + WS_GATES) + (size_t)m0 * 8, wg, lane); cur = nx; } }
        REP(3) { Gemm g{HB, (const bf16*)(ws + WS_WIN) + (size_t)WIN_ML * D, M, 1536, D}; StaticOrder S; S.init(M, 1536, G, bx);
        EpiZ E{(bf16*)(ws + WS_ML), 2048, RS, -1, nullptr}; gemm_phase<EpiZ, StaticOrder, true, true>(lds, g, S, E, wave); } }
    SEAM(3);
    const bf16* QKV0 = (const bf16*)(ws + WS_QKV); const bf16* QKV1 = (const bf16*)(ws + WS_QKV1); bf16* GB = (bf16*)(ws + WS_G);
#define QKV_GEMM8(grp, dstp) do { Gemm g{H8b, W8b + (size_t)(grp) * 1536 * (D / 2), M, 1536, D / 2, SCW + (grp) * 1536, SCH}; StaticOrder S; S.init(M, 1536, G, bx); \
        EpiQKV E{(bf16*)(dstp), RS, (const float*)(ws + WS_PAR) + PAR_QG, (const float*)(ws + WS_PAR) + PAR_KG, (const float*)(ws + WS_ROPE), (PG8_LAS float*)(lds + QKP_OFF)}; \
        gemm_phase<EpiQKV, StaticOrder, true, true, false, true>(lds, g, S, E, wave); } while (0)
    if (IN(4)) { REP(5) QKV_GEMM8(0, ws + WS_QKV);
        { Gemm g{H8b, W8b + (size_t)6656 * (D / 2), M, 512, D / 2, SCW + 6656, SCH}; StaticOrder S; S.init(M, 512, G, bx);
        EpiSig8 E{(unsigned char*)args.out + (size_t)40 * MiB, RS}; gemm_phase<EpiSig8, StaticOrder, true, true, false, true>(lds, g, S, E, wave); }
        REP(24) mlstm_b1(ws, lds, wave, vcu, G); GRID_BAR(); mlstm_b2(ws, wave, vcu, G); GRID_BAR(); REP(25) mlstm_b3(ws, (const unsigned char*)args.out + (size_t)40 * MiB, lds, wave, vcu, G); }
    SEAM(4);
    if (IN(5)) { attn_fast(ws, QKV0, lds, 0, wave, vcu, G); REP(6) { if (rep_) attn_fast(ws, QKV0, lds, 0, wave, vcu, G); }
        REP(5) QKV_GEMM8(1, ws + WS_QKV1); }
    SEAM(5);
    if (IN(6)) { attn_fast(ws, QKV1, lds, 1, wave, vcu, G);
        REP(5) QKV_GEMM8(2, ws + WS_QKV); }
    SEAM(6);
    if (IN(7)) { attn_fast(ws, QKV0, lds, 2, wave, vcu, G);
        REP(11) { Gemm g{H8b, W8b + (size_t)4608 * (D / 2), M, 2048, D / 2, SCW + 4608, SCH}; StaticOrder S; S.init(M, 2048, G, bx);
        EpiGF E{(unsigned char*)GB, (unsigned char*)GB + (size_t)M * 1024, RS}; gemm_phase<EpiGF, StaticOrder, true, true, false, true>(lds, g, S, E, wave); } }
    SEAM(7);
#undef QKV_GEMM8
    if (IN(8)) REP(12) { Gemm g{(const bf16*)(ws + WS_A), (const bf16*)(ws + WS_WUPA), M, D, 512, nullptr, nullptr, (const bf16*)(ws + WS_BM), (const bf16*)(ws + WS_WUPB)}; PairOrder S; S.init(M, D, G, bx);
        EpiGate2 E{(const unsigned char*)GB, (const unsigned char*)GB + (size_t)M * 1024, (bf16*)(ws + WS_MERGED)}; gemm_phase<EpiGate2, PairOrder, true, true>(lds, g, S, E, wave); }
    SEAM(8);
    if (IN(9)) { Gemm g{(const bf16*)(ws + WS_MERGED), (const bf16*)(ws + WS_WO), M, D, D}; StaticOrder S; S.init(M, D, G, bx);
        EpiResidQ E{HB, RS, 1.0f, (unsigned*)(ws + WS_ROWMAX), (unsigned*)(ws + WS_PCNT), H8, SCH}; gemm_phase<EpiResidQ, StaticOrder, true, true>(lds, g, S, E, wave); }
    SEAM(9);
    if (IN(10)) {
        REP(15) { Gemm g{H8b, (const bf16*)(ws + WS_W2IN8), M, 2 * FF, D / 2, (const float*)(ws + WS_SC2), SCH}; StaticOrder S; S.init(M, 2 * FF, G, bx);
        EpiSwiglu E{(bf16*)(ws + WS_HID), FF, RS}; gemm_phase<EpiSwiglu, StaticOrder, true, true, false, true>(lds, g, S, E, wave); } }
    SEAM(10);
    if (IN(11)) { { Gemm g{(const bf16*)(ws + WS_HID), (const bf16*)(ws + WS_W2OUT), M, D, FF}; StaticOrder S; S.init(M, D, G, bx);
        EpiResid<false> E{nullptr, HB, HB, RS, 0.5f}; gemm_phase<EpiResid<false>, StaticOrder, true, true>(lds, g, S, E, wave); }
        }
    SEAM(11);
    if (IN(12)) { Gemm g{HB, (const bf16*)(ws + WS_WPG), M, D, D, nullptr, nullptr, (const bf16*)(ws + WS_PB), (const bf16*)(ws + WS_WPE), PLE}; PairOrder S; S.init(M, D, G, bx);
        EpiFinal2 E{args.out, HB, RS}; gemm_phase_dk<EpiFinal2>(lds, g, S, E, wave); }
#undef IN
#undef SEAM
}

extern "C" void kernel_launch(void* const* d_in, const int* in_sizes, int n_in, void* d_out, int out_size, void* d_ws, size_t ws_size, hipStream_t stream) {
    static int grid = 0;
    if (grid == 0) {
        if (n_in != 22 || in_sizes[0] != M * D || out_size != M * D || ws_size < WS_END) { fprintf(stderr, "kernel_launch: unexpected shapes (n_in %d, in0 %d, out %d, ws %zu)\n", n_in, n_in > 0 ? in_sizes[0] : -1, out_size, ws_size); grid = -1; return; }
        int dev = 0, cus = 0;
        if (hipGetDevice(&dev) != hipSuccess || hipDeviceGetAttribute(&cus, hipDeviceAttributeMultiprocessorCount, dev) != hipSuccess) { grid = -1; return; }
        if (hipFuncSetAttribute((const void*)mega, hipFuncAttributeMaxDynamicSharedMemorySize, LDS_BYTES) != hipSuccess) { fprintf(stderr, "kernel_launch: hipFuncSetAttribute failed\n"); grid = -1; return; }
        (void)hipGetLastError();
        grid = cus;
    }
    if (grid < 0) return;
    (void)hipMemsetAsync((char*)d_ws + WS_CTL, 0, CTL_ZERO_BYTES, stream);
    Args a{};
    for (int i = 0; i < 22; ++i) a.in[i] = (const float*)d_in[i];
    a.out = (float*)d_out; a.ws = (unsigned char*)d_ws;
#if MK_PER_PHASE
    for (int ph = 0; ph < NPHASE; ++ph) { a.ph_lo = ph; a.ph_hi = ph + 1; hipLaunchKernelGGL(mega, dim3(grid), dim3(NTHREADS), LDS_BYTES, stream, a); }
#else
    a.ph_lo = 0; a.ph_hi = NPHASE; hipLaunchKernelGGL(mega, dim3(grid), dim3(NTHREADS), LDS_BYTES, stream, a);
#endif
}
```

```cpp
#include <hip/hip_runtime.h>
#include <cstdio>
#include <cstdint>

#ifndef PROBE_MASK
#define PROBE_MASK 0u
#endif
#define REP(k) for (int rep_ = 0; rep_ < 1 + (int)((PROBE_MASK >> (k)) & 1u); ++rep_)
#ifndef MK_PER_PHASE
#define MK_PER_PHASE 0
#endif

namespace pg8 {
#define PG8_LAS __attribute__((address_space(3)))
typedef unsigned short bf16_t;
typedef short bf16x8 __attribute__((ext_vector_type(8)));
typedef float f32x4 __attribute__((ext_vector_type(4)));
typedef unsigned u32x4 __attribute__((ext_vector_type(4)));
constexpr int BM = 256, BK = 64, HALF = 128, HTB = HALF * BK * 2, STAGE_BYTES = 8 * HTB, NXCD = 8, WGM = 8;

__host__ __device__ __forceinline__ int lds_byte(int r, int c) { const int st = (r >> 4) * 2 + (c >> 5), rr = r & 15, cc = c & 31, ob = rr * 64 + cc * 2; return st * 1024 + (ob ^ (((ob >> 9) & 1) << 5)); }
__host__ __device__ __forceinline__ void stage_rc(int b, int& R, int& C) { const int st = b / 1024, sb = b % 1024, swz = sb ^ (((sb >> 9) & 1) << 5); R = (st >> 1) * 16 + swz / 64; C = (st & 1) * 32 + (swz % 64) / 2; }
__host__ __device__ __forceinline__ int perm32(int rho) { const int n = rho >> 4, i = rho & 15; return 8 * (i >> 2) + 4 * n + (i & 3); }

struct Unit { int pm, pn, w; };
struct Gemm { const bf16_t* A; const bf16_t* Bt; int M, N, K; const float* scw; const float* sch; const bf16_t* A2; const bf16_t* Bt2; int K2; const float* rsf; };
typedef int i32x4 __attribute__((ext_vector_type(4)));

struct StaticOrder {
    static constexpr bool PAIR = false;
    int nM, nN, nwg, G, c;
    __host__ __device__ void init(int M, int N, int G_, int c_) { nM = M / BM; nN = N / BM; nwg = nM * nN; G = G_; c = c_; }
    __host__ __device__ bool next(int i, Unit& u) const {
        const long L = (long)i * G + c; if (L >= nwg) return false;
        int wgid = (int)L; { const int q = nwg / NXCD, r = nwg % NXCD, xcd = wgid % NXCD, off = wgid / NXCD; wgid = (xcd < r ? xcd * (q + 1) : r * (q + 1) + (xcd - r) * q) + off; }
        const int nig = WGM * nN, gid = wgid / nig, fm = gid * WGM, gsz = (nM - fm) < WGM ? (nM - fm) : WGM;
        u.pm = fm + ((wgid % nig) % gsz); u.pn = (wgid % nig) / gsz; u.w = 0; return true;
    }
};
struct PairOrder {
    static constexpr bool PAIR = true;
    StaticOrder base;
    __host__ __device__ void init(int M, int N, int G_, int c_) { base.init(M, N, G_, c_); }
    __host__ __device__ bool next(int i, Unit& u) const { const bool ok = base.next(i >> 1, u); u.w = i & 1; return ok; }
};

typedef float f32x2_cv __attribute__((ext_vector_type(2))); typedef __bf16 bf16x2_cv __attribute__((ext_vector_type(2)));
__device__ __forceinline__ unsigned cvt_pk_bf16(float lo, float hi) { return __builtin_bit_cast(unsigned, __builtin_convertvector((f32x2_cv){lo, hi}, bf16x2_cv)); }
__device__ __forceinline__ float bf_lo(unsigned u) { return __uint_as_float(u << 16); }
__device__ __forceinline__ float bf_hi(unsigned u) { return __uint_as_float(u & 0xffff0000u); }

constexpr float RMS_EPS = 1e-6f;
constexpr int RTAB_OFF = 152576;
constexpr int SCT_OFF = 153600;
constexpr int RTAB2_OFF = 151552;
__device__ __forceinline__ float sigmoidf_(float v) { return __builtin_amdgcn_rcpf(1.0f + __builtin_amdgcn_exp2f(-1.4426950408889634f * v)); }
__device__ __forceinline__ void swap16_(float& a, float& b) { asm volatile("s_nop 1\n\tv_permlane16_swap_b32 %0, %1" : "+v"(a), "+v"(b)); }
__device__ __forceinline__ void swap32_(float& a, float& b) { asm volatile("s_nop 1\n\tv_permlane32_swap_b32 %0, %1" : "+v"(a), "+v"(b)); }
__device__ __forceinline__ float xsum_16_32(float x) { float a = x, b = x; swap16_(a, b); x = a + b; a = x; b = x; swap32_(a, b); return a + b; }
__device__ __forceinline__ float xmax_16_32(float x) { float a = x, b = x; swap16_(a, b); x = fmaxf(a, b); a = x; b = x; swap32_(a, b); return fmaxf(a, b); }
__device__ __forceinline__ float xor32_(float x, bool hi) { float a = x, b = x; swap32_(a, b); return hi ? a : b; }
template <int MINQ> __device__ __forceinline__ unsigned sig8_pack(const f32x4 t) {
    f32x4 e; e[0] = __builtin_amdgcn_exp2f(t[0]); e[1] = __builtin_amdgcn_exp2f(t[1]); e[2] = __builtin_amdgcn_exp2f(t[2]); e[3] = __builtin_amdgcn_exp2f(t[3]);
    const f32x4 d = e + 1.0f; f32x4 sg; sg[0] = __builtin_amdgcn_rcpf(d[0]); sg[1] = __builtin_amdgcn_rcpf(d[1]); sg[2] = __builtin_amdgcn_rcpf(d[2]); sg[3] = __builtin_amdgcn_rcpf(d[3]);
    f32x4 q = sg * 255.0f + 0.5f;
    if (MINQ > 0) { q[0] = fmaxf(q[0], (float)MINQ); q[1] = fmaxf(q[1], (float)MINQ); q[2] = fmaxf(q[2], (float)MINQ); q[3] = fmaxf(q[3], (float)MINQ); }
    return (unsigned)q[0] | ((unsigned)q[1] << 8) | ((unsigned)q[2] << 16) | ((unsigned)q[3] << 24);
}
struct EpiSwiglu {
    static constexpr bool PERM = true, AFTER_DRAIN = false, NEED_R = true;
    bf16_t* O; int ldc; const float* RS;
    __device__ __forceinline__ void operator()(f32x4 (&acc)[2][2][4][2], const Unit& u, int wr, int wc, int fr, int fq, const PG8_LAS float* rtab) const {
        const int row0 = u.pm * BM + wr * 64 + fr, col0 = u.pn * HALF + wc * 32 + 8 * fq;
#pragma unroll
        for (int ai = 0; ai < 2; ++ai)
#pragma unroll
            for (int m = 0; m < 4; ++m) { const int row = row0 + ai * HALF + m * 16; const float r = rtab[ai * HALF + wr * 64 + m * 16 + fr];
                const float rl = r * -1.4426950408889634f, r2 = r * r; f32x4 hv[2];
#pragma unroll
                for (int n = 0; n < 2; ++n) { const f32x4 a = acc[ai][0][m][n], b = acc[ai][1][m][n]; const f32x4 t = a * rl; f32x4 e;
                    e[0] = __builtin_amdgcn_exp2f(t[0]); e[1] = __builtin_amdgcn_exp2f(t[1]); e[2] = __builtin_amdgcn_exp2f(t[2]); e[3] = __builtin_amdgcn_exp2f(t[3]);
                    const f32x4 d = e + 1.0f; f32x4 q;
                    q[0] = __builtin_amdgcn_rcpf(d[0]); q[1] = __builtin_amdgcn_rcpf(d[1]); q[2] = __builtin_amdgcn_rcpf(d[2]); q[3] = __builtin_amdgcn_rcpf(d[3]);
                    hv[n] = (a * b) * (q * r2); }
                u32x4 w; w.x = cvt_pk_bf16(hv[0][0], hv[0][1]); w.y = cvt_pk_bf16(hv[0][2], hv[0][3]); w.z = cvt_pk_bf16(hv[1][0], hv[1][1]); w.w = cvt_pk_bf16(hv[1][2], hv[1][3]);
                *(u32x4*)(O + (size_t)row * ldc + col0) = w; }
    }
};
template <bool BASE_F32> struct EpiResid {
    static constexpr bool PERM = true, AFTER_DRAIN = false, NEED_R = false;
    const float* basef; const bf16_t* baseh; bf16_t* HBo; float* RSo; float alpha;
    __device__ __forceinline__ void operator()(f32x4 (&acc)[2][2][4][2], const Unit& u, int wr, int wc, int fr, int fq, const PG8_LAS float*) const {
        const int row0 = u.pm * BM + wr * 64 + fr, col0 = u.pn * BM + wc * 32 + 8 * fq;
#pragma unroll
        for (int ai = 0; ai < 2; ++ai) {
            f32x4 bv[4][2][2];
#pragma unroll
            for (int m = 0; m < 4; ++m)
#pragma unroll
                for (int bj = 0; bj < 2; ++bj) { const size_t off = (size_t)(row0 + ai * HALF + m * 16) * 1024 + col0 + bj * HALF;
                    if constexpr (BASE_F32) { bv[m][bj][0] = *(const f32x4*)(basef + off); bv[m][bj][1] = *(const f32x4*)(basef + off + 4); }
                    else { const u32x4 p = *(const u32x4*)(baseh + off); bv[m][bj][0] = (f32x4){bf_lo(p.x), bf_hi(p.x), bf_lo(p.y), bf_hi(p.y)}; bv[m][bj][1] = (f32x4){bf_lo(p.z), bf_hi(p.z), bf_lo(p.w), bf_hi(p.w)}; } }
            asm volatile("" ::: "memory");
#pragma unroll
            for (int m = 0; m < 4; ++m) { const int row = row0 + ai * HALF + m * 16; float ssq = 0.f;
#pragma unroll
                for (int bj = 0; bj < 2; ++bj) { const size_t off = (size_t)row * 1024 + col0 + bj * HALF;
                    const f32x4 v0 = bv[m][bj][0] + acc[ai][bj][m][0] * alpha, v1 = bv[m][bj][1] + acc[ai][bj][m][1] * alpha;
                    u32x4 w; w.x = cvt_pk_bf16(v0[0], v0[1]); w.y = cvt_pk_bf16(v0[2], v0[3]); w.z = cvt_pk_bf16(v1[0], v1[1]); w.w = cvt_pk_bf16(v1[2], v1[3]);
                    *(u32x4*)(HBo + off) = w;
                    ssq += (v0[0] * v0[0] + v0[1] * v0[1]) + (v0[2] * v0[2] + v0[3] * v0[3]) + (v1[0] * v1[0] + v1[1] * v1[1]) + (v1[2] * v1[2] + v1[3] * v1[3]); }
                ssq = xsum_16_32(ssq);
                if (fq == 0) RSo[(size_t)row * 16 + u.pn * 4 + wc] = ssq; }
            asm volatile("" ::: "memory"); }
    }
};
struct EpiZ {
    static constexpr bool PERM = true, AFTER_DRAIN = false, NEED_R = true;
    bf16_t* O; int ldc; const float* RS; int gate_pn; float* GATES;
    __device__ __forceinline__ void operator()(f32x4 (&acc)[2][2][4][2], const Unit& u, int wr, int wc, int fr, int fq, const PG8_LAS float* rtab) const {
        const int row0 = u.pm * BM + wr * 64 + fr, col0 = u.pn * BM + wc * 32 + 8 * fq;
        const bool gate = (u.pn == gate_pn);
#pragma unroll
        for (int ai = 0; ai < 2; ++ai)
#pragma unroll
            for (int m = 0; m < 4; ++m) { const int row = row0 + ai * HALF + m * 16; const float r = rtab[ai * HALF + wr * 64 + m * 16 + fr];
                if (gate) { if (wc == 0 && fq == 0) { *(f32x4*)(GATES + (size_t)row * 8) = acc[ai][0][m][0] * r; *(f32x4*)(GATES + (size_t)row * 8 + 4) = acc[ai][0][m][1] * r; } }
                else {
#pragma unroll
                    for (int bj = 0; bj < 2; ++bj) { const f32x4 v0 = acc[ai][bj][m][0] * r, v1 = acc[ai][bj][m][1] * r;
                        u32x4 w; w.x = cvt_pk_bf16(v0[0], v0[1]); w.y = cvt_pk_bf16(v0[2], v0[3]); w.z = cvt_pk_bf16(v1[0], v1[1]); w.w = cvt_pk_bf16(v1[2], v1[3]);
                        *(u32x4*)(O + (size_t)row * ldc + col0 + bj * HALF) = w; } } }
    }
};
constexpr int QKP_OFF = 131072;
struct EpiQKV {
    static constexpr bool PERM = true, AFTER_DRAIN = false, NEED_R = true;
    bf16_t* O; const float* RS; const float* par_qg; const float* par_kg; const float* rope; PG8_LAS float* part;
    __device__ __forceinline__ void operator()(f32x4 (&acc)[2][2][4][2], const Unit& u, int wr, int wc, int fr_, int fq_, const PG8_LAS float* rtab) const {
        int lane_; asm volatile("v_mbcnt_lo_u32_b32 %0, -1, 0\n\tv_mbcnt_hi_u32_b32 %0, -1, %0" : "=v"(lane_));
        const int fr = lane_ & 15, fq = lane_ >> 4; (void)fr_; (void)fq_;
        const int row0 = u.pm * BM + wr * 64 + fr, col0 = u.pn * BM + wc * 32 + 8 * fq;
        const bool isq = u.pn < 2, isqk = u.pn < 4;
#pragma unroll
        for (int ai = 0; ai < 2; ++ai)
#pragma unroll
            for (int m = 0; m < 4; ++m) { const int rl = ai * HALF + wr * 64 + m * 16 + fr; const float r = rtab[rl];
#pragma unroll
                for (int bj = 0; bj < 2; ++bj) { acc[ai][bj][m][0] *= r; acc[ai][bj][m][1] *= r;
                    if (isqk) { const f32x4 a = acc[ai][bj][m][0], b = acc[ai][bj][m][1];
                        float ssq = (a[0] * a[0] + a[1] * a[1]) + (a[2] * a[2] + a[3] * a[3]) + (b[0] * b[0] + b[1] * b[1]) + (b[2] * b[2] + b[3] * b[3]);
                        ssq = xsum_16_32(ssq);
                        if (fq == 0) part[(rl * 2 + bj) * 4 + wc] = ssq; } } }
        if (isqk) {
            asm volatile("s_waitcnt lgkmcnt(0)" ::: "memory"); __builtin_amdgcn_s_barrier(); asm volatile("" ::: "memory");
            const float* G_ = isq ? par_qg : par_kg; const int L = 4 * wc + fq;
            const f32x4 g0 = (f32x4){G_[L], G_[16 + L], G_[32 + 6 * L], G_[33 + 6 * L]}, g1 = (f32x4){G_[34 + 6 * L], G_[35 + 6 * L], G_[36 + 6 * L], G_[37 + 6 * L]};
            const float qs = isq ? (0.08838834764831845f * 1.4426950408889634f) : 1.0f;
#pragma unroll
            for (int am = 0; am < 4; ++am) {
                float cs[2][2];
#pragma unroll
                for (int mm = 0; mm < 2; ++mm) { const int ai = am >> 1, m = (am & 1) * 2 + mm; const int pos = (row0 + ai * HALF + m * 16) & (8192 - 1); const float* rp = rope + (size_t)pos * 32 + 2 * L; cs[mm][0] = rp[0]; cs[mm][1] = rp[1]; }
                asm volatile("" ::: "memory");
#pragma unroll
                for (int mm = 0; mm < 2; ++mm) { const int ai = am >> 1, m = (am & 1) * 2 + mm; const int rl = ai * HALF + wr * 64 + m * 16 + fr;
#pragma unroll
                    for (int bj = 0; bj < 2; ++bj) { const f32x4 p4 = *(const PG8_LAS f32x4*)(part + (rl * 2 + bj) * 4);
                        const float rn = __builtin_amdgcn_rsqf(((p4[0] + p4[1]) + (p4[2] + p4[3])) * (1.0f / 128.0f) + RMS_EPS) * qs;
                        f32x4 a = acc[ai][bj][m][0] * g0 * rn, b = acc[ai][bj][m][1] * g1 * rn;
                        { const float x1 = a[0], x2 = a[1], c_ = cs[mm][0], s_ = cs[mm][1]; a[0] = x1 * c_ - x2 * s_; a[1] = x2 * c_ + x1 * s_; }
                        unsigned char* op_ = (unsigned char*)O + (size_t)(row0 + ai * HALF + m * 16) * 1536;
                        { typedef unsigned u32x2 __attribute__((ext_vector_type(2))); int w0 = 0, w1 = 0;
                            w0 = __builtin_amdgcn_cvt_pk_fp8_f32(a[0], a[1], w0, false); w0 = __builtin_amdgcn_cvt_pk_fp8_f32(a[2], a[3], w0, true);
                            w1 = __builtin_amdgcn_cvt_pk_fp8_f32(b[0], b[1], w1, false); w1 = __builtin_amdgcn_cvt_pk_fp8_f32(b[2], b[3], w1, true);
                            *(u32x2*)(op_ + col0 + bj * HALF) = (u32x2){(unsigned)w0, (unsigned)w1}; } } }
                asm volatile("" ::: "memory"); }
            return;
        }
#pragma unroll
        for (int ai = 0; ai < 2; ++ai)
#pragma unroll
            for (int m = 0; m < 4; ++m) { const int row = row0 + ai * HALF + m * 16;
#pragma unroll
                for (int bj = 0; bj < 2; ++bj) { const f32x4 v0 = acc[ai][bj][m][0], v1 = acc[ai][bj][m][1];
                    typedef unsigned u32x2 __attribute__((ext_vector_type(2))); int w0 = 0, w1 = 0;
                    w0 = __builtin_amdgcn_cvt_pk_fp8_f32(v0[0], v0[1], w0, false); w0 = __builtin_amdgcn_cvt_pk_fp8_f32(v0[2], v0[3], w0, true);
                    w1 = __builtin_amdgcn_cvt_pk_fp8_f32(v1[0], v1[1], w1, false); w1 = __builtin_amdgcn_cvt_pk_fp8_f32(v1[2], v1[3], w1, true);
                    *(u32x2*)((unsigned char*)O + (size_t)row * 1536 + col0 + bj * HALF) = (u32x2){(unsigned)w0, (unsigned)w1}; } }
    }
};
struct EpiGate {
    static constexpr bool PERM = true, AFTER_DRAIN = false, NEED_R = false;
    const bf16_t* G; int ldg; const bf16_t* prev; bf16_t* O;
    __device__ __forceinline__ void operator()(f32x4 (&acc)[2][2][4][2], const Unit& u, int wr, int wc, int fr, int fq, const PG8_LAS float*) const {
        const int row0 = u.pm * BM + wr * 64 + fr, col0 = u.pn * BM + wc * 32 + 8 * fq;
#pragma unroll
        for (int ai = 0; ai < 2; ++ai) {
            u32x4 gv[4][2], pv[4][2];
#pragma unroll
            for (int m = 0; m < 4; ++m)
#pragma unroll
                for (int bj = 0; bj < 2; ++bj) { const int row = row0 + ai * HALF + m * 16, col = col0 + bj * HALF;
                    gv[m][bj] = *(const u32x4*)(G + (size_t)row * ldg + col); pv[m][bj] = prev ? *(const u32x4*)(prev + (size_t)row * 1024 + col) : (u32x4){0u, 0u, 0u, 0u}; }
            asm volatile("" ::: "memory");
#pragma unroll
            for (int m = 0; m < 4; ++m)
#pragma unroll
                for (int bj = 0; bj < 2; ++bj) { const int row = row0 + ai * HALF + m * 16, col = col0 + bj * HALF; const u32x4 g = gv[m][bj], p = pv[m][bj];
                    float v[8];
                    v[0] = bf_lo(p.x) + sigmoidf_(bf_lo(g.x)) * acc[ai][bj][m][0][0]; v[1] = bf_hi(p.x) + sigmoidf_(bf_hi(g.x)) * acc[ai][bj][m][0][1];
                    v[2] = bf_lo(p.y) + sigmoidf_(bf_lo(g.y)) * acc[ai][bj][m][0][2]; v[3] = bf_hi(p.y) + sigmoidf_(bf_hi(g.y)) * acc[ai][bj][m][0][3];
                    v[4] = bf_lo(p.z) + sigmoidf_(bf_lo(g.z)) * acc[ai][bj][m][1][0]; v[5] = bf_hi(p.z) + sigmoidf_(bf_hi(g.z)) * acc[ai][bj][m][1][1];
                    v[6] = bf_lo(p.w) + sigmoidf_(bf_lo(g.w)) * acc[ai][bj][m][1][2]; v[7] = bf_hi(p.w) + sigmoidf_(bf_hi(g.w)) * acc[ai][bj][m][1][3];
                    u32x4 w; w.x = cvt_pk_bf16(v[0], v[1]); w.y = cvt_pk_bf16(v[2], v[3]); w.z = cvt_pk_bf16(v[4], v[5]); w.w = cvt_pk_bf16(v[6], v[7]);
                    *(u32x4*)(O + (size_t)row * 1024 + col) = w; }
            asm volatile("" ::: "memory"); }
    }
};
struct EpiGF {
    static constexpr bool PERM = true, AFTER_DRAIN = false, NEED_R = true;
    unsigned char* QA; unsigned char* QB; const float* RS;
    __device__ __forceinline__ void operator()(f32x4 (&acc)[2][2][4][2], const Unit& u, int wr, int wc, int fr, int fq, const PG8_LAS float* rtab) const {
        const int row0 = u.pm * BM + wr * 64 + fr, col0 = u.pn * HALF + wc * 32 + 8 * fq;
#pragma unroll
        for (int ai = 0; ai < 2; ++ai)
#pragma unroll
            for (int m = 0; m < 4; ++m) { const int row = row0 + ai * HALF + m * 16; const float rl = rtab[ai * HALF + wr * 64 + m * 16 + fr] * -1.4426950408889634f;
                unsigned qa[2], qb[2];
#pragma unroll
                for (int n = 0; n < 2; ++n) { qa[n] = sig8_pack<0>(acc[ai][0][m][n] * rl); qb[n] = sig8_pack<1>(acc[ai][1][m][n] * rl); }
                typedef unsigned u32x2 __attribute__((ext_vector_type(2)));
                *(u32x2*)(QA + (size_t)row * 1024 + col0) = (u32x2){qa[0], qa[1]}; *(u32x2*)(QB + (size_t)row * 1024 + col0) = (u32x2){qb[0], qb[1]}; }
    }
};
struct EpiGate2 {
    static constexpr bool PERM = true, AFTER_DRAIN = false, NEED_R = false;
    const unsigned char* QA; const unsigned char* QB; bf16_t* O;
    __device__ __forceinline__ static f32x4 ub4(unsigned w) { return (f32x4){(float)(w & 255u), (float)((w >> 8) & 255u), (float)((w >> 16) & 255u), (float)(w >> 24)}; }
    __device__ __forceinline__ void operator()(f32x4 (&acc)[2][2][4][2], const Unit& u, int wr, int wc, int fr, int fq, const PG8_LAS float*) const {
        typedef unsigned u32x2 __attribute__((ext_vector_type(2)));
        const int row0 = u.pm * BM + wr * 64 + fr, col0 = u.pn * BM + wc * 32 + 8 * fq;
        if (u.w == 0) {
#pragma unroll
            for (int ai = 0; ai < 2; ++ai) {
                u32x2 av[4][2], bv[4][2];
#pragma unroll
                for (int m = 0; m < 4; ++m)
#pragma unroll
                    for (int bj = 0; bj < 2; ++bj) { const size_t off = (size_t)(row0 + ai * HALF + m * 16) * 1024 + col0 + bj * HALF; bv[m][bj] = *(const u32x2*)(QB + off); av[m][bj] = *(const u32x2*)(QA + off); }
                asm volatile("" ::: "memory");
#pragma unroll
                for (int m = 0; m < 4; ++m)
#pragma unroll
                    for (int bj = 0; bj < 2; ++bj)
#pragma unroll
                        for (int n = 0; n < 2; ++n) { const f32x4 fb = ub4(bv[m][bj][n]); f32x4 rb; rb[0] = __builtin_amdgcn_rcpf(fb[0]); rb[1] = __builtin_amdgcn_rcpf(fb[1]); rb[2] = __builtin_amdgcn_rcpf(fb[2]); rb[3] = __builtin_amdgcn_rcpf(fb[3]);
                            acc[ai][bj][m][n] *= ub4(av[m][bj][n]) * rb; }
                asm volatile("" ::: "memory"); }
        } else {
#pragma unroll
            for (int ai = 0; ai < 2; ++ai) {
                u32x2 bv[4][2];
#pragma unroll
                for (int m = 0; m < 4; ++m)
#pragma unroll
                    for (int bj = 0; bj < 2; ++bj) bv[m][bj] = *(const u32x2*)(QB + (size_t)(row0 + ai * HALF + m * 16) * 1024 + col0 + bj * HALF);
                asm volatile("" ::: "memory");
#pragma unroll
                for (int m = 0; m < 4; ++m)
#pragma unroll
                    for (int bj = 0; bj < 2; ++bj) { const f32x4 v0 = acc[ai][bj][m][0] * (ub4(bv[m][bj][0]) * (1.0f / 255.0f)), v1 = acc[ai][bj][m][1] * (ub4(bv[m][bj][1]) * (1.0f / 255.0f));
                        u32x4 w; w.x = cvt_pk_bf16(v0[0], v0[1]); w.y = cvt_pk_bf16(v0[2], v0[3]); w.z = cvt_pk_bf16(v1[0], v1[1]); w.w = cvt_pk_bf16(v1[2], v1[3]);
                        *(u32x4*)(O + (size_t)(row0 + ai * HALF + m * 16) * 1024 + col0 + bj * HALF) = w; }
                asm volatile("" ::: "memory"); }
        }
    }
};
struct EpiResidQ {
    static constexpr bool PERM = true, AFTER_DRAIN = false, NEED_R = false;
    bf16_t* HBio; float* RSo; float alpha; unsigned* ROWMAX; unsigned* CNT; unsigned char* Q8; float* SCq;
    __device__ __forceinline__ void operator()(f32x4 (&acc)[2][2][4][2], const Unit& u, int wr, int wc, int fr, int fq, const PG8_LAS float*) const {
        const int row0 = u.pm * BM + wr * 64 + fr, col0 = u.pn * BM + wc * 32 + 8 * fq;
#pragma unroll
        for (int ai = 0; ai < 2; ++ai) {
            u32x4 bv[4][2];
#pragma unroll
            for (int m = 0; m < 4; ++m)
#pragma unroll
                for (int bj = 0; bj < 2; ++bj) bv[m][bj] = *(const u32x4*)(HBio + (size_t)(row0 + ai * HALF + m * 16) * 1024 + col0 + bj * HALF);
            asm volatile("" ::: "memory");
#pragma unroll
            for (int m = 0; m < 4; ++m) { const int row = row0 + ai * HALF + m * 16; float ssq = 0.f, am = 0.f;
#pragma unroll
                for (int bj = 0; bj < 2; ++bj) { const size_t off = (size_t)row * 1024 + col0 + bj * HALF; const u32x4 p = bv[m][bj];
                    const f32x4 v0 = (f32x4){bf_lo(p.x), bf_hi(p.x), bf_lo(p.y), bf_hi(p.y)} + acc[ai][bj][m][0] * alpha, v1 = (f32x4){bf_lo(p.z), bf_hi(p.z), bf_lo(p.w), bf_hi(p.w)} + acc[ai][bj][m][1] * alpha;
                    acc[ai][bj][m][0] = v0; acc[ai][bj][m][1] = v1;
                    u32x4 w; w.x = cvt_pk_bf16(v0[0], v0[1]); w.y = cvt_pk_bf16(v0[2], v0[3]); w.z = cvt_pk_bf16(v1[0], v1[1]); w.w = cvt_pk_bf16(v1[2], v1[3]);
                    *(u32x4*)(HBio + off) = w;
                    ssq += (v0[0] * v0[0] + v0[1] * v0[1]) + (v0[2] * v0[2] + v0[3] * v0[3]) + (v1[0] * v1[0] + v1[1] * v1[1]) + (v1[2] * v1[2] + v1[3] * v1[3]);
                    am = fmaxf(am, fmaxf(fmaxf(fmaxf(fabsf(v0[0]), fabsf(v0[1])), fmaxf(fabsf(v0[2]), fabsf(v0[3]))), fmaxf(fmaxf(fabsf(v1[0]), fabsf(v1[1])), fmaxf(fabsf(v1[2]), fabsf(v1[3]))))); }
                ssq = xsum_16_32(ssq);
                am = xmax_16_32(am);
                if (fq == 0) { RSo[(size_t)row * 16 + u.pn * 4 + wc] = ssq; (void)__hip_atomic_fetch_max(ROWMAX + row, __builtin_bit_cast(unsigned, am), __ATOMIC_RELAXED, __HIP_MEMORY_SCOPE_AGENT); } }
            asm volatile("" ::: "memory"); }
        asm volatile("s_waitcnt vmcnt(0)" ::: "memory"); __builtin_amdgcn_s_barrier();
        if (wr == 0 && wc == 0 && fr == 0 && fq == 0) {
            (void)__hip_atomic_fetch_add(CNT + u.pm, 1u, __ATOMIC_RELAXED, __HIP_MEMORY_SCOPE_AGENT);
            unsigned sp = 0u; while (__hip_atomic_load(CNT + u.pm, __ATOMIC_RELAXED, __HIP_MEMORY_SCOPE_AGENT) < 4u) { __builtin_amdgcn_s_sleep(1); if (++sp > (1u << 22)) break; } }
        asm volatile("s_waitcnt vmcnt(0)" ::: "memory"); __builtin_amdgcn_s_barrier(); asm volatile("" ::: "memory");
        typedef unsigned u32x2 __attribute__((ext_vector_type(2)));
#pragma unroll
        for (int ai = 0; ai < 2; ++ai)
#pragma unroll
            for (int m = 0; m < 4; ++m) { const int row = row0 + ai * HALF + m * 16;
                const float amx = __builtin_bit_cast(float, __hip_atomic_load(ROWMAX + row, __ATOMIC_RELAXED, __HIP_MEMORY_SCOPE_AGENT)); const float inv = (amx > 0.f) ? 127.0f / amx : 0.f;
#pragma unroll
                for (int bj = 0; bj < 2; ++bj) { unsigned q[2];
#pragma unroll
                    for (int n = 0; n < 2; ++n) { unsigned pq = 0u;
#pragma unroll
                        for (int j = 0; j < 4; ++j) pq |= ((unsigned)(int)__builtin_rintf(acc[ai][bj][m][n][j] * inv) & 255u) << (8 * j);
                        q[n] = pq; }
                    *(u32x2*)(Q8 + (size_t)row * 1024 + col0 + bj * HALF) = (u32x2){q[0], q[1]}; }
                if (u.pn == 0 && wc == 0 && fq == 0) SCq[row] = (amx > 0.f) ? amx * (1.0f / 127.0f) : 1.0f; }
    }
};
struct EpiSig8 {
    static constexpr bool PERM = true, AFTER_DRAIN = false, NEED_R = true;
    unsigned char* O8; const float* RS;
    __device__ __forceinline__ void operator()(f32x4 (&acc)[2][2][4][2], const Unit& u, int wr, int wc, int fr, int fq, const PG8_LAS float* rtab) const {
        typedef unsigned u32x2 __attribute__((ext_vector_type(2)));
        const int row0 = u.pm * BM + wr * 64 + fr, col0 = u.pn * BM + wc * 32 + 8 * fq;
#pragma unroll
        for (int ai = 0; ai < 2; ++ai)
#pragma unroll
            for (int m = 0; m < 4; ++m) { const int row = row0 + ai * HALF + m * 16; const float rl = rtab[ai * HALF + wr * 64 + m * 16 + fr] * -1.4426950408889634f;
#pragma unroll
                for (int bj = 0; bj < 2; ++bj) { unsigned q[2];
#pragma unroll
                    for (int n = 0; n < 2; ++n) q[n] = sig8_pack<0>(acc[ai][bj][m][n] * rl);
                    *(u32x2*)(O8 + (size_t)row * 512 + col0 + bj * HALF) = (u32x2){q[0], q[1]}; } }
    }
};
struct EpiResidX {
    static constexpr bool PERM = true, AFTER_DRAIN = false, NEED_R = false;
    const unsigned char* Q8; const unsigned char* E8; const float* SC; bf16_t* HBo; float* RSo; float alpha;
    __device__ __forceinline__ void operator()(f32x4 (&acc)[2][2][4][2], const Unit& u, int wr, int wc, int fr, int fq, const PG8_LAS float*) const {
        typedef unsigned u32x2 __attribute__((ext_vector_type(2)));
        const int row0 = u.pm * BM + wr * 64 + fr, col0 = u.pn * BM + wc * 32 + 8 * fq;
#pragma unroll
        for (int ai = 0; ai < 2; ++ai) {
            u32x2 qv[4][2], ev[4][2]; float sv[4];
#pragma unroll
            for (int m = 0; m < 4; ++m) { const int row = row0 + ai * HALF + m * 16; sv[m] = SC[row];
#pragma unroll
                for (int bj = 0; bj < 2; ++bj) { const size_t off = (size_t)row * 1024 + col0 + bj * HALF; qv[m][bj] = *(const u32x2*)(Q8 + off); ev[m][bj] = *(const u32x2*)(E8 + off); } }
            asm volatile("" ::: "memory");
#pragma unroll
            for (int m = 0; m < 4; ++m) { const int row = row0 + ai * HALF + m * 16; float ssq = 0.f; const float s1 = sv[m], s2 = sv[m] * (1.0f / 254.0f);
#pragma unroll
                for (int bj = 0; bj < 2; ++bj) { const size_t off = (size_t)row * 1024 + col0 + bj * HALF; f32x4 v[2];
#pragma unroll
                    for (int n = 0; n < 2; ++n)
#pragma unroll
                        for (int j = 0; j < 4; ++j) { const float qf_ = (float)(int)(signed char)((qv[m][bj][n] >> (8 * j)) & 255u), ef_ = (float)(int)(signed char)((ev[m][bj][n] >> (8 * j)) & 255u);
                            v[n][j] = (qf_ * s1 + ef_ * s2) + acc[ai][bj][m][n][j] * alpha; }
                    u32x4 w; w.x = cvt_pk_bf16(v[0][0], v[0][1]); w.y = cvt_pk_bf16(v[0][2], v[0][3]); w.z = cvt_pk_bf16(v[1][0], v[1][1]); w.w = cvt_pk_bf16(v[1][2], v[1][3]);
                    *(u32x4*)(HBo + off) = w;
                    ssq += (v[0][0] * v[0][0] + v[0][1] * v[0][1]) + (v[0][2] * v[0][2] + v[0][3] * v[0][3]) + (v[1][0] * v[1][0] + v[1][1] * v[1][1]) + (v[1][2] * v[1][2] + v[1][3] * v[1][3]); }
                ssq = xsum_16_32(ssq);
                if (fq == 0) RSo[(size_t)row * 16 + u.pn * 4 + wc] = ssq; }
            asm volatile("" ::: "memory"); }
    }
};
struct EpiNull {
    static constexpr bool PERM = true, AFTER_DRAIN = false, NEED_R = false;
    float* O;
    __device__ __forceinline__ void operator()(f32x4 (&acc)[2][2][4][2], const Unit& u, int wr, int wc, int fr, int fq, const PG8_LAS float*) const {
        float s_ = 0.f;
#pragma unroll
        for (int ai = 0; ai < 2; ++ai)
#pragma unroll
            for (int bj = 0; bj < 2; ++bj)
#pragma unroll
                for (int m = 0; m < 4; ++m)
#pragma unroll
                    for (int n = 0; n < 2; ++n) s_ += (acc[ai][bj][m][n][0] + acc[ai][bj][m][n][1]) + (acc[ai][bj][m][n][2] + acc[ai][bj][m][n][3]);
        if (s_ == 12345.678f) O[u.pm * 7 + u.pn + wr + wc + fr + fq] = s_;
    }
};
struct EpiPlain {
    static constexpr bool PERM = true, AFTER_DRAIN = false, NEED_R = false;
    bf16_t* O;
    __device__ __forceinline__ void operator()(f32x4 (&acc)[2][2][4][2], const Unit& u, int wr, int wc, int fr, int fq, const PG8_LAS float*) const {
        const int row0 = u.pm * BM + wr * 64 + fr, col0 = u.pn * BM + wc * 32 + 8 * fq;
#pragma unroll
        for (int ai = 0; ai < 2; ++ai)
#pragma unroll
            for (int m = 0; m < 4; ++m) { const int row = row0 + ai * HALF + m * 16;
#pragma unroll
                for (int bj = 0; bj < 2; ++bj) { const f32x4 v0 = acc[ai][bj][m][0], v1 = acc[ai][bj][m][1];
                    u32x4 w; w.x = cvt_pk_bf16(v0[0], v0[1]); w.y = cvt_pk_bf16(v0[2], v0[3]); w.z = cvt_pk_bf16(v1[0], v1[1]); w.w = cvt_pk_bf16(v1[2], v1[3]);
                    *(u32x4*)(O + (size_t)row * 1024 + col0 + bj * HALF) = w; } }
    }
};
struct EpiFinal {
    static constexpr bool PERM = true, AFTER_DRAIN = false, NEED_R = true;
    float* out; const bf16_t* HBr; const bf16_t* PE; const float* RS;
    __device__ __forceinline__ void operator()(f32x4 (&acc)[2][2][4][2], const Unit& u, int wr, int wc, int fr, int fq, const PG8_LAS float* rtab) const {
        const int row0 = u.pm * BM + wr * 64 + fr, col0 = u.pn * BM + wc * 32 + 8 * fq;
#pragma unroll
        for (int ai = 0; ai < 2; ++ai) {
            u32x4 hv[4][2], pv[4][2];
#pragma unroll
            for (int m = 0; m < 4; ++m)
#pragma unroll
                for (int bj = 0; bj < 2; ++bj) { const size_t off = (size_t)(row0 + ai * HALF + m * 16) * 1024 + col0 + bj * HALF; hv[m][bj] = *(const u32x4*)(HBr + off); pv[m][bj] = *(const u32x4*)(PE + off); }
            asm volatile("" ::: "memory");
#pragma unroll
            for (int m = 0; m < 4; ++m) { const float r = rtab[ai * HALF + wr * 64 + m * 16 + fr];
#pragma unroll
                for (int bj = 0; bj < 2; ++bj) { const size_t off = (size_t)(row0 + ai * HALF + m * 16) * 1024 + col0 + bj * HALF; const u32x4 b = hv[m][bj], p = pv[m][bj];
                    f32x4 v0, v1;
                    v0[0] = bf_lo(b.x) + bf_lo(p.x) * sigmoidf_(acc[ai][bj][m][0][0] * r); v0[1] = bf_hi(b.x) + bf_hi(p.x) * sigmoidf_(acc[ai][bj][m][0][1] * r);
                    v0[2] = bf_lo(b.y) + bf_lo(p.y) * sigmoidf_(acc[ai][bj][m][0][2] * r); v0[3] = bf_hi(b.y) + bf_hi(p.y) * sigmoidf_(acc[ai][bj][m][0][3] * r);
                    v1[0] = bf_lo(b.z) + bf_lo(p.z) * sigmoidf_(acc[ai][bj][m][1][0] * r); v1[1] = bf_hi(b.z) + bf_hi(p.z) * sigmoidf_(acc[ai][bj][m][1][1] * r);
                    v1[2] = bf_lo(b.w) + bf_lo(p.w) * sigmoidf_(acc[ai][bj][m][1][2] * r); v1[3] = bf_hi(b.w) + bf_hi(p.w) * sigmoidf_(acc[ai][bj][m][1][3] * r);
                    *(f32x4*)(out + off) = v0; *(f32x4*)(out + off + 4) = v1; } }
            asm volatile("" ::: "memory"); }
    }
};

template <class Epi, class Sched, bool ALIGN_EPI = false, bool SP2 = false, bool BAL = false, bool I8 = false>
__device__ __forceinline__ void gemm_phase(PG8_LAS unsigned char* lds, const Gemm g, const Sched& S, const Epi& E, const int wid) {
    int lane; asm volatile("v_mbcnt_lo_u32_b32 %0, -1, 0\n\tv_mbcnt_hi_u32_b32 %0, -1, %0" : "=v"(lane));
    const int tid = wid * 64 + lane, wr = wid >> 2, wc = wid & 3, fr = lane & 15, fq = lane >> 4;
    const int K = g.K, nt = K / BK;
    unsigned voffA[2], voffB[2];
#pragma unroll
    for (int i = 0; i < 2; ++i) { int R, C; stage_rc(tid * 16 + i * 8192, R, C); const int Rb = Epi::PERM ? ((R & ~31) + perm32(R & 31)) : R;
        voffA[i] = (unsigned)(R * K + C) * 2u; voffB[i] = (unsigned)(Rb * K + C) * 2u; }
    const size_t kstep = (size_t)(BK * 2);
    const size_t hstep = (size_t)HALF * K * 2;
    const size_t tstep = 2 * hstep;
    const unsigned ldsw = (unsigned)wid * 1024u;
    const int aoff = lds_byte(wr * 64 + fr, fq * 8), boff = lds_byte(wc * 32 + fr, fq * 8);
#define PG8_SA(b, h) (((b) * 2 + (h)) * HTB)
#define PG8_SB(b, h) ((4 + (b) * 2 + (h)) * HTB)
#define PG8_STAGE(bufoff, gbase, voff) do { _Pragma("unroll") for (int _i = 0; _i < 2; ++_i) \
        __builtin_amdgcn_global_load_lds((const unsigned*)((const char*)(gbase) + (voff)[_i]), (PG8_LAS unsigned*)(lds + (bufoff) + ldsw + _i * 8192), 16, 0, 0); } while (0)
#define PG8_LDA(dst, b, h) do { _Pragma("unroll") for (int m = 0; m < 4; ++m) _Pragma("unroll") for (int k = 0; k < 2; ++k) dst[m][k] = *(const PG8_LAS bf16x8*)(lds + PG8_SA(b, h) + aoff + m * 2048 + k * 1024); } while (0)
#define PG8_LDB(dst, b, h) do { _Pragma("unroll") for (int n = 0; n < 2; ++n) _Pragma("unroll") for (int k = 0; k < 2; ++k) dst[n][k] = *(const PG8_LAS bf16x8*)(lds + PG8_SB(b, h) + boff + n * 2048 + k * 1024); } while (0)
#define PG8_MMA(ai, bj, At, Bt) do { __builtin_amdgcn_s_setprio(3); _Pragma("unroll") for (int m = 0; m < 4; ++m) _Pragma("unroll") for (int n = 0; n < 2; ++n) _Pragma("unroll") for (int k = 0; k < 2; ++k) \
        { if constexpr (I8) acc[ai][bj][m][n] = __builtin_bit_cast(f32x4, __builtin_amdgcn_mfma_i32_16x16x64_i8(__builtin_bit_cast(i32x4, Bt[n][k]), __builtin_bit_cast(i32x4, At[m][k]), __builtin_bit_cast(i32x4, acc[ai][bj][m][n]), 0, 0, 0)); \
          else acc[ai][bj][m][n] = __builtin_amdgcn_mfma_f32_16x16x32_bf16(Bt[n][k], At[m][k], acc[ai][bj][m][n], 0, 0, 0); } __builtin_amdgcn_s_setprio(0); } while (0)
#define PG8_WAIT_V(n) asm volatile("s_waitcnt vmcnt(" #n ")" ::: "memory")
#define PG8_WAIT_L(n) asm volatile("s_waitcnt lgkmcnt(" #n ")" ::: "memory")
#define PG8_BAR __builtin_amdgcn_s_barrier()
#define PG8_SCHED __builtin_amdgcn_sched_barrier(0)
    Unit cur, nxt; int ui = 0; int rt_pm = -1; PG8_LAS float* rtab = (PG8_LAS float*)(lds + RTAB_OFF);
    if (!S.next(0, cur)) return;
    f32x4 acc[2][2][4][2];
#pragma unroll
    for (int a = 0; a < 2; ++a)
#pragma unroll
        for (int b = 0; b < 2; ++b)
#pragma unroll
            for (int m = 0; m < 4; ++m)
#pragma unroll
                for (int n = 0; n < 2; ++n) acc[a][b][m][n] = (f32x4){0.f, 0.f, 0.f, 0.f};
    bf16x8 At[4][2], B0[2][2], B1[2][2];
    const char* cA = (const char*)g.A + (size_t)cur.pm * tstep; const char* cB = (const char*)g.Bt + (size_t)cur.pn * tstep;
    PG8_LAS float* sct = (PG8_LAS float*)(lds + SCT_OFF);
#define PG8_SCT_DMA(u_, par_) do { if (wid < 4) __builtin_amdgcn_global_load_lds((const unsigned*)(g.scw + (u_).pn * BM + wid * 64 + lane), (PG8_LAS unsigned*)(sct + (par_) * 256 + wid * 64), 4, 0, 0); } while (0)
    if constexpr (I8) PG8_SCT_DMA(cur, 0);
    bool rdma = false; int rt_par = 0; PG8_LAS float* rtab2 = (PG8_LAS float*)(lds + RTAB2_OFF);
    if constexpr (I8) rdma = (g.rsf != nullptr);
#define PG8_RT_DMA(u_, par_) do { if (wid < 4) __builtin_amdgcn_global_load_lds((const unsigned*)(g.rsf + (u_).pm * BM + wid * 64 + lane), (PG8_LAS unsigned*)(((par_) ? rtab2 : rtab) + wid * 64), 4, 0, 0); } while (0)
    if constexpr (I8) { if (rdma) PG8_RT_DMA(cur, 0); }
    if constexpr (SP2 && BAL) {
        PG8_STAGE(PG8_SB(0, 0), cB, voffB); PG8_STAGE(PG8_SB(0, 1), cB + hstep, voffB); PG8_STAGE(PG8_SA(0, 0), cA, voffA); PG8_STAGE(PG8_SA(0, 1), cA + hstep, voffA);
        if (wr == 1) PG8_BAR;
        PG8_WAIT_V(2); PG8_BAR;
        PG8_STAGE(PG8_SB(1, 0), cB + kstep, voffB); PG8_STAGE(PG8_SB(1, 1), cB + hstep + kstep, voffB);
        PG8_WAIT_V(4); PG8_BAR;
    } else if constexpr (SP2) {
        PG8_STAGE(PG8_SB(0, 0), cB, voffB); PG8_STAGE(PG8_SB(0, 1), cB + hstep, voffB); PG8_STAGE(PG8_SA(0, 0), cA, voffA); PG8_STAGE(PG8_SA(0, 1), cA + hstep, voffA);
        if (wr == 1) PG8_BAR;
        PG8_WAIT_V(2); PG8_BAR;
        PG8_STAGE(PG8_SB(1, 0), cB + kstep, voffB); PG8_STAGE(PG8_SA(1, 0), cA + kstep, voffA); PG8_STAGE(PG8_SB(1, 1), cB + hstep + kstep, voffB);
        PG8_WAIT_V(6); PG8_BAR;
    } else {
        PG8_STAGE(PG8_SB(0, 0), cB, voffB); PG8_STAGE(PG8_SA(0, 0), cA, voffA); PG8_STAGE(PG8_SB(0, 1), cB + hstep, voffB); PG8_STAGE(PG8_SA(0, 1), cA + hstep, voffA);
        if (wr == 1) PG8_BAR;
        PG8_WAIT_V(4); PG8_BAR;
        PG8_STAGE(PG8_SB(1, 0), cB + kstep, voffB); PG8_STAGE(PG8_SA(1, 0), cA + kstep, voffA); PG8_STAGE(PG8_SB(1, 1), cB + hstep + kstep, voffB);
        PG8_WAIT_V(6); PG8_BAR;
    }
    for (;;) {
        const bool has_next = S.next(ui + 1, nxt);
        const char* nA = has_next ? (const char*)((Sched::PAIR && nxt.w) ? g.A2 : g.A) + (size_t)nxt.pm * tstep : cA; const char* nB = has_next ? (const char*)((Sched::PAIR && nxt.w) ? g.Bt2 : g.Bt) + (size_t)nxt.pn * tstep : cB;
#pragma unroll 1
        for (int t = 0; t < nt; t += 2) {
            const bool last = (t == nt - 2);
            const char* a1 = cA + (size_t)(t + 1) * kstep;
            const char* a2 = last ? nA : cA + (size_t)(t + 2) * kstep; const char* b2 = last ? nB : cB + (size_t)(t + 2) * kstep;
            const char* a3 = a2 + kstep; const char* b3 = b2 + kstep;
            if constexpr (SP2 && BAL) {
            PG8_LDB(B0, 0, 0); PG8_LDB(B1, 0, 1); PG8_SCHED; PG8_LDA(At, 0, 0); PG8_STAGE(PG8_SA(1, 1), a1 + hstep, voffA); PG8_STAGE(PG8_SA(1, 0), a1, voffA);
            PG8_WAIT_V(8); PG8_WAIT_L(0); PG8_BAR; PG8_MMA(0, 0, At, B0); PG8_MMA(0, 1, At, B1); PG8_BAR; PG8_SCHED;
            PG8_LDA(At, 0, 1); PG8_STAGE(PG8_SB(0, 0), b2, voffB); PG8_STAGE(PG8_SB(0, 1), b2 + hstep, voffB);
            PG8_WAIT_V(4); PG8_WAIT_L(0); PG8_BAR; PG8_MMA(1, 0, At, B0); PG8_MMA(1, 1, At, B1); PG8_BAR; PG8_SCHED;
            PG8_LDB(B0, 1, 0); PG8_LDB(B1, 1, 1); PG8_SCHED; PG8_LDA(At, 1, 0); PG8_STAGE(PG8_SA(0, 1), a2 + hstep, voffA); PG8_STAGE(PG8_SA(0, 0), a2, voffA);
            PG8_WAIT_V(8); PG8_WAIT_L(0); PG8_BAR; PG8_MMA(0, 0, At, B0); PG8_MMA(0, 1, At, B1); PG8_BAR; PG8_SCHED;
            PG8_LDA(At, 1, 1); PG8_STAGE(PG8_SB(1, 0), b3, voffB); PG8_STAGE(PG8_SB(1, 1), b3 + hstep, voffB);
            PG8_WAIT_V(4); PG8_WAIT_L(0); PG8_BAR; PG8_MMA(1, 0, At, B0); PG8_MMA(1, 1, At, B1); PG8_BAR; PG8_SCHED;
            } else if constexpr (SP2) {
            PG8_LDB(B0, 0, 0); PG8_LDB(B1, 0, 1); PG8_SCHED; PG8_LDA(At, 0, 0); PG8_STAGE(PG8_SA(1, 1), a1 + hstep, voffA);
            PG8_WAIT_V(8); PG8_WAIT_L(0); PG8_BAR; PG8_MMA(0, 0, At, B0); PG8_MMA(0, 1, At, B1); PG8_BAR; PG8_SCHED;
            PG8_LDA(At, 0, 1); PG8_STAGE(PG8_SB(0, 0), b2, voffB); PG8_STAGE(PG8_SB(0, 1), b2 + hstep, voffB); PG8_STAGE(PG8_SA(0, 0), a2, voffA);
            PG8_WAIT_V(8); PG8_WAIT_L(0); PG8_BAR; PG8_MMA(1, 0, At, B0); PG8_MMA(1, 1, At, B1); PG8_BAR; PG8_SCHED;
            PG8_LDB(B0, 1, 0); PG8_LDB(B1, 1, 1); PG8_SCHED; PG8_LDA(At, 1, 0); PG8_STAGE(PG8_SA(0, 1), a2 + hstep, voffA);
            PG8_WAIT_V(8); PG8_WAIT_L(0); PG8_BAR; PG8_MMA(0, 0, At, B0); PG8_MMA(0, 1, At, B1); PG8_BAR; PG8_SCHED;
            PG8_LDA(At, 1, 1); PG8_STAGE(PG8_SB(1, 0), b3, voffB); PG8_STAGE(PG8_SB(1, 1), b3 + hstep, voffB); PG8_STAGE(PG8_SA(1, 0), a3, voffA);
            PG8_WAIT_V(8); PG8_WAIT_L(0); PG8_BAR; PG8_MMA(1, 0, At, B0); PG8_MMA(1, 1, At, B1); PG8_BAR; PG8_SCHED;
            } else {
            PG8_LDB(B0, 0, 0); PG8_SCHED; PG8_LDA(At, 0, 0); PG8_STAGE(PG8_SA(1, 1), a1 + hstep, voffA);
            PG8_WAIT_L(8); PG8_BAR; PG8_WAIT_L(0); PG8_MMA(0, 0, At, B0); PG8_BAR; PG8_SCHED;
            PG8_LDB(B1, 0, 1); PG8_STAGE(PG8_SB(0, 0), b2, voffB);
            PG8_BAR; PG8_WAIT_L(0); PG8_MMA(0, 1, At, B1); PG8_BAR;
            PG8_LDA(At, 0, 1); PG8_STAGE(PG8_SA(0, 0), a2, voffA);
            PG8_BAR; PG8_WAIT_L(0); PG8_MMA(1, 0, At, B0); PG8_BAR; PG8_SCHED;
            PG8_STAGE(PG8_SB(0, 1), b2 + hstep, voffB);
            PG8_WAIT_V(6); PG8_BAR; PG8_MMA(1, 1, At, B1); PG8_BAR;
            PG8_LDB(B0, 1, 0); PG8_SCHED; PG8_LDA(At, 1, 0); PG8_STAGE(PG8_SA(0, 1), a2 + hstep, voffA);
            PG8_WAIT_L(8); PG8_BAR; PG8_WAIT_L(0); PG8_MMA(0, 0, At, B0); PG8_BAR; PG8_SCHED;
            PG8_LDB(B1, 1, 1); PG8_STAGE(PG8_SB(1, 0), b3, voffB);
            PG8_BAR; PG8_WAIT_L(0); PG8_MMA(0, 1, At, B1); PG8_BAR;
            PG8_LDA(At, 1, 1); PG8_STAGE(PG8_SA(1, 0), a3, voffA);
            PG8_BAR; PG8_WAIT_L(0); PG8_MMA(1, 0, At, B0); PG8_BAR; PG8_SCHED;
            PG8_STAGE(PG8_SB(1, 1), b3 + hstep, voffB);
            PG8_WAIT_V(6); PG8_BAR; PG8_MMA(1, 1, At, B1); PG8_BAR;
            }
        }
        if constexpr (I8) { if (has_next) PG8_SCT_DMA(nxt, (ui + 1) & 1);
            if (rdma && has_next && nxt.pm != cur.pm) PG8_RT_DMA(nxt, rt_par ^ 1); }
        if constexpr (ALIGN_EPI) { if (wr == 0) PG8_BAR; }
        if constexpr (Epi::NEED_R) {
            static_assert(ALIGN_EPI, "row-scale table needs both halves in the epilogue together");
            if (!rdma && cur.pm != rt_pm) {
                if (tid < 256) { const f32x4* rp = (const f32x4*)(E.RS + (size_t)(cur.pm * BM + tid) * 16); const f32x4 p0 = rp[0], p1 = rp[1], p2 = rp[2], p3 = rp[3];
                    const float ss = ((p0[0] + p0[1]) + (p0[2] + p0[3])) + ((p1[0] + p1[1]) + (p1[2] + p1[3])) + ((p2[0] + p2[1]) + (p2[2] + p2[3])) + ((p3[0] + p3[1]) + (p3[2] + p3[3]));
                    float rv_ = __builtin_amdgcn_rsqf(ss * (1.0f / 1024.0f) + RMS_EPS); if constexpr (I8) rv_ *= g.sch[cur.pm * BM + tid]; rtab[tid] = rv_; }
                PG8_WAIT_L(0); PG8_BAR; rt_pm = cur.pm; }
        }
        if constexpr (I8) {
#pragma unroll
            for (int bj = 0; bj < 2; ++bj) { const PG8_LAS float* sp_ = sct + (ui & 1) * 256 + bj * HALF + wc * 32 + 8 * fq; const f32x4 s0 = *(const PG8_LAS f32x4*)sp_, s1 = *(const PG8_LAS f32x4*)(sp_ + 4);
#pragma unroll
                for (int ai = 0; ai < 2; ++ai)
#pragma unroll
                    for (int m = 0; m < 4; ++m) { acc[ai][bj][m][0] = __builtin_convertvector(__builtin_bit_cast(i32x4, acc[ai][bj][m][0]), f32x4) * s0; acc[ai][bj][m][1] = __builtin_convertvector(__builtin_bit_cast(i32x4, acc[ai][bj][m][1]), f32x4) * s1; } } }
        E(acc, cur, wr, wc, fr, fq, (const PG8_LAS float*)((I8 && rt_par) ? rtab2 : rtab));
        if (!has_next) break;
        if constexpr (I8) { if (rdma && nxt.pm != cur.pm) rt_par ^= 1; }
        if (!Sched::PAIR || cur.w) {
#pragma unroll
        for (int a = 0; a < 2; ++a)
#pragma unroll
            for (int b = 0; b < 2; ++b)
#pragma unroll
                for (int m = 0; m < 4; ++m)
#pragma unroll
                    for (int n = 0; n < 2; ++n) acc[a][b][m][n] = (f32x4){0.f, 0.f, 0.f, 0.f}; }
        cur = nxt; cA = nA; cB = nB; ++ui;
        if constexpr (ALIGN_EPI) { if (wr == 1) PG8_BAR; }
    }
    PG8_WAIT_V(0);
    if constexpr (!ALIGN_EPI) { if (wr == 0) PG8_BAR; }
    PG8_BAR;
#undef PG8_SA
#undef PG8_SB
#undef PG8_STAGE
#undef PG8_LDA
#undef PG8_LDB
#undef PG8_MMA
#undef PG8_SCT_DMA
#undef PG8_RT_DMA
#undef PG8_WAIT_V
#undef PG8_WAIT_L
#undef PG8_BAR
#undef PG8_SCHED
}

struct EpiFinal2 {
    static constexpr bool PERM = true, AFTER_DRAIN = false, NEED_R = true;
    float* out; const bf16_t* HBr; const float* RS;
    static constexpr int NREG = 26;
    struct State { unsigned s8[NREG]; };
    __device__ __forceinline__ void operator()(f32x4 (&acc)[2][2][4][2], State& st, const Unit& u, int wr, int wc, int fr, int fq, const PG8_LAS float* rtab, PG8_LAS unsigned* xl) const {
        if (u.w == 0) {
#pragma unroll
            for (int ai = 0; ai < 2; ++ai)
#pragma unroll
                for (int m = 0; m < 4; ++m) { const float rl = rtab[ai * HALF + wr * 64 + m * 16 + fr] * -1.4426950408889634f;
#pragma unroll
                    for (int bj = 0; bj < 2; ++bj)
#pragma unroll
                        for (int n = 0; n < 2; ++n) { unsigned p = sig8_pack<0>(acc[ai][bj][m][n] * rl);
                            asm volatile("" : "+v"(p));
                            { constexpr int dummy_ = 0; (void)dummy_; const int ix = ((ai * 2 + bj) * 4 + m) * 2 + n; if (ix < NREG) st.s8[ix < NREG ? ix : 0] = p; else xl[(ix - NREG) * 512] = p; }
                            acc[ai][bj][m][n] = (f32x4){0.f, 0.f, 0.f, 0.f}; } }
        } else {
            const int row0 = u.pm * BM + wr * 64 + fr, col0 = u.pn * BM + wc * 32 + 8 * fq;
#pragma unroll
            for (int ai = 0; ai < 2; ++ai) {
                u32x4 hv[4][2];
#pragma unroll
                for (int m = 0; m < 4; ++m)
#pragma unroll
                    for (int bj = 0; bj < 2; ++bj) hv[m][bj] = *(const u32x4*)(HBr + (size_t)(row0 + ai * HALF + m * 16) * 1024 + col0 + bj * HALF);
                asm volatile("" ::: "memory");
#pragma unroll
                for (int m = 0; m < 4; ++m)
#pragma unroll
                    for (int bj = 0; bj < 2; ++bj) { const size_t off = (size_t)(row0 + ai * HALF + m * 16) * 1024 + col0 + bj * HALF; const u32x4 b = hv[m][bj];
                        const int ix0 = ((ai * 2 + bj) * 4 + m) * 2, ix1 = ix0 + 1; constexpr float I255 = 1.0f / 255.0f;
                        const unsigned q0 = (ix0 < NREG) ? st.s8[ix0 < NREG ? ix0 : 0] : xl[(ix0 - NREG) * 512], q1 = (ix1 < NREG) ? st.s8[ix1 < NREG ? ix1 : 0] : xl[(ix1 - NREG) * 512];
                        f32x4 v0, v1;
                        v0[0] = bf_lo(b.x) + acc[ai][bj][m][0][0] * ((float)(q0 & 255u) * I255); v0[1] = bf_hi(b.x) + acc[ai][bj][m][0][1] * ((float)((q0 >> 8) & 255u) * I255);
                        v0[2] = bf_lo(b.y) + acc[ai][bj][m][0][2] * ((float)((q0 >> 16) & 255u) * I255); v0[3] = bf_hi(b.y) + acc[ai][bj][m][0][3] * ((float)(q0 >> 24) * I255);
                        v1[0] = bf_lo(b.z) + acc[ai][bj][m][1][0] * ((float)(q1 & 255u) * I255); v1[1] = bf_hi(b.z) + acc[ai][bj][m][1][1] * ((float)((q1 >> 8) & 255u) * I255);
                        v1[2] = bf_lo(b.w) + acc[ai][bj][m][1][2] * ((float)((q1 >> 16) & 255u) * I255); v1[3] = bf_hi(b.w) + acc[ai][bj][m][1][3] * ((float)(q1 >> 24) * I255);
                        *(f32x4*)(out + off) = v0; *(f32x4*)(out + off + 4) = v1; }
                asm volatile("" ::: "memory"); }
        }
    }
};
template <class Epi>
__device__ __forceinline__ void gemm_phase_dk(PG8_LAS unsigned char* lds, const Gemm g, const PairOrder& S, const Epi& E, const int wid) {
    int lane; asm volatile("v_mbcnt_lo_u32_b32 %0, -1, 0\n\tv_mbcnt_hi_u32_b32 %0, -1, %0" : "=v"(lane));
    const int tid = wid * 64 + lane, wr = wid >> 2, wc = wid & 3, fr = lane & 15, fq = lane >> 4;
    const int K0 = g.K, K1 = g.K2, nt0 = K0 / BK, nt1 = K1 / BK;
    unsigned vA0[2], vB0[2];
#pragma unroll
    for (int i = 0; i < 2; ++i) { int R, C; stage_rc(tid * 16 + i * 8192, R, C); const int Rb = (R & ~31) + perm32(R & 31);
        vA0[i] = (unsigned)(R * K0 + C) * 2u; vB0[i] = (unsigned)(Rb * K0 + C) * 2u; }
    const size_t kstep = (size_t)(BK * 2);
    const size_t hs0 = (size_t)HALF * K0 * 2, hs1 = (size_t)HALF * K1 * 2;
    const unsigned ldsw = (unsigned)wid * 1024u;
    const int aoff = lds_byte(wr * 64 + fr, fq * 8), boff = lds_byte(wc * 32 + fr, fq * 8);
#define PG8_SA(b, h) (((b) * 2 + (h)) * HTB)
#define PG8_SB(b, h) ((4 + (b) * 2 + (h)) * HTB)
#define PG8_STAGE(bufoff, gbase, voff) do { _Pragma("unroll") for (int _i = 0; _i < 2; ++_i) \
        __builtin_amdgcn_global_load_lds((const unsigned*)((const char*)(gbase) + (voff)[_i]), (PG8_LAS unsigned*)(lds + (bufoff) + ldsw + _i * 8192), 16, 0, 0); } while (0)
#define DK_V1(v) ((((v) >> 11) * (unsigned)K1 + (((v) >> 1) & 1023u)) * 2u)
#define DK_STA(bufoff, gbase, sel) do { if (sel) { unsigned t_[2] = {vA0[0], vA0[1]}; asm volatile("" : "+v"(t_[0]), "+v"(t_[1])); t_[0] = DK_V1(t_[0]); t_[1] = DK_V1(t_[1]); PG8_STAGE(bufoff, gbase, t_); } else PG8_STAGE(bufoff, gbase, vA0); } while (0)
#define DK_STB(bufoff, gbase, sel) do { if (sel) { unsigned t_[2] = {vB0[0], vB0[1]}; asm volatile("" : "+v"(t_[0]), "+v"(t_[1])); t_[0] = DK_V1(t_[0]); t_[1] = DK_V1(t_[1]); PG8_STAGE(bufoff, gbase, t_); } else PG8_STAGE(bufoff, gbase, vB0); } while (0)
#define PG8_LDA(dst, b, h) do { _Pragma("unroll") for (int m = 0; m < 4; ++m) _Pragma("unroll") for (int k = 0; k < 2; ++k) dst[m][k] = *(const PG8_LAS bf16x8*)(lds + PG8_SA(b, h) + aoff + m * 2048 + k * 1024); } while (0)
#define PG8_LDB(dst, b, h) do { _Pragma("unroll") for (int n = 0; n < 2; ++n) _Pragma("unroll") for (int k = 0; k < 2; ++k) dst[n][k] = *(const PG8_LAS bf16x8*)(lds + PG8_SB(b, h) + boff + n * 2048 + k * 1024); } while (0)
#define PG8_MMA(ai, bj, At, Bt) do { __builtin_amdgcn_s_setprio(3); _Pragma("unroll") for (int m = 0; m < 4; ++m) _Pragma("unroll") for (int n = 0; n < 2; ++n) _Pragma("unroll") for (int k = 0; k < 2; ++k) \
        acc[ai][bj][m][n] = __builtin_amdgcn_mfma_f32_16x16x32_bf16(Bt[n][k], At[m][k], acc[ai][bj][m][n], 0, 0, 0); __builtin_amdgcn_s_setprio(0); } while (0)
#define PG8_WAIT_V(n) asm volatile("s_waitcnt vmcnt(" #n ")" ::: "memory")
#define PG8_WAIT_L(n) asm volatile("s_waitcnt lgkmcnt(" #n ")" ::: "memory")
#define PG8_BAR __builtin_amdgcn_s_barrier()
#define PG8_SCHED __builtin_amdgcn_sched_barrier(0)
    Unit cur, nxt; int ui = 0; int rt_pm = -1; PG8_LAS float* rtab = (PG8_LAS float*)(lds + RTAB_OFF);
    if (!S.next(0, cur)) return;
    f32x4 acc[2][2][4][2];
#pragma unroll
    for (int a = 0; a < 2; ++a)
#pragma unroll
        for (int b = 0; b < 2; ++b)
#pragma unroll
            for (int m = 0; m < 4; ++m)
#pragma unroll
                for (int n = 0; n < 2; ++n) acc[a][b][m][n] = (f32x4){0.f, 0.f, 0.f, 0.f};
    typename Epi::State st;
    bf16x8 At[4][2], B0[2][2], B1[2][2];
    const char* cA = (const char*)g.A + (size_t)cur.pm * (2 * hs0); const char* cB = (const char*)g.Bt + (size_t)cur.pn * (2 * hs0);
    PG8_STAGE(PG8_SB(0, 0), cB, vB0); PG8_STAGE(PG8_SB(0, 1), cB + hs0, vB0); PG8_STAGE(PG8_SA(0, 0), cA, vA0); PG8_STAGE(PG8_SA(0, 1), cA + hs0, vA0);
    if (wr == 1) PG8_BAR;
    PG8_WAIT_V(2); PG8_BAR;
    PG8_STAGE(PG8_SB(1, 0), cB + kstep, vB0); PG8_STAGE(PG8_SA(1, 0), cA + kstep, vA0); PG8_STAGE(PG8_SB(1, 1), cB + hs0 + kstep, vB0);
    PG8_WAIT_V(6); PG8_BAR;
    for (;;) {
        const bool has_next = S.next(ui + 1, nxt);
        const bool cw = cur.w != 0, nw = has_next ? (nxt.w != 0) : cw;
        const size_t hsc = cw ? hs1 : hs0; const int ntc = cw ? nt1 : nt0;
        const char* nA = has_next ? (const char*)(nw ? g.A2 : g.A) + (size_t)nxt.pm * (2 * (nw ? hs1 : hs0)) : cA; const char* nB = has_next ? (const char*)(nw ? g.Bt2 : g.Bt) + (size_t)nxt.pn * (2 * (nw ? hs1 : hs0)) : cB;
#pragma unroll 1
        for (int t = 0; t < ntc; t += 2) {
            const bool last = (t == ntc - 2);
            const char* a1 = cA + (size_t)(t + 1) * kstep;
            const char* a2 = last ? nA : cA + (size_t)(t + 2) * kstep; const char* b2 = last ? nB : cB + (size_t)(t + 2) * kstep;
            const char* a3 = a2 + kstep; const char* b3 = b2 + kstep;
            const bool xs = last ? nw : cw; const size_t hx = xs ? hs1 : hs0;
            PG8_LDB(B0, 0, 0); PG8_LDB(B1, 0, 1); PG8_SCHED; PG8_LDA(At, 0, 0); DK_STA(PG8_SA(1, 1), a1 + hsc, cw);
            PG8_WAIT_V(8); PG8_WAIT_L(0); PG8_BAR; PG8_MMA(0, 0, At, B0); PG8_MMA(0, 1, At, B1); PG8_BAR; PG8_SCHED;
            PG8_LDA(At, 0, 1); DK_STB(PG8_SB(0, 0), b2, xs); DK_STB(PG8_SB(0, 1), b2 + hx, xs); DK_STA(PG8_SA(0, 0), a2, xs);
            PG8_WAIT_V(8); PG8_WAIT_L(0); PG8_BAR; PG8_MMA(1, 0, At, B0); PG8_MMA(1, 1, At, B1); PG8_BAR; PG8_SCHED;
            PG8_LDB(B0, 1, 0); PG8_LDB(B1, 1, 1); PG8_SCHED; PG8_LDA(At, 1, 0); DK_STA(PG8_SA(0, 1), a2 + hx, xs);
            PG8_WAIT_V(8); PG8_WAIT_L(0); PG8_BAR; PG8_MMA(0, 0, At, B0); PG8_MMA(0, 1, At, B1); PG8_BAR; PG8_SCHED;
            PG8_LDA(At, 1, 1); DK_STB(PG8_SB(1, 0), b3, xs); DK_STB(PG8_SB(1, 1), b3 + hx, xs); DK_STA(PG8_SA(1, 0), a3, xs);
            PG8_WAIT_V(8); PG8_WAIT_L(0); PG8_BAR; PG8_MMA(1, 0, At, B0); PG8_MMA(1, 1, At, B1); PG8_BAR; PG8_SCHED;
        }
        if (wr == 0) PG8_BAR;
        int l2_; asm volatile("v_mbcnt_lo_u32_b32 %0, -1, 0\n\tv_mbcnt_hi_u32_b32 %0, -1, %0" : "=v"(l2_));
        if (cur.pm != rt_pm) { const int tid2 = wid * 64 + l2_;
            if (tid2 < 256) { const f32x4* rp = (const f32x4*)(E.RS + (size_t)(cur.pm * BM + tid2) * 16); const f32x4 p0 = rp[0], p1 = rp[1], p2 = rp[2], p3 = rp[3];
                const float ss = ((p0[0] + p0[1]) + (p0[2] + p0[3])) + ((p1[0] + p1[1]) + (p1[2] + p1[3])) + ((p2[0] + p2[1]) + (p2[2] + p2[3])) + ((p3[0] + p3[1]) + (p3[2] + p3[3]));
                rtab[tid2] = __builtin_amdgcn_rsqf(ss * (1.0f / 1024.0f) + RMS_EPS); }
            PG8_WAIT_L(0); PG8_BAR; rt_pm = cur.pm; }
        E(acc, st, cur, wr, wc, l2_ & 15, l2_ >> 4, (const PG8_LAS float*)rtab, (PG8_LAS unsigned*)(lds + 139264) + (wid * 64 + l2_));
        if (!has_next) break;
        if (cur.w) {
#pragma unroll
        for (int a = 0; a < 2; ++a)
#pragma unroll
            for (int b = 0; b < 2; ++b)
#pragma unroll
                for (int m = 0; m < 4; ++m)
#pragma unroll
                    for (int n = 0; n < 2; ++n) acc[a][b][m][n] = (f32x4){0.f, 0.f, 0.f, 0.f}; }
        cur = nxt; cA = nA; cB = nB; ++ui;
        if (wr == 1) PG8_BAR;
    }
    PG8_WAIT_V(0);
    PG8_BAR;
#undef PG8_SA
#undef PG8_SB
#undef PG8_STAGE
#undef DK_STA
#undef DK_V1
#undef DK_STB
#undef PG8_LDA
#undef PG8_LDB
#undef PG8_MMA
#undef PG8_WAIT_V
#undef PG8_WAIT_L
#undef PG8_BAR
#undef PG8_SCHED
}
}

using pg8::sigmoidf_;
constexpr int NWAVES = 8, NTHREADS = NWAVES * 64;
constexpr int BATCH = 4, SEQ = 8192, D = 1024, M = BATCH * SEQ, FF = 2816, PLE = 256, D_IN = 8712;
constexpr int NHD = 128;
constexpr int WIN_ROWS = 8960;
constexpr int WIN_ML = 4608, WIN_GT = 6656, WIN_G = 6912;
constexpr int NPHASE = 13;

constexpr size_t MiB = 1u << 20;
constexpr size_t WS_CTL = 0, CTL_ZERO_BYTES = 64 * 1024;
constexpr size_t WS_ROPE = 1 * MiB;
constexpr size_t WS_GATES = 2 * MiB;
constexpr size_t WS_LSE = 3 * MiB;
constexpr size_t WS_RS = 4 * MiB;
constexpr size_t WS_W1IN = 6 * MiB;
constexpr size_t WS_W1OUT = 17 * MiB;
constexpr size_t WS_WIN = 22 * MiB + 512 * 1024;
constexpr size_t WS_WUPA = 40 * MiB, WS_WUPB = 41 * MiB, WS_WO = 42 * MiB;
constexpr size_t WS_W2IN = 44 * MiB, WS_W2OUT = 55 * MiB, WS_WPG = 60 * MiB + 512 * 1024, WS_WPE = 62 * MiB + 512 * 1024;
constexpr size_t WS_HB = 64 * MiB;
constexpr size_t WS_HID = 128 * MiB;
constexpr size_t WS_ML = 128 * MiB;
constexpr size_t WS_MST = 256 * MiB;
constexpr size_t WS_QKV1 = 368 * MiB;
constexpr size_t WS_QKV = 320 * MiB;
constexpr size_t WS_A = 416 * MiB, WS_BM = 448 * MiB;
constexpr size_t WS_PB = 480 * MiB;
constexpr size_t WS_G = 128 * MiB;
constexpr size_t WS_TMP = 256 * MiB, WS_MERGED = 320 * MiB;
constexpr size_t WS_PE = 320 * MiB;
constexpr size_t WS_W8 = 497 * MiB;
constexpr size_t WS_SCW = 504 * MiB;
constexpr size_t WS_SC1 = 504 * MiB + 256 * 1024;
constexpr size_t WS_RSF = 3 * MiB + 640 * 1024;
constexpr size_t WS_SCX = 3 * MiB + 512 * 1024;
constexpr size_t WS_W1IN8 = 320 * MiB;
constexpr size_t WS_W2IN8 = 505 * MiB;
constexpr size_t WS_SC2 = 504 * MiB + 512 * 1024;
constexpr size_t WS_END = 511 * MiB;
constexpr int CW_BAR = 4096;
constexpr size_t WS_PCNT = 64 * 1024, WS_ROWMAX = 128 * 1024;
constexpr size_t WS_PAR = 512 * 1024;
constexpr int PAR_QG = 0, PAR_KG = 128, PAR_CW = 256, PAR_CB = 256 + 4096, PAR_IB = PAR_CB + 1024, PAR_FB = PAR_IB + 4, PAR_N = PAR_FB + 4;

constexpr int RING_BYTES = 131072, SCR_BYTES = 4 * 36864 + 8192, LDSCTL_OFF = SCR_BYTES, MISC_OFF = LDSCTL_OFF + 320, LDS_BYTES = 163840;

#define GAS __attribute__((address_space(1)))
#define LAS __attribute__((address_space(3)))
typedef unsigned short bf16;
typedef unsigned v4u __attribute__((ext_vector_type(4)));
typedef unsigned v2u __attribute__((ext_vector_type(2)));
typedef float f32x4 __attribute__((ext_vector_type(4)));
typedef GAS unsigned gu32;
#define RLX_AGENT __ATOMIC_RELAXED, __HIP_MEMORY_SCOPE_AGENT
#define LDS_WAIT() asm volatile("s_waitcnt lgkmcnt(0)" ::: "memory")
#define VM_WAIT() asm volatile("s_waitcnt vmcnt(0)" ::: "memory")
__device__ __forceinline__ unsigned f2bf(float f) { unsigned u = __builtin_bit_cast(unsigned, f); return (u + 0x7fffu + ((u >> 16) & 1u)) >> 16; }
__device__ __forceinline__ unsigned pk2(float lo, float hi) { return pg8::cvt_pk_bf16(lo, hi); }
__device__ __forceinline__ float bfl(unsigned u) { return __uint_as_float(u << 16); }
__device__ __forceinline__ float bfh(unsigned u) { return __uint_as_float(u & 0xffff0000u); }
__device__ __forceinline__ float bf1(bf16 u) { return __uint_as_float((unsigned)u << 16); }

#define XB_TMO      128
#define XB_XCNT(j)  (256  + 64 * (j))
#define XB_XSUB(j)  (1280 + 64 * (j))
#define XB_XGEN(j)  (2304 + 64 * (j))
#define XB_TOP      3328
#define XB_TOPGEN   3392
#define XCD_BAR_WORDS 3456
#define XB_SPIN_CAP (1u << 20)
__device__ __forceinline__ unsigned xb_ld(unsigned* p)              { return __hip_atomic_load(p, __ATOMIC_RELAXED, __HIP_MEMORY_SCOPE_AGENT); }
__device__ __forceinline__ unsigned xb_add(unsigned* p, unsigned v) { return __hip_atomic_fetch_add(p, v, __ATOMIC_RELAXED, __HIP_MEMORY_SCOPE_AGENT); }
__device__ __forceinline__ unsigned xb_xcc_id() { return (unsigned)__builtin_amdgcn_s_getreg((3 << 11) | 20) & 0xFu; }
#define XB_SPIN(cond, bar) do { unsigned _sp = 0; while (cond) { __builtin_amdgcn_s_sleep(1); \
    if ((++_sp & 255u) == 0u) { if (xb_ld(&(bar)[XB_TMO])) break; if (_sp > XB_SPIN_CAP) { atomicAdd(&(bar)[XB_TMO], 1u); break; } } } } while (0)
struct XcdBarrier { unsigned* bar; unsigned x; volatile LAS unsigned* st; };
__device__ __forceinline__ XcdBarrier xcd_barrier_post(unsigned* bar, volatile LAS unsigned* st, bool leader) {
    XcdBarrier b; b.bar = bar; b.x = xb_xcc_id(); b.st = st;
    if (leader) (void)xb_add(&bar[XB_XCNT(b.x)], 1u);
    return b;
}
__device__ __forceinline__ void xcd_barrier_complete(unsigned* bar, unsigned x, unsigned& nloc, unsigned& nx) {
    const unsigned G = gridDim.x * gridDim.y * gridDim.z;
    unsigned sum, cnt, mine, sp = 0u;
    for (;;) {
        sum = 0u; cnt = 0u; mine = 0u;
#pragma unroll
        for (unsigned j = 0; j < 16; ++j) { const unsigned c = xb_ld(&bar[XB_XCNT(j)]); sum += c; cnt += (c > 0u) ? 1u : 0u; mine = (j == x) ? c : mine; }
        if (sum == G) break;
        __builtin_amdgcn_s_sleep(1);
        if ((++sp & 255u) == 0u) { if (xb_ld(&bar[XB_TMO])) break; if (sp > XB_SPIN_CAP) { atomicAdd(&bar[XB_TMO], 1u); break; } }
    }
    nloc = mine > 0u ? mine : 1u; nx = cnt > 0u ? cnt : 1u;
}
__device__ __forceinline__ void xcd_barrier(const XcdBarrier& b, bool leader) {
    asm volatile("s_waitcnt vmcnt(0)" ::: "memory");
    __syncthreads();
    if (leader) {
        unsigned* bar = b.bar;
        __builtin_amdgcn_s_waitcnt(0);
        unsigned nloc = b.st[0], nx = b.st[1];
        if (nloc == 0u) { xcd_barrier_complete(bar, b.x, nloc, nx); b.st[0] = nloc; b.st[1] = nx; }
        const unsigned old = xb_add(&bar[XB_XSUB(b.x)], 1u);
        const unsigned gen = old / nloc;
        if (old + 1u == (gen + 1u) * nloc) {
            __builtin_amdgcn_fence(__ATOMIC_RELEASE, "agent");
            asm volatile("s_waitcnt vmcnt(0)" ::: "memory");
            (void)xb_add(&bar[XB_TOP], 1u); }
        XB_SPIN(xb_ld(&bar[XB_TOP]) < (gen + 1u) * nx, bar);
        __builtin_amdgcn_fence(__ATOMIC_ACQUIRE, "agent");
        asm volatile("s_waitcnt vmcnt(0)" ::: "memory");
    }
    __syncthreads();
}

__device__ __forceinline__ void quad_barrier(unsigned* w, unsigned target, bool leader, unsigned* bar) {
    asm volatile("s_waitcnt vmcnt(0)" ::: "memory");
    __syncthreads();
    if (leader) {
        __builtin_amdgcn_s_waitcnt(0);
        __builtin_amdgcn_fence(__ATOMIC_RELEASE, "agent");
        asm volatile("s_waitcnt vmcnt(0)" ::: "memory");
        (void)xb_add(w, 1u);
        XB_SPIN(xb_ld(w) < target, bar);
        __builtin_amdgcn_fence(__ATOMIC_ACQUIRE, "agent");
        asm volatile("s_waitcnt vmcnt(0)" ::: "memory");
    }
    __syncthreads();
}

struct WD { int src; int gain; unsigned dst; int K, Nsrc, Ndst, kind; };
__constant__ float c_invfreq[16] = {1.000000000e+00f, 4.403666258e-01f, 1.939227581e-01f, 8.539710194e-02f, 3.760603070e-02f, 1.656044088e-02f, 7.292665076e-03f, 3.211446106e-03f,
    1.414213446e-03f, 6.227724371e-04f, 2.742481884e-04f, 1.207697424e-04f, 5.318296462e-05f, 2.341999789e-05f, 1.031338525e-05f, 4.541670478e-06f};
struct Args { const float* in[22]; float* out; unsigned char* ws; int ph_lo, ph_hi; };
enum { I_X = 0, I_P, I_F1N, I_F1WI, I_F1WO, I_MIXN, I_WIN, I_QG, I_KG, I_CW, I_CB, I_IB, I_FB, I_WUA, I_WUM, I_WOUT, I_F2N, I_F2WI, I_F2WO, I_PLN, I_WPG, I_WPE };

__constant__ WD c_wd[10] = {
    {I_F1WI, I_F1N, (unsigned)WS_W1IN, D, 2 * FF, 2 * FF, 1}, {I_F1WO, -1, (unsigned)WS_W1OUT, FF, D, D, 0}, {I_WIN, I_MIXN, (unsigned)WS_WIN, D, D_IN, WIN_ROWS, 2},
    {I_WUA, -1, (unsigned)WS_WUPA, 512, D, D, 0}, {I_WUM, -1, (unsigned)WS_WUPB, 512, D, D, 0}, {I_WOUT, -1, (unsigned)WS_WO, D, D, D, 0},
    {I_F2WI, I_F2N, (unsigned)WS_W2IN, D, 2 * FF, 2 * FF, 1}, {I_F2WO, -1, (unsigned)WS_W2OUT, FF, D, D, 0}, {I_WPG, I_PLN, (unsigned)WS_WPG, D, D, D, 0}, {I_WPE, -1, (unsigned)WS_WPE, PLE, D, D, 0}};
__device__ __forceinline__ float wave_sum(float v) {
#pragma unroll
    for (int o = 1; o < 64; o <<= 1) v += __shfl_xor(v, o);
    return v;
}
__device__ __forceinline__ float wave_max(float v) {
#pragma unroll
    for (int o = 1; o < 64; o <<= 1) v = fmaxf(v, __shfl_xor(v, o));
    return v;
}

__device__ __forceinline__ int wsrc_col(int kind, int n) {
    if (kind == 0) return n;
    if (kind == 1) { const int t = n >> 8, w = n & 255; return (w < 128) ? (128 * t + w) : (FF + 128 * t + (w - 128)); }
    if (n < WIN_ML) { const int g = n / 1536, w = n % 1536, part = w >> 9, c = w & 511; return part * 1536 + g * 512 + c; }
    if (n < WIN_GT + 8) return n;
    if (n < WIN_G) return -1;
    { const int e = n - WIN_G, t = e >> 8, w = e & 255; return (w < 128) ? (WIN_GT + 8) + 128 * t + w : (WIN_GT + 8) + 1024 + 128 * t + (w - 128); }
}
__device__ __forceinline__ void p0_transpose_item(const float* W, const float* gain, int K, int Nsrc, int Ndst, bf16* WT, int kind, LAS float* scr, int item, int lane) {
    const int nblk = Ndst / 64, kb = item / nblk, nb = item % nblk, k0 = 64 * kb, n0 = 64 * nb;
    const int n4 = lane & 15, kr = lane >> 4;
    const int sc = wsrc_col(kind, n0 + 4 * n4);
    f32x4 v[16];
#pragma unroll
    for (int i = 0; i < 16; ++i) { const int k = k0 + 4 * i + kr; v[i] = (sc >= 0) ? *(const f32x4*)(W + (size_t)k * Nsrc + sc) : (f32x4){0.f, 0.f, 0.f, 0.f}; }
#pragma unroll
    for (int i = 0; i < 16; ++i) { const int kk = 4 * i + kr; const float gsc = gain ? gain[k0 + kk] : 1.0f; LAS float* d_ = scr + kk * 65 + 4 * n4;
        d_[0] = v[i][0] * gsc; d_[1] = v[i][1] * gsc; d_[2] = v[i][2] * gsc; d_[3] = v[i][3] * gsc; }
    LDS_WAIT(); asm volatile("" ::: "memory");
#pragma unroll
    for (int j = 0; j < 8; ++j) { const int id = lane + 64 * j, n = id >> 3, c = id & 7; const LAS float* s_ = scr + (8 * c) * 65 + n;
        v4u o; o.x = pk2(s_[0 * 65], s_[1 * 65]); o.y = pk2(s_[2 * 65], s_[3 * 65]); o.z = pk2(s_[4 * 65], s_[5 * 65]); o.w = pk2(s_[6 * 65], s_[7 * 65]);
        *(GAS v4u*)(WT + (size_t)(n0 + n) * K + k0 + 8 * c) = o; }
    LDS_WAIT(); asm volatile("" ::: "memory");
}

__device__ __forceinline__ void mlstm_seq_v0(const Args& a, LAS unsigned char* lds, int bh, int tid) {
    const int f = tid & 127, eg = tid >> 7;
    const int b = bh >> 2, h = bh & 3;
    const bf16* ML = (const bf16*)(a.ws + WS_ML); const float* GT = (const float*)(a.ws + WS_GATES); bf16* BMo = (bf16*)(a.ws + WS_BM);
    LAS float* qs = (LAS float*)lds;
    LAS float* ks = qs + 256;
    LAS float* hp = ks + 256;
    LAS float* dp = hp + 1024;
    const float* par = (const float*)(a.ws + WS_PAR); const float* cw = par + PAR_CW; const float* cb = par + PAR_CB;
    const float ib = par[PAR_IB + h], fb = par[PAR_FB + h];
    const int cch = (tid < 128) ? (h * 128 + tid) : (512 + h * 128 + (tid - 128));
    float w0 = 0.f, w1 = 0.f, w2 = 0.f, w3 = 0.f, wb = 0.f;
    if (tid < 256) { w0 = cw[0 * 1024 + cch]; w1 = cw[1 * 1024 + cch]; w2 = cw[2 * 1024 + cch]; w3 = cw[3 * 1024 + cch]; wb = cb[cch]; }
    float x0 = 0.f, x1 = 0.f, x2 = 0.f;
    float C[32], n[32];
#pragma unroll
    for (int i = 0; i < 32; ++i) { C[i] = 0.f; n[i] = 0.f; }
    float mst = 0.f;
    const size_t row0 = (size_t)b * SEQ;
    float xn = 0.f, vn = 0.f, on = 0.f, lin = 0.f, lfn = 0.f;
    if (tid < 256) xn = bf1(ML[row0 * 2048 + cch]);
    vn = bf1(ML[row0 * 2048 + 1024 + h * 128 + f]); on = bf1(ML[row0 * 2048 + 1536 + h * 128 + f]); lin = GT[row0 * 8 + h]; lfn = GT[row0 * 8 + 4 + h];
    for (int t = 0; t < SEQ; ++t) {
        const int par = t & 1;
        const float x3 = xn, v = vn, og = on, lipre = lin, lfpre = lfn;
        if (t + 1 < SEQ) { const size_t r = row0 + t + 1;
            if (tid < 256) xn = bf1(ML[r * 2048 + cch]);
            vn = bf1(ML[r * 2048 + 1024 + h * 128 + f]); on = bf1(ML[r * 2048 + 1536 + h * 128 + f]); lin = GT[r * 8 + h]; lfn = GT[r * 8 + 4 + h]; }
        if (tid < 256) { float c = wb + w0 * x0 + w1 * x1 + w2 * x2 + w3 * x3; c = c * sigmoidf_(c); if (tid >= 128) c *= 0.08838834764831845f;
            if (tid < 128) qs[par * 128 + tid] = c; else ks[par * 128 + tid - 128] = c; x0 = x1; x1 = x2; x2 = x3; }
        __syncthreads();
        const float li = lipre + ib; const float fx = lfpre + fb;
        const float lf = fminf(fx, 0.f) - log1pf(expf(-fabsf(fx)));
        const float mnew = fmaxf(lf + mst, li);
        const float fp = expf(lf + mst - mnew), ip = expf(li - mnew);
        mst = mnew;
        float hacc = 0.f, dacc = 0.f;
#pragma unroll
        for (int i = 0; i < 32; ++i) { const float kk = ks[par * 128 + eg * 32 + i], qq = qs[par * 128 + eg * 32 + i];
            C[i] = fp * C[i] + ip * kk * v; n[i] = fp * n[i] + ip * kk; hacc += qq * C[i]; dacc += qq * n[i]; }
        hp[par * 512 + eg * 128 + f] = hacc; if (f == 0) dp[par * 4 + eg] = dacc;
        __syncthreads();
        if (tid < 128) { const float num = (hp[par * 512 + f] + hp[par * 512 + 128 + f]) + (hp[par * 512 + 256 + f] + hp[par * 512 + 384 + f]);
            const float den = (dp[par * 4] + dp[par * 4 + 1]) + (dp[par * 4 + 2] + dp[par * 4 + 3]);
            const float hv = num / fmaxf(fabsf(den), expf(-mnew));
            BMo[(row0 + t) * 512 + h * 128 + f] = (bf16)f2bf(sigmoidf_(og) * hv); }
    }
    __syncthreads();
}

__device__ __forceinline__ void attn_v0(const Args& a, LAS unsigned char* lds, int g, int gwave, int ngwave, int wave, int lane, int tid) {
    const int d = (g == 0) ? 1 : (g == 1 ? 4 : 16);
    const bf16* QKV = (const bf16*)(a.ws + WS_QKV); bf16* Ao = (bf16*)(a.ws + WS_A); float* LSE = (float*)(a.ws + WS_LSE);
    const float* rope = (const float*)(a.ws + WS_ROPE);
    const float* qg = (const float*)(a.ws + WS_PAR) + PAR_QG; const float* kg = (const float*)(a.ws + WS_PAR) + PAR_KG;
    LAS float* qsh = (LAS float*)lds + wave * 128;
    LAS float* kgs = (LAS float*)lds + 8 * 128;
    if (tid < 128) kgs[tid] = kg[tid];
    __syncthreads();
    for (int it = gwave; it < M * 4; it += ngwave) {
        const int row = it >> 2, j = it & 3, t = row & (SEQ - 1);
        { const unsigned qq = *(const unsigned*)(QKV + (size_t)row * 1536 + j * 128 + 2 * lane);
          float q0 = bfl(qq), q1 = bfh(qq);
          const float ss = wave_sum(q0 * q0 + q1 * q1); const float rn = __builtin_amdgcn_rsqf(ss * (1.f / 128.f) + 1e-6f);
          q0 *= rn * qg[2 * lane]; q1 *= rn * qg[2 * lane + 1];
          const float p0 = __shfl_xor(q0, 8), p1 = __shfl_xor(q1, 8);
          if (lane < 16) { const int i0 = (2 * lane) & 15; const float c0 = rope[(t * 16 + i0) * 2], s0 = rope[(t * 16 + i0) * 2 + 1], c1 = rope[(t * 16 + i0 + 1) * 2], s1 = rope[(t * 16 + i0 + 1) * 2 + 1];
              if (lane < 8) { q0 = q0 * c0 - p0 * s0; q1 = q1 * c1 - p1 * s1; } else { q0 = q0 * c0 + p0 * s0; q1 = q1 * c1 + p1 * s1; } }
          qsh[2 * lane] = q0; qsh[2 * lane + 1] = q1; }
        LDS_WAIT(); asm volatile("" ::: "memory");
        float sc[3];
#pragma unroll
        for (int c = 0; c < 3; ++c) { const int i = lane + 64 * c; const int s = t - i * d; sc[c] = -INFINITY;
            if (i <= 128 && s >= 0) { const bf16* kr = QKV + (size_t)(row - i * d) * 1536 + 512 + j * 128;
                float ss = 0.f, dot = 0.f; float kx[32];
#pragma unroll
                for (int e8 = 0; e8 < 16; ++e8) { const v4u kv = *(const v4u*)(kr + e8 * 8);
                    float kf[8] = {bfl(kv.x), bfh(kv.x), bfl(kv.y), bfh(kv.y), bfl(kv.z), bfh(kv.z), bfl(kv.w), bfh(kv.w)};
#pragma unroll
                    for (int u = 0; u < 8; ++u) { ss += kf[u] * kf[u]; const int e = e8 * 8 + u; if (e < 32) kx[e] = kf[u] * kgs[e]; else dot += qsh[e] * kf[u] * kgs[e]; } }
#pragma unroll
                for (int i2 = 0; i2 < 16; ++i2) { const float cs = rope[(s * 16 + i2) * 2], sn = rope[(s * 16 + i2) * 2 + 1];
                    dot += qsh[i2] * (kx[i2] * cs - kx[i2 + 16] * sn) + qsh[i2 + 16] * (kx[i2 + 16] * cs + kx[i2] * sn); }
                sc[c] = dot * __builtin_amdgcn_rsqf(ss * (1.f / 128.f) + 1e-6f) * 0.08838834764831845f; } }
        const float mx = wave_max(fmaxf(fmaxf(sc[0], sc[1]), sc[2]));
        float p[3]; float ls = 0.f;
#pragma unroll
        for (int c = 0; c < 3; ++c) { p[c] = expf(sc[c] - mx); ls += p[c]; }
        ls = wave_sum(ls);
        float lse = mx + logf(ls);
        float o0 = 0.f, o1 = 0.f;
        const int imax = (t / d < 128) ? (t / d) : 128;
        for (int i = 0; i <= imax; ++i) { const float psel = (i < 64) ? p[0] : ((i < 128) ? p[1] : p[2]); const float pi = __shfl(psel, i & 63);
            const unsigned vv = *(const unsigned*)(QKV + (size_t)(row - i * d) * 1536 + 1024 + j * 128 + 2 * lane);
            o0 += pi * bfl(vv); o1 += pi * bfh(vv); }
        const float il = 1.f / ls; o0 *= il; o1 *= il;
        if (g > 0) { const float lo = LSE[(size_t)row * 4 + j]; const unsigned ov = *(const unsigned*)(Ao + (size_t)row * 512 + j * 128 + 2 * lane);
            const float mm = fmaxf(lo, lse); const float wo = expf(lo - mm), wn = expf(lse - mm); const float inv = 1.f / (wo + wn);
            o0 = (wo * bfl(ov) + wn * o0) * inv; o1 = (wo * bfh(ov) + wn * o1) * inv; lse = mm + logf(wo + wn); }
        *(unsigned*)(Ao + (size_t)row * 512 + j * 128 + 2 * lane) = pk2(o0, o1);
        if (lane == 0) LSE[(size_t)row * 4 + j] = lse;
    }
    __syncthreads();
}


typedef short bf16x8_t __attribute__((ext_vector_type(8)));
typedef short v4i16_t __attribute__((ext_vector_type(4)));
constexpr int TP = 288, TILE_B = 128 * TP;
#define LANE_ID_F() ({ int _l; asm volatile("v_mbcnt_lo_u32_b32 %0, -1, 0\n\tv_mbcnt_hi_u32_b32 %0, -1, %0" : "=v"(_l)); _l; })
__device__ __forceinline__ bf16x8_t trpair(const LAS unsigned char* pa, const LAS unsigned char* pb) {
    const v4i16_t lo = __builtin_amdgcn_ds_read_tr16_b64_v4i16((LAS v4i16_t*)pa), hi = __builtin_amdgcn_ds_read_tr16_b64_v4i16((LAS v4i16_t*)pb);
    return (bf16x8_t){lo[0], lo[1], lo[2], lo[3], hi[0], hi[1], hi[2], hi[3]};
}
__device__ __forceinline__ void unpack8(const v4u v, float (&f)[8]) { f[0] = bfl(v.x); f[1] = bfh(v.x); f[2] = bfl(v.y); f[3] = bfh(v.y); f[4] = bfl(v.z); f[5] = bfh(v.z); f[6] = bfl(v.w); f[7] = bfh(v.w); }
__device__ __forceinline__ v4u pack8(const float (&f)[8]) { v4u w; w.x = pg8::cvt_pk_bf16(f[0], f[1]); w.y = pg8::cvt_pk_bf16(f[2], f[3]); w.z = pg8::cvt_pk_bf16(f[4], f[5]); w.w = pg8::cvt_pk_bf16(f[6], f[7]); return w; }

typedef float f2_t __attribute__((ext_vector_type(2)));
__device__ __forceinline__ v4u f8to16(const v2u q) {
    const f2_t a_ = __builtin_amdgcn_cvt_pk_f32_fp8((int)q.x, false), b_ = __builtin_amdgcn_cvt_pk_f32_fp8((int)q.x, true), c_ = __builtin_amdgcn_cvt_pk_f32_fp8((int)q.y, false), d_ = __builtin_amdgcn_cvt_pk_f32_fp8((int)q.y, true);
    v4u o_; o_.x = pg8::cvt_pk_bf16(a_[0], a_[1]); o_.y = pg8::cvt_pk_bf16(b_[0], b_[1]); o_.z = pg8::cvt_pk_bf16(c_[0], c_[1]); o_.w = pg8::cvt_pk_bf16(d_[0], d_[1]); return o_; }
__device__ __forceinline__ void attn_fast(unsigned char* ws, const unsigned short* QKV, LAS unsigned char* lds, const int g, const int wave, const int vcu, const int G) {
    const int lane = LANE_ID_F(), tid = wave * 64 + lane, fr = lane & 15, fq = lane >> 4;
    const int lgd = 2 * g, d = 1 << lgd, lgseg = 4 - lgd;
    bf16* Ao = (bf16*)(ws + WS_A); float* LSE = (float*)(ws + WS_LSE);
    const int srow = tid >> 4, c = tid & 15;
    for (int seg = vcu; seg < 256; seg += G) {
        const int stream = seg >> lgseg, n0 = (seg & ((1 << lgseg) - 1)) * 4;
        const int r = stream & (d - 1), j = (stream >> lgd) & 3, b = stream >> (lgd + 2);
        const size_t rowbase = (size_t)b * SEQ + r;
        v2u kreg[4], vreg[4], qraw[4]; bf16x8_t qf[4];
        v4u aold[4]; float lold = 0.f;
#define AT_LOADKV(n) do { _Pragma("unroll") for (int i = 0; i < 4; ++i) { const unsigned char* p_ = (const unsigned char*)QKV + (rowbase + (size_t)((n) * 128 + srow + 32 * i) * d) * 1536 + j * 128 + c * 8; \
            kreg[i] = *(const v2u*)(p_ + 512); vreg[i] = *(const v2u*)(p_ + 1024); } } while (0)
#define AT_LOADQ(n) do { const unsigned char* p_ = (const unsigned char*)QKV + (rowbase + (size_t)((n) * 128 + wave * 16 + fr) * d) * 1536 + j * 128 + fq * 8; \
            _Pragma("unroll") for (int ds = 0; ds < 4; ++ds) qraw[ds] = *(const v2u*)(p_ + ds * 32); } while (0)
        if (n0 > 0) AT_LOADKV(n0 - 1);
#pragma unroll 1
        for (int it = -1; it < 4; ++it) {
            const int n = n0 + it;
            __syncthreads();
            if (it >= 0) {
#pragma unroll
                for (int ds = 0; ds < 4; ++ds) qf[ds] = __builtin_bit_cast(bf16x8_t, f8to16(qraw[ds]));
            }
            { LAS unsigned char* kt = lds + (n & 1) * TILE_B; LAS unsigned char* vt = lds + (2 + (n & 1)) * TILE_B;
              if (n >= 0) {
#pragma unroll
                for (int i = 0; i < 4; ++i) { *(LAS v4u*)(kt + (srow + 32 * i) * TP + c * 16) = f8to16(kreg[i]); *(LAS v4u*)(vt + (srow + 32 * i) * TP + c * 16) = f8to16(vreg[i]); }
              } else {
#pragma unroll
                for (int i = 0; i < 4; ++i) { *(LAS v4u*)(kt + (srow + 32 * i) * TP + c * 16) = (v4u){0u, 0u, 0u, 0u}; *(LAS v4u*)(vt + (srow + 32 * i) * TP + c * 16) = (v4u){0u, 0u, 0u, 0u}; }
              } }
            const size_t qrow = rowbase + (size_t)(n * 128 + wave * 16 + fr) * d;
            bf16* ap = Ao + qrow * 512 + j * 128 + 8 * fq;
            if (it >= 0 && g > 0) {
#pragma unroll
                for (int k4 = 0; k4 < 4; ++k4) aold[k4] = *(const v4u*)(ap + k4 * 32);
                lold = LSE[qrow * 4 + j]; }
            if (it < 3) { AT_LOADKV(n + 1); AT_LOADQ(n + 1); }
            __syncthreads();
            if (it >= 0) {
                const int kb0 = (wave < 6) ? wave : 6;
                const int slot_prev = (n + 1) & 1, slot_cur = n & 1;
                f32x4 sacc[10];
#pragma unroll
                for (int bp = 0; bp < 5; ++bp) {
                    bf16x8_t kfr[2][4];
#pragma unroll
                    for (int h2 = 0; h2 < 2; ++h2) { const int kb = kb0 + 2 * bp + h2; const int slot = (kb < 8) ? slot_prev : slot_cur;
                        const LAS unsigned char* kp = lds + slot * TILE_B + ((kb & 7) * 16 + fr) * TP + fq * 16;
#pragma unroll
                        for (int ds = 0; ds < 4; ++ds) kfr[h2][ds] = *(const LAS bf16x8_t*)(kp + ds * 64); }
#pragma unroll
                    for (int h2 = 0; h2 < 2; ++h2) { f32x4 a_ = (f32x4){0.f, 0.f, 0.f, 0.f};
#pragma unroll
                        for (int ds = 0; ds < 4; ++ds) a_ = __builtin_amdgcn_mfma_f32_16x16x32_bf16(kfr[h2][ds], qf[ds], a_, 0, 0, 0);
                        sacc[2 * bp + h2] = a_; } }
                const int qi = wave * 16 + fr; float mx = -1e30f;
#pragma unroll
                for (int bb = 0; bb < 10; ++bb) {
                    if (bb < 2 || bb > 7) {
#pragma unroll
                        for (int rg = 0; rg < 4; ++rg) { const int kj = (kb0 + bb) * 16 + 4 * fq + rg; const bool ok = (kj >= qi) && (kj <= qi + 128); sacc[bb][rg] = ok ? sacc[bb][rg] : -1e30f; } }
                    if (n == 0) {
#pragma unroll
                        for (int rg = 0; rg < 4; ++rg) { const int kj = (kb0 + bb) * 16 + 4 * fq + rg; sacc[bb][rg] = (kj >= 128) ? sacc[bb][rg] : -1e30f; } }
#pragma unroll
                    for (int rg = 0; rg < 4; ++rg) mx = fmaxf(mx, sacc[bb][rg]); }
                mx = pg8::xmax_16_32(mx);
                float l = 0.f;
#pragma unroll
                for (int bb = 0; bb < 10; ++bb)
#pragma unroll
                    for (int rg = 0; rg < 4; ++rg) { const float p_ = __builtin_amdgcn_exp2f(sacc[bb][rg] - mx); sacc[bb][rg] = p_; l += p_; }
                l = pg8::xsum_16_32(l);
                f32x4 oacc[8];
#pragma unroll
                for (int db = 0; db < 8; ++db) oacc[db] = (f32x4){0.f, 0.f, 0.f, 0.f};
                const int trq = (lane & 15) >> 2, trp = lane & 3;
#pragma unroll
                for (int sg = 0; sg < 5; ++sg) { const int kbA = kb0 + 2 * sg, kbB = kbA + 1;
                    v4u pw; pw.x = pg8::cvt_pk_bf16(sacc[2 * sg][0], sacc[2 * sg][1]); pw.y = pg8::cvt_pk_bf16(sacc[2 * sg][2], sacc[2 * sg][3]);
                    pw.z = pg8::cvt_pk_bf16(sacc[2 * sg + 1][0], sacc[2 * sg + 1][1]); pw.w = pg8::cvt_pk_bf16(sacc[2 * sg + 1][2], sacc[2 * sg + 1][3]);
                    const bf16x8_t pf = __builtin_bit_cast(bf16x8_t, pw);
                    const LAS unsigned char* va = lds + (2 + ((kbA < 8) ? slot_prev : slot_cur)) * TILE_B + ((kbA & 7) * 16 + 4 * fq + trq) * TP + trp * 8;
                    const LAS unsigned char* vb = lds + (2 + ((kbB < 8) ? slot_prev : slot_cur)) * TILE_B + ((kbB & 7) * 16 + 4 * fq + trq) * TP + trp * 8;
                    bf16x8_t vfr[8];
#pragma unroll
                    for (int db = 0; db < 8; ++db) vfr[db] = trpair(va + db * 32, vb + db * 32);
#pragma unroll
                    for (int db = 0; db < 8; ++db) oacc[db] = __builtin_amdgcn_mfma_f32_16x16x32_bf16(vfr[db], pf, oacc[db], 0, 0, 0); }
                const float il = __builtin_amdgcn_rcpf(l); float lse = mx * 0.6931471805599453f + __logf(l);
                float wo = 0.f, wn = il;
                if (g > 0) { const float mm = fmaxf(lold, lse); const float eo = __expf(lold - mm), en = __expf(lse - mm); const float inv = __builtin_amdgcn_rcpf(eo + en);
                    wo = eo * inv; wn = en * inv * il; lse = mm + __logf(eo + en); }
#pragma unroll
                for (int k4 = 0; k4 < 4; ++k4)
#pragma unroll
                    for (int i = 0; i < 4; ++i) { float X = oacc[2 * k4][i] * wn, Y = oacc[2 * k4 + 1][i] * wn;
                        pg8::swap32_(X, Y); pg8::swap16_(X, Y); oacc[2 * k4][i] = X; oacc[2 * k4 + 1][i] = Y; }
#pragma unroll
                for (int k4 = 0; k4 < 4; ++k4) { const f32x4 a_ = oacc[2 * k4], b_ = oacc[2 * k4 + 1];
                    float o0 = a_[0], o1 = a_[1], o2 = a_[2], o3 = a_[3], o4 = b_[0], o5 = b_[1], o6 = b_[2], o7 = b_[3];
                    if (g > 0) { const v4u old = aold[k4]; o0 += wo * bfl(old.x); o1 += wo * bfh(old.x); o2 += wo * bfl(old.y); o3 += wo * bfh(old.y); o4 += wo * bfl(old.z); o5 += wo * bfh(old.z); o6 += wo * bfl(old.w); o7 += wo * bfh(old.w); }
                    v4u w_; w_.x = pg8::cvt_pk_bf16(o0, o1); w_.y = pg8::cvt_pk_bf16(o2, o3); w_.z = pg8::cvt_pk_bf16(o4, o5); w_.w = pg8::cvt_pk_bf16(o6, o7); *(v4u*)(ap + k4 * 32) = w_; }
                if (fq == 0) LSE[qrow * 4 + j] = lse;
            }
        }
#undef AT_LOADKV
#undef AT_LOADQ
    }
    __syncthreads();
}

constexpr size_t WS_MSC = 496 * MiB;
constexpr size_t WS_CPB = 288 * MiB;
constexpr int GSM_OFF = 4 * TILE_B;
__device__ __forceinline__ float log_sigmoid_(float x) { return fminf(x, 0.f) - log1pf(__expf(-fabsf(x))); }
__device__ __forceinline__ void conv_load(v4u (&raw)[4], const bf16* ML, size_t grow, int tpos, int col) {
#pragma unroll
    for (int jt = 0; jt < 4; ++jt) { const bool ok = (tpos - 3 + jt >= 0); raw[jt] = *(const v4u*)(ML + (ok ? (grow - 3 + jt) : grow) * 2048 + col); }
}
__device__ __forceinline__ void conv_apply(const v4u (&raw)[4], int tpos, const float (&w)[4][8], const float (&bs)[8], float (&o)[8]) {
#pragma unroll
    for (int u = 0; u < 8; ++u) o[u] = bs[u];
#pragma unroll
    for (int jt = 0; jt < 4; ++jt) { const float msk = (tpos - 3 + jt >= 0) ? 1.f : 0.f; float x[8]; unpack8(raw[jt], x);
#pragma unroll
        for (int u = 0; u < 8; ++u) o[u] += (w[jt][u] * msk) * x[u]; }
#pragma unroll
    for (int u = 0; u < 8; ++u) o[u] = o[u] * sigmoidf_(o[u]);
}
__device__ __forceinline__ void conv_piece(const bf16* ML, size_t grow, int tpos, int col, const float (&w)[4][8], const float (&bs)[8], float (&o)[8]) {
    v4u raw[4];
#pragma unroll
    for (int jt = 0; jt < 4; ++jt) { const bool ok = (tpos - 3 + jt >= 0); raw[jt] = *(const v4u*)(ML + (ok ? (grow - 3 + jt) : grow) * 2048 + col); }
#pragma unroll
    for (int u = 0; u < 8; ++u) o[u] = bs[u];
#pragma unroll
    for (int jt = 0; jt < 4; ++jt) { const float msk = (tpos - 3 + jt >= 0) ? 1.f : 0.f; float x[8]; unpack8(raw[jt], x);
#pragma unroll
        for (int u = 0; u < 8; ++u) o[u] += (w[jt][u] * msk) * x[u]; }
#pragma unroll
    for (int u = 0; u < 8; ++u) o[u] = o[u] * sigmoidf_(o[u]);
}
__device__ __forceinline__ float wave_scan_add(float v, int lane) {
#pragma unroll
    for (int o = 1; o < 64; o <<= 1) { const float t = __shfl_up(v, o); if (lane >= o) v += t; }
    return v;
}
__device__ __forceinline__ float wave_scan_max(float v, int lane) {
#pragma unroll
    for (int o = 1; o < 64; o <<= 1) { const float t = __shfl_up(v, o); if (lane >= o) v = fmaxf(v, t); }
    return v;
}
__device__ __forceinline__ void mlstm_b1(unsigned char* ws, LAS unsigned char* lds, const int wave, const int vcu, const int G) {
    const int lane = LANE_ID_F(), tid = wave * 64 + lane, fq = lane >> 4;
    const bf16* ML = (const bf16*)(ws + WS_ML); const float* GT = (const float*)(ws + WS_GATES); const float* par = (const float*)(ws + WS_PAR);
    float* MST = (float*)(ws + WS_MST); float* MSC = (float*)(ws + WS_MSC);
    LAS float* gsm = (LAS float*)(lds + GSM_OFF);
    LAS unsigned char* kt = lds; LAS unsigned char* vt = lds + TILE_B; LAS float* dnp = (LAS float*)(lds + 2 * TILE_B);
    const int srow = tid >> 4, c = tid & 15;
    struct B1Pre { v4u vr[4]; v4u raw[4][4]; };
#define B1_LOAD(P, item_) do { const int bh_ = (item_) >> 6, ch_ = (item_) & 63, h_ = bh_ & 3; const size_t r0_ = (size_t)(bh_ >> 2) * SEQ + ch_ * 128; \
        _Pragma("unroll") for (int i = 0; i < 4; ++i) { const int sr_ = srow + 32 * i; (P).vr[i] = *(const v4u*)(ML + (r0_ + sr_) * 2048 + 1024 + h_ * 128 + c * 8); conv_load((P).raw[i], ML, r0_ + sr_, ch_ * 128 + sr_, 512 + h_ * 128 + c * 8); } } while (0)
    for (int base = 0; base < 1024; base += 4 * G) {
        B1Pre cur_;
        if (base + vcu < 1024) B1_LOAD(cur_, base + vcu);
        __syncthreads();
        { const int k = tid >> 7, s_ = tid & 127, it_ = base + vcu + G * k; const bool ok = it_ < 1024; const int itc = ok ? it_ : 0;
          const int bh = itc >> 6, ch = itc & 63, h = bh & 3; const size_t r = (size_t)(bh >> 2) * SEQ + ch * 128 + s_;
          const float lf = log_sigmoid_(GT[r * 8 + 4 + h] + par[PAR_FB + h]), li = GT[r * 8 + h] + par[PAR_IB + h];
          float b_ = wave_scan_add(lf, lane);
          if (lane == 63) gsm[1664 + wave] = b_;
          __syncthreads();
          if (wave & 1) b_ += gsm[1664 + wave - 1];
          const float bL = gsm[1664 + 2 * k] + gsm[1664 + 2 * k + 1];
          const float g_ = bL - b_ + li;
          const float mw = wave_max(g_);
          if (lane == 0) gsm[1680 + wave] = mw;
          __syncthreads();
          const float mloc = fmaxf(gsm[1680 + 2 * k], gsm[1680 + 2 * k + 1]);
          gsm[k * 128 + s_] = __expf(g_ - mloc);
          if (s_ == 0) { gsm[1696 + k] = mloc; gsm[1700 + k] = bL; }
        }
        __syncthreads();
#pragma unroll 1
        for (int k = 0; k < 4; ++k) { const int item = base + vcu + G * k; if (item >= 1024) break;
            const int bh = item >> 6, ch = item & 63, h = bh & 3; const size_t row0 = (size_t)(bh >> 2) * SEQ + ch * 128;
            if (k > 0) __syncthreads();
            { float w[4][8], bs[8]; const int col = 512 + h * 128 + c * 8;
#pragma unroll
              for (int jt = 0; jt < 4; ++jt)
#pragma unroll
                  for (int u = 0; u < 8; ++u) w[jt][u] = par[PAR_CW + jt * 1024 + col + u];
#pragma unroll
              for (int u = 0; u < 8; ++u) bs[u] = par[PAR_CB + col + u];
              float dn[8];
#pragma unroll
              for (int u = 0; u < 8; ++u) dn[u] = 0.f;
#pragma unroll
              for (int i = 0; i < 4; ++i) { const int sr = srow + 32 * i; float o[8]; conv_apply(cur_.raw[i], ch * 128 + sr, w, bs, o);
                  const float sc = 0.08838834764831845f * gsm[k * 128 + sr];
#pragma unroll
                  for (int u = 0; u < 8; ++u) { o[u] *= sc; dn[u] += o[u]; }
                  *(LAS v4u*)(kt + sr * TP + c * 16) = pack8(o);
                  *(LAS v4u*)(vt + sr * TP + c * 16) = cur_.vr[i]; }
#pragma unroll
              for (int u = 0; u < 8; ++u) dnp[srow * 128 + c * 8 + u] = dn[u]; }
            __syncthreads();
            if (tid < 128) { float a_ = 0.f;
#pragma unroll 8
                for (int r = 0; r < 32; ++r) a_ += dnp[r * 128 + tid];
                MSC[(size_t)item * 256 + tid] = a_; }
            if (tid == 0) { MSC[(size_t)item * 256 + 128] = gsm[1696 + k]; MSC[(size_t)item * 256 + 129] = gsm[1700 + k]; }
            { const int nitem = item + G; if (k < 3 && nitem < 1024) B1_LOAD(cur_, nitem); }
            { const int trq = (lane & 15) >> 2, trp = lane & 3; f32x4 acc[8];
#pragma unroll
              for (int fb = 0; fb < 8; ++fb) acc[fb] = (f32x4){0.f, 0.f, 0.f, 0.f};
#pragma unroll
              for (int ks = 0; ks < 4; ++ks) { const int ra = ks * 32 + 4 * fq + trq;
                  const bf16x8_t kf = trpair(kt + ra * TP + (wave * 16 + 4 * trp) * 2, kt + (ra + 16) * TP + (wave * 16 + 4 * trp) * 2);
                  bf16x8_t vfr[8];
#pragma unroll
                  for (int fb = 0; fb < 8; ++fb) vfr[fb] = trpair(vt + ra * TP + (fb * 16 + 4 * trp) * 2, vt + (ra + 16) * TP + (fb * 16 + 4 * trp) * 2);
#pragma unroll
                  for (int fb = 0; fb < 8; ++fb) acc[fb] = __builtin_amdgcn_mfma_f32_16x16x32_bf16(vfr[fb], kf, acc[fb], 0, 0, 0); }
              bf16* dst = (bf16*)MST + (size_t)item * 16384 + (size_t)(wave * 16 + (lane & 15)) * 128 + 4 * fq;
#pragma unroll
              for (int fb = 0; fb < 8; ++fb) { v2u w_; w_.x = pg8::cvt_pk_bf16(acc[fb][0], acc[fb][1]); w_.y = pg8::cvt_pk_bf16(acc[fb][2], acc[fb][3]); *(v2u*)(dst + fb * 16) = w_; } }
        }
    }
    __syncthreads();
}
__device__ __forceinline__ void mlstm_b2(unsigned char* ws, LAS unsigned char* lds, const int wave, const int vcu, const int G) {
    const int lane = LANE_ID_F(), tid = wave * 64 + lane;
    const float* MST = (const float*)(ws + WS_MST); float* MSC = (float*)(ws + WS_MSC); unsigned* CPB = (unsigned*)(ws + WS_CPB);
    typedef float f32x2 __attribute__((ext_vector_type(2)));
    LAS float* mb = (LAS float*)lds;
    for (int gid = vcu * NTHREADS + tid; gid < 16 * 8192; gid += G * NTHREADS) {
        const int bh = gid >> 13, rem = gid & 8191;
        const unsigned* p = (const unsigned*)MST + (size_t)bh * 64 * 8192 + rem; unsigned* cp = CPB + (size_t)bh * 64 * 8192 + rem; float* sc = MSC + (size_t)bh * 64 * 256;
        unsigned dv[64];
#pragma unroll
        for (int k = 0; k < 64; ++k) dv[k] = p[(size_t)k * 8192];
        __syncthreads();
        if (tid < 128) mb[tid] = sc[(tid >> 1) * 256 + 128 + (tid & 1)];
        __syncthreads();
        { float m = 0.f; f32x2 C = {0.f, 0.f};
#pragma unroll
          for (int k = 0; k < 64; ++k) { const float ml = mb[2 * k], bl = mb[2 * k + 1]; const float mn = fmaxf(bl + m, ml); const float sp = __expf(bl + m - mn), sn = __expf(ml - mn);
              cp[(size_t)k * 8192] = pg8::cvt_pk_bf16(C[0], C[1]); C = C * sp + (f32x2){bfl(dv[k]), bfh(dv[k])} * sn;
              if (rem == 0) sc[k * 256 + 130] = m;
              m = mn; } }
        if (rem < 64) {
            float m = 0.f; f32x2 nn = {0.f, 0.f};
#pragma unroll 1
            for (int c0 = 0; c0 < 64; c0 += 16) { f32x2 dn[16];
#pragma unroll
                for (int k = 0; k < 16; ++k) dn[k] = *(const f32x2*)(sc + (c0 + k) * 256 + 2 * rem);
#pragma unroll
                for (int k = 0; k < 16; ++k) { const float ml = mb[2 * (c0 + k)], bl = mb[2 * (c0 + k) + 1]; const float mn = fmaxf(bl + m, ml); const float sp = __expf(bl + m - mn), sn = __expf(ml - mn);
                    *(f32x2*)(sc + (c0 + k) * 256 + 2 * rem) = nn; nn = nn * sp + dn[k] * sn; m = mn; } } }
    }
    __syncthreads();
}
__device__ __forceinline__ void mlstm_b3(unsigned char* ws, const unsigned char* MO8, LAS unsigned char* lds, const int wave, const int vcu, const int G) {
    const int lane = LANE_ID_F(), tid = wave * 64 + lane, fr = lane & 15, fq = lane >> 4;
    const bf16* ML = (const bf16*)(ws + WS_ML); const float* GT = (const float*)(ws + WS_GATES); const float* par = (const float*)(ws + WS_PAR);
    const bf16* CPBr = (const bf16*)(ws + WS_CPB); const float* MSC = (const float*)(ws + WS_MSC); bf16* BMo = (bf16*)(ws + WS_BM);
    LAS float* gsm = (LAS float*)(lds + GSM_OFF);
    LAS unsigned char* qt = lds; LAS unsigned char* kt = lds + TILE_B; LAS unsigned char* vt = lds + 2 * TILE_B; LAS unsigned char* ct = lds + 3 * TILE_B;
    const int srow = tid >> 4, c = tid & 15;
    struct B3Pre { v4u vr[4], cr[4]; };
#define B3_LOAD(P, item_) do { const int bh_ = (item_) >> 6, ch_ = (item_) & 63, h_ = bh_ & 3; const size_t r0_ = (size_t)(bh_ >> 2) * SEQ + ch_ * 128; \
        _Pragma("unroll") for (int i = 0; i < 4; ++i) { const int sr_ = srow + 32 * i; (P).vr[i] = *(const v4u*)(ML + (r0_ + sr_) * 2048 + 1024 + h_ * 128 + c * 8); (P).cr[i] = *(const v4u*)(CPBr + (size_t)(item_) * 16384 + sr_ * 128 + c * 8); \
            } } while (0)
    for (int base = 0; base < 1024; base += 4 * G) {
        B3Pre cur_;
        if (base + vcu < 1024) B3_LOAD(cur_, base + vcu);
        __syncthreads();
        { const int k = tid >> 7, s_ = tid & 127, it_ = base + vcu + G * k; const bool ok = it_ < 1024; const int itc = ok ? it_ : 0;
          const int bh = itc >> 6, ch = itc & 63, h = bh & 3; const size_t r = (size_t)(bh >> 2) * SEQ + ch * 128 + s_;
          const float lf = log_sigmoid_(GT[r * 8 + 4 + h] + par[PAR_FB + h]), li = GT[r * 8 + h] + par[PAR_IB + h];
          const float mprev = MSC[(size_t)itc * 256 + 130];
          float b_ = wave_scan_add(lf, lane);
          if (lane == 63) gsm[1664 + wave] = b_;
          __syncthreads();
          if (wave & 1) b_ += gsm[1664 + wave - 1];
          const float a_ = li - b_;
          float cm = wave_scan_max(a_, lane);
          if (lane == 63) gsm[1680 + wave] = cm;
          __syncthreads();
          if (wave & 1) cm = fmaxf(cm, gsm[1680 + wave - 1]);
          const float Mt = fmaxf(mprev, cm);
          gsm[k * 128 + s_] = a_; gsm[512 + k * 128 + s_] = Mt; gsm[1024 + k * 128 + s_] = b_ + Mt;
          if (s_ == 0) gsm[1696 + k] = mprev;
        }
        __syncthreads();
#pragma unroll 1
        for (int k = 0; k < 4; ++k) { const int item = base + vcu + G * k; if (item >= 1024) break;
            const int bh = item >> 6, ch = item & 63, h = bh & 3; const size_t row0 = (size_t)(bh >> 2) * SEQ + ch * 128;
            if (k > 0) __syncthreads();
            const float mprev = gsm[1696 + k];
            if (tid < 128) gsm[1536 + tid] = MSC[(size_t)item * 256 + tid];
            {
#pragma unroll
              for (int which = 0; which < 2; ++which) { float w[4][8], bs[8]; const int col = which * 512 + h * 128 + c * 8; LAS unsigned char* dt = which ? kt : qt; const float sc = which ? 0.08838834764831845f : 1.0f;
#pragma unroll
                for (int jt = 0; jt < 4; ++jt)
#pragma unroll
                    for (int u = 0; u < 8; ++u) w[jt][u] = par[PAR_CW + jt * 1024 + col + u];
#pragma unroll
                for (int u = 0; u < 8; ++u) bs[u] = par[PAR_CB + col + u];
#pragma unroll
                for (int i = 0; i < 4; ++i) { const int sr = srow + 32 * i; float o[8]; conv_piece(ML, row0 + sr, ch * 128 + sr, col, w, bs, o);
#pragma unroll
                    for (int u = 0; u < 8; ++u) o[u] *= sc;
                    *(LAS v4u*)(dt + sr * TP + c * 16) = pack8(o); } }
#pragma unroll
              for (int i = 0; i < 4; ++i) { const int sr = srow + 32 * i; *(LAS v4u*)(vt + sr * TP + c * 16) = cur_.vr[i]; *(LAS v4u*)(ct + sr * TP + c * 16) = cur_.cr[i]; } }
            { const int nitem = item + G; if (k < 3 && nitem < 1024) B3_LOAD(cur_, nitem); }
            __syncthreads();
            { const int trq = (lane & 15) >> 2, trp = lane & 3;
              bf16x8_t qf[4];
#pragma unroll
              for (int ds = 0; ds < 4; ++ds) qf[ds] = *(const LAS bf16x8_t*)(qt + (wave * 16 + fr) * TP + ds * 64 + fq * 16);
              const int t = wave * 16 + fr; const float Mt = gsm[512 + k * 128 + t], mt = gsm[1024 + k * 128 + t]; const float dec = __expf(mprev - Mt);
              const size_t orow = row0 + t;
              unsigned og[8];
#pragma unroll
              for (int fb = 0; fb < 8; ++fb) og[fb] = *(const unsigned*)(MO8 + orow * 512 + h * 128 + fb * 16 + 4 * fq);
              f32x4 acc[8];
#pragma unroll
              for (int fb = 0; fb < 8; ++fb) acc[fb] = (f32x4){0.f, 0.f, 0.f, 0.f};
#pragma unroll
              for (int ds = 0; ds < 4; ++ds) { const int ra = ds * 32 + 8 * fq + trq;
                  bf16x8_t cfr[8];
#pragma unroll
                  for (int fb = 0; fb < 8; ++fb) cfr[fb] = trpair(ct + ra * TP + (fb * 16 + 4 * trp) * 2, ct + (ra + 4) * TP + (fb * 16 + 4 * trp) * 2);
#pragma unroll
                  for (int fb = 0; fb < 8; ++fb) acc[fb] = __builtin_amdgcn_mfma_f32_16x16x32_bf16(cfr[fb], qf[ds], acc[fb], 0, 0, 0); }
              float qn = 0.f;
#pragma unroll
              for (int ds = 0; ds < 4; ++ds) { float qv[8]; unpack8(__builtin_bit_cast(v4u, qf[ds]), qv); const f32x4 n0 = *(const LAS f32x4*)(gsm + 1536 + ds * 32 + fq * 8), n1 = *(const LAS f32x4*)(gsm + 1536 + ds * 32 + fq * 8 + 4);
#pragma unroll
                  for (int u = 0; u < 4; ++u) qn += qv[u] * n0[u] + qv[4 + u] * n1[u]; }
              qn = pg8::xsum_16_32(qn);
#pragma unroll
              for (int fb = 0; fb < 8; ++fb) acc[fb] *= dec;
              f32x4 sacc[8]; float dsum = 0.f;
#pragma unroll
              for (int sb = 0; sb < 8; ++sb) { sacc[sb] = (f32x4){0.f, 0.f, 0.f, 0.f};
                  if (sb <= wave) {
                      bf16x8_t kfr[4];
#pragma unroll
                      for (int ds = 0; ds < 4; ++ds) kfr[ds] = *(const LAS bf16x8_t*)(kt + (sb * 16 + fr) * TP + ds * 64 + fq * 16);
#pragma unroll
                      for (int ds = 0; ds < 4; ++ds) sacc[sb] = __builtin_amdgcn_mfma_f32_16x16x32_bf16(kfr[ds], qf[ds], sacc[sb], 0, 0, 0);
                      const f32x4 a4 = *(const LAS f32x4*)(gsm + k * 128 + sb * 16 + 4 * fq);
#pragma unroll
                      for (int rg = 0; rg < 4; ++rg) { const int s_ = sb * 16 + 4 * fq + rg; const float p_ = (s_ <= t) ? sacc[sb][rg] * __expf(a4[rg] - Mt) : 0.f; sacc[sb][rg] = p_; dsum += p_; } } }
              dsum = pg8::xsum_16_32(dsum);
#pragma unroll
              for (int ks = 0; ks < 4; ++ks) { if (2 * ks <= wave) {
                  v4u pw; pw.x = pg8::cvt_pk_bf16(sacc[2 * ks][0], sacc[2 * ks][1]); pw.y = pg8::cvt_pk_bf16(sacc[2 * ks][2], sacc[2 * ks][3]);
                  pw.z = pg8::cvt_pk_bf16(sacc[2 * ks + 1][0], sacc[2 * ks + 1][1]); pw.w = pg8::cvt_pk_bf16(sacc[2 * ks + 1][2], sacc[2 * ks + 1][3]);
                  const bf16x8_t pf = __builtin_bit_cast(bf16x8_t, pw); const int ra = ks * 32 + 4 * fq + trq;
                  bf16x8_t vfr[8];
#pragma unroll
                  for (int fb = 0; fb < 8; ++fb) vfr[fb] = trpair(vt + ra * TP + (fb * 16 + 4 * trp) * 2, vt + (ra + 16) * TP + (fb * 16 + 4 * trp) * 2);
#pragma unroll
                  for (int fb = 0; fb < 8; ++fb) acc[fb] = __builtin_amdgcn_mfma_f32_16x16x32_bf16(vfr[fb], pf, acc[fb], 0, 0, 0); } }
              const float den = dec * qn + dsum; const float inv = __builtin_amdgcn_rcpf(fmaxf(fabsf(den), __expf(-mt)));
#pragma unroll
              for (int fb = 0; fb < 8; ++fb) {
                  const float i5 = inv * (1.0f / 255.0f); const unsigned o8 = og[fb];
                  v2u w_; w_.x = pg8::cvt_pk_bf16((float)(o8 & 255u) * acc[fb][0] * i5, (float)((o8 >> 8) & 255u) * acc[fb][1] * i5);
                  w_.y = pg8::cvt_pk_bf16((float)((o8 >> 16) & 255u) * acc[fb][2] * i5, (float)(o8 >> 24) * acc[fb][3] * i5);
                  *(v2u*)(BMo + orow * 512 + h * 128 + fb * 16 + 4 * fq) = w_; } }
        }
    }
    __syncthreads();
}

template <int NR> __device__ __forceinline__ void quant_rows_i8(const bf16* const (&src)[NR], unsigned char* const (&dst)[NR], float* const (&sc)[NR], int lane) {
    v4u ra[NR], rb[NR];
#pragma unroll
    for (int q = 0; q < NR; ++q) { ra[q] = *(const v4u*)(src[q] + lane * 16); rb[q] = *(const v4u*)(src[q] + lane * 16 + 8); }
#pragma unroll
    for (int q = 0; q < NR; ++q) { float f[16];
        { float t0[8], t1[8]; unpack8(ra[q], t0); unpack8(rb[q], t1);
#pragma unroll
          for (int u = 0; u < 8; ++u) { f[u] = t0[u]; f[8 + u] = t1[u]; } }
        float am = 0.f;
#pragma unroll
        for (int u = 0; u < 16; ++u) am = fmaxf(am, fabsf(f[u]));
        am = wave_max(am);
        const float inv = (am > 0.f) ? 127.0f / am : 0.f;
        unsigned w[4];
#pragma unroll
        for (int d4 = 0; d4 < 4; ++d4) { unsigned p = 0u;
#pragma unroll
            for (int u = 0; u < 4; ++u) { const int qi = (int)__builtin_rintf(f[d4 * 4 + u] * inv); p |= ((unsigned)qi & 255u) << (8 * u); }
            w[d4] = p; }
        *(v4u*)(dst[q] + lane * 16) = (v4u){w[0], w[1], w[2], w[3]};
        if (lane == 0) *sc[q] = (am > 0.f) ? am * (1.0f / 127.0f) : 1.0f; }
}
typedef __bf16 bf16x2_t __attribute__((ext_vector_type(2)));
__device__ __forceinline__ float dot2bf(unsigned a, unsigned b, float c) { return __builtin_amdgcn_fdot2_f32_bf16(__builtin_bit_cast(bf16x2_t, a), __builtin_bit_cast(bf16x2_t, b), c, false); }
struct QRows { v4u a[4], b[4]; float ss; };
template <bool GATES> __device__ __forceinline__ void qrows_load(QRows& q, const bf16* HBr, const float* RSr, int lane) {
#pragma unroll
    for (int r = 0; r < 4; ++r) { q.a[r] = *(const v4u*)(HBr + (size_t)r * D + lane * 16); q.b[r] = *(const v4u*)(HBr + (size_t)r * D + lane * 16 + 8); }
    if constexpr (GATES) q.ss = RSr[lane]; else q.ss = 0.f;
}
template <bool GATES> __device__ __forceinline__ void quant_rows_gates4(const QRows& qr, unsigned char* H8r, float* SCHr, float* RSFr, float* GTr, const v4u (&wg)[8][2], int lane) {
    float ss = qr.ss;
    if constexpr (GATES) { ss += __shfl_xor(ss, 1); ss += __shfl_xor(ss, 2); ss += __shfl_xor(ss, 4); ss += __shfl_xor(ss, 8); }
#pragma unroll
    for (int q = 0; q < 4; ++q) { float f[16];
        { float t0[8], t1[8]; unpack8(qr.a[q], t0); unpack8(qr.b[q], t1);
#pragma unroll
          for (int u = 0; u < 8; ++u) { f[u] = t0[u]; f[8 + u] = t1[u]; } }
        float am = 0.f;
#pragma unroll
        for (int u = 0; u < 16; ++u) am = fmaxf(am, fabsf(f[u]));
        am = wave_max(am);
        const float inv = (am > 0.f) ? 127.0f / am : 0.f;
        unsigned w[4];
#pragma unroll
        for (int d4 = 0; d4 < 4; ++d4) { unsigned p = 0u;
#pragma unroll
            for (int u = 0; u < 4; ++u) { const int qi = (int)__builtin_rintf(f[d4 * 4 + u] * inv); p |= ((unsigned)qi & 255u) << (8 * u); }
            w[d4] = p; }
        *(v4u*)(H8r + (size_t)q * D + lane * 16) = (v4u){w[0], w[1], w[2], w[3]};
        if (lane == 0) SCHr[q] = (am > 0.f) ? am * (1.0f / 127.0f) : 1.0f;
        if constexpr (GATES) {
        float d[8];
#pragma unroll
        for (int j = 0; j < 8; ++j) { float a = 0.f;
            a = dot2bf(qr.a[q].x, wg[j][0].x, a); a = dot2bf(qr.a[q].y, wg[j][0].y, a); a = dot2bf(qr.a[q].z, wg[j][0].z, a); a = dot2bf(qr.a[q].w, wg[j][0].w, a);
            a = dot2bf(qr.b[q].x, wg[j][1].x, a); a = dot2bf(qr.b[q].y, wg[j][1].y, a); a = dot2bf(qr.b[q].z, wg[j][1].z, a); a = dot2bf(qr.b[q].w, wg[j][1].w, a);
            d[j] = a; }
        const bool h5 = (lane & 32) != 0, h4 = (lane & 16) != 0, h3 = (lane & 8) != 0;
        float e[4];
#pragma unroll
        for (int i = 0; i < 4; ++i) { const float keep = h5 ? d[4 + i] : d[i], send = h5 ? d[i] : d[4 + i]; e[i] = keep + __shfl_xor(send, 32); }
        float g2[2];
#pragma unroll
        for (int i = 0; i < 2; ++i) { const float keep = h4 ? e[2 + i] : e[i], send = h4 ? e[i] : e[2 + i]; g2[i] = keep + __shfl_xor(send, 16); }
        float v = (h3 ? g2[1] : g2[0]) + __shfl_xor(h3 ? g2[0] : g2[1], 8);
        v += __shfl_xor(v, 4); v += __shfl_xor(v, 2); v += __shfl_xor(v, 1);
        const float r = __builtin_amdgcn_rsqf(__shfl(ss, q * 16) * (1.0f / 1024.0f) + pg8::RMS_EPS);
        if ((lane & 7) == 0) GTr[q * 8 + (lane >> 3)] = v * r;
        if (lane == 0) RSFr[q] = r * ((am > 0.f) ? am * (1.0f / 127.0f) : 1.0f); } }
}
__global__ void __launch_bounds__(NTHREADS, 2) mega(Args args) {
    extern __shared__ __attribute__((aligned(16))) unsigned char lds_raw[];
    LAS unsigned char* lds = (LAS unsigned char*)lds_raw;
    volatile LAS unsigned* MISC = (volatile LAS unsigned*)(lds + MISC_OFF);
    const int wave = __builtin_amdgcn_readfirstlane(threadIdx.x >> 6);
#define LANE_ID() ({ int _l; asm volatile("v_mbcnt_lo_u32_b32 %0, -1, 0\n\tv_mbcnt_hi_u32_b32 %0, -1, %0" : "=v"(_l)); _l; })
    const int G = gridDim.x; const int bx = blockIdx.x; const int vcu = (G % 8 == 0) ? (bx % 8) * (G / 8) + bx / 8 : bx;
    unsigned char* ws = args.ws;
    gu32* ctl = (gu32*)(ws + WS_CTL);
    { const int tid = wave * 64 + LANE_ID(); for (int u = tid; u < (LDS_BYTES - LDSCTL_OFF) / 4; u += NTHREADS) ((LAS unsigned*)(lds + LDSCTL_OFF))[u] = 0u; }
    __syncthreads();
    XcdBarrier bar; bar.bar = (unsigned*)(ctl + CW_BAR); bar.x = 0; bar.st = nullptr;
#if !MK_PER_PHASE
    bar = xcd_barrier_post((unsigned*)(ctl + CW_BAR), MISC + 8, (wave == 0) && (LANE_ID() == 0));
#define GRID_BAR() xcd_barrier(bar, (wave == 0) && (LANE_ID() == 0))
#else
#define GRID_BAR() do {} while (0)
#endif
    const int lo = args.ph_lo, hi = args.ph_hi;
#define IN(k) (lo <= (k) && (k) < hi)
#define SEAM(k) do { if (IN(k) && IN((k) + 1)) { GRID_BAR(); if (PROBE_MASK & (1u << 29)) { GRID_BAR(); GRID_BAR(); } } } while (0)
#if !MK_PER_PHASE
    unsigned* const quadw = (unsigned*)(ctl + 8192) + (((bx & 7) * 8 + ((bx >> 3) & 7)) * 16);
#define SEAMQ(k, n) do { if (IN(k) && IN((k) + 1)) { if (G == 256) quad_barrier(quadw, 4u * (n), (wave == 0) && (LANE_ID() == 0), (unsigned*)(ctl + CW_BAR)); else GRID_BAR(); } } while (0)
#else
#define SEAMQ(k, n) SEAM(k)
#endif
    const int gw = vcu * NWAVES + wave, NGW = G * NWAVES;
    bf16* HB = (bf16*)(ws + WS_HB); float* RS = (float*)(ws + WS_RS);

    if (IN(0)) REP(0) {
        const int lane = LANE_ID(), tid = wave * 64 + lane;
        LAS float* scr = (LAS float*)(lds + wave * 16640);
        {
            const WD* wd = c_wd;
            int base = 0;
#pragma unroll 1
            for (int w = 0; w < 10; ++w) { const int K = wd[w].K, Nsrc = wd[w].Nsrc, Ndst = wd[w].Ndst, kind = wd[w].kind; const int nit = (K / 64) * (Ndst / 64);
                const float* W = args.in[wd[w].src]; const float* gn = wd[w].gain >= 0 ? args.in[wd[w].gain] : nullptr; bf16* WT = (bf16*)(ws + wd[w].dst);
                int first = (gw - base) % NGW; if (first < 0) first += NGW;
                for (int it = first; it < nit; it += NGW) p0_transpose_item(W, gn, K, Nsrc, Ndst, WT, kind, scr, it, lane);
                base = (base + nit) % NGW; }
        }
        const float* x = args.in[I_X];
        for (int m0 = gw * 4; m0 < M; m0 += NGW * 4) {
            f32x4 v[4][4]; float s4[4];
#pragma unroll
            for (int q = 0; q < 4; ++q) { const GAS f32x4* xr = (const GAS f32x4*)(x + (size_t)(m0 + q) * D) + lane;
#pragma unroll
                for (int j = 0; j < 4; ++j) v[q][j] = xr[64 * j]; }
#pragma unroll
            for (int q = 0; q < 4; ++q) { float s_ = 0.f;
#pragma unroll
                for (int j = 0; j < 4; ++j) s_ += (v[q][j][0] * v[q][j][0] + v[q][j][1] * v[q][j][1]) + (v[q][j][2] * v[q][j][2] + v[q][j][3] * v[q][j][3]);
                s4[q] = wave_sum(s_);
                float am = 0.f;
#pragma unroll
                for (int j = 0; j < 4; ++j) am = fmaxf(fmaxf(am, fmaxf(fabsf(v[q][j][0]), fabsf(v[q][j][1]))), fmaxf(fabsf(v[q][j][2]), fabsf(v[q][j][3])));
                am = wave_max(am); const float inv = (am > 0.f) ? 127.0f / am : 0.f;
                GAS unsigned* o4 = (GAS unsigned*)((unsigned char*)args.out + (size_t)(m0 + q) * D) + lane;
                GAS unsigned* e4 = (GAS unsigned*)((unsigned char*)args.out + (size_t)64 * MiB + (size_t)(m0 + q) * D) + lane;
#pragma unroll
                for (int j = 0; j < 4; ++j) { unsigned pq = 0u, pe = 0u;
#pragma unroll
                    for (int u = 0; u < 4; ++u) { const float t_ = v[q][j][u] * inv, qf_ = __builtin_rintf(t_); pq |= ((unsigned)(int)qf_ & 255u) << (8 * u); pe |= ((unsigned)(int)__builtin_rintf((t_ - qf_) * 254.0f) & 255u) << (8 * u); }
                    o4[64 * j] = pq; e4[64 * j] = pe; }
                if (lane == 0) { const float sc_ = (am > 0.f) ? am * (1.0f / 127.0f) : 1.0f; ((float*)(ws + WS_SCX))[m0 + q] = sc_;
                    ((float*)(ws + WS_RSF))[m0 + q] = __builtin_amdgcn_rsqf(s4[q] * (1.0f / 1024.0f) + pg8::RMS_EPS) * sc_; } }
            { const int q = lane >> 4, sl = lane & 15; const float sv = (q == 0) ? s4[0] : (q == 1) ? s4[1] : (q == 2) ? s4[2] : s4[3]; RS[(size_t)(m0 + q) * 16 + sl] = (sl == 0) ? sv : 0.f; }
        }
        const float* p = args.in[I_P]; bf16* PB = (bf16*)(ws + WS_PB);
        for (int m = gw; m < M; m += 4 * NGW) { f32x4 v[4];
#pragma unroll
            for (int q = 0; q < 4; ++q) { const int mq = m + q * NGW; v[q] = *((const GAS f32x4*)(p + (size_t)(mq < M ? mq : m) * PLE) + lane); }
#pragma unroll
            for (int q = 0; q < 4; ++q) { const int mq = m + q * NGW; if (mq < M) { v2u o; o.x = pk2(v[q][0], v[q][1]); o.y = pk2(v[q][2], v[q][3]); *((GAS v2u*)(PB + (size_t)mq * PLE) + lane) = o; } } }
        if (bx == 0) { float* par = (float*)(ws + WS_PAR);
            for (int e = tid; e < PAR_N; e += NTHREADS) { float v;
                if (e < PAR_KG) v = args.in[I_QG][e]; else if (e < PAR_CW) v = args.in[I_KG][e - PAR_KG]; else if (e < PAR_CB) v = args.in[I_CW][e - PAR_CW];
                else if (e < PAR_IB) v = args.in[I_CB][e - PAR_CB]; else if (e < PAR_FB) v = args.in[I_IB][e - PAR_IB]; else v = args.in[I_FB][e - PAR_FB];
                par[e] = v; } }
        { unsigned* rm_ = (unsigned*)(ws + WS_ROWMAX); unsigned* pc_ = (unsigned*)(ws + WS_PCNT);
          for (int e = vcu * NTHREADS + tid; e < M + 128; e += G * NTHREADS) { if (e < M) rm_[e] = 0u; else pc_[e - M] = 0u; } }
        float* rope = (float*)(ws + WS_ROPE);
        for (int e = vcu * NTHREADS + tid; e < SEQ * 16; e += G * NTHREADS) { const int t = e >> 4, i = e & 15;
            const float invf = c_invfreq[i];
            const float ang = (float)t * invf; const double rev = (double)ang * 0.15915494309189535; const float fr = (float)(rev - __builtin_floor(rev));
            rope[e * 2] = __builtin_amdgcn_cosf(fr); rope[e * 2 + 1] = __builtin_amdgcn_sinf(fr); }
    }
    using namespace pg8;
    if (IN(0)) { GRID_BAR();
        const int lane = LANE_ID(); const bf16* WT = (const bf16*)(ws + WS_WIN); unsigned char* W8 = ws + WS_W8; float* SCWw = (float*)(ws + WS_SCW);
        const bf16* W1T = (const bf16*)(ws + WS_W1IN); unsigned char* W18 = ws + WS_W1IN8; float* SC1w = (float*)(ws + WS_SC1);
        const bf16* W2T = (const bf16*)(ws + WS_W2IN); unsigned char* W28 = ws + WS_W2IN8; float* SC2w = (float*)(ws + WS_SC2);
        constexpr int NROWS8 = 7168 + 2 * 5632;
        for (int n0 = gw; n0 < NROWS8; n0 += 3 * NGW) {
            const bf16* src[3]; unsigned char* dst[3]; float* sc[3];
#pragma unroll
            for (int q3 = 0; q3 < 3; ++q3) { const int nq = n0 + q3 * NGW; const int n = nq < NROWS8 ? nq : n0;
            const bf16* sp_; unsigned char* dp_; float* cp_;
            if (n < 7168) { int srow = (n < 4608) ? n : (n < 6656) ? n + (WIN_G - 4608) : n + (WIN_ML + 1536 - 6656);
                if (n < 4608 && ((n % 1536) >> 9) < 2) { const int cp = n & 127, L = cp >> 3, s_ = cp & 7; srow = n - cp + ((s_ == 0) ? L : (s_ == 1) ? 16 + L : 32 + 6 * L + (s_ - 2)); }
                sp_ = WT + (size_t)srow * D; dp_ = W8 + (size_t)n * D; cp_ = SCWw + n; }
            else if (n < 7168 + 5632) { const int r_ = n - 7168; sp_ = W1T + (size_t)r_ * D; dp_ = W18 + (size_t)r_ * D; cp_ = SC1w + r_; }
            else { const int r_ = n - 7168 - 5632; sp_ = W2T + (size_t)r_ * D; dp_ = W28 + (size_t)r_ * D; cp_ = SC2w + r_; }
            src[q3] = sp_; dst[q3] = dp_; sc[q3] = cp_; }
            quant_rows_i8<3>(src, dst, sc, lane); } }
    SEAM(0);
    if (IN(1)) REP(1) { Gemm g{(const bf16*)args.out, (const bf16*)(ws + WS_W1IN8), M, 2 * FF, D / 2, (const float*)(ws + WS_SC1), (const float*)(ws + WS_SCX), nullptr, nullptr, 0, (const float*)(ws + WS_RSF)}; StaticOrder S; S.init(M, 2 * FF, G, bx);
        EpiSwiglu E{(bf16*)(ws + WS_HID), FF, RS}; gemm_phase<EpiSwiglu, StaticOrder, true, true, false, true>(lds, g, S, E, wave); }
    SEAMQ(1, 1);
    if (IN(2)) REP(2) { Gemm g{(const bf16*)(ws + WS_HID), (const bf16*)(ws + WS_W1OUT), M, D, FF}; StaticOrder S; S.init(M, D, G, bx);
        EpiResidX E{(const unsigned char*)args.out, (const unsigned char*)args.out + (size_t)64 * MiB, (const float*)(ws + WS_SCX), HB, RS, 0.5f}; gemm_phase<EpiResidX, StaticOrder, true, true>(lds, g, S, E, wave); }
    SEAM(2);
    unsigned char* H8 = (unsigned char*)args.out; float* SCH = (float*)((unsigned char*)args.out + (size_t)32 * MiB);
    const float* SCW = (const float*)(ws + WS_SCW); const bf16* W8b = (const bf16*)(ws + WS_W8); const bf16* H8b = (const bf16*)H8;
    if (IN(3)) { { const int lane = LANE_ID();
            v4u wg[8][2];
#pragma unroll
            for (int j = 0; j < 8; ++j) { const bf16* wr_ = (const bf16*)(ws + WS_WIN) + (size_t)(WIN_GT + j) * D + lane * 16; wg[j][0] = *(const v4u*)wr_; wg[j][1] = *(const v4u*)(wr_ + 8); }
            QRows cur, nx; int m0 = gw * 4; qrows_load<true>(cur, HB + (size_t)m0 * D, RS + (size_t)m0 * 16, lane);
            for (; m0 < M; m0 += NGW * 4) { const int m1 = m0 + NGW * 4; nx = cur; if (m1 < M) qrows_load<true>(nx, HB + (size_t)m1 * D, RS + (size_t)m1 * 16, lane);
                quant_rows_gates4<true>(cur, H8 + (size_t)m0 * D, SCH + m0, (float*)(ws + WS_RSF) + m0, (float*)(ws + WS_GATES) + (size_t)m0 * 8, wg, lane); cur = nx; } }
        REP(3) { Gemm g{HB, (const bf16*)(ws + WS_WIN) + (size_t)WIN_ML * D, M, 1536, D}; StaticOrder S; S.init(M, 1536, G, bx);
        EpiZ E{(bf16*)(ws + WS_ML), 2048, RS, -1, nullptr}; gemm_phase<EpiZ, StaticOrder, true, true>(lds, g, S, E, wave); } }
    SEAM(3);
    const bf16* QKV0 = (const bf16*)(ws + WS_QKV); const bf16* QKV1 = (const bf16*)(ws + WS_QKV1); bf16* GB = (bf16*)((unsigned char*)args.out + (size_t)64 * MiB);
#define QKV_GEMM8(grp, dstp) do { Gemm g{H8b, W8b + (size_t)(grp) * 1536 * (D / 2), M, 1536, D / 2, SCW + (grp) * 1536, SCH, nullptr, nullptr, 0, (const float*)(ws + WS_RSF)}; StaticOrder S; S.init(M, 1536, G, bx); \
        EpiQKV E{(bf16*)(dstp), RS, (const float*)(ws + WS_PAR) + PAR_QG, (const float*)(ws + WS_PAR) + PAR_KG, (const float*)(ws + WS_ROPE), (PG8_LAS float*)(lds + QKP_OFF)}; \
        gemm_phase<EpiQKV, StaticOrder, true, true, false, true>(lds, g, S, E, wave); } while (0)
    if (IN(4)) { REP(5) QKV_GEMM8(0, ws + WS_QKV);
        { Gemm g{H8b, W8b + (size_t)6656 * (D / 2), M, 512, D / 2, SCW + 6656, SCH, nullptr, nullptr, 0, (const float*)(ws + WS_RSF)}; StaticOrder S; S.init(M, 512, G, bx);
        EpiSig8 E{(unsigned char*)args.out + (size_t)40 * MiB, RS}; gemm_phase<EpiSig8, StaticOrder, true, true, false, true>(lds, g, S, E, wave); }
        REP(24) mlstm_b1(ws, lds, wave, vcu, G); GRID_BAR(); mlstm_b2(ws, lds, wave, vcu, G); GRID_BAR(); REP(25) mlstm_b3(ws, (const unsigned char*)args.out + (size_t)40 * MiB, lds, wave, vcu, G); }
    if (IN(5)) { attn_fast(ws, QKV0, lds, 0, wave, vcu, G); REP(6) { if (rep_) attn_fast(ws, QKV0, lds, 0, wave, vcu, G); }
        REP(5) QKV_GEMM8(1, ws + WS_QKV1); }
    SEAM(5);
    if (IN(6)) { attn_fast(ws, QKV1, lds, 1, wave, vcu, G);
        REP(5) QKV_GEMM8(2, ws + WS_QKV); }
    SEAM(6);
    if (IN(7)) { attn_fast(ws, QKV0, lds, 2, wave, vcu, G);
        REP(11) { Gemm g{H8b, W8b + (size_t)4608 * (D / 2), M, 2048, D / 2, SCW + 4608, SCH, nullptr, nullptr, 0, (const float*)(ws + WS_RSF)}; StaticOrder S; S.init(M, 2048, G, bx);
        EpiGF E{(unsigned char*)GB, (unsigned char*)GB + (size_t)M * 1024, RS}; gemm_phase<EpiGF, StaticOrder, true, true, false, true>(lds, g, S, E, wave); } }
    SEAM(7);
#undef QKV_GEMM8
    if (IN(8)) REP(12) { Gemm g{(const bf16*)(ws + WS_A), (const bf16*)(ws + WS_WUPA), M, D, 512, nullptr, nullptr, (const bf16*)(ws + WS_BM), (const bf16*)(ws + WS_WUPB)}; PairOrder S; S.init(M, D, G, bx);
        EpiGate2 E{(const unsigned char*)GB, (const unsigned char*)GB + (size_t)M * 1024, (bf16*)(ws + WS_MERGED)}; gemm_phase<EpiGate2, PairOrder, true, true>(lds, g, S, E, wave); }
    SEAMQ(8, 2);
    if (IN(9)) { Gemm g{(const bf16*)(ws + WS_MERGED), (const bf16*)(ws + WS_WO), M, D, D}; StaticOrder S; S.init(M, D, G, bx);
        EpiResidQ E{HB, RS, 1.0f, (unsigned*)(ws + WS_ROWMAX), (unsigned*)(ws + WS_PCNT), H8, SCH}; gemm_phase<EpiResidQ, StaticOrder, true, true>(lds, g, S, E, wave); }
    SEAMQ(9, 3);
    if (IN(10)) {
        REP(15) { Gemm g{H8b, (const bf16*)(ws + WS_W2IN8), M, 2 * FF, D / 2, (const float*)(ws + WS_SC2), SCH}; StaticOrder S; S.init(M, 2 * FF, G, bx);
        EpiSwiglu E{(bf16*)(ws + WS_HID), FF, RS}; gemm_phase<EpiSwiglu, StaticOrder, true, true, false, true>(lds, g, S, E, wave); } }
    SEAMQ(10, 4);
    if (IN(11)) { { Gemm g{(const bf16*)(ws + WS_HID), (const bf16*)(ws + WS_W2OUT), M, D, FF}; StaticOrder S; S.init(M, D, G, bx);
        EpiResid<false> E{nullptr, HB, HB, RS, 0.5f}; gemm_phase<EpiResid<false>, StaticOrder, true, true>(lds, g, S, E, wave); }
        }
    SEAM(11);
    if (IN(12)) { Gemm g{HB, (const bf16*)(ws + WS_WPG), M, D, D, nullptr, nullptr, (const bf16*)(ws + WS_PB), (const bf16*)(ws + WS_WPE), PLE}; PairOrder S; S.init(M, D, G, bx);
        EpiFinal2 E{args.out, HB, RS}; gemm_phase_dk<EpiFinal2>(lds, g, S, E, wave); }
#undef IN
#undef SEAM
#undef SEAMQ
}

extern "C" void kernel_launch(void* const* d_in, const int* in_sizes, int n_in, void* d_out, int out_size, void* d_ws, size_t ws_size, hipStream_t stream) {
    static int grid = 0;
    if (grid == 0) {
        if (n_in != 22 || in_sizes[0] != M * D || out_size != M * D || ws_size < WS_END) { fprintf(stderr, "kernel_launch: unexpected shapes (n_in %d, in0 %d, out %d, ws %zu)\n", n_in, n_in > 0 ? in_sizes[0] : -1, out_size, ws_size); grid = -1; return; }
        int dev = 0, cus = 0;
        if (hipGetDevice(&dev) != hipSuccess || hipDeviceGetAttribute(&cus, hipDeviceAttributeMultiprocessorCount, dev) != hipSuccess) { grid = -1; return; }
        if (hipFuncSetAttribute((const void*)mega, hipFuncAttributeMaxDynamicSharedMemorySize, LDS_BYTES) != hipSuccess) { fprintf(stderr, "kernel_launch: hipFuncSetAttribute failed\n"); grid = -1; return; }
        int nb = 0;
        if (hipOccupancyMaxActiveBlocksPerMultiprocessor(&nb, (const void*)mega, NTHREADS, LDS_BYTES) != hipSuccess || nb < 1) { fprintf(stderr, "kernel_launch: occupancy query failed / no resident block (%d)\n", nb); grid = -1; return; }
        (void)hipGetLastError();
        grid = cus;
    }
    if (grid < 0) return;
    (void)hipMemsetAsync((char*)d_ws + WS_CTL, 0, CTL_ZERO_BYTES, stream);
    Args a{};
    for (int i = 0; i < 22; ++i) a.in[i] = (const float*)d_in[i];
    a.out = (float*)d_out; a.ws = (unsigned char*)d_ws;
#if MK_PER_PHASE
    for (int ph = 0; ph < NPHASE; ++ph) { a.ph_lo = ph; a.ph_hi = ph + 1; hipLaunchKernelGGL(mega, dim3(grid), dim3(NTHREADS), LDS_BYTES, stream, a); }
#else
    a.ph_lo = 0; a.ph_hi = NPHASE; hipLaunchKernelGGL(mega, dim3(grid), dim3(NTHREADS), LDS_BYTES, stream, a);
#endif
}
```
